# Optimizing an MI355X kernel written in HIP

```python
import jax, jax.numpy as jnp
from jax import lax
import numpy as np

D_MODEL = 2048
BATCH = 1
SEQ = 16384
DEPTH = 2

GRID_W = 64
CTX_LEN = 256
EPS = 1e-6

D_MIX = D_MODEL
D_LRU = D_MIX // 2
LRU_HEADS = 16
LRU_HEAD_DIM = D_LRU // LRU_HEADS
LRU_C = 8.0
LRU_CONV = 4
D_CONV = D_MIX // 4
CONV_WIDTH = 31
D_SGU = D_MIX // 4
SGU_HEADS = 8
SGU_HEAD_DIM = D_SGU // SGU_HEADS
CHUNK = 128
ROWS_PER_CHUNK = CHUNK // GRID_W

O_LRU_G = D_LRU
O_CV = 2 * D_LRU
O_CV_G = O_CV + 2 * D_CONV
O_SGU = O_CV_G + D_CONV
O_SGU_G = O_SGU + 2 * D_SGU
D_IN = O_SGU_G + D_SGU

kernel_name = "hybrid_lru_conformer_sgu_prefix_dit"


def rms_norm(x, g):
    xf = x.astype(jnp.float32)
    y = xf * lax.rsqrt(jnp.mean(xf * xf, axis=-1, keepdims=True) + EPS)
    return (y * g.astype(jnp.float32)).astype(x.dtype)


def layer_norm(x, g, b):
    xf = x.astype(jnp.float32)
    mu = jnp.mean(xf, axis=-1, keepdims=True)
    var = jnp.mean(jnp.square(xf - mu), axis=-1, keepdims=True)
    y = (xf - mu) * lax.rsqrt(var + EPS) * g.astype(jnp.float32) + b.astype(jnp.float32)
    return y.astype(x.dtype)


def depthwise_conv(x, w, b, pad):
    y = lax.conv_general_dilated(
        x, w[:, None, :].astype(x.dtype), window_strides=(1,), padding=[pad],
        dimension_numbers=("NWC", "WIO", "NWC"), feature_group_count=x.shape[-1])
    return y + b.astype(x.dtype)


def rglru_coeffs(xc, lam, w_r, b_r, w_i, b_i):
    bsz, length, _ = xc.shape
    xh = xc.reshape(bsz, length, LRU_HEADS, LRU_HEAD_DIM).astype(jnp.float32)
    r = jax.nn.sigmoid(jnp.einsum("blhi,hij->blhj", xh, w_r.astype(jnp.float32)) + b_r.astype(jnp.float32))
    i = jax.nn.sigmoid(jnp.einsum("blhi,hij->blhj", xh, w_i.astype(jnp.float32)) + b_i.astype(jnp.float32))
    log_a = -LRU_C * jax.nn.softplus(-lam.astype(jnp.float32).reshape(LRU_HEADS, LRU_HEAD_DIM)) * r
    a = jnp.exp(log_a)
    mult = jnp.sqrt(-jnp.expm1(2.0 * log_a))
    bb = mult * (i * xh)
    return a.reshape(bsz, length, D_LRU), bb.reshape(bsz, length, D_LRU)


def linear_scan(a, b, h0, reverse):
    if h0 is not None:
        idx = -1 if reverse else 0
        b = b.at[:, idx].add(a[:, idx] * h0)

    def combine(lhs, rhs):
        return (lhs[0] * rhs[0], rhs[0] * lhs[1] + rhs[1])

    _, h = lax.associative_scan(combine, (a, b), axis=1, reverse=reverse)
    return h


def rglru_mixer(xa_lat, xa_ctx, conv_w, conv_b, lam, w_r, b_r, w_i, b_i, need_ctx):
    pad = (LRU_CONV // 2, LRU_CONV - 1 - LRU_CONV // 2)
    xl = depthwise_conv(xa_lat, conv_w, conv_b, pad)
    xc = depthwise_conv(xa_ctx, conv_w, conv_b, pad)
    y_lat = None
    y_ctx = None
    for d, rev in enumerate((False, True)):
        a_c, b_c = rglru_coeffs(xc, lam[d], w_r[d], b_r[d], w_i[d], b_i[d])
        h_c = linear_scan(a_c, b_c, None, rev)
        h_end = h_c[:, 0] if rev else h_c[:, -1]
        a_l, b_l = rglru_coeffs(xl, lam[d], w_r[d], b_r[d], w_i[d], b_i[d])
        h_l = linear_scan(a_l, b_l, h_end, rev)
        y_lat = h_l if y_lat is None else y_lat + h_l
        if need_ctx:
            y_ctx = h_c if y_ctx is None else y_ctx + h_c
    y_lat = y_lat.astype(xa_lat.dtype)
    if need_ctx:
        y_ctx = y_ctx.astype(xa_ctx.dtype)
    return y_lat, y_ctx


def conformer_conv(p, w, b, ln_g, ln_b):
    z = p[..., :D_CONV] * jax.nn.sigmoid(p[..., D_CONV:])
    z = depthwise_conv(z, w, b, (CONV_WIDTH // 2, CONV_WIDTH // 2))
    return jax.nn.silu(layer_norm(z, ln_g, ln_b))


def chunk_sgu(p, n_chunks, ln_g, ln_b, w_s, b_s):
    bsz, length, _ = p.shape
    z = jax.nn.gelu(p)
    u, v = z[..., :D_SGU], z[..., D_SGU:]
    v = layer_norm(v, ln_g, ln_b)
    vh = v.reshape(bsz, n_chunks, CHUNK, SGU_HEADS, SGU_HEAD_DIM)
    s = jnp.einsum("hqp,bnphd->bnqhd", w_s.astype(vh.dtype), vh)
    s = s + jnp.swapaxes(b_s, 0, 1).astype(vh.dtype)[:, :, None]
    return u * s.reshape(bsz, length, D_SGU)


def mix_out(p, y_lru, n_chunks, w_out, cv_w, cv_b, cv_ln_g, cv_ln_b, sgu_ln_g, sgu_ln_b, sgu_w, sgu_b):
    y_cv = conformer_conv(p[..., O_CV:O_CV_G], cv_w, cv_b, cv_ln_g, cv_ln_b)
    y_sg = chunk_sgu(p[..., O_SGU:O_SGU_G], n_chunks, sgu_ln_g, sgu_ln_b, sgu_w, sgu_b)
    y = jnp.concatenate([
        y_lru * jax.nn.silu(p[..., O_LRU_G:O_CV]),
        y_cv * jax.nn.silu(p[..., O_CV_G:O_SGU]),
        y_sg * jax.nn.silu(p[..., O_SGU_G:D_IN]),
    ], axis=-1)
    return y @ w_out


def setup_inputs(seed: int = 0) -> dict:
    key = jax.random.key(seed)
    ks = jax.random.split(key, 32)
    f32 = jnp.float32
    nrm = lambda k, shape, s: jax.random.normal(k, shape, f32) * s
    u = jax.random.uniform(ks[10], (DEPTH, 2, D_LRU), f32, minval=0.9, maxval=0.999)
    sg = u ** (1.0 / LRU_C)
    lam = jnp.log(sg) - jnp.log1p(-sg)
    return {
        "x": nrm(ks[0], (BATCH, SEQ, D_MODEL), 1.0),
        "c": nrm(ks[1], (BATCH, D_MODEL), 1.0),
        "ctx": nrm(ks[2], (BATCH, CTX_LEN, D_MODEL), 1.0),
        "c_ctx": nrm(ks[3], (D_MODEL,), 1.0),
        "w_mod": nrm(ks[4], (DEPTH, D_MODEL, 3 * D_MODEL), 0.5 * D_MODEL ** -0.5),
        "b_mod": nrm(ks[5], (DEPTH, 3 * D_MODEL), 0.01),
        "norm_g": 1.0 + nrm(ks[6], (DEPTH, D_MODEL), 0.01),
        "w_in": nrm(ks[7], (DEPTH, D_MODEL, D_IN), D_MODEL ** -0.5),
        "w_out": nrm(ks[8], (DEPTH, D_MIX, D_MODEL), D_MIX ** -0.5),
        "lru_conv_w": nrm(ks[9], (DEPTH, LRU_CONV, D_LRU), LRU_CONV ** -0.5),
        "lru_conv_b": nrm(ks[11], (DEPTH, D_LRU), 0.01),
        "lru_lam": lam,
        "lru_w_r": nrm(ks[12], (DEPTH, 2, LRU_HEADS, LRU_HEAD_DIM, LRU_HEAD_DIM), LRU_HEAD_DIM ** -0.5),
        "lru_b_r": nrm(ks[13], (DEPTH, 2, LRU_HEADS, LRU_HEAD_DIM), 0.01),
        "lru_w_i": nrm(ks[14], (DEPTH, 2, LRU_HEADS, LRU_HEAD_DIM, LRU_HEAD_DIM), LRU_HEAD_DIM ** -0.5),
        "lru_b_i": nrm(ks[15], (DEPTH, 2, LRU_HEADS, LRU_HEAD_DIM), 0.01),
        "cv_w": nrm(ks[16], (DEPTH, CONV_WIDTH, D_CONV), CONV_WIDTH ** -0.5),
        "cv_b": nrm(ks[17], (DEPTH, D_CONV), 0.01),
        "cv_ln_g": 1.0 + nrm(ks[18], (DEPTH, D_CONV), 0.01),
        "cv_ln_b": nrm(ks[19], (DEPTH, D_CONV), 0.01),
        "sgu_ln_g": 1.0 + nrm(ks[20], (DEPTH, D_SGU), 0.01),
        "sgu_ln_b": nrm(ks[21], (DEPTH, D_SGU), 0.01),
        "sgu_w": nrm(ks[22], (DEPTH, SGU_HEADS, CHUNK, CHUNK), CHUNK ** -0.5),
        "sgu_b": 1.0 + nrm(ks[23], (DEPTH, SGU_HEADS, CHUNK), 0.01),
        "final_g": 1.0 + nrm(ks[24], (D_MODEL,), 0.01),
    }


def reference(x, c, ctx, c_ctx, w_mod, b_mod, norm_g, w_in, w_out, lru_conv_w, lru_conv_b,
              lru_lam, lru_w_r, lru_b_r, lru_w_i, lru_b_i, cv_w, cv_b, cv_ln_g, cv_ln_b,
              sgu_ln_g, sgu_ln_b, sgu_w, sgu_b, final_g):
    rows = x.shape[1] // GRID_W
    lat_chunks = rows // ROWS_PER_CHUNK
    ctx_chunks = ctx.shape[1] // CHUNK
    c_act = jax.nn.silu(c)
    cc_act = jax.nn.silu(c_ctx)
    for l in range(DEPTH):
        last = l == DEPTH - 1
        mod_x = c_act @ w_mod[l] + b_mod[l]
        mod_c = cc_act @ w_mod[l] + b_mod[l]
        sh_x, sc_x, g_x = jnp.split(mod_x, 3, axis=-1)
        sh_c, sc_c, g_c = jnp.split(mod_c, 3, axis=-1)
        hx = rms_norm(x, norm_g[l]) * (1.0 + sc_x[:, None]) + sh_x[:, None]
        hc = rms_norm(ctx, norm_g[l]) * (1.0 + sc_c) + sh_c
        px = hx @ w_in[l]
        pc = hc @ (w_in[l][:, :D_LRU] if last else w_in[l])
        y_lru_x, y_lru_c = rglru_mixer(
            px[..., :D_LRU], pc[..., :D_LRU], lru_conv_w[l], lru_conv_b[l], lru_lam[l],
            lru_w_r[l], lru_b_r[l], lru_w_i[l], lru_b_i[l], need_ctx=not last)
        x = x + g_x[:, None] * mix_out(px, y_lru_x, lat_chunks, w_out[l], cv_w[l], cv_b[l],
                                       cv_ln_g[l], cv_ln_b[l], sgu_ln_g[l], sgu_ln_b[l],
                                       sgu_w[l], sgu_b[l])
        if not last:
            ctx = ctx + g_c * mix_out(pc, y_lru_c, ctx_chunks, w_out[l], cv_w[l], cv_b[l],
                                      cv_ln_g[l], cv_ln_b[l], sgu_ln_g[l], sgu_ln_b[l],
                                      sgu_w[l], sgu_b[l])
    return rms_norm(x, final_g)
```

```cpp
#include <hip/hip_runtime.h>
#include <hip/hip_cooperative_groups.h>
#include <cstdio>
#include <cstdint>
namespace cg = cooperative_groups;
namespace pg8 {
#define PG8_LAS __attribute__((address_space(3)))
typedef unsigned short bf16_t;
typedef short bf16x8 __attribute__((ext_vector_type(8)));
typedef float f32x4 __attribute__((ext_vector_type(4)));
typedef unsigned u32x4 __attribute__((ext_vector_type(4)));
constexpr int BM = 256, BK = 64, HALF = 128, HTB = HALF * BK * 2  , STAGE_BYTES = 8 * HTB, NXCD = 8, WGM = 8;

__host__ __device__ __forceinline__ int lds_byte(int r, int c) { const int st = (r >> 4) * 2 + (c >> 5), rr = r & 15, cc = c & 31, ob = rr * 64 + cc * 2; return st * 1024 + (ob ^ (((ob >> 9) & 1) << 5)); }
__host__ __device__ __forceinline__ void stage_rc(int b, int& R, int& C) { const int st = b / 1024, sb = b % 1024, swz = sb ^ (((sb >> 9) & 1) << 5); R = (st >> 1) * 16 + swz / 64; C = (st & 1) * 32 + (swz % 64) / 2; }
__host__ __device__ __forceinline__ int perm32(int rho) { const int n = rho >> 4, i = rho & 15; return 8 * (i >> 2) + 4 * n + (i & 3); }

struct Unit { int pm, pn; };
struct Gemm { const bf16_t* A; const bf16_t* Bt; int M, N, K; };

struct StaticOrder {
    int nM, nN, nwg, G, c;
    __host__ __device__ void init(int M, int N, int G_, int c_) { nM = M / BM; nN = N / BM; nwg = nM * nN; G = G_; c = c_; }
    __host__ __device__ bool next(int i, Unit& u) const {
        const long L = (long)i * G + c; if (L >= nwg) return false;
        int wgid = (int)L; { const int q = nwg / NXCD, r = nwg % NXCD, xcd = wgid % NXCD, off = wgid / NXCD; wgid = (xcd < r ? xcd * (q + 1) : r * (q + 1) + (xcd - r) * q) + off; }
        const int nig = WGM * nN, gid = wgid / nig, fm = gid * WGM, gsz = (nM - fm) < WGM ? (nM - fm) : WGM;
        u.pm = fm + ((wgid % nig) % gsz); u.pn = (wgid % nig) / gsz; return true;
    }
    __device__ __forceinline__ void a_ready(const Unit&) const {}
    __device__ __forceinline__ void done(const Unit&) const {}
};
__device__ __forceinline__ unsigned cvt_pk_bf16(float lo, float hi) { unsigned r; asm volatile("v_cvt_pk_bf16_f32 %0, %1, %2" : "=v"(r) : "v"(lo), "v"(hi)); return r; }
template <class Epi, class Sched, bool ALIGN_EPI = false, bool SP2 = false>
__device__ __forceinline__ void gemm_phase(PG8_LAS unsigned char* lds, const Gemm g, const Sched& S, const Epi& E) {
    int tid_ = threadIdx.x; asm volatile("" : "+v"(tid_)); const int tid = tid_, wid = __builtin_amdgcn_readfirstlane(tid >> 6), lane = tid & 63, wr = wid >> 2, wc = wid & 3, fr = lane & 15, fq = lane >> 4;
    const int K = g.K, nt = K / BK;
    unsigned voffA[2], voffB[2];
#pragma unroll
    for (int i = 0; i < 2; ++i) { int R, C; stage_rc(tid * 16 + i * 8192, R, C); const int Rb = Epi::PERM ? ((R & ~31) + perm32(R & 31)) : R;
        voffA[i] = (unsigned)(R * K + C) * 2u; voffB[i] = (unsigned)(Rb * K + C) * 2u; }
    const size_t kstep = (size_t)(BK * 2);
    const size_t hstep = (size_t)HALF * K * 2;
    const size_t tstep = 2 * hstep;
    const unsigned ldsw = (unsigned)wid * 1024u;
    const int aoff = lds_byte(wr * 64 + fr, fq * 8), boff = lds_byte(wc * 32 + fr, fq * 8);
#define PG8_SA(b, h) (((b) * 2 + (h)) * HTB)
#define PG8_SB(b, h) ((4 + (b) * 2 + (h)) * HTB)
#define PG8_STAGE(bufoff, gbase, voff) do { _Pragma("unroll") for (int _i = 0; _i < 2; ++_i) \
        __builtin_amdgcn_global_load_lds((const unsigned*)((const char*)(gbase) + (voff)[_i]), (PG8_LAS unsigned*)(lds + (bufoff) + ldsw + _i * 8192), 16, 0, 0); } while (0)
#define PG8_LDA(dst, b, h) do { _Pragma("unroll") for (int m = 0; m < 4; ++m) _Pragma("unroll") for (int k = 0; k < 2; ++k) dst[m][k] = *(const PG8_LAS bf16x8*)(lds + PG8_SA(b, h) + aoff + m * 2048 + k * 1024); } while (0)
#define PG8_LDB(dst, b, h) do { _Pragma("unroll") for (int n = 0; n < 2; ++n) _Pragma("unroll") for (int k = 0; k < 2; ++k) dst[n][k] = *(const PG8_LAS bf16x8*)(lds + PG8_SB(b, h) + boff + n * 2048 + k * 1024); } while (0)
#define PG8_MMA(ai, bj, At, Bt) do { __builtin_amdgcn_s_setprio(1); _Pragma("unroll") for (int m = 0; m < 4; ++m) _Pragma("unroll") for (int n = 0; n < 2; ++n) _Pragma("unroll") for (int k = 0; k < 2; ++k) \
        acc[ai][bj][m][n] = __builtin_amdgcn_mfma_f32_16x16x32_bf16(Bt[n][k], At[m][k], acc[ai][bj][m][n], 0, 0, 0); __builtin_amdgcn_s_setprio(0); } while (0)
#define PG8_WAIT_V(n) asm volatile("s_waitcnt vmcnt(" #n ")" ::: "memory")
#define PG8_WAIT_L(n) asm volatile("s_waitcnt lgkmcnt(" #n ")" ::: "memory")
#define PG8_BAR __builtin_amdgcn_s_barrier()
#define PG8_SCHED __builtin_amdgcn_sched_barrier(0)
    Unit cur, nxt; int ui = 0;
    if (!S.next(0, cur)) return;
    f32x4 acc[2][2][4][2];
#pragma unroll
    for (int a = 0; a < 2; ++a)
#pragma unroll
        for (int b = 0; b < 2; ++b)
#pragma unroll
            for (int m = 0; m < 4; ++m)
#pragma unroll
                for (int n = 0; n < 2; ++n) acc[a][b][m][n] = (f32x4){0.f, 0.f, 0.f, 0.f};
    bf16x8 At[4][2], B0[2][2], B1[2][2];
    const char* cA = (const char*)g.A + (size_t)cur.pm * tstep; const char* cB = (const char*)g.Bt + (size_t)cur.pn * tstep;
    S.a_ready(cur);
    if constexpr (SP2) {
        PG8_STAGE(PG8_SB(0, 0), cB, voffB); PG8_STAGE(PG8_SB(0, 1), cB + hstep, voffB); PG8_STAGE(PG8_SA(0, 0), cA, voffA); PG8_STAGE(PG8_SA(0, 1), cA + hstep, voffA);
        if (wr == 1) PG8_BAR;
        PG8_WAIT_V(2); PG8_BAR;
        PG8_STAGE(PG8_SB(1, 0), cB + kstep, voffB); PG8_STAGE(PG8_SA(1, 0), cA + kstep, voffA); PG8_STAGE(PG8_SB(1, 1), cB + hstep + kstep, voffB);
        PG8_WAIT_V(6); PG8_BAR;
    } else {
        PG8_STAGE(PG8_SB(0, 0), cB, voffB); PG8_STAGE(PG8_SA(0, 0), cA, voffA); PG8_STAGE(PG8_SB(0, 1), cB + hstep, voffB); PG8_STAGE(PG8_SA(0, 1), cA + hstep, voffA);
        if (wr == 1) PG8_BAR;
        PG8_WAIT_V(4); PG8_BAR;
        PG8_STAGE(PG8_SB(1, 0), cB + kstep, voffB); PG8_STAGE(PG8_SA(1, 0), cA + kstep, voffA); PG8_STAGE(PG8_SB(1, 1), cB + hstep + kstep, voffB);
        PG8_WAIT_V(6); PG8_BAR;
    }
    for (;;) {
        const bool has_next = S.next(ui + 1, nxt);
        const char* nA = has_next ? (const char*)g.A + (size_t)nxt.pm * tstep : cA; const char* nB = has_next ? (const char*)g.Bt + (size_t)nxt.pn * tstep : cB;
        for (int t = 0; t < nt; t += 2) {
            const bool last = (t == nt - 2);
            const char* a1 = cA + (size_t)(t + 1) * kstep;
            const char* a2 = last ? nA : cA + (size_t)(t + 2) * kstep; const char* b2 = last ? nB : cB + (size_t)(t + 2) * kstep;
            const char* a3 = a2 + kstep; const char* b3 = b2 + kstep;
            if (last && has_next) S.a_ready(nxt);
            if constexpr (SP2) {
            PG8_LDB(B0, 0, 0); PG8_LDB(B1, 0, 1); PG8_SCHED; PG8_LDA(At, 0, 0); PG8_STAGE(PG8_SA(1, 1), a1 + hstep, voffA);
            PG8_WAIT_V(8); PG8_WAIT_L(0); PG8_BAR; PG8_MMA(0, 0, At, B0); PG8_MMA(0, 1, At, B1); PG8_BAR; PG8_SCHED;
            PG8_LDA(At, 0, 1); PG8_STAGE(PG8_SB(0, 0), b2, voffB); PG8_STAGE(PG8_SB(0, 1), b2 + hstep, voffB); PG8_STAGE(PG8_SA(0, 0), a2, voffA);
            PG8_WAIT_V(8); PG8_WAIT_L(0); PG8_BAR; PG8_MMA(1, 0, At, B0); PG8_MMA(1, 1, At, B1); PG8_BAR; PG8_SCHED;
            PG8_LDB(B0, 1, 0); PG8_LDB(B1, 1, 1); PG8_SCHED; PG8_LDA(At, 1, 0); PG8_STAGE(PG8_SA(0, 1), a2 + hstep, voffA);
            PG8_WAIT_V(8); PG8_WAIT_L(0); PG8_BAR; PG8_MMA(0, 0, At, B0); PG8_MMA(0, 1, At, B1); PG8_BAR; PG8_SCHED;
            PG8_LDA(At, 1, 1); PG8_STAGE(PG8_SB(1, 0), b3, voffB); PG8_STAGE(PG8_SB(1, 1), b3 + hstep, voffB); PG8_STAGE(PG8_SA(1, 0), a3, voffA);
            PG8_WAIT_V(8); PG8_WAIT_L(0); PG8_BAR; PG8_MMA(1, 0, At, B0); PG8_MMA(1, 1, At, B1); PG8_BAR; PG8_SCHED;
            } else {
            PG8_LDB(B0, 0, 0); PG8_SCHED; PG8_LDA(At, 0, 0); PG8_STAGE(PG8_SA(1, 1), a1 + hstep, voffA);
            PG8_WAIT_L(8); PG8_BAR; PG8_WAIT_L(0); PG8_MMA(0, 0, At, B0); PG8_BAR; PG8_SCHED;
            PG8_LDB(B1, 0, 1); PG8_STAGE(PG8_SB(0, 0), b2, voffB);
            PG8_BAR; PG8_WAIT_L(0); PG8_MMA(0, 1, At, B1); PG8_BAR;
            PG8_LDA(At, 0, 1); PG8_STAGE(PG8_SA(0, 0), a2, voffA);
            PG8_BAR; PG8_WAIT_L(0); PG8_MMA(1, 0, At, B0); PG8_BAR; PG8_SCHED;
            PG8_STAGE(PG8_SB(0, 1), b2 + hstep, voffB);
            PG8_WAIT_V(6); PG8_BAR; PG8_MMA(1, 1, At, B1); PG8_BAR;
            PG8_LDB(B0, 1, 0); PG8_SCHED; PG8_LDA(At, 1, 0); PG8_STAGE(PG8_SA(0, 1), a2 + hstep, voffA);
            PG8_WAIT_L(8); PG8_BAR; PG8_WAIT_L(0); PG8_MMA(0, 0, At, B0); PG8_BAR; PG8_SCHED;
            PG8_LDB(B1, 1, 1); PG8_STAGE(PG8_SB(1, 0), b3, voffB);
            PG8_BAR; PG8_WAIT_L(0); PG8_MMA(0, 1, At, B1); PG8_BAR;
            PG8_LDA(At, 1, 1); PG8_STAGE(PG8_SA(1, 0), a3, voffA);
            PG8_BAR; PG8_WAIT_L(0); PG8_MMA(1, 0, At, B0); PG8_BAR; PG8_SCHED;
            PG8_STAGE(PG8_SB(1, 1), b3 + hstep, voffB);
            PG8_WAIT_V(6); PG8_BAR; PG8_MMA(1, 1, At, B1); PG8_BAR;
            }
        }
        if constexpr (ALIGN_EPI) { if (wr == 0) PG8_BAR; }
        if constexpr (!Epi::AFTER_DRAIN) { E(acc, cur, wr, wc, fr, fq); S.done(cur); }
        if (!has_next) break;
#pragma unroll
        for (int a = 0; a < 2; ++a)
#pragma unroll
            for (int b = 0; b < 2; ++b)
#pragma unroll
                for (int m = 0; m < 4; ++m)
#pragma unroll
                    for (int n = 0; n < 2; ++n) acc[a][b][m][n] = (f32x4){0.f, 0.f, 0.f, 0.f};
        cur = nxt; cA = nA; cB = nB; ++ui;
        if constexpr (ALIGN_EPI) { if (wr == 1) PG8_BAR; }
    }
    PG8_WAIT_V(0);
    if constexpr (!ALIGN_EPI) { if (wr == 0) PG8_BAR; }
    PG8_BAR;
    if constexpr (Epi::AFTER_DRAIN) { E.fused(acc, cur, wr, wc, fr, fq, lds, wid, lane); S.done(cur); }
#undef PG8_SA
#undef PG8_SB
#undef PG8_STAGE
#undef PG8_LDA
#undef PG8_LDB
#undef PG8_MMA
#undef PG8_WAIT_V
#undef PG8_WAIT_L
#undef PG8_BAR
#undef PG8_SCHED
}
}

#define LAS __attribute__((address_space(3)))
typedef unsigned short bf16_t;
typedef short bf16x8 __attribute__((ext_vector_type(8)));
typedef float f32x4 __attribute__((ext_vector_type(4)));
typedef float f32x2 __attribute__((ext_vector_type(2)));
typedef float f32x16 __attribute__((ext_vector_type(16)));
typedef unsigned u32x4 __attribute__((ext_vector_type(4)));
typedef unsigned u32x2 __attribute__((ext_vector_type(2)));

#ifndef GEMM_ALIGN
#define GEMM_ALIGN true
#endif
#ifndef GEMM_SP2
#define GEMM_SP2 true
#endif
#ifndef N_LAUNCH_MODE
#define N_LAUNCH_MODE 1
#endif

constexpr int D = 2048, T = 16384, CL = 256, R = T + CL, DIN = 5120, NCHK = R / 128;
constexpr int NPHASE = 13;
constexpr float EPS = 1e-6f;
constexpr int LDS_BYTES = 131072 + 4096;

constexpr size_t WS_WINT = 0;
constexpr size_t WS_WOUTT = WS_WINT + (size_t)2 * DIN * D * 2;
constexpr size_t WS_XG = WS_WOUTT + (size_t)2 * D * D * 2;
constexpr size_t WS_PX = WS_XG + (size_t)R * D * 2;
constexpr size_t WS_Y = WS_PX + (size_t)R * DIN * 2;
constexpr size_t WS_X1C = WS_Y + (size_t)R * D * 2;
constexpr size_t WS_MOD = WS_X1C + (size_t)CL * D * 4;
constexpr size_t WS_GG = WS_MOD + (size_t)2 * 2 * 6144 * 4;
constexpr size_t WS_SHW = WS_GG + (size_t)2 * 2 * D * 4;
constexpr size_t WS_RSS = WS_SHW + (size_t)2 * 2 * DIN * 4;
constexpr size_t WS_GW = WS_RSS + (size_t)3 * R * 4 + 64;
constexpr size_t WS_SW = WS_GW + (size_t)2 * 16 * 2 * 2 * 2 * 4 * 64 * 8 * 2;
constexpr size_t WS_AGG = WS_SW + (size_t)2 * 8 * 128 * 128 * 2;
constexpr size_t WS_CARRY = WS_AGG + (size_t)2 * NCHK * 1024 * 8;
constexpr size_t WS_BAR = (WS_CARRY + (size_t)2 * NCHK * 1024 * 4 + 255) / 256 * 256;
constexpr size_t WS_DL0 = WS_BAR + 16384;
constexpr size_t WS_END = WS_DL0 + (size_t)T * D * 2;

struct Args { const float* in[25]; float* out; unsigned char* ws; int ph_lo, ph_hi; };

__device__ __forceinline__ float bflo(unsigned w) { return __uint_as_float(w << 16); }
__device__ __forceinline__ float bfhi(unsigned w) { return __uint_as_float(w & 0xffff0000u); }
__device__ __forceinline__ float bf1(bf16_t h) { return __uint_as_float((unsigned)h << 16); }
__device__ __forceinline__ unsigned pk2(float lo, float hi) { return pg8::cvt_pk_bf16(lo, hi); }
__device__ __forceinline__ bf16_t f2bf(float f) { return (bf16_t)(pk2(f, 0.f) & 0xffffu); }
__device__ __forceinline__ float rcpf_(float x) { return __builtin_amdgcn_rcpf(x); }
__device__ __forceinline__ float sigm(float x) { return rcpf_(1.0f + __expf(-x)); }
__device__ __forceinline__ float silu(float x) { return x * sigm(x); }
__device__ __forceinline__ float gelu_t(float x) { return x * sigm(1.5957691216f * (x + 0.044715f * x * x * x)); }
template <int CTRL> __device__ __forceinline__ float dpp_mov(float v) { return __int_as_float(__builtin_amdgcn_update_dpp(0, __float_as_int(v), CTRL, 0xf, 0xf, true)); }
__device__ __forceinline__ float wave_sum(float v) {
    v += dpp_mov<0xB1>(v);
    v += dpp_mov<0x4E>(v);
    v += dpp_mov<0x141>(v);
    v += dpp_mov<0x140>(v);
    const int iv = __float_as_int(v);
    return (__int_as_float(__builtin_amdgcn_readlane(iv, 0)) + __int_as_float(__builtin_amdgcn_readlane(iv, 16))) + (__int_as_float(__builtin_amdgcn_readlane(iv, 32)) + __int_as_float(__builtin_amdgcn_readlane(iv, 48)));
}
__device__ __forceinline__ int tid_fresh() { int t = threadIdx.x; asm volatile("" : "+v"(t)); return t; }
#define GAS __attribute__((address_space(1)))
__device__ __forceinline__ unsigned char* ptr_fresh(unsigned char* p) {
#ifdef FLAT_WS
    asm volatile("" : "+s"(p)); return p; }
#else
    unsigned long long v = (unsigned long long)p; asm volatile("" : "+s"(v)); return (unsigned char*)(GAS unsigned char*)v; }
#endif
#define LDS_WAIT() asm volatile("s_waitcnt lgkmcnt(0)" ::: "memory")

struct EpiIn {
    static constexpr bool PERM = true, AFTER_DRAIN = false;
    bf16_t* PX; const float* rss; const float* shw;
    __device__ __forceinline__ void operator()(const f32x4 (&acc)[2][2][4][2], const pg8::Unit& u, int wr, int wc, int fr, int fq) const {
        const int row0 = CL + u.pm * 256 + wr * 64 + fr, col0 = u.pn * 256 + wc * 32 + 8 * fq;
        const float* sw = shw + col0;
        f32x4 bv[2][2];
#pragma unroll
        for (int bj = 0; bj < 2; ++bj)
#pragma unroll
            for (int n = 0; n < 2; ++n) bv[bj][n] = *(const f32x4*)(sw + bj * 128 + 4 * n);
#pragma unroll
        for (int ai = 0; ai < 2; ++ai)
#pragma unroll
            for (int m = 0; m < 4; ++m) {
                const int r = row0 + ai * 128 + m * 16;
                const float rs = 1.0f / sqrtf(rss[r] * (1.0f / D) + EPS);
                bf16_t* rowp = PX + (size_t)r * DIN + col0;
#pragma unroll
                for (int bj = 0; bj < 2; ++bj) {
                    const f32x4 v0 = acc[ai][bj][m][0] * rs + bv[bj][0], v1 = acc[ai][bj][m][1] * rs + bv[bj][1];
                    u32x4 w; w.x = pk2(v0[0], v0[1]); w.y = pk2(v0[2], v0[3]); w.z = pk2(v1[0], v1[1]); w.w = pk2(v1[2], v1[3]);
                    *(u32x4*)(rowp + bj * 128) = w;
                }
            }
    }
};
struct EpiOut {
    static constexpr bool PERM = true, AFTER_DRAIN = false;
    int row_off, last;
    const float* xold_lat; const float* xold_ctx; float* xnew_lat; float* xnew_ctx;
    const float* gvec;
    const float* ggn;
    bf16_t* XG; float* rssn;
    __device__ __forceinline__ void operator()(const f32x4 (&acc)[2][2][4][2], const pg8::Unit& u, int wr, int wc, int fr, int fq) const {
        const int gbase = row_off + u.pm * 256;
        const bool isctx = gbase < CL;
        const int seg = isctx ? 1 : 0;
        const int grow0 = gbase + wr * 64 + fr, col0 = u.pn * 256 + wc * 32 + 8 * fq;
        const float* xo = isctx ? xold_ctx : (xold_lat - (size_t)CL * D);
        float* xn = isctx ? xnew_ctx : (xnew_lat - (size_t)CL * D);
        const float* gp = gvec + seg * 6144 + 4096 + col0;
        const float* ggp = ggn + seg * D + col0;
        f32x4 gv[2][2], gg[2][2];
#pragma unroll
        for (int bj = 0; bj < 2; ++bj)
#pragma unroll
            for (int n = 0; n < 2; ++n) { gv[bj][n] = *(const f32x4*)(gp + bj * 128 + 4 * n); gg[bj][n] = last ? (f32x4){0.f, 0.f, 0.f, 0.f} : *(const f32x4*)(ggp + bj * 128 + 4 * n); }
#pragma unroll
        for (int ai = 0; ai < 2; ++ai)
#pragma unroll
            for (int m = 0; m < 4; ++m) {
                const int r = grow0 + ai * 128 + m * 16;
                const size_t ro = (size_t)r * D + col0;
                float ss = 0.f;
#pragma unroll
                for (int bj = 0; bj < 2; ++bj) {
                    const f32x4 o0 = *(const f32x4*)(xo + ro + bj * 128), o1 = *(const f32x4*)(xo + ro + bj * 128 + 4);
                    const f32x4 v0 = o0 + gv[bj][0] * acc[ai][bj][m][0], v1 = o1 + gv[bj][1] * acc[ai][bj][m][1];
                    *(f32x4*)(xn + ro + bj * 128) = v0; *(f32x4*)(xn + ro + bj * 128 + 4) = v1;
                    ss += (v0[0] * v0[0] + v0[1] * v0[1]) + (v0[2] * v0[2] + v0[3] * v0[3]) + (v1[0] * v1[0] + v1[1] * v1[1]) + (v1[2] * v1[2] + v1[3] * v1[3]);
                    if (!last) {
                        const f32x4 a0 = v0 * gg[bj][0], a1 = v1 * gg[bj][1];
                        u32x4 w; w.x = pk2(a0[0], a0[1]); w.y = pk2(a0[2], a0[3]); w.z = pk2(a1[0], a1[1]); w.w = pk2(a1[2], a1[3]);
                        *(u32x4*)(XG + ro + bj * 128) = w;
                    }
                }
                ss += __shfl_xor(ss, 16); ss += __shfl_xor(ss, 32);
                if (fq == 0) unsafeAtomicAdd(rssn + r, ss);
            }
    }
};

struct EpiDelta {
    static constexpr bool PERM = true, AFTER_DRAIN = false;
    bf16_t* DL; const float* gvec;
    __device__ __forceinline__ void operator()(const f32x4 (&acc)[2][2][4][2], const pg8::Unit& u, int wr, int wc, int fr, int fq) const {
        const int row0 = u.pm * 256 + wr * 64 + fr, col0 = u.pn * 256 + wc * 32 + 8 * fq;
        f32x4 gv[2][2];
#pragma unroll
        for (int bj = 0; bj < 2; ++bj)
#pragma unroll
            for (int n = 0; n < 2; ++n) gv[bj][n] = *(const f32x4*)(gvec + col0 + bj * 128 + 4 * n);
#pragma unroll
        for (int ai = 0; ai < 2; ++ai)
#pragma unroll
            for (int m = 0; m < 4; ++m) {
                bf16_t* rowp = DL + (size_t)(row0 + ai * 128 + m * 16) * D + col0;
#pragma unroll
                for (int bj = 0; bj < 2; ++bj) {
                    const f32x4 v0 = acc[ai][bj][m][0] * gv[bj][0], v1 = acc[ai][bj][m][1] * gv[bj][1];
                    u32x4 w; w.x = pk2(v0[0], v0[1]); w.y = pk2(v0[2], v0[3]); w.z = pk2(v1[0], v1[1]); w.w = pk2(v1[2], v1[3]);
                    *(u32x4*)(rowp + bj * 128) = w;
                }
            }
    }
};

__device__ __forceinline__ void transpose_item(const float* W, int K, int N, bf16_t* WT, LAS float* scr, int item, int lane) {
    const int nblk = N / 32, kb = item / nblk, nb = item % nblk, k0 = 64 * kb, n0 = 32 * nb;
#pragma unroll 8
    for (int i = 0; i < 32; ++i) { const int kk = 2 * i + (lane >> 5); scr[kk * 33 + (lane & 31)] = W[(size_t)(k0 + kk) * N + n0 + (lane & 31)]; }
    LDS_WAIT();
    const int c = lane & 7;
#pragma unroll
    for (int j = 0; j < 4; ++j) { const int n = (lane >> 3) + 8 * j; const LAS float* s = scr + (8 * c) * 33 + n;
        u32x4 o; o.x = pk2(s[0 * 33], s[1 * 33]); o.y = pk2(s[2 * 33], s[3 * 33]); o.z = pk2(s[4 * 33], s[5 * 33]); o.w = pk2(s[6 * 33], s[7 * 33]);
        *(u32x4*)(WT + (size_t)(n0 + n) * K + k0 + 8 * c) = o; }
    LDS_WAIT();
}

__device__ __forceinline__ void phase0a(const Args a, LAS unsigned char* lds) {
    const int tid = tid_fresh(), lane = tid & 63, wave = tid >> 6, b = blockIdx.x, G = gridDim.x;
    unsigned char* ws = ptr_fresh(a.ws);
    { float* rss = (float*)(ws + WS_RSS); for (int i = b * 512 + tid; i < 2 * R; i += G * 512) rss[R + i] = 0.f; }
    { bf16_t* GW = (bf16_t*)(ws + WS_GW);
      for (int gid = b * 512 + tid; gid < 2 * 16 * 2 * 2 * 2 * 4 * 64; gid += G * 512) {
          int x = gid; const int ln = x & 63; x >>= 6; const int s = x & 3; x >>= 2; const int half = x & 1; x >>= 1; const int gate = x & 1; x >>= 1; const int dir = x & 1; x >>= 1; const int hd = x & 15; x >>= 4; const int l = x;
          const float* w = (gate ? a.in[14] : a.in[12]) + ((size_t)((l * 2 + dir) * 16 + hd)) * 4096;
          const int col = 32 * half + (ln & 31), k0 = 16 * s + 8 * (ln >> 5);
          float v[8];
#pragma unroll
          for (int j = 0; j < 8; ++j) v[j] = w[(k0 + j) * 64 + col];
          u32x4 o; o.x = pk2(v[0], v[1]); o.y = pk2(v[2], v[3]); o.z = pk2(v[4], v[5]); o.w = pk2(v[6], v[7]);
          *(u32x4*)(GW + (size_t)gid * 8) = o;
      } }
    { bf16_t* SW = (bf16_t*)(ws + WS_SW); const float* sw = a.in[22];
      for (int i = b * 512 + tid; i < 2 * 8 * 128 * 128 / 4; i += G * 512) { const f32x4 v = *(const f32x4*)(sw + (size_t)i * 4); u32x2 o; o.x = pk2(v[0], v[1]); o.y = pk2(v[2], v[3]); *(u32x2*)(SW + (size_t)i * 4) = o; } }
    { const float* c = a.in[1]; const float* cc = a.in[3]; float* MOD = (float*)(ws + WS_MOD);
      LAS float* red = (LAS float*)lds;
      for (int u = b; u < 192; u += G) {
          const int l = u / 96, n0 = (u % 96) * 64, q = tid & 15, ks = tid >> 4;
          const float* W = a.in[4] + (size_t)l * D * 6144 + n0 + 4 * q;
          f32x4 a0 = {0.f, 0.f, 0.f, 0.f}, a1 = {0.f, 0.f, 0.f, 0.f};
#pragma unroll 8
          for (int kk = 0; kk < 64; ++kk) { const int k = ks * 64 + kk; const f32x4 wv = *(const f32x4*)(W + (size_t)k * 6144); const float ca = silu(c[k]), cb = silu(cc[k]); a0 += wv * ca; a1 += wv * cb; }
          LAS float* rp = red + (ks * 16 + q) * 8;
          *(LAS f32x4*)rp = a0; *(LAS f32x4*)(rp + 4) = a1;
          __syncthreads();
          if (tid < 128) { const int qq = tid >> 3, e = tid & 7; float s = 0.f;
#pragma unroll 8
              for (int k2 = 0; k2 < 32; ++k2) s += red[(k2 * 16 + qq) * 8 + e];
              const int seg = e >> 2, col = n0 + 4 * qq + (e & 3);
              MOD[(l * 2 + seg) * 6144 + col] = s + a.in[5][l * 6144 + col]; }
          __syncthreads();
      } }
    { LAS float* scr = (LAS float*)(lds + wave * 16384);
      const int gw = b * 8 + wave, NGW = G * 8;
      constexpr int I_IN = (D / 64) * (DIN / 32), I_OUT = (D / 64) * (D / 32);
      for (int it = gw; it < 2 * I_IN + 2 * I_OUT; it += NGW) {
          int r = it;
          if (r < 2 * I_IN) { const int l = r / I_IN; transpose_item(a.in[7] + (size_t)l * D * DIN, D, DIN, (bf16_t*)(ws + WS_WINT) + (size_t)l * DIN * D, scr, r % I_IN, lane); continue; }
          r -= 2 * I_IN; { const int l = r / I_OUT; transpose_item(a.in[8] + (size_t)l * D * D, D, D, (bf16_t*)(ws + WS_WOUTT) + (size_t)l * D * D, scr, r % I_OUT, lane); }
      } }
}

__device__ __forceinline__ void phase0b(const Args a, LAS unsigned char* lds) {
    const int tid = tid_fresh(), lane = tid & 63, wave = tid >> 6, b = blockIdx.x, G = gridDim.x;
    unsigned char* ws = ptr_fresh(a.ws);
    const float* MOD = (const float*)(ws + WS_MOD);
    LAS float* GG0 = (LAS float*)lds;
    LAS float* SH = (LAS float*)(lds + 16384);
    for (int i = tid; i < 2 * D; i += 512) { const int seg = i >> 11, k = i & 2047; float gv_ = a.in[6][k] * (1.0f + MOD[seg * 6144 + 2048 + k]); if (gv_ == 0.f) gv_ = 1e-30f; GG0[i] = gv_; }
    for (int i = tid; i < 4 * D; i += 512) { const int ls = i >> 11, k = i & 2047; SH[i] = MOD[ls * 6144 + k]; }
    { float* GGt = (float*)(ws + WS_GG); for (int i = b * 512 + tid; i < 4 * D; i += G * 512) { const int ls = i >> 11, l = ls >> 1, k = i & 2047; float gv_ = a.in[6][l * D + k] * (1.0f + MOD[ls * 6144 + 2048 + k]); if (gv_ == 0.f) gv_ = 1e-30f; GGt[i] = gv_; } }
    __syncthreads();
    const int gw = b * 8 + wave, NGW = G * 8;
    { bf16_t* XG = (bf16_t*)(ws + WS_XG); float* rss = (float*)(ws + WS_RSS);
      f32x4 vr[8];
#define P0B_LOAD(r_, V) do { const float* _src = (r_) < CL ? a.in[2] + (size_t)(r_) * D : a.in[0] + (size_t)((r_) - CL) * D; \
          _Pragma("unroll") for (int j = 0; j < 8; ++j) V[j] = *(const f32x4*)(_src + 4 * (lane + 64 * j)); } while (0)
      int r = gw;
      if (r < R) P0B_LOAD(r, vr);
      for (; r < R; r += NGW) {
          f32x4 vn[8];
          const int rn = r + NGW;
          if (rn < R) P0B_LOAD(rn, vn);
          const int seg = r < CL ? 1 : 0;
          float ss = 0.f;
#pragma unroll
          for (int j = 0; j < 8; ++j) ss += (vr[j][0] * vr[j][0] + vr[j][1] * vr[j][1]) + (vr[j][2] * vr[j][2] + vr[j][3] * vr[j][3]);
#pragma unroll
          for (int j = 0; j < 8; ++j) { const f32x4 g = *(LAS f32x4*)(GG0 + seg * D + 4 * (lane + 64 * j)); const f32x4 p = vr[j] * g; u32x2 o; o.x = pk2(p[0], p[1]); o.y = pk2(p[2], p[3]); *(u32x2*)(XG + (size_t)r * D + 4 * (lane + 64 * j)) = o; }
          ss = wave_sum(ss);
          if (lane == 0) rss[r] = ss;
          if (rn < R) {
#pragma unroll
              for (int j = 0; j < 8; ++j) vr[j] = vn[j];
          }
      }
#undef P0B_LOAD
    }
    { float* SHW = (float*)(ws + WS_SHW); const bf16_t* WinT = (const bf16_t*)(ws + WS_WINT);
      for (int idx = gw; idx < 2 * DIN; idx += NGW) {
          const int l = idx / DIN, n = idx % DIN;
          const bf16_t* row = WinT + ((size_t)l * DIN + n) * D;
          float d0 = 0.f, d1 = 0.f;
#pragma unroll
          for (int j = 0; j < 4; ++j) { const int k = 8 * (lane + 64 * j); const u32x4 w = *(const u32x4*)(row + k);
              const LAS float* s0 = SH + (l * 2 + 0) * D + k; const LAS float* s1 = SH + (l * 2 + 1) * D + k;
              const f32x4 x0 = *(LAS f32x4*)s0, x1 = *(LAS f32x4*)(s0 + 4), y0 = *(LAS f32x4*)s1, y1 = *(LAS f32x4*)(s1 + 4);
              const float w0 = bflo(w.x), w1 = bfhi(w.x), w2 = bflo(w.y), w3 = bfhi(w.y), w4 = bflo(w.z), w5 = bfhi(w.z), w6 = bflo(w.w), w7 = bfhi(w.w);
              d0 += (w0 * x0[0] + w1 * x0[1]) + (w2 * x0[2] + w3 * x0[3]) + (w4 * x1[0] + w5 * x1[1]) + (w6 * x1[2] + w7 * x1[3]);
              d1 += (w0 * y0[0] + w1 * y0[1]) + (w2 * y0[2] + w3 * y0[3]) + (w4 * y1[0] + w5 * y1[1]) + (w6 * y1[2] + w7 * y1[3]); }
          d0 = wave_sum(d0); d1 = wave_sum(d1);
          if (lane == 0) { SHW[(l * 2 + 0) * DIN + n] = d0; SHW[(l * 2 + 1) * DIN + n] = d1; }
      } }
    __syncthreads();
}

constexpr int XLF_STRIDE = 68, XLB_STRIDE = 72;
constexpr int LRU_XLF = 0, LRU_XLB = 128 * XLF_STRIDE * 4, LRU_TAGG = LRU_XLB + 128 * XLB_STRIDE * 2;

template <bool PASSC>
__device__ __forceinline__ void lru_item(const Args a, int l, int chunk, int hd, LAS unsigned char* lds) {
    const int tid = tid_fresh(), lane = tid & 63, wave = tid >> 6;
    unsigned char* ws = ptr_fresh(a.ws);
    const bf16_t* PX = (const bf16_t*)(ws + WS_PX);
    LAS float* XLF = (LAS float*)(lds + LRU_XLF);
    LAS bf16_t* XLB = (LAS bf16_t*)(lds + LRU_XLB);
    LAS f32x2* TAGG = (LAS f32x2*)(lds + LRU_TAGG);
    __syncthreads();
    {
        const int t = tid >> 2, q = tid & 3, ch0 = hd * 64 + q * 16;
        const int grow = chunk * 128 + t, seg_lo = chunk < 2 ? 0 : CL, seg_hi = chunk < 2 ? CL : R;
        const float* cw = a.in[9] + (size_t)l * 4 * 1024 + ch0; const float* cb = a.in[10] + (size_t)l * 1024 + ch0;
        float xl[16];
#pragma unroll
        for (int c4 = 0; c4 < 4; ++c4) { const f32x4 bb = *(const f32x4*)(cb + 4 * c4); xl[4 * c4] = bb[0]; xl[4 * c4 + 1] = bb[1]; xl[4 * c4 + 2] = bb[2]; xl[4 * c4 + 3] = bb[3]; }
#pragma unroll
        for (int j = 0; j < 4; ++j) {
            const int rr = grow + j - 2;
            if (rr >= seg_lo && rr < seg_hi) {
                const u32x4 p0 = *(const u32x4*)(PX + (size_t)rr * DIN + ch0), p1 = *(const u32x4*)(PX + (size_t)rr * DIN + ch0 + 8);
                const unsigned pw[8] = {p0.x, p0.y, p0.z, p0.w, p1.x, p1.y, p1.z, p1.w};
#pragma unroll
                for (int c4 = 0; c4 < 4; ++c4) { const f32x4 wv = *(const f32x4*)(cw + j * 1024 + 4 * c4);
                    xl[4 * c4 + 0] += wv[0] * bflo(pw[2 * c4]); xl[4 * c4 + 1] += wv[1] * bfhi(pw[2 * c4]); xl[4 * c4 + 2] += wv[2] * bflo(pw[2 * c4 + 1]); xl[4 * c4 + 3] += wv[3] * bfhi(pw[2 * c4 + 1]); }
            }
        }
        LAS float* xf = XLF + t * XLF_STRIDE + q * 16;
#pragma unroll
        for (int c4 = 0; c4 < 4; ++c4) *(LAS f32x4*)(xf + 4 * c4) = (f32x4){xl[4 * c4], xl[4 * c4 + 1], xl[4 * c4 + 2], xl[4 * c4 + 3]};
        LAS bf16_t* xb = XLB + t * XLB_STRIDE + q * 16;
        u32x4 o0, o1; o0.x = pk2(xl[0], xl[1]); o0.y = pk2(xl[2], xl[3]); o0.z = pk2(xl[4], xl[5]); o0.w = pk2(xl[6], xl[7]); o1.x = pk2(xl[8], xl[9]); o1.y = pk2(xl[10], xl[11]); o1.z = pk2(xl[12], xl[13]); o1.w = pk2(xl[14], xl[15]);
        *(LAS u32x4*)xb = o0; *(LAS u32x4*)(xb + 8) = o1;
    }
    __syncthreads();
    const int tw = wave >> 1, chh = wave & 1, cl = lane & 31, hh = lane >> 5;
    const int cin = 32 * chh + cl, cg_ = hd * 64 + cin;
    bf16x8 Af[4];
#pragma unroll
    for (int s = 0; s < 4; ++s) Af[s] = *(const LAS bf16x8*)(XLB + (32 * tw + cl) * XLB_STRIDE + 16 * s + 8 * hh);
    float xlv[16];
#pragma unroll
    for (int i = 0; i < 16; ++i) xlv[i] = XLF[(32 * tw + (i & 3) + 8 * (i >> 2) + 4 * hh) * XLF_STRIDE + cin];
    float av[2][16], bv[2][16];
    float GA[2][8], GB[2][8];
    const bf16_t* GW = (const bf16_t*)(ws + WS_GW);
#pragma unroll
    for (int dir = 0; dir < 2; ++dir) {
        f32x16 ar, ai;
#pragma unroll
        for (int i = 0; i < 16; ++i) { ar[i] = 0.f; ai[i] = 0.f; }
#pragma unroll
        for (int s = 0; s < 4; ++s) {
            const size_t gr = ((((((size_t)(l * 16 + hd) * 2 + dir) * 2 + 0) * 2 + chh) * 4 + s) * 64 + lane) * 8;
            const size_t gi = ((((((size_t)(l * 16 + hd) * 2 + dir) * 2 + 1) * 2 + chh) * 4 + s) * 64 + lane) * 8;
            const bf16x8 Br = *(const bf16x8*)(GW + gr), Bi = *(const bf16x8*)(GW + gi);
            ar = __builtin_amdgcn_mfma_f32_32x32x16_bf16(Af[s], Br, ar, 0, 0, 0);
            ai = __builtin_amdgcn_mfma_f32_32x32x16_bf16(Af[s], Bi, ai, 0, 0, 0);
        }
        const float brv = a.in[13][(size_t)(l * 2 + dir) * 1024 + cg_], biv = a.in[15][(size_t)(l * 2 + dir) * 1024 + cg_];
        const float lam = a.in[11][(size_t)(l * 2 + dir) * 1024 + cg_];
        const float k8 = -8.0f * log1pf(__expf(-lam));
#pragma unroll
        for (int i = 0; i < 16; ++i) {
            const float rg = sigm(ar[i] + brv), ig = sigm(ai[i] + biv);
            const float la = k8 * rg;
            av[dir][i] = __expf(la);
            const float aa = av[dir][i]; bv[dir][i] = __builtin_amdgcn_sqrtf(fmaxf(1.0f - aa * aa, 0.f)) * ig * xlv[i];
        }
        float oA[4], oB[4];
#pragma unroll
        for (int g = 0; g < 4; ++g) {
            const float a0 = av[dir][4 * g], a1 = av[dir][4 * g + 1], a2 = av[dir][4 * g + 2], a3 = av[dir][4 * g + 3];
            const float b0 = bv[dir][4 * g], b1 = bv[dir][4 * g + 1], b2 = bv[dir][4 * g + 2], b3 = bv[dir][4 * g + 3];
            oA[g] = (a0 * a1) * (a2 * a3);
            oB[g] = dir == 0 ? ((b0 * a1 + b1) * a2 + b2) * a3 + b3 : ((b3 * a2 + b2) * a1 + b1) * a0 + b0;
        }
#pragma unroll
        for (int g = 0; g < 4; ++g) {
            const float pA = __shfl_xor(oA[g], 32), pB = __shfl_xor(oB[g], 32);
            GA[dir][2 * g] = hh ? pA : oA[g]; GA[dir][2 * g + 1] = hh ? oA[g] : pA;
            GB[dir][2 * g] = hh ? pB : oB[g]; GB[dir][2 * g + 1] = hh ? oB[g] : pB;
        }
        float tA = 1.f, tB = 0.f;
        if (dir == 0) {
#pragma unroll
            for (int gq = 0; gq < 8; ++gq) { tB = GA[dir][gq] * tB + GB[dir][gq]; tA *= GA[dir][gq]; }
        } else {
#pragma unroll
            for (int gq = 7; gq >= 0; --gq) { tB = GA[dir][gq] * tB + GB[dir][gq]; tA *= GA[dir][gq]; }
        }
        if (hh == 0) TAGG[(tw * 2 + dir) * 64 + cin] = (f32x2){tA, tB};
    }
    __syncthreads();
    if constexpr (!PASSC) {
        if (tid < 128) {
            const int dir = tid >> 6, c = tid & 63;
            float cA = 1.f, cB = 0.f;
#pragma unroll
            for (int k = 0; k < 4; ++k) { const int t2 = dir == 0 ? k : 3 - k; const f32x2 v = TAGG[(t2 * 2 + dir) * 64 + c]; cB = v[0] * cB + v[1]; cA *= v[0]; }
            f32x2* AGG = (f32x2*)(ws + WS_AGG);
            AGG[((size_t)dir * NCHK + chunk) * 1024 + hd * 64 + c] = (f32x2){cA, cB};
        }
    } else {
        const float* CARRY = (const float*)(ws + WS_CARRY);
        float yv[16];
#pragma unroll
        for (int dir = 0; dir < 2; ++dir) {
            float st = CARRY[((size_t)dir * NCHK + chunk) * 1024 + cg_];
            if (dir == 0) {
#pragma unroll
                for (int t2 = 0; t2 < 3; ++t2) if (t2 < tw) { const f32x2 v = TAGG[(t2 * 2 + 0) * 64 + cin]; st = v[0] * st + v[1]; }
            } else {
#pragma unroll
                for (int t2 = 3; t2 > 0; --t2) if (t2 > tw) { const f32x2 v = TAGG[(t2 * 2 + 1) * 64 + cin]; st = v[0] * st + v[1]; }
            }
            float hst[4];
            if (dir == 0) {
                float s = st;
#pragma unroll
                for (int g = 0; g < 4; ++g) { const float sE = s; s = GA[0][2 * g] * s + GB[0][2 * g]; const float sO = s; s = GA[0][2 * g + 1] * s + GB[0][2 * g + 1]; hst[g] = hh ? sO : sE; }
            } else {
                float s = st;
#pragma unroll
                for (int g = 3; g >= 0; --g) { const float sO = s; s = GA[1][2 * g + 1] * s + GB[1][2 * g + 1]; const float sE = s; s = GA[1][2 * g] * s + GB[1][2 * g]; hst[g] = hh ? sO : sE; }
            }
#pragma unroll
            for (int g = 0; g < 4; ++g) {
                float h = hst[g];
                if (dir == 0) {
#pragma unroll
                    for (int k = 0; k < 4; ++k) { h = av[0][4 * g + k] * h + bv[0][4 * g + k]; yv[4 * g + k] = h; }
                } else {
#pragma unroll
                    for (int k = 3; k >= 0; --k) { h = av[1][4 * g + k] * h + bv[1][4 * g + k]; yv[4 * g + k] += h; }
                }
            }
        }
        bf16_t* Y = (bf16_t*)(ws + WS_Y);
#pragma unroll
        for (int i = 0; i < 16; ++i) {
            const int row = chunk * 128 + 32 * tw + (i & 3) + 8 * (i >> 2) + 4 * hh;
            const float gt = bf1(PX[(size_t)row * DIN + 1024 + cg_]);
            Y[(size_t)row * D + cg_] = f2bf(yv[i] * silu(gt));
        }
    }
}

__device__ __forceinline__ void conv_item(const Args a, int l, int ct, LAS unsigned char* lds) {
    const int tid = tid_fresh(), lane = tid & 63, wave = tid >> 6, c = tid;
    unsigned char* ws = ptr_fresh(a.ws);
    const bf16_t* PX = (const bf16_t*)(ws + WS_PX); bf16_t* Y = (bf16_t*)(ws + WS_Y);
    LAS float* CB = (LAS float*)lds;
    const int t0 = ct * 128, seg_lo = ct < 2 ? 0 : CL, seg_hi = ct < 2 ? CL : R;
    float w[31];
#pragma unroll
    for (int j = 0; j < 31; ++j) w[j] = a.in[16][((size_t)l * 31 + j) * 512 + c];
    const float bias = a.in[17][l * 512 + c];
    float win[32];
#define CONV_Z(dst, rr_) do { const int _rr = (rr_); const int _rc = _rr < seg_lo ? seg_lo : (_rr >= seg_hi ? seg_hi - 1 : _rr); const float _v = bf1(PX[(size_t)_rc * DIN + 2048 + c]), _g = bf1(PX[(size_t)_rc * DIN + 2560 + c]); const float _z = _v * sigm(_g); dst = (_rr == _rc) ? _z : 0.f; } while (0)
#pragma unroll
    for (int e = 0; e < 30; ++e) CONV_Z(win[e], t0 - 15 + e);
    win[30] = 0.f; win[31] = 0.f;
    __syncthreads();
#pragma unroll 1
    for (int bb = 0; bb < 4; ++bb) {
        LAS float* cbuf = CB + (bb & 1) * (32 * 512);
#pragma unroll
        for (int u = 0; u < 32; ++u) {
            if ((u & 7) == 0) asm volatile("" ::: "memory");
            CONV_Z(win[(u + 30) & 31], t0 - 15 + 32 * bb + u + 30);
            float acc = bias;
#pragma unroll
            for (int j = 0; j < 31; ++j) acc += w[j] * win[(u + j) & 31];
            cbuf[u * 512 + c] = acc;
        }
        __syncthreads();
#pragma unroll 1
        for (int uu = 0; uu < 4; ++uu) {
            const int u = wave * 4 + uu, row = t0 + 32 * bb + u;
            float v[8]; float s = 0.f;
#pragma unroll
            for (int k = 0; k < 8; ++k) { v[k] = cbuf[u * 512 + lane + 64 * k]; s += v[k]; }
            const float mean = wave_sum(s) * (1.0f / 512.0f);
            float s2 = 0.f;
#pragma unroll
            for (int k = 0; k < 8; ++k) { v[k] -= mean; s2 += v[k] * v[k]; }
            const float rstd = 1.0f / sqrtf(wave_sum(s2) * (1.0f / 512.0f) + EPS);
#pragma unroll
            for (int k = 0; k < 8; ++k) {
                const int ch = lane + 64 * k;
                const float y = silu(v[k] * rstd * a.in[18][l * 512 + ch] + a.in[19][l * 512 + ch]);
                const float gt = bf1(PX[(size_t)row * DIN + 3072 + ch]);
                Y[(size_t)row * D + 1024 + ch] = f2bf(y * silu(gt));
            }
        }
    }
#undef CONV_Z
}

constexpr int TT_STRIDE = 136;
__device__ __forceinline__ void sgu_item(const Args a, int l, int sc, LAS unsigned char* lds) {
    const int tid = tid_fresh(), lane = tid & 63, wave = tid >> 6;
    unsigned char* ws = ptr_fresh(a.ws);
    const bf16_t* PX = (const bf16_t*)(ws + WS_PX); bf16_t* Y = (bf16_t*)(ws + WS_Y);
    const bf16_t* SW = (const bf16_t*)(ws + WS_SW) + (size_t)l * 8 * 128 * 128;
    LAS f32x2* ST = (LAS f32x2*)lds;
    LAS bf16_t* TT = (LAS bf16_t*)(lds + 1024);
    const int t0 = sc * 128;
    __syncthreads();
#pragma unroll 1
    for (int k = 0; k < 16; ++k) {
        const int tok = wave * 16 + k;
        const u32x4 p = *(const u32x4*)(PX + (size_t)(t0 + tok) * DIN + 4096 + 8 * lane);
        float g[8] = {gelu_t(bflo(p.x)), gelu_t(bfhi(p.x)), gelu_t(bflo(p.y)), gelu_t(bfhi(p.y)), gelu_t(bflo(p.z)), gelu_t(bfhi(p.z)), gelu_t(bflo(p.w)), gelu_t(bfhi(p.w))};
        float s = 0.f;
#pragma unroll
        for (int j = 0; j < 8; ++j) s += g[j];
        const float mean = wave_sum(s) * (1.0f / 512.0f);
        float s2 = 0.f;
#pragma unroll
        for (int j = 0; j < 8; ++j) { const float d = g[j] - mean; s2 += d * d; }
        const float rstd = 1.0f / sqrtf(wave_sum(s2) * (1.0f / 512.0f) + EPS);
        if (lane == 0) ST[tok] = (f32x2){mean, rstd};
    }
    __syncthreads();
    const int p_ = tid >> 2, dq = tid & 3;
    const f32x2 st = ST[p_];
    const int fr = lane & 15, fq = lane >> 4;
#pragma unroll 1
    for (int h = 0; h < 8; ++h) {
        LAS bf16_t* tt = TT + (h & 1) * (64 * TT_STRIDE);
        {
            const int ch = 64 * h + 16 * dq;
            const u32x4 q0 = *(const u32x4*)(PX + (size_t)(t0 + p_) * DIN + 4096 + ch), q1 = *(const u32x4*)(PX + (size_t)(t0 + p_) * DIN + 4096 + ch + 8);
            const unsigned pw[8] = {q0.x, q0.y, q0.z, q0.w, q1.x, q1.y, q1.z, q1.w};
            const float* lg = a.in[20] + l * 512 + ch; const float* lb = a.in[21] + l * 512 + ch;
#pragma unroll
            for (int j = 0; j < 8; ++j) {
                const float v0 = (gelu_t(bflo(pw[j])) - st[0]) * st[1] * lg[2 * j] + lb[2 * j];
                const float v1 = (gelu_t(bfhi(pw[j])) - st[0]) * st[1] * lg[2 * j + 1] + lb[2 * j + 1];
                tt[(16 * dq + 2 * j) * TT_STRIDE + p_] = f2bf(v0);
                tt[(16 * dq + 2 * j + 1) * TT_STRIDE + p_] = f2bf(v1);
            }
        }
        __syncthreads();
        f32x4 acc[4];
#pragma unroll
        for (int nt = 0; nt < 4; ++nt) acc[nt] = (f32x4){0.f, 0.f, 0.f, 0.f};
#pragma unroll
        for (int s = 0; s < 4; ++s) {
            const bf16x8 Afr = *(const bf16x8*)(SW + ((size_t)h * 128 + 16 * wave + fr) * 128 + 32 * s + 8 * fq);
#pragma unroll
            for (int nt = 0; nt < 4; ++nt) {
                const bf16x8 Bfr = *(const LAS bf16x8*)(tt + (16 * nt + fr) * TT_STRIDE + 32 * s + 8 * fq);
                acc[nt] = __builtin_amdgcn_mfma_f32_16x16x32_bf16(Afr, Bfr, acc[nt], 0, 0, 0);
            }
        }
#pragma unroll
        for (int reg = 0; reg < 4; ++reg) {
            const int q = 16 * wave + 4 * fq + reg, row = t0 + q;
            const float bs = a.in[23][((size_t)l * 8 + h) * 128 + q];
#pragma unroll
            for (int nt = 0; nt < 4; ++nt) {
                const int ch = 64 * h + 16 * nt + fr;
                const float uu = gelu_t(bf1(PX[(size_t)row * DIN + 3584 + ch]));
                const float gt = bf1(PX[(size_t)row * DIN + 4608 + ch]);
                Y[(size_t)row * D + 1536 + ch] = f2bf(uu * (acc[nt][reg] + bs) * silu(gt));
            }
        }
    }
}


constexpr int L2_GWL = 0;
constexpr int L2_CW = 32768;
constexpr int L2_RAW = 34816;
constexpr int RAW_ROWB = 144, RAW_BUFB = 132 * RAW_ROWB;
constexpr int L2_XLF = L2_RAW + 2 * RAW_BUFB;
constexpr int L2_XLB = L2_XLF + 128 * XLF_STRIDE * 4;
constexpr int L2_TAGG = L2_XLB + 128 * XLB_STRIDE * 2;
static_assert(L2_TAGG + 4096 <= LDS_BYTES, "lds map");

template <bool PASSC>
__device__ __forceinline__ void lru_phase(const Args a, int l, int c_lo, LAS unsigned char* lds) {
    const int tid = tid_fresh(), lane = tid & 63, wave = tid >> 6, b = blockIdx.x, G = gridDim.x;
    unsigned char* ws = ptr_fresh(a.ws);
    const bf16_t* PX = (const bf16_t*)(ws + WS_PX);
    const int hd = b & 15, cstep = G >> 4;
    int chunk = c_lo + (b >> 4);
    if (chunk >= NCHK) return;
    LAS float* CW = (LAS float*)(lds + L2_CW);
    LAS float* XLF = (LAS float*)(lds + L2_XLF);
    LAS bf16_t* XLB = (LAS bf16_t*)(lds + L2_XLB);
    LAS f32x2* TAGG = (LAS f32x2*)(lds + L2_TAGG);
    __syncthreads();
    {
        if (tid < 320) { const int j = tid >> 6, c = tid & 63; CW[tid] = j < 4 ? a.in[9][((size_t)l * 4 + j) * 1024 + hd * 64 + c] : a.in[10][(size_t)l * 1024 + hd * 64 + c]; }
    }
    const int tw = wave >> 1, chh = wave & 1, cl = lane & 31, hh = lane >> 5;
    const int cin = 32 * chh + cl, cg_ = hd * 64 + cin;
    bf16x8 Bf[2][2][4];
    if constexpr (PASSC) {
        const bf16_t* GW = (const bf16_t*)(ws + WS_GW) + (size_t)(l * 16 + hd) * 16384;
#pragma unroll
        for (int i = 0; i < 4; ++i) *(LAS u32x4*)(lds + L2_GWL + (tid + 512 * i) * 16) = *(const u32x4*)(GW + (size_t)(tid + 512 * i) * 8);
    } else { const bf16_t* GWh = (const bf16_t*)(ws + WS_GW) + (size_t)(l * 16 + hd) * 16384;
#pragma unroll
      for (int dir = 0; dir < 2; ++dir)
#pragma unroll
          for (int gt = 0; gt < 2; ++gt)
#pragma unroll
              for (int s2 = 0; s2 < 4; ++s2) Bf[dir][gt][s2] = *(const bf16x8*)(GWh + (size_t)((((dir * 2 + gt) * 2 + chh) * 4 + s2) * 64 + lane) * 8); }
    float brv[2], biv[2], k8[2];
#pragma unroll
    for (int dir = 0; dir < 2; ++dir) {
        brv[dir] = a.in[13][(size_t)(l * 2 + dir) * 1024 + cg_]; biv[dir] = a.in[15][(size_t)(l * 2 + dir) * 1024 + cg_];
        k8[dir] = -8.0f * log1pf(__expf(-a.in[11][(size_t)(l * 2 + dir) * 1024 + cg_]));
    }
    const int t = tid >> 2, q = tid & 3, ch0 = hd * 64 + q * 16;
    const int hrow = (tid >> 2) < 2 ? (tid >> 2) : 130;
    u32x4 r0, r1, h0, h1;
    const u32x4 zero4 = {0u, 0u, 0u, 0u};
#define LRU_LOAD_RAW(ck) do { const int _t0 = (ck) * 128, _lo = (ck) < 2 ? 0 : CL, _hi = (ck) < 2 ? CL : R; \
        const bf16_t* _p = PX + (size_t)(_t0 + t) * DIN + ch0; r0 = *(const u32x4*)_p; r1 = *(const u32x4*)(_p + 8); \
        h0 = zero4; h1 = zero4; \
        if (tid < 12) { const int _gr = _t0 - 2 + hrow; if (_gr >= _lo && _gr < _hi) { const bf16_t* _ph = PX + (size_t)_gr * DIN + ch0; h0 = *(const u32x4*)_ph; h1 = *(const u32x4*)(_ph + 8); } } } while (0)
#define LRU_STORE_RAW(buf) do { LAS unsigned char* _rb = lds + L2_RAW + (buf) * RAW_BUFB; \
        *(LAS u32x4*)(_rb + (t + 2) * RAW_ROWB + 32 * q) = r0; *(LAS u32x4*)(_rb + (t + 2) * RAW_ROWB + 32 * q + 16) = r1; \
        if (tid < 12) { *(LAS u32x4*)(_rb + hrow * RAW_ROWB + 32 * q) = h0; *(LAS u32x4*)(_rb + hrow * RAW_ROWB + 32 * q + 16) = h1; } } while (0)
    LRU_LOAD_RAW(chunk);
    LRU_STORE_RAW(0);
    int cur = 0;
    __syncthreads();
#pragma unroll 1
    for (; chunk < NCHK; chunk += cstep) {
        const int nchunk = chunk + cstep;
        const bool has_next = nchunk < NCHK;
        u32x4 g0 = zero4, g1 = zero4; float cry[2] = {0.f, 0.f};
        if (PASSC) {
            const bf16_t* gp = PX + (size_t)(chunk * 128 + t) * DIN + 1024 + ch0;
            g0 = *(const u32x4*)gp; g1 = *(const u32x4*)(gp + 8);
            const float* CARRY = (const float*)(ws + WS_CARRY);
            cry[0] = CARRY[((size_t)0 * NCHK + chunk) * 1024 + cg_]; cry[1] = CARRY[((size_t)1 * NCHK + chunk) * 1024 + cg_];
        }
        if (has_next) LRU_LOAD_RAW(nchunk);
        {
            LAS unsigned char* rb = lds + L2_RAW + cur * RAW_BUFB;
            const int tg = tid >> 4, c4 = (tid & 15) * 4;
            f32x4 wv[4];
#pragma unroll
            for (int j = 0; j < 4; ++j) wv[j] = *(LAS f32x4*)(CW + j * 64 + c4);
            const f32x4 bb = *(LAS f32x4*)(CW + 256 + c4);
            f32x4 xr[7];
#pragma unroll
            for (int r = 0; r < 7; ++r) { const u32x2 pr = *(LAS u32x2*)(rb + (4 * tg + r) * RAW_ROWB + c4 * 2); xr[r] = (f32x4){bflo(pr.x), bfhi(pr.x), bflo(pr.y), bfhi(pr.y)}; }
#pragma unroll
            for (int tt = 0; tt < 4; ++tt) {
                const f32x4 xl = bb + wv[0] * xr[tt] + wv[1] * xr[tt + 1] + wv[2] * xr[tt + 2] + wv[3] * xr[tt + 3];
                *(LAS f32x4*)(XLF + (4 * tg + tt) * XLF_STRIDE + c4) = xl;
                u32x2 o; o.x = pk2(xl[0], xl[1]); o.y = pk2(xl[2], xl[3]);
                *(LAS u32x2*)(XLB + (4 * tg + tt) * XLB_STRIDE + c4) = o;
            }
        }
        __syncthreads();
        bf16x8 Af[4];
#pragma unroll
        for (int s = 0; s < 4; ++s) Af[s] = *(const LAS bf16x8*)(XLB + (32 * tw + cl) * XLB_STRIDE + 16 * s + 8 * hh);
        float xlv[16];
#pragma unroll
        for (int i = 0; i < 16; ++i) xlv[i] = XLF[(32 * tw + (i & 3) + 8 * (i >> 2) + 4 * hh) * XLF_STRIDE + cin];
        float av[2][16], bv[2][16], GA[2][8], GB[2][8];
#pragma unroll
        for (int dir = 0; dir < 2; ++dir) {
            f32x16 ar, ai;
#pragma unroll
            for (int i = 0; i < 16; ++i) { ar[i] = 0.f; ai[i] = 0.f; }
#pragma unroll
            for (int s = 0; s < 4; ++s) {
                if constexpr (PASSC) {
                    const bf16x8 Br = *(const LAS bf16x8*)(lds + L2_GWL + ((((dir * 2 + 0) * 2 + chh) * 4 + s) * 64 + lane) * 16);
                    const bf16x8 Bi = *(const LAS bf16x8*)(lds + L2_GWL + ((((dir * 2 + 1) * 2 + chh) * 4 + s) * 64 + lane) * 16);
                    ar = __builtin_amdgcn_mfma_f32_32x32x16_bf16(Af[s], Br, ar, 0, 0, 0);
                    ai = __builtin_amdgcn_mfma_f32_32x32x16_bf16(Af[s], Bi, ai, 0, 0, 0);
                } else {
                    ar = __builtin_amdgcn_mfma_f32_32x32x16_bf16(Af[s], Bf[dir][0][s], ar, 0, 0, 0);
                    ai = __builtin_amdgcn_mfma_f32_32x32x16_bf16(Af[s], Bf[dir][1][s], ai, 0, 0, 0);
                }
            }
#pragma unroll
            for (int i = 0; i < 16; ++i) {
                const float rg = sigm(ar[i] + brv[dir]), ig = sigm(ai[i] + biv[dir]);
                const float aa = __expf(k8[dir] * rg);
                av[dir][i] = aa;
                bv[dir][i] = __builtin_amdgcn_sqrtf(fmaxf(1.0f - aa * aa, 0.f)) * ig * xlv[i];
            }
            float oA[4], oB[4];
#pragma unroll
            for (int g = 0; g < 4; ++g) {
                const float a0 = av[dir][4 * g], a1 = av[dir][4 * g + 1], a2 = av[dir][4 * g + 2], a3 = av[dir][4 * g + 3];
                const float b0 = bv[dir][4 * g], b1 = bv[dir][4 * g + 1], b2 = bv[dir][4 * g + 2], b3 = bv[dir][4 * g + 3];
                oA[g] = (a0 * a1) * (a2 * a3);
                oB[g] = dir == 0 ? ((b0 * a1 + b1) * a2 + b2) * a3 + b3 : ((b3 * a2 + b2) * a1 + b1) * a0 + b0;
            }
#pragma unroll
            for (int g = 0; g < 4; ++g) {
                const float pA = __shfl_xor(oA[g], 32), pB = __shfl_xor(oB[g], 32);
                GA[dir][2 * g] = hh ? pA : oA[g]; GA[dir][2 * g + 1] = hh ? oA[g] : pA;
                GB[dir][2 * g] = hh ? pB : oB[g]; GB[dir][2 * g + 1] = hh ? oB[g] : pB;
            }
            float tA = 1.f, tB = 0.f;
            if (dir == 0) {
#pragma unroll
                for (int gq = 0; gq < 8; ++gq) { tB = GA[dir][gq] * tB + GB[dir][gq]; tA *= GA[dir][gq]; }
            } else {
#pragma unroll
                for (int gq = 7; gq >= 0; --gq) { tB = GA[dir][gq] * tB + GB[dir][gq]; tA *= GA[dir][gq]; }
            }
            if (hh == 0) TAGG[(tw * 2 + dir) * 64 + cin] = (f32x2){tA, tB};
        }
        if (has_next) LRU_STORE_RAW(cur ^ 1);
        __syncthreads();
        if constexpr (!PASSC) {
            if (tid < 128) {
                const int dir = tid >> 6, c = tid & 63;
                float cA = 1.f, cB = 0.f;
#pragma unroll
                for (int k = 0; k < 4; ++k) { const int t2 = dir == 0 ? k : 3 - k; const f32x2 v = TAGG[(t2 * 2 + dir) * 64 + c]; cB = v[0] * cB + v[1]; cA *= v[0]; }
                f32x2* AGG = (f32x2*)(ws + WS_AGG);
                AGG[((size_t)dir * NCHK + chunk) * 1024 + hd * 64 + c] = (f32x2){cA, cB};
            }
        } else {
            float yv[16];
#pragma unroll
            for (int dir = 0; dir < 2; ++dir) {
                float st = cry[dir];
                if (dir == 0) {
#pragma unroll
                    for (int t2 = 0; t2 < 3; ++t2) if (t2 < tw) { const f32x2 v = TAGG[(t2 * 2 + 0) * 64 + cin]; st = v[0] * st + v[1]; }
                } else {
#pragma unroll
                    for (int t2 = 3; t2 > 0; --t2) if (t2 > tw) { const f32x2 v = TAGG[(t2 * 2 + 1) * 64 + cin]; st = v[0] * st + v[1]; }
                }
                float hst[4];
                if (dir == 0) {
                    float s = st;
#pragma unroll
                    for (int g = 0; g < 4; ++g) { const float sE = s; s = GA[0][2 * g] * s + GB[0][2 * g]; const float sO = s; s = GA[0][2 * g + 1] * s + GB[0][2 * g + 1]; hst[g] = hh ? sO : sE; }
                } else {
                    float s = st;
#pragma unroll
                    for (int g = 3; g >= 0; --g) { const float sO = s; s = GA[1][2 * g + 1] * s + GB[1][2 * g + 1]; const float sE = s; s = GA[1][2 * g] * s + GB[1][2 * g]; hst[g] = hh ? sO : sE; }
                }
#pragma unroll
                for (int g = 0; g < 4; ++g) {
                    float h = hst[g];
                    if (dir == 0) {
#pragma unroll
                        for (int k = 0; k < 4; ++k) { h = av[0][4 * g + k] * h + bv[0][4 * g + k]; yv[4 * g + k] = h; }
                    } else {
#pragma unroll
                        for (int k = 3; k >= 0; --k) { h = av[1][4 * g + k] * h + bv[1][4 * g + k]; yv[4 * g + k] += h; }
                    }
                }
            }
            LAS bf16_t* YB = (LAS bf16_t*)(lds + L2_RAW + cur * RAW_BUFB);
#pragma unroll
            for (int i = 0; i < 16; ++i) YB[(32 * tw + (i & 3) + 8 * (i >> 2) + 4 * hh) * 72 + cin] = f2bf(yv[i]);
            __syncthreads();
            {
                const u32x4 y0 = *(LAS u32x4*)(YB + t * 72 + 16 * q), y1 = *(LAS u32x4*)(YB + t * 72 + 16 * q + 8);
                const unsigned yw[8] = {y0.x, y0.y, y0.z, y0.w, y1.x, y1.y, y1.z, y1.w};
                const unsigned gw_[8] = {g0.x, g0.y, g0.z, g0.w, g1.x, g1.y, g1.z, g1.w};
                unsigned ow[8];
#pragma unroll
                for (int j = 0; j < 8; ++j) ow[j] = pk2(bflo(yw[j]) * silu(bflo(gw_[j])), bfhi(yw[j]) * silu(bfhi(gw_[j])));
                bf16_t* yp = (bf16_t*)(ws + WS_Y) + (size_t)(chunk * 128 + t) * D + ch0;
                *(u32x4*)yp = (u32x4){ow[0], ow[1], ow[2], ow[3]}; *(u32x4*)(yp + 8) = (u32x4){ow[4], ow[5], ow[6], ow[7]};
            }
        }
        cur ^= 1;
    }
#undef LRU_LOAD_RAW
#undef LRU_STORE_RAW
}

constexpr int CV_ZT = 0;
constexpr int CV_CB = 94 * 1024;
static_assert(CV_CB + 16 * 512 * 4 <= LDS_BYTES, "conv lds map");
__device__ __forceinline__ void conv_item2(const Args a, int l, int ct, LAS unsigned char* lds) {
    const int tid = tid_fresh(), lane = tid & 63, wave = tid >> 6, c = tid;
    unsigned char* ws = ptr_fresh(a.ws);
    const bf16_t* PX = (const bf16_t*)(ws + WS_PX); bf16_t* Y = (bf16_t*)(ws + WS_Y);
    LAS bf16_t* ZT = (LAS bf16_t*)(lds + CV_ZT);
    LAS float* CB = (LAS float*)(lds + CV_CB);
    const int t0 = ct * 64, seg_lo = t0 < CL ? 0 : CL, seg_hi = t0 < CL ? CL : R;
    __syncthreads();
#pragma unroll 4
    for (int it = 0; it < 12; ++it) {
        const int pid = tid + 512 * it, e = pid >> 6, pc = pid & 63;
        if (e < 94) {
            const int rr = t0 - 15 + e, rc = rr < seg_lo ? seg_lo : (rr >= seg_hi ? seg_hi - 1 : rr);
            const u32x4 v = *(const u32x4*)(PX + (size_t)rc * DIN + 2048 + 8 * pc), g = *(const u32x4*)(PX + (size_t)rc * DIN + 2560 + 8 * pc);
            const unsigned vw[4] = {v.x, v.y, v.z, v.w}, gw_[4] = {g.x, g.y, g.z, g.w};
            u32x4 o;
            unsigned ow[4];
#pragma unroll
            for (int j = 0; j < 4; ++j) ow[j] = pk2(bflo(vw[j]) * sigm(bflo(gw_[j])), bfhi(vw[j]) * sigm(bfhi(gw_[j])));
            const bool ok = rr == rc;
            o.x = ok ? ow[0] : 0u; o.y = ok ? ow[1] : 0u; o.z = ok ? ow[2] : 0u; o.w = ok ? ow[3] : 0u;
            *(LAS u32x4*)(ZT + e * 512 + 8 * pc) = o;
        }
    }
    float w[31];
#pragma unroll
    for (int j = 0; j < 31; ++j) w[j] = a.in[16][((size_t)l * 31 + j) * 512 + c];
    const float bias = a.in[17][l * 512 + c];
    float lg[8], lb[8];
    { const f32x4 x0 = *(const f32x4*)(a.in[18] + l * 512 + 8 * lane), x1 = *(const f32x4*)(a.in[18] + l * 512 + 8 * lane + 4), y0 = *(const f32x4*)(a.in[19] + l * 512 + 8 * lane), y1 = *(const f32x4*)(a.in[19] + l * 512 + 8 * lane + 4);
#pragma unroll
      for (int k = 0; k < 4; ++k) { lg[k] = x0[k]; lg[4 + k] = x1[k]; lb[k] = y0[k]; lb[4 + k] = y1[k]; } }
    __syncthreads();
    float win[32];
#pragma unroll
    for (int e = 0; e < 30; ++e) win[e] = bf1(ZT[e * 512 + c]);
    win[30] = 0.f; win[31] = 0.f;
#pragma unroll 1
    for (int bb = 0; bb < 2; ++bb) {
#pragma unroll
        for (int hb = 0; hb < 2; ++hb) {
            u32x4 gt[2];
#pragma unroll
            for (int uu = 0; uu < 2; ++uu) gt[uu] = *(const u32x4*)(PX + (size_t)(t0 + 32 * bb + 16 * hb + wave * 2 + uu) * DIN + 3072 + 8 * lane);
#pragma unroll
            for (int u16 = 0; u16 < 16; ++u16) {
                const int u = 16 * hb + u16;
                win[(u + 30) & 31] = bf1(ZT[(32 * bb + u + 30) * 512 + c]);
                float acc = bias;
#pragma unroll
                for (int j = 0; j < 31; ++j) acc += w[j] * win[(u + j) & 31];
                CB[u16 * 512 + c] = acc;
            }
            __syncthreads();
#pragma unroll
            for (int uu = 0; uu < 2; ++uu) {
                const int u = wave * 2 + uu, row = t0 + 32 * bb + 16 * hb + u;
                float v[8]; float s = 0.f;
                { const f32x4 c0 = *(LAS f32x4*)(CB + u * 512 + 8 * lane), c1 = *(LAS f32x4*)(CB + u * 512 + 8 * lane + 4);
#pragma unroll
                  for (int k = 0; k < 4; ++k) { v[k] = c0[k]; v[4 + k] = c1[k]; } }
#pragma unroll
                for (int k = 0; k < 8; ++k) s += v[k];
                const float mean = wave_sum(s) * (1.0f / 512.0f);
                float s2 = 0.f;
#pragma unroll
                for (int k = 0; k < 8; ++k) { v[k] -= mean; s2 += v[k] * v[k]; }
                const float rstd = 1.0f / sqrtf(wave_sum(s2) * (1.0f / 512.0f) + EPS);
                const unsigned gw_[4] = {gt[uu].x, gt[uu].y, gt[uu].z, gt[uu].w};
                unsigned ow[4];
#pragma unroll
                for (int k = 0; k < 4; ++k) {
                    const float y0 = silu(v[2 * k] * rstd * lg[2 * k] + lb[2 * k]) * silu(bflo(gw_[k]));
                    const float y1 = silu(v[2 * k + 1] * rstd * lg[2 * k + 1] + lb[2 * k + 1]) * silu(bfhi(gw_[k]));
                    ow[k] = pk2(y0, y1);
                }
                *(u32x4*)(Y + (size_t)row * D + 1024 + 8 * lane) = (u32x4){ow[0], ow[1], ow[2], ow[3]};
            }
            __syncthreads();
        }
    }
}

__device__ __forceinline__ void sgu_item2(const Args a, int l, int item, LAS unsigned char* lds) {
    const int tid = tid_fresh(), lane = tid & 63, wave = tid >> 6;
    unsigned char* ws = ptr_fresh(a.ws);
    const bf16_t* PX = (const bf16_t*)(ws + WS_PX); bf16_t* Y = (bf16_t*)(ws + WS_Y);
    const bf16_t* SW = (const bf16_t*)(ws + WS_SW) + (size_t)l * 8 * 128 * 128;
    LAS f32x2* ST = (LAS f32x2*)lds;
    LAS bf16_t* TT = (LAS bf16_t*)(lds + 1024);
    const int sc = item >> 1, hg = item & 1, t0 = sc * 128;
    __syncthreads();
#pragma unroll
    for (int kb = 0; kb < 2; ++kb) {
        u32x4 p[8];
#pragma unroll
        for (int k = 0; k < 8; ++k) p[k] = *(const u32x4*)(PX + (size_t)(t0 + wave * 16 + kb * 8 + k) * DIN + 4096 + 8 * lane);
#pragma unroll
        for (int k = 0; k < 8; ++k) {
            float g[8] = {gelu_t(bflo(p[k].x)), gelu_t(bfhi(p[k].x)), gelu_t(bflo(p[k].y)), gelu_t(bfhi(p[k].y)), gelu_t(bflo(p[k].z)), gelu_t(bfhi(p[k].z)), gelu_t(bflo(p[k].w)), gelu_t(bfhi(p[k].w))};
            float s = 0.f;
#pragma unroll
            for (int j = 0; j < 8; ++j) s += g[j];
            const float mean = wave_sum(s) * (1.0f / 512.0f);
            float s2 = 0.f;
#pragma unroll
            for (int j = 0; j < 8; ++j) { const float d = g[j] - mean; s2 += d * d; }
            const float rstd = 1.0f / sqrtf(wave_sum(s2) * (1.0f / 512.0f) + EPS);
            if (lane == 0) ST[wave * 16 + kb * 8 + k] = (f32x2){mean, rstd};
        }
    }
    __syncthreads();
    const int p_ = tid >> 2, dq = tid & 3;
    const f32x2 st = ST[p_];
    const int fr = lane & 15, fq = lane >> 4;
    LAS float* SO = (LAS float*)(lds + 1024 + 2 * 64 * TT_STRIDE * 2);
    u32x4 Lq0[2], Lq1[2], Lu0[2], Lu1[2], Lg0[2], Lg1[2]; bf16x8 LA[2][4]; f32x4 Llg[2][4], Llb[2][4]; float Lbs[2];
#define SGU_LOAD(sl, h_) do { const int _ch = 64 * (h_) + 16 * dq; const bf16_t* _pr = PX + (size_t)(t0 + p_) * DIN + _ch; \
        Lq0[sl] = *(const u32x4*)(_pr + 4096); Lq1[sl] = *(const u32x4*)(_pr + 4096 + 8); Lu0[sl] = *(const u32x4*)(_pr + 3584); Lu1[sl] = *(const u32x4*)(_pr + 3584 + 8); \
        Lg0[sl] = *(const u32x4*)(_pr + 4608); Lg1[sl] = *(const u32x4*)(_pr + 4608 + 8); \
        _Pragma("unroll") for (int s = 0; s < 4; ++s) LA[sl][s] = *(const bf16x8*)(SW + ((size_t)(h_) * 128 + 16 * wave + fr) * 128 + 32 * s + 8 * fq); \
        Lbs[sl] = a.in[23][((size_t)l * 8 + (h_)) * 128 + p_]; \
        _Pragma("unroll") for (int j = 0; j < 4; ++j) { Llg[sl][j] = *(const f32x4*)(a.in[20] + l * 512 + _ch + 4 * j); Llb[sl][j] = *(const f32x4*)(a.in[21] + l * 512 + _ch + 4 * j); } } while (0)
    SGU_LOAD(0, 4 * hg);
#pragma unroll
    for (int h4 = 0; h4 < 4; ++h4) {
        const int h = 4 * hg + h4, sl = h4 & 1;
        LAS bf16_t* tt = TT + (h4 & 1) * (64 * TT_STRIDE);
        if (h4 + 1 < 4) SGU_LOAD(sl ^ 1, h + 1);
        const int ch = 64 * h + 16 * dq;
        const u32x4 q0 = Lq0[sl], q1 = Lq1[sl], u0 = Lu0[sl], u1 = Lu1[sl], g0 = Lg0[sl], g1 = Lg1[sl];
        bf16x8 Afr[4];
#pragma unroll
        for (int s = 0; s < 4; ++s) Afr[s] = LA[sl][s];
        const float bs = Lbs[sl];
        f32x4 lgv[4], lbv[4];
#pragma unroll
        for (int j = 0; j < 4; ++j) { lgv[j] = Llg[sl][j]; lbv[j] = Llb[sl][j]; }
        {
            const unsigned pw[8] = {q0.x, q0.y, q0.z, q0.w, q1.x, q1.y, q1.z, q1.w};
#pragma unroll
            for (int j = 0; j < 8; ++j) {
                const float v0 = (gelu_t(bflo(pw[j])) - st[0]) * st[1] * lgv[j >> 1][(2 * j) & 3] + lbv[j >> 1][(2 * j) & 3];
                const float v1 = (gelu_t(bfhi(pw[j])) - st[0]) * st[1] * lgv[j >> 1][(2 * j + 1) & 3] + lbv[j >> 1][(2 * j + 1) & 3];
                tt[(16 * dq + 2 * j) * TT_STRIDE + (p_ ^ (16 * dq))] = f2bf(v0);
                tt[(16 * dq + 2 * j + 1) * TT_STRIDE + (p_ ^ (16 * dq))] = f2bf(v1);
            }
        }
        __syncthreads();
        f32x4 acc[4];
#pragma unroll
        for (int nt = 0; nt < 4; ++nt) acc[nt] = (f32x4){0.f, 0.f, 0.f, 0.f};
#pragma unroll
        for (int s = 0; s < 4; ++s)
#pragma unroll
            for (int nt = 0; nt < 4; ++nt) {
                const bf16x8 Bfr = *(const LAS bf16x8*)(tt + (16 * nt + fr) * TT_STRIDE + ((32 * s + 8 * fq) ^ (16 * nt)))    ;
                acc[nt] = __builtin_amdgcn_mfma_f32_16x16x32_bf16(Afr[s], Bfr, acc[nt], 0, 0, 0);
            }
#pragma unroll
        for (int reg = 0; reg < 4; ++reg)
#pragma unroll
            for (int nt = 0; nt < 4; ++nt) SO[(16 * wave + 4 * fq + reg) * 68 + 16 * nt + fr] = acc[nt][reg];
        __syncthreads();
        {
            const unsigned uw[8] = {u0.x, u0.y, u0.z, u0.w, u1.x, u1.y, u1.z, u1.w}, gw_[8] = {g0.x, g0.y, g0.z, g0.w, g1.x, g1.y, g1.z, g1.w};
            unsigned ow[8];
#pragma unroll
            for (int j4 = 0; j4 < 4; ++j4) {
                const f32x4 sv = *(LAS f32x4*)(SO + p_ * 68 + 16 * dq + 4 * j4);
                ow[2 * j4] = pk2(gelu_t(bflo(uw[2 * j4])) * (sv[0] + bs) * silu(bflo(gw_[2 * j4])), gelu_t(bfhi(uw[2 * j4])) * (sv[1] + bs) * silu(bfhi(gw_[2 * j4])));
                ow[2 * j4 + 1] = pk2(gelu_t(bflo(uw[2 * j4 + 1])) * (sv[2] + bs) * silu(bflo(gw_[2 * j4 + 1])), gelu_t(bfhi(uw[2 * j4 + 1])) * (sv[3] + bs) * silu(bfhi(gw_[2 * j4 + 1])));
            }
            bf16_t* yp = Y + (size_t)(t0 + p_) * D + 1536 + ch;
            *(u32x4*)yp = (u32x4){ow[0], ow[1], ow[2], ow[3]}; *(u32x4*)(yp + 8) = (u32x4){ow[4], ow[5], ow[6], ow[7]};
        }
    }
#undef SGU_LOAD
}

__device__ __forceinline__ int scan_chunk(int dir, int o) { return dir == 0 ? o : (o == 0 ? 1 : (o == 1 ? 0 : (NCHK + 1 - o))); }
__device__ __forceinline__ void phase_carry(const Args a, LAS unsigned char* lds) {
    const int tid = tid_fresh(), b = blockIdx.x, G = gridDim.x;
    unsigned char* ws = ptr_fresh(a.ws);
    const f32x2* AGG = (const f32x2*)(ws + WS_AGG); float* CARRY = (float*)(ws + WS_CARRY);
    LAS f32x2* SEG = (LAS f32x2*)lds;
    for (int u = b; u < 64; u += G) {
        const int dir = u >> 5, ch = (u & 31) * 32 + (tid & 31), sg = tid >> 5;
        f32x2 ab[10];
        if (sg < 13) {
#pragma unroll
            for (int k = 0; k < 10; ++k) ab[k] = AGG[((size_t)dir * NCHK + scan_chunk(dir, 10 * sg + k)) * 1024 + ch];
            float sA = 1.f, sB = 0.f;
#pragma unroll
            for (int k = 0; k < 10; ++k) { sB = ab[k][0] * sB + ab[k][1]; sA *= ab[k][0]; }
            SEG[sg * 32 + (tid & 31)] = (f32x2){sA, sB};
        }
        __syncthreads();
        if (sg < 13) {
            float st = 0.f;
            for (int s2 = 0; s2 < sg; ++s2) { const f32x2 v = SEG[s2 * 32 + (tid & 31)]; st = v[0] * st + v[1]; }
#pragma unroll
            for (int k = 0; k < 10; ++k) { CARRY[((size_t)dir * NCHK + scan_chunk(dir, 10 * sg + k)) * 1024 + ch] = st; st = ab[k][0] * st + ab[k][1]; }
        }
        __syncthreads();
    }
}

__device__ __forceinline__ void phase_resid0(const Args a) {
    const int tid = tid_fresh(), lane = tid & 63, wave = tid >> 6, b = blockIdx.x, G = gridDim.x;
    unsigned char* ws = ptr_fresh(a.ws);
    const bf16_t* DL0 = (const bf16_t*)(ws + WS_DL0);
    const float* gg0 = (const float*)(ws + WS_GG);
    const float* gg = (const float*)(ws + WS_GG) + (size_t)2 * D;
    bf16_t* XG = (bf16_t*)(ws + WS_XG) + (size_t)CL * D; float* rss1 = (float*)(ws + WS_RSS) + R + CL;
    f32x4 g[8], rg0[8];
#pragma unroll
    for (int j = 0; j < 4; ++j) { g[2 * j] = *(const f32x4*)(gg + 8 * (lane + 64 * j)); g[2 * j + 1] = *(const f32x4*)(gg + 8 * (lane + 64 * j) + 4);
        const f32x4 h0 = *(const f32x4*)(gg0 + 8 * (lane + 64 * j)), h1 = *(const f32x4*)(gg0 + 8 * (lane + 64 * j) + 4);
        rg0[2 * j] = (f32x4){1.0f / h0[0], 1.0f / h0[1], 1.0f / h0[2], 1.0f / h0[3]}; rg0[2 * j + 1] = (f32x4){1.0f / h1[0], 1.0f / h1[1], 1.0f / h1[2], 1.0f / h1[3]}; }
    u32x4 xr[4], dr[4];
#define RS_LOAD(t_, X, Dd) do { _Pragma("unroll") for (int j = 0; j < 4; ++j) { X[j] = *(const u32x4*)(XG + (size_t)(t_) * D + 8 * (lane + 64 * j)); Dd[j] = *(const u32x4*)(DL0 + (size_t)(t_) * D + 8 * (lane + 64 * j)); } } while (0)
    int t = b * 8 + wave;
    if (t < T) RS_LOAD(t, xr, dr);
    for (; t < T; t += G * 8) {
        u32x4 xn[4], dn[4];
        const int tn = t + G * 8;
        if (tn < T) RS_LOAD(tn, xn, dn);
        f32x4 v[8]; float ss = 0.f;
#pragma unroll
        for (int j = 0; j < 4; ++j) {
            v[2 * j] = (f32x4){bflo(xr[j].x), bfhi(xr[j].x), bflo(xr[j].y), bfhi(xr[j].y)} * rg0[2 * j] + (f32x4){bflo(dr[j].x), bfhi(dr[j].x), bflo(dr[j].y), bfhi(dr[j].y)};
            v[2 * j + 1] = (f32x4){bflo(xr[j].z), bfhi(xr[j].z), bflo(xr[j].w), bfhi(xr[j].w)} * rg0[2 * j + 1] + (f32x4){bflo(dr[j].z), bfhi(dr[j].z), bflo(dr[j].w), bfhi(dr[j].w)};
        }
#pragma unroll
        for (int j = 0; j < 8; ++j) ss += (v[j][0] * v[j][0] + v[j][1] * v[j][1]) + (v[j][2] * v[j][2] + v[j][3] * v[j][3]);
#pragma unroll
        for (int j = 0; j < 4; ++j) {
            const f32x4 p0 = v[2 * j] * g[2 * j], p1 = v[2 * j + 1] * g[2 * j + 1];
            u32x4 w; w.x = pk2(p0[0], p0[1]); w.y = pk2(p0[2], p0[3]); w.z = pk2(p1[0], p1[1]); w.w = pk2(p1[2], p1[3]);
            *(u32x4*)(XG + (size_t)t * D + 8 * (lane + 64 * j)) = w;
        }
        ss = wave_sum(ss);
        if (lane == 0) rss1[t] = ss;
        if (tn < T) {
#pragma unroll
            for (int j = 0; j < 4; ++j) { xr[j] = xn[j]; dr[j] = dn[j]; }
        }
    }
#undef RS_LOAD
}
__device__ __forceinline__ void phase_final(const Args a) {
    const int tid = tid_fresh(), lane = tid & 63, wave = tid >> 6, b = blockIdx.x, G = gridDim.x;
    unsigned char* ws = ptr_fresh(a.ws);
    const bf16_t* XG1 = (const bf16_t*)(ws + WS_XG) + (size_t)CL * D;
    const bf16_t* DL1 = (const bf16_t*)(ws + WS_DL0);
    const float* fg = a.in[24];
    const float* gg = (const float*)(ws + WS_GG) + (size_t)2 * D;
    u32x4 xr[4], er[4];
#define FN_LOAD(t_, X, Ee) do { _Pragma("unroll") for (int j = 0; j < 4; ++j) { X[j] = *(const u32x4*)(XG1 + (size_t)(t_) * D + 8 * (lane + 64 * j)); Ee[j] = *(const u32x4*)(DL1 + (size_t)(t_) * D + 8 * (lane + 64 * j)); } } while (0)
    f32x4 fgv[8], rg[8];
#pragma unroll
    for (int j = 0; j < 4; ++j) { fgv[2 * j] = *(const f32x4*)(fg + 8 * (lane + 64 * j)); fgv[2 * j + 1] = *(const f32x4*)(fg + 8 * (lane + 64 * j) + 4);
        const f32x4 g0 = *(const f32x4*)(gg + 8 * (lane + 64 * j)), g1 = *(const f32x4*)(gg + 8 * (lane + 64 * j) + 4);
        rg[2 * j] = (f32x4){1.0f / g0[0], 1.0f / g0[1], 1.0f / g0[2], 1.0f / g0[3]}; rg[2 * j + 1] = (f32x4){1.0f / g1[0], 1.0f / g1[1], 1.0f / g1[2], 1.0f / g1[3]}; }
    int t = b * 8 + wave;
    if (t < T) FN_LOAD(t, xr, er);
    for (; t < T; t += G * 8) {
        u32x4 xn[4], en[4];
        const int tn = t + G * 8;
        if (tn < T) FN_LOAD(tn, xn, en);
        float* orow = a.out + (size_t)t * D;
        f32x4 v[8]; float ss = 0.f;
#pragma unroll
        for (int j = 0; j < 4; ++j) {
            v[2 * j] = (f32x4){bflo(xr[j].x), bfhi(xr[j].x), bflo(xr[j].y), bfhi(xr[j].y)} * rg[2 * j] + (f32x4){bflo(er[j].x), bfhi(er[j].x), bflo(er[j].y), bfhi(er[j].y)};
            v[2 * j + 1] = (f32x4){bflo(xr[j].z), bfhi(xr[j].z), bflo(xr[j].w), bfhi(xr[j].w)} * rg[2 * j + 1] + (f32x4){bflo(er[j].z), bfhi(er[j].z), bflo(er[j].w), bfhi(er[j].w)};
        }
#pragma unroll
        for (int j = 0; j < 8; ++j) ss += (v[j][0] * v[j][0] + v[j][1] * v[j][1]) + (v[j][2] * v[j][2] + v[j][3] * v[j][3]);
        const float rs = 1.0f / sqrtf(wave_sum(ss) * (1.0f / D) + EPS);
#pragma unroll
        for (int j = 0; j < 4; ++j) {
            *(f32x4*)(orow + 8 * (lane + 64 * j)) = v[2 * j] * rs * fgv[2 * j]; *(f32x4*)(orow + 8 * (lane + 64 * j) + 4) = v[2 * j + 1] * rs * fgv[2 * j + 1];
        }
        if (tn < T) {
#pragma unroll
            for (int j = 0; j < 4; ++j) { xr[j] = xn[j]; er[j] = en[j]; }
        }
    }
#undef FN_LOAD
}

template <int NT, int MODE>
__device__ __forceinline__ void ctx_gemm(const Args a, int l, LAS unsigned char* lds) {
    const int tid = tid_fresh(), lane = tid & 63, wave = tid >> 6, b = blockIdx.x, G = gridDim.x;
    unsigned char* ws = ptr_fresh(a.ws);
    constexpr int TN = 16 * NT, N = 64 * TN, TS = TN + 4;
    const bf16_t* A = (const bf16_t*)(ws + (MODE == 0 ? WS_XG : WS_Y));
    const bf16_t* Bt = MODE == 0 ? (const bf16_t*)(ws + WS_WINT) + (size_t)l * DIN * D : (const bf16_t*)(ws + WS_WOUTT) + (size_t)l * D * D;
    LAS float* CT = (LAS float*)lds;
    const int fr = lane & 15, fq = lane >> 4;
#pragma unroll 1
    for (int tile = b; tile < 256; tile += G) {
        const int r0 = (tile >> 6) * 64, n0 = (tile & 63) * TN;
        __syncthreads();
        f32x4 acc[4][NT];
#pragma unroll
        for (int m = 0; m < 4; ++m)
#pragma unroll
            for (int n = 0; n < NT; ++n) acc[m][n] = (f32x4){0.f, 0.f, 0.f, 0.f};
        const bf16_t* ap = A + (size_t)(r0 + fr) * D + wave * 256 + 8 * fq;
        const bf16_t* bp = Bt + (size_t)(n0 + fr) * D + wave * 256 + 8 * fq;
        bf16x8 af[2][4], bfr[2][NT];
#define CTXG_LOAD(buf, ks_) do { _Pragma("unroll") for (int m = 0; m < 4; ++m) af[buf][m] = *(const bf16x8*)(ap + (size_t)(16 * m) * D + 32 * (ks_)); \
        _Pragma("unroll") for (int n = 0; n < NT; ++n) bfr[buf][n] = *(const bf16x8*)(bp + (size_t)(16 * n) * D + 32 * (ks_)); } while (0)
#define CTXG_MMA(buf) do { _Pragma("unroll") for (int m = 0; m < 4; ++m) _Pragma("unroll") for (int n = 0; n < NT; ++n) \
        acc[m][n] = __builtin_amdgcn_mfma_f32_16x16x32_bf16(af[buf][m], bfr[buf][n], acc[m][n], 0, 0, 0); } while (0)
        CTXG_LOAD(0, 0);
#pragma unroll
        for (int ks = 0; ks < 8; ks += 2) {
            CTXG_LOAD(1, ks + 1);
            __builtin_amdgcn_sched_barrier(0);
            CTXG_MMA(0);
            __builtin_amdgcn_sched_barrier(0);
            if (ks + 2 < 8) CTXG_LOAD(0, ks + 2);
            __builtin_amdgcn_sched_barrier(0);
            CTXG_MMA(1);
            __builtin_amdgcn_sched_barrier(0);
        }
#undef CTXG_LOAD
#undef CTXG_MMA
#pragma unroll
        for (int ps = 0; ps < 2; ++ps) {
#pragma unroll
            for (int m2 = 0; m2 < 2; ++m2)
#pragma unroll
                for (int n = 0; n < NT; ++n)
#pragma unroll
                    for (int reg = 0; reg < 4; ++reg) CT[(wave * 32 + 16 * m2 + 4 * fq + reg) * TS + 16 * n + fr] = acc[2 * ps + m2][n][reg];
            __syncthreads();
            for (int wi = tid; wi < 32 * (TN / 8); wi += 512) {
                const int rr = wi / (TN / 8), cgp = wi % (TN / 8), row = r0 + 32 * ps + rr, col = n0 + 8 * cgp;
                f32x4 c0 = {0.f, 0.f, 0.f, 0.f}, c1 = {0.f, 0.f, 0.f, 0.f};
#pragma unroll
                for (int w8 = 0; w8 < 8; ++w8) { c0 += *(LAS f32x4*)(CT + (w8 * 32 + rr) * TS + 8 * cgp); c1 += *(LAS f32x4*)(CT + (w8 * 32 + rr) * TS + 8 * cgp + 4); }
                if (MODE == 0) {
                    const float* rss = (const float*)(ws + WS_RSS) + (size_t)l * R;
                    const float* shw = (const float*)(ws + WS_SHW) + (size_t)(l * 2 + 1) * DIN;
                    bf16_t* PXo = (bf16_t*)(ws + WS_PX);
                    const float rs = 1.0f / sqrtf(rss[row] * (1.0f / D) + EPS);
                    const f32x4 s0 = *(const f32x4*)(shw + col), s1 = *(const f32x4*)(shw + col + 4);
                    const f32x4 v0 = c0 * rs + s0, v1 = c1 * rs + s1;
                    u32x4 w; w.x = pk2(v0[0], v0[1]); w.y = pk2(v0[2], v0[3]); w.z = pk2(v1[0], v1[1]); w.w = pk2(v1[2], v1[3]);
                    *(u32x4*)(PXo + (size_t)row * DIN + col) = w;
                } else {
                    const float* gp = (const float*)(ws + WS_MOD) + (size_t)(l * 2 + 1) * 6144 + 4096;
                    const float* ggp = (const float*)(ws + WS_GG) + (size_t)((l + 1) * 2 + 1) * D;
                    float* rssn = (float*)(ws + WS_RSS) + (size_t)(l + 1) * R;
                    float* xn = (float*)(ws + WS_X1C); bf16_t* XG = (bf16_t*)(ws + WS_XG);
                    const f32x4 o0 = *(const f32x4*)(a.in[2] + (size_t)row * D + col), o1 = *(const f32x4*)(a.in[2] + (size_t)row * D + col + 4);
                    const f32x4 g0 = *(const f32x4*)(gp + col), g1 = *(const f32x4*)(gp + col + 4);
                    const f32x4 v0 = o0 + g0 * c0, v1 = o1 + g1 * c1;
                    *(f32x4*)(xn + (size_t)row * D + col) = v0; *(f32x4*)(xn + (size_t)row * D + col + 4) = v1;
                    const f32x4 q0 = *(const f32x4*)(ggp + col), q1 = *(const f32x4*)(ggp + col + 4);
                    const f32x4 a0 = v0 * q0, a1 = v1 * q1;
                    u32x4 w; w.x = pk2(a0[0], a0[1]); w.y = pk2(a0[2], a0[3]); w.z = pk2(a1[0], a1[1]); w.w = pk2(a1[2], a1[3]);
                    *(u32x4*)(XG + (size_t)row * D + col) = w;
                    const float ss = (v0[0] * v0[0] + v0[1] * v0[1]) + (v0[2] * v0[2] + v0[3] * v0[3]) + (v1[0] * v1[0] + v1[1] * v1[1]) + (v1[2] * v1[2] + v1[3] * v1[3]);
                    unsafeAtomicAdd(rssn + row, ss);
                }
            }
            __syncthreads();
        }
    }
    __syncthreads();
}

#define XB_TMO      128
#define XB_XCNT(j)  (256  + 64 * (j))
#define XB_XSUB(j)  (1280 + 64 * (j))
#define XB_XGEN(j)  (2304 + 64 * (j))
#define XB_TOP      3328
#define XB_TOPGEN   3392
#define XCD_BAR_WORDS 3456
#define XB_SPIN_CAP (1u << 18)

__device__ __forceinline__ unsigned xb_ld(unsigned* p)              { return __hip_atomic_load(p, __ATOMIC_RELAXED, __HIP_MEMORY_SCOPE_AGENT); }
__device__ __forceinline__ unsigned xb_add(unsigned* p, unsigned v) { return __hip_atomic_fetch_add(p, v, __ATOMIC_RELAXED, __HIP_MEMORY_SCOPE_AGENT); }
__device__ __forceinline__ unsigned xb_xcc_id() { return (unsigned)__builtin_amdgcn_s_getreg((3 << 11) | 20) & 0xFu; }
#define XB_SPIN(cond, bar) do { unsigned _sp = 0; while (cond) { __builtin_amdgcn_s_sleep(1); \
    if ((++_sp & 255u) == 0u) { if (xb_ld(&(bar)[XB_TMO])) break; if (_sp > XB_SPIN_CAP) { atomicAdd(&(bar)[XB_TMO], 1u); break; } } } } while (0)

struct XcdBarrier {
    unsigned* bar; unsigned x;
    volatile LAS unsigned* st;
};

__device__ __forceinline__ XcdBarrier xcd_barrier_post(unsigned* bar, volatile LAS unsigned* st) {
    XcdBarrier b; b.bar = bar; b.x = xb_xcc_id(); b.st = st;
    if (threadIdx.x == 0) (void)xb_add(&bar[XB_XCNT(b.x)], 1u);
    return b;
}
__device__ __forceinline__ void xcd_barrier_complete(unsigned* bar, unsigned x, unsigned& nloc, unsigned& nx) {
    const unsigned G = gridDim.x * gridDim.y * gridDim.z;
    unsigned sum, cnt, mine, sp = 0u;
    for (;;) {
        sum = 0u; cnt = 0u; mine = 0u;
#pragma unroll
        for (unsigned j = 0; j < 16; ++j) { const unsigned c = xb_ld(&bar[XB_XCNT(j)]); sum += c; cnt += (c > 0u) ? 1u : 0u; mine = (j == x) ? c : mine; }
        if (sum == G) break;
        __builtin_amdgcn_s_sleep(1);
        if ((++sp & 255u) == 0u) { if (xb_ld(&bar[XB_TMO])) break; if (sp > XB_SPIN_CAP) { atomicAdd(&bar[XB_TMO], 1u); break; } }
    }
    nloc = mine > 0u ? mine : 1u; nx = cnt > 0u ? cnt : 1u;
}

__device__ __forceinline__ void xcd_barrier(const XcdBarrier& b) {
    asm volatile("s_waitcnt vmcnt(0)" ::: "memory");
    __syncthreads();
    if (threadIdx.x == 0) {
        unsigned* bar = b.bar;
        __builtin_amdgcn_s_waitcnt(0);
        unsigned nloc = b.st[0], nx = b.st[1];
        if (nloc == 0u) { xcd_barrier_complete(bar, b.x, nloc, nx); b.st[0] = nloc; b.st[1] = nx; }
        const unsigned old = xb_add(&bar[XB_XSUB(b.x)], 1u);
        const unsigned gen = old / nloc;
        if (old + 1u == (gen + 1u) * nloc) {
            __builtin_amdgcn_fence(__ATOMIC_RELEASE, "agent");
            asm volatile("s_waitcnt vmcnt(0)" ::: "memory");
            const unsigned og = xb_add(&bar[XB_TOP], 1u);
            const unsigned tg = og / nx;
            if (og + 1u == (tg + 1u) * nx) xb_add(&bar[XB_TOPGEN], 1u);
            else XB_SPIN(xb_ld(&bar[XB_TOPGEN]) == tg, bar);
            __builtin_amdgcn_fence(__ATOMIC_ACQUIRE, "agent");
            xb_add(&bar[XB_XGEN(b.x)], 1u);
            asm volatile("s_waitcnt vmcnt(0)" ::: "memory");
        } else {
            XB_SPIN(xb_ld(&bar[XB_XGEN(b.x)]) == gen, bar);
            __builtin_amdgcn_fence(__ATOMIC_ACQUIRE, "agent");
            asm volatile("s_waitcnt vmcnt(0)" ::: "memory");
        }
    }
    __syncthreads();
}


__global__ void __launch_bounds__(512, 2) mega_fwd(Args a) {
    extern __shared__ __attribute__((aligned(16))) unsigned char lds_raw[];
    LAS unsigned char* lds = (LAS unsigned char*)lds_raw;
    cg::grid_group grid = cg::this_grid();
    const int lo = a.ph_lo, hi = a.ph_hi;
    const int b = blockIdx.x, G = gridDim.x;
    unsigned char* ws = ptr_fresh(a.ws);
    { volatile LAS unsigned* xst = (volatile LAS unsigned*)(lds + LDS_BYTES - 16); if (threadIdx.x < 4) xst[threadIdx.x] = 0u; }
    __syncthreads();
    const XcdBarrier xbar = xcd_barrier_post((unsigned*)(a.ws + WS_BAR), (volatile LAS unsigned*)(lds + LDS_BYTES - 16));
#ifndef PHMASK
#define PHMASK 0x1fff
#endif
#define IN(k) (((PHMASK >> (k)) & 1) && lo <= (k) && (k) < hi)
#ifndef DUPMASK
#define DUPMASK 0
#endif
#define DUP(k) ((DUPMASK >> (k)) & 1)
#define GSYNC(k) do { if (a.ph_lo < 0) grid.sync();     \
    xcd_barrier(xbar); } while (0)
#define SEAM(k) do { if (IN(k) && IN((k) + 1)) GSYNC(k); } while (0)
#define REPB(k) for (int rep_ = 0; rep_ <= DUP(k); ++rep_) { if (rep_) xcd_barrier(xbar);
#define REPE }
    if (IN(0)) { REPB(0) phase0a(a, lds); REPE }
    SEAM(0);
    if (IN(1)) { REPB(1) phase0b(a, lds); REPE }
    SEAM(1);
#pragma unroll 1
    for (int l = 0; l < 2; ++l) {
        const int pb = 2 + 5 * l; const bool last = (l == 1);
        if (IN(pb) && (PHMASK & 0x84)) { REPB(pb)
            pg8::Gemm g{(const bf16_t*)(ws + WS_XG) + (size_t)CL * D, (const bf16_t*)(ws + WS_WINT) + (size_t)l * DIN * D, T, DIN, D};
            pg8::StaticOrder S; S.init(T, DIN, G, b);
            EpiIn E{(bf16_t*)(ws + WS_PX), (const float*)(ws + WS_RSS) + (size_t)l * R, (const float*)(ws + WS_SHW) + (size_t)l * 2 * DIN};
            const bool ctx_first = ((b >> 3) & 1) != 0;
            if (ctx_first) ctx_gemm<5, 0>(a, l, lds);
            pg8::gemm_phase<EpiIn, pg8::StaticOrder, GEMM_ALIGN, GEMM_SP2>(lds, g, S, E);
            if (!ctx_first) ctx_gemm<5, 0>(a, l, lds);
        REPE }
        SEAM(pb);
        if (IN(pb + 1) && (PHMASK & 0x108)) { REPB(pb + 1)
            const int c_lo = last ? 2 : 0, n_cv = 2 * (NCHK - c_lo);
            lru_phase<false>(a, l, 0, lds);
            unsigned* qctr = (unsigned*)(a.ws + WS_BAR) + 16 + 2 * l + rep_;
            volatile LAS int* qslot = (volatile LAS int*)(lds + LDS_BYTES - 32);
            for (;;) {
                __syncthreads();
                if (threadIdx.x == 0) *qslot = (int)__hip_atomic_fetch_add(qctr, 1u, __ATOMIC_RELAXED, __HIP_MEMORY_SCOPE_AGENT);
                __syncthreads();
                const int it = *qslot;
                if (it >= 2 * n_cv) break;
                if (it < n_cv) sgu_item2(a, l, 2 * c_lo + it, lds); else conv_item2(a, l, 2 * c_lo + it - n_cv, lds);
            }
        REPE }
        SEAM(pb + 1);
        if (IN(pb + 2) && (PHMASK & 0x210)) { REPB(pb + 2) phase_carry(a, lds); REPE }
        SEAM(pb + 2);
        if (IN(pb + 3) && (PHMASK & 0x420)) { REPB(pb + 3)
            lru_phase<true>(a, l, last ? 2 : 0, lds);
            __syncthreads();
        REPE }
        SEAM(pb + 3);
        if (IN(pb + 4) && (PHMASK & 0x840)) {
            const int roff = CL, M = T;
            pg8::Gemm g{(const bf16_t*)(ws + WS_Y) + (size_t)roff * D, (const bf16_t*)(ws + WS_WOUTT) + (size_t)l * D * D, M, D, D};
            pg8::StaticOrder S; S.init(M, D, G, b);
            EpiDelta E{(bf16_t*)(ws + WS_DL0),
                        (const float*)(ws + WS_MOD) + (size_t)l * 2 * 6144 + 4096};
            const bool ctx_first = !last && ((b >> 3) & 1) != 0;
            if (ctx_first) ctx_gemm<2, 1>(a, l, lds);
            pg8::gemm_phase<EpiDelta, pg8::StaticOrder, GEMM_ALIGN, GEMM_SP2>(lds, g, S, E);
            if (!last) { if (!ctx_first) ctx_gemm<2, 1>(a, l, lds); xcd_barrier(xbar); phase_resid0(a); }
        }
        SEAM(pb + 4);
    }
    if (IN(12)) phase_final(a);
#undef IN
#undef SEAM
}

extern "C" void kernel_launch(void* const* d_in, const int* in_sizes, int n_in, void* d_out, int out_size, void* d_ws, size_t ws_size, hipStream_t stream) {
    static int grid = 0;
    if (grid == 0) {
        int dev = 0, cus = 0, per_cu = 0;
        if (n_in != 25 || ws_size < WS_END) { fprintf(stderr, "kernel_launch: unexpected inputs (n_in %d, ws %zu < %zu)\n", n_in, ws_size, (size_t)WS_END); grid = -1; return; }
        hipGetDevice(&dev);
        hipDeviceGetAttribute(&cus, hipDeviceAttributeMultiprocessorCount, dev);
        if (hipFuncSetAttribute((const void*)mega_fwd, hipFuncAttributeMaxDynamicSharedMemorySize, LDS_BYTES) != hipSuccess) { fprintf(stderr, "kernel_launch: hipFuncSetAttribute failed\n"); grid = -1; return; }
        hipOccupancyMaxActiveBlocksPerMultiprocessor(&per_cu, (const void*)mega_fwd, 512, LDS_BYTES);
        (void)hipGetLastError();
        if (per_cu < 1) { fprintf(stderr, "kernel_launch: occupancy query says %d blocks per CU\n", per_cu); per_cu = 1; }
        grid = cus;
    }
    if (grid < 0) return;
    if (hipMemsetAsync((char*)d_ws + WS_BAR, 0, 16384, stream) != hipSuccess) { fprintf(stderr, "kernel_launch: memset of the barrier words failed\n"); return; }
    Args a{};
    for (int i = 0; i < 25; ++i) a.in[i] = (const float*)d_in[i];
    a.out = (float*)d_out; a.ws = (unsigned char*)d_ws;
#if N_LAUNCH_MODE == 1
    a.ph_lo = 0; a.ph_hi = NPHASE;
    void* args[] = {&a};
    hipError_t e = hipLaunchCooperativeKernel((const void*)mega_fwd, dim3(grid), dim3(512), args, LDS_BYTES, stream);
    if (e != hipSuccess) fprintf(stderr, "kernel_launch: cooperative launch failed: %s (grid %d)\n", hipGetErrorString(e), grid);
#else
    for (int p = 0; p < NPHASE; ++p) {
        a.ph_lo = p; a.ph_hi = p + 1;
        hipLaunchKernelGGL(mega_fwd, dim3(grid), dim3(512), LDS_BYTES, stream, a);
    }
#endif
}
```

```cpp
#include <hip/hip_runtime.h>
#include <hip/hip_cooperative_groups.h>
#include <cstdio>
#include <cstdint>
namespace cg = cooperative_groups;
namespace pg8 {
#define PG8_LAS __attribute__((address_space(3)))
typedef unsigned short bf16_t;
typedef short bf16x8 __attribute__((ext_vector_type(8)));
typedef float f32x4 __attribute__((ext_vector_type(4)));
typedef unsigned u32x4 __attribute__((ext_vector_type(4)));
constexpr int BM = 256, BK = 64, HALF = 128, HTB = HALF * BK * 2  , STAGE_BYTES = 8 * HTB, NXCD = 8, WGM = 8;

__host__ __device__ __forceinline__ int lds_byte(int r, int c) { const int st = (r >> 4) * 2 + (c >> 5), rr = r & 15, cc = c & 31, ob = rr * 64 + cc * 2; return st * 1024 + (ob ^ (((ob >> 9) & 1) << 5)); }
__host__ __device__ __forceinline__ void stage_rc(int b, int& R, int& C) { const int st = b / 1024, sb = b % 1024, swz = sb ^ (((sb >> 9) & 1) << 5); R = (st >> 1) * 16 + swz / 64; C = (st & 1) * 32 + (swz % 64) / 2; }
__host__ __device__ __forceinline__ int perm32(int rho) { const int n = rho >> 4, i = rho & 15; return 8 * (i >> 2) + 4 * n + (i & 3); }

struct Unit { int pm, pn; };
struct Gemm { const bf16_t* A; const bf16_t* Bt; int M, N, K; };

struct StaticOrder {
    int nM, nN, nwg, G, c;
    __host__ __device__ void init(int M, int N, int G_, int c_) { nM = M / BM; nN = N / BM; nwg = nM * nN; G = G_; c = c_; }
    __host__ __device__ bool next(int i, Unit& u) const {
        const long L = (long)i * G + c; if (L >= nwg) return false;
        int wgid = (int)L; { const int q = nwg / NXCD, r = nwg % NXCD, xcd = wgid % NXCD, off = wgid / NXCD; wgid = (xcd < r ? xcd * (q + 1) : r * (q + 1) + (xcd - r) * q) + off; }
        const int nig = WGM * nN, gid = wgid / nig, fm = gid * WGM, gsz = (nM - fm) < WGM ? (nM - fm) : WGM;
        u.pm = fm + ((wgid % nig) % gsz); u.pn = (wgid % nig) / gsz; return true;
    }
    __device__ __forceinline__ void a_ready(const Unit&) const {}
    __device__ __forceinline__ void done(const Unit&) const {}
};
__device__ __forceinline__ unsigned cvt_pk_bf16(float lo, float hi) { unsigned r; asm volatile("v_cvt_pk_bf16_f32 %0, %1, %2" : "=v"(r) : "v"(lo), "v"(hi)); return r; }
template <class Epi, class Sched, bool ALIGN_EPI = false, bool SP2 = false>
__device__ __forceinline__ void gemm_phase(PG8_LAS unsigned char* lds, const Gemm g, const Sched& S, const Epi& E) {
    int tid_ = threadIdx.x; asm volatile("" : "+v"(tid_)); const int tid = tid_, wid = __builtin_amdgcn_readfirstlane(tid >> 6), lane = tid & 63, wr = wid >> 2, wc = wid & 3, fr = lane & 15, fq = lane >> 4;
    const int K = g.K, nt = K / BK;
    unsigned voffA[2], voffB[2];
#pragma unroll
    for (int i = 0; i < 2; ++i) { int R, C; stage_rc(tid * 16 + i * 8192, R, C); const int Rb = Epi::PERM ? ((R & ~31) + perm32(R & 31)) : R;
        voffA[i] = (unsigned)(R * K + C) * 2u; voffB[i] = (unsigned)(Rb * K + C) * 2u; }
    const size_t kstep = (size_t)(BK * 2);
    const size_t hstep = (size_t)HALF * K * 2;
    const size_t tstep = 2 * hstep;
    const unsigned ldsw = (unsigned)wid * 1024u;
    const int aoff = lds_byte(wr * 64 + fr, fq * 8), boff = lds_byte(wc * 32 + fr, fq * 8);
#define PG8_SA(b, h) (((b) * 2 + (h)) * HTB)
#define PG8_SB(b, h) ((4 + (b) * 2 + (h)) * HTB)
#define PG8_STAGE(bufoff, gbase, voff) do { _Pragma("unroll") for (int _i = 0; _i < 2; ++_i) \
        __builtin_amdgcn_global_load_lds((const unsigned*)((const char*)(gbase) + (voff)[_i]), (PG8_LAS unsigned*)(lds + (bufoff) + ldsw + _i * 8192), 16, 0, 0); } while (0)
#define PG8_LDA(dst, b, h) do { _Pragma("unroll") for (int m = 0; m < 4; ++m) _Pragma("unroll") for (int k = 0; k < 2; ++k) dst[m][k] = *(const PG8_LAS bf16x8*)(lds + PG8_SA(b, h) + aoff + m * 2048 + k * 1024); } while (0)
#define PG8_LDB(dst, b, h) do { _Pragma("unroll") for (int n = 0; n < 2; ++n) _Pragma("unroll") for (int k = 0; k < 2; ++k) dst[n][k] = *(const PG8_LAS bf16x8*)(lds + PG8_SB(b, h) + boff + n * 2048 + k * 1024); } while (0)
#define PG8_MMA(ai, bj, At, Bt) do { __builtin_amdgcn_s_setprio(1); _Pragma("unroll") for (int m = 0; m < 4; ++m) _Pragma("unroll") for (int n = 0; n < 2; ++n) _Pragma("unroll") for (int k = 0; k < 2; ++k) \
        acc[ai][bj][m][n] = __builtin_amdgcn_mfma_f32_16x16x32_bf16(Bt[n][k], At[m][k], acc[ai][bj][m][n], 0, 0, 0); __builtin_amdgcn_s_setprio(0); } while (0)
#define PG8_WAIT_V(n) asm volatile("s_waitcnt vmcnt(" #n ")" ::: "memory")
#define PG8_WAIT_L(n) asm volatile("s_waitcnt lgkmcnt(" #n ")" ::: "memory")
#define PG8_BAR __builtin_amdgcn_s_barrier()
#define PG8_SCHED __builtin_amdgcn_sched_barrier(0)
    Unit cur, nxt; int ui = 0;
    if (!S.next(0, cur)) return;
    f32x4 acc[2][2][4][2];
#pragma unroll
    for (int a = 0; a < 2; ++a)
#pragma unroll
        for (int b = 0; b < 2; ++b)
#pragma unroll
            for (int m = 0; m < 4; ++m)
#pragma unroll
                for (int n = 0; n < 2; ++n) acc[a][b][m][n] = (f32x4){0.f, 0.f, 0.f, 0.f};
    bf16x8 At[4][2], B0[2][2], B1[2][2];
    const char* cA = (const char*)g.A + (size_t)cur.pm * tstep; const char* cB = (const char*)g.Bt + (size_t)cur.pn * tstep;
    S.a_ready(cur);
    if constexpr (SP2) {
        PG8_STAGE(PG8_SB(0, 0), cB, voffB); PG8_STAGE(PG8_SB(0, 1), cB + hstep, voffB); PG8_STAGE(PG8_SA(0, 0), cA, voffA); PG8_STAGE(PG8_SA(0, 1), cA + hstep, voffA);
        if (wr == 1) PG8_BAR;
        PG8_WAIT_V(2); PG8_BAR;
        PG8_STAGE(PG8_SB(1, 0), cB + kstep, voffB); PG8_STAGE(PG8_SA(1, 0), cA + kstep, voffA); PG8_STAGE(PG8_SB(1, 1), cB + hstep + kstep, voffB);
        PG8_WAIT_V(6); PG8_BAR;
    } else {
        PG8_STAGE(PG8_SB(0, 0), cB, voffB); PG8_STAGE(PG8_SA(0, 0), cA, voffA); PG8_STAGE(PG8_SB(0, 1), cB + hstep, voffB); PG8_STAGE(PG8_SA(0, 1), cA + hstep, voffA);
        if (wr == 1) PG8_BAR;
        PG8_WAIT_V(4); PG8_BAR;
        PG8_STAGE(PG8_SB(1, 0), cB + kstep, voffB); PG8_STAGE(PG8_SA(1, 0), cA + kstep, voffA); PG8_STAGE(PG8_SB(1, 1), cB + hstep + kstep, voffB);
        PG8_WAIT_V(6); PG8_BAR;
    }
    for (;;) {
        const bool has_next = S.next(ui + 1, nxt);
        const char* nA = has_next ? (const char*)g.A + (size_t)nxt.pm * tstep : cA; const char* nB = has_next ? (const char*)g.Bt + (size_t)nxt.pn * tstep : cB;
        for (int t = 0; t < nt; t += 2) {
            const bool last = (t == nt - 2);
            const char* a1 = cA + (size_t)(t + 1) * kstep;
            const char* a2 = last ? nA : cA + (size_t)(t + 2) * kstep; const char* b2 = last ? nB : cB + (size_t)(t + 2) * kstep;
            const char* a3 = a2 + kstep; const char* b3 = b2 + kstep;
            if (last && has_next) S.a_ready(nxt);
            if constexpr (SP2) {
            PG8_LDB(B0, 0, 0); PG8_LDB(B1, 0, 1); PG8_SCHED; PG8_LDA(At, 0, 0); PG8_STAGE(PG8_SA(1, 1), a1 + hstep, voffA);
            PG8_WAIT_V(8); PG8_WAIT_L(0); PG8_BAR; PG8_MMA(0, 0, At, B0); PG8_MMA(0, 1, At, B1); PG8_BAR; PG8_SCHED;
            PG8_LDA(At, 0, 1); PG8_STAGE(PG8_SB(0, 0), b2, voffB); PG8_STAGE(PG8_SB(0, 1), b2 + hstep, voffB); PG8_STAGE(PG8_SA(0, 0), a2, voffA);
            PG8_WAIT_V(8); PG8_WAIT_L(0); PG8_BAR; PG8_MMA(1, 0, At, B0); PG8_MMA(1, 1, At, B1); PG8_BAR; PG8_SCHED;
            PG8_LDB(B0, 1, 0); PG8_LDB(B1, 1, 1); PG8_SCHED; PG8_LDA(At, 1, 0); PG8_STAGE(PG8_SA(0, 1), a2 + hstep, voffA);
            PG8_WAIT_V(8); PG8_WAIT_L(0); PG8_BAR; PG8_MMA(0, 0, At, B0); PG8_MMA(0, 1, At, B1); PG8_BAR; PG8_SCHED;
            PG8_LDA(At, 1, 1); PG8_STAGE(PG8_SB(1, 0), b3, voffB); PG8_STAGE(PG8_SB(1, 1), b3 + hstep, voffB); PG8_STAGE(PG8_SA(1, 0), a3, voffA);
            PG8_WAIT_V(8); PG8_WAIT_L(0); PG8_BAR; PG8_MMA(1, 0, At, B0); PG8_MMA(1, 1, At, B1); PG8_BAR; PG8_SCHED;
            } else {
            PG8_LDB(B0, 0, 0); PG8_SCHED; PG8_LDA(At, 0, 0); PG8_STAGE(PG8_SA(1, 1), a1 + hstep, voffA);
            PG8_WAIT_L(8); PG8_BAR; PG8_WAIT_L(0); PG8_MMA(0, 0, At, B0); PG8_BAR; PG8_SCHED;
            PG8_LDB(B1, 0, 1); PG8_STAGE(PG8_SB(0, 0), b2, voffB);
            PG8_BAR; PG8_WAIT_L(0); PG8_MMA(0, 1, At, B1); PG8_BAR;
            PG8_LDA(At, 0, 1); PG8_STAGE(PG8_SA(0, 0), a2, voffA);
            PG8_BAR; PG8_WAIT_L(0); PG8_MMA(1, 0, At, B0); PG8_BAR; PG8_SCHED;
            PG8_STAGE(PG8_SB(0, 1), b2 + hstep, voffB);
            PG8_WAIT_V(6); PG8_BAR; PG8_MMA(1, 1, At, B1); PG8_BAR;
            PG8_LDB(B0, 1, 0); PG8_SCHED; PG8_LDA(At, 1, 0); PG8_STAGE(PG8_SA(0, 1), a2 + hstep, voffA);
            PG8_WAIT_L(8); PG8_BAR; PG8_WAIT_L(0); PG8_MMA(0, 0, At, B0); PG8_BAR; PG8_SCHED;
            PG8_LDB(B1, 1, 1); PG8_STAGE(PG8_SB(1, 0), b3, voffB);
            PG8_BAR; PG8_WAIT_L(0); PG8_MMA(0, 1, At, B1); PG8_BAR;
            PG8_LDA(At, 1, 1); PG8_STAGE(PG8_SA(1, 0), a3, voffA);
            PG8_BAR; PG8_WAIT_L(0); PG8_MMA(1, 0, At, B0); PG8_BAR; PG8_SCHED;
            PG8_STAGE(PG8_SB(1, 1), b3 + hstep, voffB);
            PG8_WAIT_V(6); PG8_BAR; PG8_MMA(1, 1, At, B1); PG8_BAR;
            }
        }
        if constexpr (ALIGN_EPI) { if (wr == 0) PG8_BAR; }
        if constexpr (!Epi::AFTER_DRAIN) { E(acc, cur, wr, wc, fr, fq); S.done(cur); }
        if (!has_next) break;
#pragma unroll
        for (int a = 0; a < 2; ++a)
#pragma unroll
            for (int b = 0; b < 2; ++b)
#pragma unroll
                for (int m = 0; m < 4; ++m)
#pragma unroll
                    for (int n = 0; n < 2; ++n) acc[a][b][m][n] = (f32x4){0.f, 0.f, 0.f, 0.f};
        cur = nxt; cA = nA; cB = nB; ++ui;
        if constexpr (ALIGN_EPI) { if (wr == 1) PG8_BAR; }
    }
    PG8_WAIT_V(0);
    if constexpr (!ALIGN_EPI) { if (wr == 0) PG8_BAR; }
    PG8_BAR;
    if constexpr (Epi::AFTER_DRAIN) { E.fused(acc, cur, wr, wc, fr, fq, lds, wid, lane); S.done(cur); }
#undef PG8_SA
#undef PG8_SB
#undef PG8_STAGE
#undef PG8_LDA
#undef PG8_LDB
#undef PG8_MMA
#undef PG8_WAIT_V
#undef PG8_WAIT_L
#undef PG8_BAR
#undef PG8_SCHED
}
}

#define LAS __attribute__((address_space(3)))
typedef unsigned short bf16_t;
typedef short bf16x8 __attribute__((ext_vector_type(8)));
typedef float f32x4 __attribute__((ext_vector_type(4)));
typedef float f32x2 __attribute__((ext_vector_type(2)));
typedef float f32x16 __attribute__((ext_vector_type(16)));
typedef unsigned u32x4 __attribute__((ext_vector_type(4)));
typedef unsigned u32x2 __attribute__((ext_vector_type(2)));

#ifndef GEMM_ALIGN
#define GEMM_ALIGN true
#endif
#ifndef GEMM_SP2
#define GEMM_SP2 true
#endif
#ifndef N_LAUNCH_MODE
#define N_LAUNCH_MODE 1
#endif

constexpr int D = 2048, T = 16384, CL = 256, R = T + CL, DIN = 5120, NCHK = R / 128;
constexpr int NPHASE = 13;
constexpr float EPS = 1e-6f;
constexpr int LDS_BYTES = 131072 + 4096;

constexpr size_t WS_WINT = 0;
constexpr size_t WS_WOUTT = WS_WINT + (size_t)2 * DIN * D * 2;
constexpr size_t WS_XG = WS_WOUTT + (size_t)2 * D * D * 2;
constexpr size_t WS_PX = WS_XG + (size_t)R * D * 2;
constexpr size_t WS_Y = WS_PX + (size_t)R * DIN * 2;
constexpr size_t WS_X1C = WS_Y + (size_t)R * D * 2;
constexpr size_t WS_MOD = WS_X1C + (size_t)CL * D * 4;
constexpr size_t WS_GG = WS_MOD + (size_t)2 * 2 * 6144 * 4;
constexpr size_t WS_SHW = WS_GG + (size_t)2 * 2 * D * 4;
constexpr size_t WS_RSS = WS_SHW + (size_t)2 * 2 * DIN * 4;
constexpr size_t WS_GW = WS_RSS + (size_t)3 * R * 4 + 64;
constexpr size_t WS_SW = WS_GW + (size_t)2 * 16 * 2 * 2 * 2 * 4 * 64 * 8 * 2;
constexpr size_t WS_AGG = WS_SW + (size_t)2 * 8 * 128 * 128 * 2;
constexpr size_t WS_CARRY = WS_AGG + (size_t)2 * NCHK * 1024 * 8;
constexpr size_t WS_BAR = (WS_CARRY + (size_t)2 * NCHK * 1024 * 4 + 255) / 256 * 256;
constexpr size_t WS_DL0 = WS_BAR + 16384;
constexpr size_t WS_END = WS_DL0 + (size_t)T * D * 2;

struct Args { const float* in[25]; float* out; unsigned char* ws; int ph_lo, ph_hi; };

__device__ __forceinline__ float bflo(unsigned w) { return __uint_as_float(w << 16); }
__device__ __forceinline__ float bfhi(unsigned w) { return __uint_as_float(w & 0xffff0000u); }
__device__ __forceinline__ float bf1(bf16_t h) { return __uint_as_float((unsigned)h << 16); }
__device__ __forceinline__ unsigned pk2(float lo, float hi) { return pg8::cvt_pk_bf16(lo, hi); }
__device__ __forceinline__ bf16_t f2bf(float f) { return (bf16_t)(pk2(f, 0.f) & 0xffffu); }
__device__ __forceinline__ float rcpf_(float x) { return __builtin_amdgcn_rcpf(x); }
__device__ __forceinline__ float sigm(float x) { return rcpf_(1.0f + __expf(-x)); }
__device__ __forceinline__ float silu(float x) { return x * sigm(x); }
__device__ __forceinline__ float gelu_t(float x) { return x * sigm(1.5957691216f * (x + 0.044715f * x * x * x)); }
template <int CTRL> __device__ __forceinline__ float dpp_mov(float v) { return __int_as_float(__builtin_amdgcn_update_dpp(0, __float_as_int(v), CTRL, 0xf, 0xf, true)); }
__device__ __forceinline__ float wave_sum(float v) {
    v += dpp_mov<0xB1>(v);
    v += dpp_mov<0x4E>(v);
    v += dpp_mov<0x141>(v);
    v += dpp_mov<0x140>(v);
    const int iv = __float_as_int(v);
    return (__int_as_float(__builtin_amdgcn_readlane(iv, 0)) + __int_as_float(__builtin_amdgcn_readlane(iv, 16))) + (__int_as_float(__builtin_amdgcn_readlane(iv, 32)) + __int_as_float(__builtin_amdgcn_readlane(iv, 48)));
}
__device__ __forceinline__ int tid_fresh() { int t = threadIdx.x; asm volatile("" : "+v"(t)); return t; }
#define GAS __attribute__((address_space(1)))
__device__ __forceinline__ unsigned char* ptr_fresh(unsigned char* p) {
#ifdef FLAT_WS
    asm volatile("" : "+s"(p)); return p; }
#else
    unsigned long long v = (unsigned long long)p; asm volatile("" : "+s"(v)); return (unsigned char*)(GAS unsigned char*)v; }
#endif
#define LDS_WAIT() asm volatile("s_waitcnt lgkmcnt(0)" ::: "memory")

struct EpiIn {
    static constexpr bool PERM = true, AFTER_DRAIN = false;
    bf16_t* PX; const float* rss; const float* shw;
    __device__ __forceinline__ void operator()(const f32x4 (&acc)[2][2][4][2], const pg8::Unit& u, int wr, int wc, int fr, int fq) const {
        const int row0 = CL + u.pm * 256 + wr * 64 + fr, col0 = u.pn * 256 + wc * 32 + 8 * fq;
        const float* sw = shw + col0;
        f32x4 bv[2][2];
#pragma unroll
        for (int bj = 0; bj < 2; ++bj)
#pragma unroll
            for (int n = 0; n < 2; ++n) bv[bj][n] = *(const f32x4*)(sw + bj * 128 + 4 * n);
#pragma unroll
        for (int ai = 0; ai < 2; ++ai)
#pragma unroll
            for (int m = 0; m < 4; ++m) {
                const int r = row0 + ai * 128 + m * 16;
                const float rs = 1.0f / sqrtf(rss[r] * (1.0f / D) + EPS);
                bf16_t* rowp = PX + (size_t)r * DIN + col0;
#pragma unroll
                for (int bj = 0; bj < 2; ++bj) {
                    const f32x4 v0 = acc[ai][bj][m][0] * rs + bv[bj][0], v1 = acc[ai][bj][m][1] * rs + bv[bj][1];
                    u32x4 w; w.x = pk2(v0[0], v0[1]); w.y = pk2(v0[2], v0[3]); w.z = pk2(v1[0], v1[1]); w.w = pk2(v1[2], v1[3]);
                    *(u32x4*)(rowp + bj * 128) = w;
                }
            }
    }
};
struct EpiOut {
    static constexpr bool PERM = true, AFTER_DRAIN = false;
    int row_off, last;
    const float* xold_lat; const float* xold_ctx; float* xnew_lat; float* xnew_ctx;
    const float* gvec;
    const float* ggn;
    bf16_t* XG; float* rssn;
    __device__ __forceinline__ void operator()(const f32x4 (&acc)[2][2][4][2], const pg8::Unit& u, int wr, int wc, int fr, int fq) const {
        const int gbase = row_off + u.pm * 256;
        const bool isctx = gbase < CL;
        const int seg = isctx ? 1 : 0;
        const int grow0 = gbase + wr * 64 + fr, col0 = u.pn * 256 + wc * 32 + 8 * fq;
        const float* xo = isctx ? xold_ctx : (xold_lat - (size_t)CL * D);
        float* xn = isctx ? xnew_ctx : (xnew_lat - (size_t)CL * D);
        const float* gp = gvec + seg * 6144 + 4096 + col0;
        const float* ggp = ggn + seg * D + col0;
        f32x4 gv[2][2], gg[2][2];
#pragma unroll
        for (int bj = 0; bj < 2; ++bj)
#pragma unroll
            for (int n = 0; n < 2; ++n) { gv[bj][n] = *(const f32x4*)(gp + bj * 128 + 4 * n); gg[bj][n] = last ? (f32x4){0.f, 0.f, 0.f, 0.f} : *(const f32x4*)(ggp + bj * 128 + 4 * n); }
#pragma unroll
        for (int ai = 0; ai < 2; ++ai)
#pragma unroll
            for (int m = 0; m < 4; ++m) {
                const int r = grow0 + ai * 128 + m * 16;
                const size_t ro = (size_t)r * D + col0;
                float ss = 0.f;
#pragma unroll
                for (int bj = 0; bj < 2; ++bj) {
                    const f32x4 o0 = *(const f32x4*)(xo + ro + bj * 128), o1 = *(const f32x4*)(xo + ro + bj * 128 + 4);
                    const f32x4 v0 = o0 + gv[bj][0] * acc[ai][bj][m][0], v1 = o1 + gv[bj][1] * acc[ai][bj][m][1];
                    *(f32x4*)(xn + ro + bj * 128) = v0; *(f32x4*)(xn + ro + bj * 128 + 4) = v1;
                    ss += (v0[0] * v0[0] + v0[1] * v0[1]) + (v0[2] * v0[2] + v0[3] * v0[3]) + (v1[0] * v1[0] + v1[1] * v1[1]) + (v1[2] * v1[2] + v1[3] * v1[3]);
                    if (!last) {
                        const f32x4 a0 = v0 * gg[bj][0], a1 = v1 * gg[bj][1];
                        u32x4 w; w.x = pk2(a0[0], a0[1]); w.y = pk2(a0[2], a0[3]); w.z = pk2(a1[0], a1[1]); w.w = pk2(a1[2], a1[3]);
                        *(u32x4*)(XG + ro + bj * 128) = w;
                    }
                }
                ss += __shfl_xor(ss, 16); ss += __shfl_xor(ss, 32);
                if (fq == 0) unsafeAtomicAdd(rssn + r, ss);
            }
    }
};

struct EpiDelta {
    static constexpr bool PERM = true, AFTER_DRAIN = false;
    bf16_t* DL; const float* gvec;
    __device__ __forceinline__ void operator()(const f32x4 (&acc)[2][2][4][2], const pg8::Unit& u, int wr, int wc, int fr, int fq) const {
        const int row0 = u.pm * 256 + wr * 64 + fr, col0 = u.pn * 256 + wc * 32 + 8 * fq;
        f32x4 gv[2][2];
#pragma unroll
        for (int bj = 0; bj < 2; ++bj)
#pragma unroll
            for (int n = 0; n < 2; ++n) gv[bj][n] = *(const f32x4*)(gvec + col0 + bj * 128 + 4 * n);
#pragma unroll
        for (int ai = 0; ai < 2; ++ai)
#pragma unroll
            for (int m = 0; m < 4; ++m) {
                bf16_t* rowp = DL + (size_t)(row0 + ai * 128 + m * 16) * D + col0;
#pragma unroll
                for (int bj = 0; bj < 2; ++bj) {
                    const f32x4 v0 = acc[ai][bj][m][0] * gv[bj][0], v1 = acc[ai][bj][m][1] * gv[bj][1];
                    u32x4 w; w.x = pk2(v0[0], v0[1]); w.y = pk2(v0[2], v0[3]); w.z = pk2(v1[0], v1[1]); w.w = pk2(v1[2], v1[3]);
                    *(u32x4*)(rowp + bj * 128) = w;
                }
            }
    }
};

__device__ __forceinline__ void transpose_item(const float* W, int K, int N, bf16_t* WT, LAS float* scr, int item, int lane) {
    const int nblk = N / 32, kb = item / nblk, nb = item % nblk, k0 = 64 * kb, n0 = 32 * nb;
#pragma unroll 8
    for (int i = 0; i < 32; ++i) { const int kk = 2 * i + (lane >> 5); scr[kk * 33 + (lane & 31)] = W[(size_t)(k0 + kk) * N + n0 + (lane & 31)]; }
    LDS_WAIT();
    const int c = lane & 7;
#pragma unroll
    for (int j = 0; j < 4; ++j) { const int n = (lane >> 3) + 8 * j; const LAS float* s = scr + (8 * c) * 33 + n;
        u32x4 o; o.x = pk2(s[0 * 33], s[1 * 33]); o.y = pk2(s[2 * 33], s[3 * 33]); o.z = pk2(s[4 * 33], s[5 * 33]); o.w = pk2(s[6 * 33], s[7 * 33]);
        *(u32x4*)(WT + (size_t)(n0 + n) * K + k0 + 8 * c) = o; }
    LDS_WAIT();
}

__device__ __forceinline__ void phase0a(const Args a, LAS unsigned char* lds) {
    const int tid = tid_fresh(), lane = tid & 63, wave = tid >> 6, b = blockIdx.x, G = gridDim.x;
    unsigned char* ws = ptr_fresh(a.ws);
    { float* rss = (float*)(ws + WS_RSS); for (int i = b * 512 + tid; i < 2 * R; i += G * 512) rss[R + i] = 0.f; }
    { bf16_t* GW = (bf16_t*)(ws + WS_GW);
      for (int gid = b * 512 + tid; gid < 2 * 16 * 2 * 2 * 2 * 4 * 64; gid += G * 512) {
          int x = gid; const int ln = x & 63; x >>= 6; const int s = x & 3; x >>= 2; const int half = x & 1; x >>= 1; const int gate = x & 1; x >>= 1; const int dir = x & 1; x >>= 1; const int hd = x & 15; x >>= 4; const int l = x;
          const float* w = (gate ? a.in[14] : a.in[12]) + ((size_t)((l * 2 + dir) * 16 + hd)) * 4096;
          const int col = 32 * half + (ln & 31), k0 = 16 * s + 8 * (ln >> 5);
          float v[8];
#pragma unroll
          for (int j = 0; j < 8; ++j) v[j] = w[(k0 + j) * 64 + col];
          u32x4 o; o.x = pk2(v[0], v[1]); o.y = pk2(v[2], v[3]); o.z = pk2(v[4], v[5]); o.w = pk2(v[6], v[7]);
          *(u32x4*)(GW + (size_t)gid * 8) = o;
      } }
    { bf16_t* SW = (bf16_t*)(ws + WS_SW); const float* sw = a.in[22];
      for (int i = b * 512 + tid; i < 2 * 8 * 128 * 128 / 4; i += G * 512) { const f32x4 v = *(const f32x4*)(sw + (size_t)i * 4); u32x2 o; o.x = pk2(v[0], v[1]); o.y = pk2(v[2], v[3]); *(u32x2*)(SW + (size_t)i * 4) = o; } }
    { const float* c = a.in[1]; const float* cc = a.in[3]; float* MOD = (float*)(ws + WS_MOD);
      LAS float* red = (LAS float*)lds;
      for (int u = b; u < 192; u += G) {
          const int l = u / 96, n0 = (u % 96) * 64, q = tid & 15, ks = tid >> 4;
          const float* W = a.in[4] + (size_t)l * D * 6144 + n0 + 4 * q;
          f32x4 a0 = {0.f, 0.f, 0.f, 0.f}, a1 = {0.f, 0.f, 0.f, 0.f};
#pragma unroll 8
          for (int kk = 0; kk < 64; ++kk) { const int k = ks * 64 + kk; const f32x4 wv = *(const f32x4*)(W + (size_t)k * 6144); const float ca = silu(c[k]), cb = silu(cc[k]); a0 += wv * ca; a1 += wv * cb; }
          LAS float* rp = red + (ks * 16 + q) * 8;
          *(LAS f32x4*)rp = a0; *(LAS f32x4*)(rp + 4) = a1;
          __syncthreads();
          if (tid < 128) { const int qq = tid >> 3, e = tid & 7; float s = 0.f;
#pragma unroll 8
              for (int k2 = 0; k2 < 32; ++k2) s += red[(k2 * 16 + qq) * 8 + e];
              const int seg = e >> 2, col = n0 + 4 * qq + (e & 3);
              MOD[(l * 2 + seg) * 6144 + col] = s + a.in[5][l * 6144 + col]; }
          __syncthreads();
      } }
    { LAS float* scr = (LAS float*)(lds + wave * 16384);
      const int gw = b * 8 + wave, NGW = G * 8;
      constexpr int I_IN = (D / 64) * (DIN / 32), I_OUT = (D / 64) * (D / 32);
      for (int it = gw; it < 2 * I_IN + 2 * I_OUT; it += NGW) {
          int r = it;
          if (r < 2 * I_IN) { const int l = r / I_IN; transpose_item(a.in[7] + (size_t)l * D * DIN, D, DIN, (bf16_t*)(ws + WS_WINT) + (size_t)l * DIN * D, scr, r % I_IN, lane); continue; }
          r -= 2 * I_IN; { const int l = r / I_OUT; transpose_item(a.in[8] + (size_t)l * D * D, D, D, (bf16_t*)(ws + WS_WOUTT) + (size_t)l * D * D, scr, r % I_OUT, lane); }
      } }
}

__device__ __forceinline__ void phase0b(const Args a, LAS unsigned char* lds) {
    const int tid = tid_fresh(), lane = tid & 63, wave = tid >> 6, b = blockIdx.x, G = gridDim.x;
    unsigned char* ws = ptr_fresh(a.ws);
    const float* MOD = (const float*)(ws + WS_MOD);
    LAS float* GG0 = (LAS float*)lds;
    LAS float* SH = (LAS float*)(lds + 16384);
    for (int i = tid; i < 2 * D; i += 512) { const int seg = i >> 11, k = i & 2047; float gv_ = a.in[6][k] * (1.0f + MOD[seg * 6144 + 2048 + k]); if (gv_ == 0.f) gv_ = 1e-30f; GG0[i] = gv_; }
    for (int i = tid; i < 4 * D; i += 512) { const int ls = i >> 11, k = i & 2047; SH[i] = MOD[ls * 6144 + k]; }
    { float* GGt = (float*)(ws + WS_GG); for (int i = b * 512 + tid; i < 4 * D; i += G * 512) { const int ls = i >> 11, l = ls >> 1, k = i & 2047; float gv_ = a.in[6][l * D + k] * (1.0f + MOD[ls * 6144 + 2048 + k]); if (gv_ == 0.f) gv_ = 1e-30f; GGt[i] = gv_; } }
    __syncthreads();
    const int gw = b * 8 + wave, NGW = G * 8;
    { bf16_t* XG = (bf16_t*)(ws + WS_XG); float* rss = (float*)(ws + WS_RSS);
      f32x4 vr[8];
#define P0B_LOAD(r_, V) do { const float* _src = (r_) < CL ? a.in[2] + (size_t)(r_) * D : a.in[0] + (size_t)((r_) - CL) * D; \
          _Pragma("unroll") for (int j = 0; j < 8; ++j) V[j] = *(const f32x4*)(_src + 4 * (lane + 64 * j)); } while (0)
      int r = gw;
      if (r < R) P0B_LOAD(r, vr);
      for (; r < R; r += NGW) {
          f32x4 vn[8];
          const int rn = r + NGW;
          if (rn < R) P0B_LOAD(rn, vn);
          const int seg = r < CL ? 1 : 0;
          float ss = 0.f;
#pragma unroll
          for (int j = 0; j < 8; ++j) ss += (vr[j][0] * vr[j][0] + vr[j][1] * vr[j][1]) + (vr[j][2] * vr[j][2] + vr[j][3] * vr[j][3]);
#pragma unroll
          for (int j = 0; j < 8; ++j) { const f32x4 g = *(LAS f32x4*)(GG0 + seg * D + 4 * (lane + 64 * j)); const f32x4 p = vr[j] * g; u32x2 o; o.x = pk2(p[0], p[1]); o.y = pk2(p[2], p[3]); *(u32x2*)(XG + (size_t)r * D + 4 * (lane + 64 * j)) = o; }
          ss = wave_sum(ss);
          if (lane == 0) rss[r] = ss;
          if (rn < R) {
#pragma unroll
              for (int j = 0; j < 8; ++j) vr[j] = vn[j];
          }
      }
#undef P0B_LOAD
    }
    { float* SHW = (float*)(ws + WS_SHW); const bf16_t* WinT = (const bf16_t*)(ws + WS_WINT);
      for (int idx = gw; idx < 2 * DIN; idx += NGW) {
          const int l = idx / DIN, n = idx % DIN;
          const bf16_t* row = WinT + ((size_t)l * DIN + n) * D;
          float d0 = 0.f, d1 = 0.f;
#pragma unroll
          for (int j = 0; j < 4; ++j) { const int k = 8 * (lane + 64 * j); const u32x4 w = *(const u32x4*)(row + k);
              const LAS float* s0 = SH + (l * 2 + 0) * D + k; const LAS float* s1 = SH + (l * 2 + 1) * D + k;
              const f32x4 x0 = *(LAS f32x4*)s0, x1 = *(LAS f32x4*)(s0 + 4), y0 = *(LAS f32x4*)s1, y1 = *(LAS f32x4*)(s1 + 4);
              const float w0 = bflo(w.x), w1 = bfhi(w.x), w2 = bflo(w.y), w3 = bfhi(w.y), w4 = bflo(w.z), w5 = bfhi(w.z), w6 = bflo(w.w), w7 = bfhi(w.w);
              d0 += (w0 * x0[0] + w1 * x0[1]) + (w2 * x0[2] + w3 * x0[3]) + (w4 * x1[0] + w5 * x1[1]) + (w6 * x1[2] + w7 * x1[3]);
              d1 += (w0 * y0[0] + w1 * y0[1]) + (w2 * y0[2] + w3 * y0[3]) + (w4 * y1[0] + w5 * y1[1]) + (w6 * y1[2] + w7 * y1[3]); }
          d0 = wave_sum(d0); d1 = wave_sum(d1);
          if (lane == 0) { SHW[(l * 2 + 0) * DIN + n] = d0; SHW[(l * 2 + 1) * DIN + n] = d1; }
      } }
    __syncthreads();
}

constexpr int XLF_STRIDE = 68, XLB_STRIDE = 72;
constexpr int LRU_XLF = 0, LRU_XLB = 128 * XLF_STRIDE * 4, LRU_TAGG = LRU_XLB + 128 * XLB_STRIDE * 2;

template <bool PASSC>
__device__ __forceinline__ void lru_item(const Args a, int l, int chunk, int hd, LAS unsigned char* lds) {
    const int tid = tid_fresh(), lane = tid & 63, wave = tid >> 6;
    unsigned char* ws = ptr_fresh(a.ws);
    const bf16_t* PX = (const bf16_t*)(ws + WS_PX);
    LAS float* XLF = (LAS float*)(lds + LRU_XLF);
    LAS bf16_t* XLB = (LAS bf16_t*)(lds + LRU_XLB);
    LAS f32x2* TAGG = (LAS f32x2*)(lds + LRU_TAGG);
    __syncthreads();
    {
        const int t = tid >> 2, q = tid & 3, ch0 = hd * 64 + q * 16;
        const int grow = chunk * 128 + t, seg_lo = chunk < 2 ? 0 : CL, seg_hi = chunk < 2 ? CL : R;
        const float* cw = a.in[9] + (size_t)l * 4 * 1024 + ch0; const float* cb = a.in[10] + (size_t)l * 1024 + ch0;
        float xl[16];
#pragma unroll
        for (int c4 = 0; c4 < 4; ++c4) { const f32x4 bb = *(const f32x4*)(cb + 4 * c4); xl[4 * c4] = bb[0]; xl[4 * c4 + 1] = bb[1]; xl[4 * c4 + 2] = bb[2]; xl[4 * c4 + 3] = bb[3]; }
#pragma unroll
        for (int j = 0; j < 4; ++j) {
            const int rr = grow + j - 2;
            if (rr >= seg_lo && rr < seg_hi) {
                const u32x4 p0 = *(const u32x4*)(PX + (size_t)rr * DIN + ch0), p1 = *(const u32x4*)(PX + (size_t)rr * DIN + ch0 + 8);
                const unsigned pw[8] = {p0.x, p0.y, p0.z, p0.w, p1.x, p1.y, p1.z, p1.w};
#pragma unroll
                for (int c4 = 0; c4 < 4; ++c4) { const f32x4 wv = *(const f32x4*)(cw + j * 1024 + 4 * c4);
                    xl[4 * c4 + 0] += wv[0] * bflo(pw[2 * c4]); xl[4 * c4 + 1] += wv[1] * bfhi(pw[2 * c4]); xl[4 * c4 + 2] += wv[2] * bflo(pw[2 * c4 + 1]); xl[4 * c4 + 3] += wv[3] * bfhi(pw[2 * c4 + 1]); }
            }
        }
        LAS float* xf = XLF + t * XLF_STRIDE + q * 16;
#pragma unroll
        for (int c4 = 0; c4 < 4; ++c4) *(LAS f32x4*)(xf + 4 * c4) = (f32x4){xl[4 * c4], xl[4 * c4 + 1], xl[4 * c4 + 2], xl[4 * c4 + 3]};
        LAS bf16_t* xb = XLB + t * XLB_STRIDE + q * 16;
        u32x4 o0, o1; o0.x = pk2(xl[0], xl[1]); o0.y = pk2(xl[2], xl[3]); o0.z = pk2(xl[4], xl[5]); o0.w = pk2(xl[6], xl[7]); o1.x = pk2(xl[8], xl[9]); o1.y = pk2(xl[10], xl[11]); o1.z = pk2(xl[12], xl[13]); o1.w = pk2(xl[14], xl[15]);
        *(LAS u32x4*)xb = o0; *(LAS u32x4*)(xb + 8) = o1;
    }
    __syncthreads();
    const int tw = wave >> 1, chh = wave & 1, cl = lane & 31, hh = lane >> 5;
    const int cin = 32 * chh + cl, cg_ = hd * 64 + cin;
    bf16x8 Af[4];
#pragma unroll
    for (int s = 0; s < 4; ++s) Af[s] = *(const LAS bf16x8*)(XLB + (32 * tw + cl) * XLB_STRIDE + 16 * s + 8 * hh);
    float xlv[16];
#pragma unroll
    for (int i = 0; i < 16; ++i) xlv[i] = XLF[(32 * tw + (i & 3) + 8 * (i >> 2) + 4 * hh) * XLF_STRIDE + cin];
    float av[2][16], bv[2][16];
    float GA[2][8], GB[2][8];
    const bf16_t* GW = (const bf16_t*)(ws + WS_GW);
#pragma unroll
    for (int dir = 0; dir < 2; ++dir) {
        f32x16 ar, ai;
#pragma unroll
        for (int i = 0; i < 16; ++i) { ar[i] = 0.f; ai[i] = 0.f; }
#pragma unroll
        for (int s = 0; s < 4; ++s) {
            const size_t gr = ((((((size_t)(l * 16 + hd) * 2 + dir) * 2 + 0) * 2 + chh) * 4 + s) * 64 + lane) * 8;
            const size_t gi = ((((((size_t)(l * 16 + hd) * 2 + dir) * 2 + 1) * 2 + chh) * 4 + s) * 64 + lane) * 8;
            const bf16x8 Br = *(const bf16x8*)(GW + gr), Bi = *(const bf16x8*)(GW + gi);
            ar = __builtin_amdgcn_mfma_f32_32x32x16_bf16(Af[s], Br, ar, 0, 0, 0);
            ai = __builtin_amdgcn_mfma_f32_32x32x16_bf16(Af[s], Bi, ai, 0, 0, 0);
        }
        const float brv = a.in[13][(size_t)(l * 2 + dir) * 1024 + cg_], biv = a.in[15][(size_t)(l * 2 + dir) * 1024 + cg_];
        const float lam = a.in[11][(size_t)(l * 2 + dir) * 1024 + cg_];
        const float k8 = -8.0f * log1pf(__expf(-lam));
#pragma unroll
        for (int i = 0; i < 16; ++i) {
            const float rg = sigm(ar[i] + brv), ig = sigm(ai[i] + biv);
            const float la = k8 * rg;
            av[dir][i] = __expf(la);
            const float aa = av[dir][i]; bv[dir][i] = __builtin_amdgcn_sqrtf(fmaxf(1.0f - aa * aa, 0.f)) * ig * xlv[i];
        }
        float oA[4], oB[4];
#pragma unroll
        for (int g = 0; g < 4; ++g) {
            const float a0 = av[dir][4 * g], a1 = av[dir][4 * g + 1], a2 = av[dir][4 * g + 2], a3 = av[dir][4 * g + 3];
            const float b0 = bv[dir][4 * g], b1 = bv[dir][4 * g + 1], b2 = bv[dir][4 * g + 2], b3 = bv[dir][4 * g + 3];
            oA[g] = (a0 * a1) * (a2 * a3);
            oB[g] = dir == 0 ? ((b0 * a1 + b1) * a2 + b2) * a3 + b3 : ((b3 * a2 + b2) * a1 + b1) * a0 + b0;
        }
#pragma unroll
        for (int g = 0; g < 4; ++g) {
            const float pA = __shfl_xor(oA[g], 32), pB = __shfl_xor(oB[g], 32);
            GA[dir][2 * g] = hh ? pA : oA[g]; GA[dir][2 * g + 1] = hh ? oA[g] : pA;
            GB[dir][2 * g] = hh ? pB : oB[g]; GB[dir][2 * g + 1] = hh ? oB[g] : pB;
        }
        float tA = 1.f, tB = 0.f;
        if (dir == 0) {
#pragma unroll
            for (int gq = 0; gq < 8; ++gq) { tB = GA[dir][gq] * tB + GB[dir][gq]; tA *= GA[dir][gq]; }
        } else {
#pragma unroll
            for (int gq = 7; gq >= 0; --gq) { tB = GA[dir][gq] * tB + GB[dir][gq]; tA *= GA[dir][gq]; }
        }
        if (hh == 0) TAGG[(tw * 2 + dir) * 64 + cin] = (f32x2){tA, tB};
    }
    __syncthreads();
    if constexpr (!PASSC) {
        if (tid < 128) {
            const int dir = tid >> 6, c = tid & 63;
            float cA = 1.f, cB = 0.f;
#pragma unroll
            for (int k = 0; k < 4; ++k) { const int t2 = dir == 0 ? k : 3 - k; const f32x2 v = TAGG[(t2 * 2 + dir) * 64 + c]; cB = v[0] * cB + v[1]; cA *= v[0]; }
            f32x2* AGG = (f32x2*)(ws + WS_AGG);
            AGG[((size_t)dir * NCHK + chunk) * 1024 + hd * 64 + c] = (f32x2){cA, cB};
        }
    } else {
        const float* CARRY = (const float*)(ws + WS_CARRY);
        float yv[16];
#pragma unroll
        for (int dir = 0; dir < 2; ++dir) {
            float st = CARRY[((size_t)dir * NCHK + chunk) * 1024 + cg_];
            if (dir == 0) {
#pragma unroll
                for (int t2 = 0; t2 < 3; ++t2) if (t2 < tw) { const f32x2 v = TAGG[(t2 * 2 + 0) * 64 + cin]; st = v[0] * st + v[1]; }
            } else {
#pragma unroll
                for (int t2 = 3; t2 > 0; --t2) if (t2 > tw) { const f32x2 v = TAGG[(t2 * 2 + 1) * 64 + cin]; st = v[0] * st + v[1]; }
            }
            float hst[4];
            if (dir == 0) {
                float s = st;
#pragma unroll
                for (int g = 0; g < 4; ++g) { const float sE = s; s = GA[0][2 * g] * s + GB[0][2 * g]; const float sO = s; s = GA[0][2 * g + 1] * s + GB[0][2 * g + 1]; hst[g] = hh ? sO : sE; }
            } else {
                float s = st;
#pragma unroll
                for (int g = 3; g >= 0; --g) { const float sO = s; s = GA[1][2 * g + 1] * s + GB[1][2 * g + 1]; const float sE = s; s = GA[1][2 * g] * s + GB[1][2 * g]; hst[g] = hh ? sO : sE; }
            }
#pragma unroll
            for (int g = 0; g < 4; ++g) {
                float h = hst[g];
                if (dir == 0) {
#pragma unroll
                    for (int k = 0; k < 4; ++k) { h = av[0][4 * g + k] * h + bv[0][4 * g + k]; yv[4 * g + k] = h; }
                } else {
#pragma unroll
                    for (int k = 3; k >= 0; --k) { h = av[1][4 * g + k] * h + bv[1][4 * g + k]; yv[4 * g + k] += h; }
                }
            }
        }
        bf16_t* Y = (bf16_t*)(ws + WS_Y);
#pragma unroll
        for (int i = 0; i < 16; ++i) {
            const int row = chunk * 128 + 32 * tw + (i & 3) + 8 * (i >> 2) + 4 * hh;
            const float gt = bf1(PX[(size_t)row * DIN + 1024 + cg_]);
            Y[(size_t)row * D + cg_] = f2bf(yv[i] * silu(gt));
        }
    }
}

__device__ __forceinline__ void conv_item(const Args a, int l, int ct, LAS unsigned char* lds) {
    const int tid = tid_fresh(), lane = tid & 63, wave = tid >> 6, c = tid;
    unsigned char* ws = ptr_fresh(a.ws);
    const bf16_t* PX = (const bf16_t*)(ws + WS_PX); bf16_t* Y = (bf16_t*)(ws + WS_Y);
    LAS float* CB = (LAS float*)lds;
    const int t0 = ct * 128, seg_lo = ct < 2 ? 0 : CL, seg_hi = ct < 2 ? CL : R;
    float w[31];
#pragma unroll
    for (int j = 0; j < 31; ++j) w[j] = a.in[16][((size_t)l * 31 + j) * 512 + c];
    const float bias = a.in[17][l * 512 + c];
    float win[32];
#define CONV_Z(dst, rr_) do { const int _rr = (rr_); const int _rc = _rr < seg_lo ? seg_lo : (_rr >= seg_hi ? seg_hi - 1 : _rr); const float _v = bf1(PX[(size_t)_rc * DIN + 2048 + c]), _g = bf1(PX[(size_t)_rc * DIN + 2560 + c]); const float _z = _v * sigm(_g); dst = (_rr == _rc) ? _z : 0.f; } while (0)
#pragma unroll
    for (int e = 0; e < 30; ++e) CONV_Z(win[e], t0 - 15 + e);
    win[30] = 0.f; win[31] = 0.f;
    __syncthreads();
#pragma unroll 1
    for (int bb = 0; bb < 4; ++bb) {
        LAS float* cbuf = CB + (bb & 1) * (32 * 512);
#pragma unroll
        for (int u = 0; u < 32; ++u) {
            if ((u & 7) == 0) asm volatile("" ::: "memory");
            CONV_Z(win[(u + 30) & 31], t0 - 15 + 32 * bb + u + 30);
            float acc = bias;
#pragma unroll
            for (int j = 0; j < 31; ++j) acc += w[j] * win[(u + j) & 31];
            cbuf[u * 512 + c] = acc;
        }
        __syncthreads();
#pragma unroll 1
        for (int uu = 0; uu < 4; ++uu) {
            const int u = wave * 4 + uu, row = t0 + 32 * bb + u;
            float v[8]; float s = 0.f;
#pragma unroll
            for (int k = 0; k < 8; ++k) { v[k] = cbuf[u * 512 + lane + 64 * k]; s += v[k]; }
            const float mean = wave_sum(s) * (1.0f / 512.0f);
            float s2 = 0.f;
#pragma unroll
            for (int k = 0; k < 8; ++k) { v[k] -= mean; s2 += v[k] * v[k]; }
            const float rstd = 1.0f / sqrtf(wave_sum(s2) * (1.0f / 512.0f) + EPS);
#pragma unroll
            for (int k = 0; k < 8; ++k) {
                const int ch = lane + 64 * k;
                const float y = silu(v[k] * rstd * a.in[18][l * 512 + ch] + a.in[19][l * 512 + ch]);
                const float gt = bf1(PX[(size_t)row * DIN + 3072 + ch]);
                Y[(size_t)row * D + 1024 + ch] = f2bf(y * silu(gt));
            }
        }
    }
#undef CONV_Z
}

constexpr int TT_STRIDE = 136;
__device__ __forceinline__ void sgu_item(const Args a, int l, int sc, LAS unsigned char* lds) {
    const int tid = tid_fresh(), lane = tid & 63, wave = tid >> 6;
    unsigned char* ws = ptr_fresh(a.ws);
    const bf16_t* PX = (const bf16_t*)(ws + WS_PX); bf16_t* Y = (bf16_t*)(ws + WS_Y);
    const bf16_t* SW = (const bf16_t*)(ws + WS_SW) + (size_t)l * 8 * 128 * 128;
    LAS f32x2* ST = (LAS f32x2*)lds;
    LAS bf16_t* TT = (LAS bf16_t*)(lds + 1024);
    const int t0 = sc * 128;
    __syncthreads();
#pragma unroll 1
    for (int k = 0; k < 16; ++k) {
        const int tok = wave * 16 + k;
        const u32x4 p = *(const u32x4*)(PX + (size_t)(t0 + tok) * DIN + 4096 + 8 * lane);
        float g[8] = {gelu_t(bflo(p.x)), gelu_t(bfhi(p.x)), gelu_t(bflo(p.y)), gelu_t(bfhi(p.y)), gelu_t(bflo(p.z)), gelu_t(bfhi(p.z)), gelu_t(bflo(p.w)), gelu_t(bfhi(p.w))};
        float s = 0.f;
#pragma unroll
        for (int j = 0; j < 8; ++j) s += g[j];
        const float mean = wave_sum(s) * (1.0f / 512.0f);
        float s2 = 0.f;
#pragma unroll
        for (int j = 0; j < 8; ++j) { const float d = g[j] - mean; s2 += d * d; }
        const float rstd = 1.0f / sqrtf(wave_sum(s2) * (1.0f / 512.0f) + EPS);
        if (lane == 0) ST[tok] = (f32x2){mean, rstd};
    }
    __syncthreads();
    const int p_ = tid >> 2, dq = tid & 3;
    const f32x2 st = ST[p_];
    const int fr = lane & 15, fq = lane >> 4;
#pragma unroll 1
    for (int h = 0; h < 8; ++h) {
        LAS bf16_t* tt = TT + (h & 1) * (64 * TT_STRIDE);
        {
            const int ch = 64 * h + 16 * dq;
            const u32x4 q0 = *(const u32x4*)(PX + (size_t)(t0 + p_) * DIN + 4096 + ch), q1 = *(const u32x4*)(PX + (size_t)(t0 + p_) * DIN + 4096 + ch + 8);
            const unsigned pw[8] = {q0.x, q0.y, q0.z, q0.w, q1.x, q1.y, q1.z, q1.w};
            const float* lg = a.in[20] + l * 512 + ch; const float* lb = a.in[21] + l * 512 + ch;
#pragma unroll
            for (int j = 0; j < 8; ++j) {
                const float v0 = (gelu_t(bflo(pw[j])) - st[0]) * st[1] * lg[2 * j] + lb[2 * j];
                const float v1 = (gelu_t(bfhi(pw[j])) - st[0]) * st[1] * lg[2 * j + 1] + lb[2 * j + 1];
                tt[(16 * dq + 2 * j) * TT_STRIDE + p_] = f2bf(v0);
                tt[(16 * dq + 2 * j + 1) * TT_STRIDE + p_] = f2bf(v1);
            }
        }
        __syncthreads();
        f32x4 acc[4];
#pragma unroll
        for (int nt = 0; nt < 4; ++nt) acc[nt] = (f32x4){0.f, 0.f, 0.f, 0.f};
#pragma unroll
        for (int s = 0; s < 4; ++s) {
            const bf16x8 Afr = *(const bf16x8*)(SW + ((size_t)h * 128 + 16 * wave + fr) * 128 + 32 * s + 8 * fq);
#pragma unroll
            for (int nt = 0; nt < 4; ++nt) {
                const bf16x8 Bfr = *(const LAS bf16x8*)(tt + (16 * nt + fr) * TT_STRIDE + 32 * s + 8 * fq);
                acc[nt] = __builtin_amdgcn_mfma_f32_16x16x32_bf16(Afr, Bfr, acc[nt], 0, 0, 0);
            }
        }
#pragma unroll
        for (int reg = 0; reg < 4; ++reg) {
            const int q = 16 * wave + 4 * fq + reg, row = t0 + q;
            const float bs = a.in[23][((size_t)l * 8 + h) * 128 + q];
#pragma unroll
            for (int nt = 0; nt < 4; ++nt) {
                const int ch = 64 * h + 16 * nt + fr;
                const float uu = gelu_t(bf1(PX[(size_t)row * DIN + 3584 + ch]));
                const float gt = bf1(PX[(size_t)row * DIN + 4608 + ch]);
                Y[(size_t)row * D + 1536 + ch] = f2bf(uu * (acc[nt][reg] + bs) * silu(gt));
            }
        }
    }
}


constexpr int L2_GWL = 0;
constexpr int L2_CW = 32768;
constexpr int L2_RAW = 34816;
constexpr int RAW_ROWB = 144, RAW_BUFB = 132 * RAW_ROWB;
constexpr int L2_XLF = L2_RAW + 2 * RAW_BUFB;
constexpr int L2_XLB = L2_XLF + 128 * XLF_STRIDE * 4;
constexpr int L2_TAGG = L2_XLB + 128 * XLB_STRIDE * 2;
static_assert(L2_TAGG + 4096 <= LDS_BYTES, "lds map");

template <bool PASSC>
__device__ __forceinline__ void lru_phase(const Args a, int l, int c_lo, LAS unsigned char* lds) {
    const int tid = tid_fresh(), lane = tid & 63, wave = tid >> 6, b = blockIdx.x, G = gridDim.x;
    unsigned char* ws = ptr_fresh(a.ws);
    const bf16_t* PX = (const bf16_t*)(ws + WS_PX);
    const int hd = b & 15, cstep = G >> 4;
    int chunk = c_lo + (b >> 4);
    if (chunk >= NCHK) return;
    LAS float* CW = (LAS float*)(lds + L2_CW);
    LAS float* XLF = (LAS float*)(lds + L2_XLF);
    LAS bf16_t* XLB = (LAS bf16_t*)(lds + L2_XLB);
    LAS f32x2* TAGG = (LAS f32x2*)(lds + L2_TAGG);
    __syncthreads();
    {
        const bf16_t* GW = (const bf16_t*)(ws + WS_GW) + (size_t)(l * 16 + hd) * 16384;
#pragma unroll
        for (int i = 0; i < 4; ++i) *(LAS u32x4*)(lds + L2_GWL + (tid + 512 * i) * 16) = *(const u32x4*)(GW + (size_t)(tid + 512 * i) * 8);
        if (tid < 320) { const int j = tid >> 6, c = tid & 63; CW[tid] = j < 4 ? a.in[9][((size_t)l * 4 + j) * 1024 + hd * 64 + c] : a.in[10][(size_t)l * 1024 + hd * 64 + c]; }
    }
    const int tw = wave >> 1, chh = wave & 1, cl = lane & 31, hh = lane >> 5;
    const int cin = 32 * chh + cl, cg_ = hd * 64 + cin;
    float brv[2], biv[2], k8[2];
#pragma unroll
    for (int dir = 0; dir < 2; ++dir) {
        brv[dir] = a.in[13][(size_t)(l * 2 + dir) * 1024 + cg_]; biv[dir] = a.in[15][(size_t)(l * 2 + dir) * 1024 + cg_];
        k8[dir] = -8.0f * log1pf(__expf(-a.in[11][(size_t)(l * 2 + dir) * 1024 + cg_]));
    }
    const int t = tid >> 2, q = tid & 3, ch0 = hd * 64 + q * 16;
    const int hrow = (tid >> 2) < 2 ? (tid >> 2) : 130;
    u32x4 r0, r1, h0, h1;
    const u32x4 zero4 = {0u, 0u, 0u, 0u};
#define LRU_LOAD_RAW(ck) do { const int _t0 = (ck) * 128, _lo = (ck) < 2 ? 0 : CL, _hi = (ck) < 2 ? CL : R; \
        const bf16_t* _p = PX + (size_t)(_t0 + t) * DIN + ch0; r0 = *(const u32x4*)_p; r1 = *(const u32x4*)(_p + 8); \
        h0 = zero4; h1 = zero4; \
        if (tid < 12) { const int _gr = _t0 - 2 + hrow; if (_gr >= _lo && _gr < _hi) { const bf16_t* _ph = PX + (size_t)_gr * DIN + ch0; h0 = *(const u32x4*)_ph; h1 = *(const u32x4*)(_ph + 8); } } } while (0)
#define LRU_STORE_RAW(buf) do { LAS unsigned char* _rb = lds + L2_RAW + (buf) * RAW_BUFB; \
        *(LAS u32x4*)(_rb + (t + 2) * RAW_ROWB + 32 * q) = r0; *(LAS u32x4*)(_rb + (t + 2) * RAW_ROWB + 32 * q + 16) = r1; \
        if (tid < 12) { *(LAS u32x4*)(_rb + hrow * RAW_ROWB + 32 * q) = h0; *(LAS u32x4*)(_rb + hrow * RAW_ROWB + 32 * q + 16) = h1; } } while (0)
    LRU_LOAD_RAW(chunk);
    LRU_STORE_RAW(0);
    int cur = 0;
    __syncthreads();
#pragma unroll 1
    for (; chunk < NCHK; chunk += cstep) {
        const int nchunk = chunk + cstep;
        const bool has_next = nchunk < NCHK;
        u32x4 g0 = zero4, g1 = zero4; float cry[2] = {0.f, 0.f};
        if (PASSC) {
            const bf16_t* gp = PX + (size_t)(chunk * 128 + t) * DIN + 1024 + ch0;
            g0 = *(const u32x4*)gp; g1 = *(const u32x4*)(gp + 8);
            const float* CARRY = (const float*)(ws + WS_CARRY);
            cry[0] = CARRY[((size_t)0 * NCHK + chunk) * 1024 + cg_]; cry[1] = CARRY[((size_t)1 * NCHK + chunk) * 1024 + cg_];
        }
        if (has_next) LRU_LOAD_RAW(nchunk);
        {
            LAS unsigned char* rb = lds + L2_RAW + cur * RAW_BUFB;
            const int tg = tid >> 4, c4 = (tid & 15) * 4;
            f32x4 wv[4];
#pragma unroll
            for (int j = 0; j < 4; ++j) wv[j] = *(LAS f32x4*)(CW + j * 64 + c4);
            const f32x4 bb = *(LAS f32x4*)(CW + 256 + c4);
            f32x4 xr[7];
#pragma unroll
            for (int r = 0; r < 7; ++r) { const u32x2 pr = *(LAS u32x2*)(rb + (4 * tg + r) * RAW_ROWB + c4 * 2); xr[r] = (f32x4){bflo(pr.x), bfhi(pr.x), bflo(pr.y), bfhi(pr.y)}; }
#pragma unroll
            for (int tt = 0; tt < 4; ++tt) {
                const f32x4 xl = bb + wv[0] * xr[tt] + wv[1] * xr[tt + 1] + wv[2] * xr[tt + 2] + wv[3] * xr[tt + 3];
                *(LAS f32x4*)(XLF + (4 * tg + tt) * XLF_STRIDE + c4) = xl;
                u32x2 o; o.x = pk2(xl[0], xl[1]); o.y = pk2(xl[2], xl[3]);
                *(LAS u32x2*)(XLB + (4 * tg + tt) * XLB_STRIDE + c4) = o;
            }
        }
        __syncthreads();
        bf16x8 Af[4];
#pragma unroll
        for (int s = 0; s < 4; ++s) Af[s] = *(const LAS bf16x8*)(XLB + (32 * tw + cl) * XLB_STRIDE + 16 * s + 8 * hh);
        float xlv[16];
#pragma unroll
        for (int i = 0; i < 16; ++i) xlv[i] = XLF[(32 * tw + (i & 3) + 8 * (i >> 2) + 4 * hh) * XLF_STRIDE + cin];
        float av[2][16], bv[2][16], GA[2][8], GB[2][8];
#pragma unroll
        for (int dir = 0; dir < 2; ++dir) {
            f32x16 ar, ai;
#pragma unroll
            for (int i = 0; i < 16; ++i) { ar[i] = 0.f; ai[i] = 0.f; }
#pragma unroll
            for (int s = 0; s < 4; ++s) {
                const bf16x8 Br = *(const LAS bf16x8*)(lds + L2_GWL + ((((dir * 2 + 0) * 2 + chh) * 4 + s) * 64 + lane) * 16);
                const bf16x8 Bi = *(const LAS bf16x8*)(lds + L2_GWL + ((((dir * 2 + 1) * 2 + chh) * 4 + s) * 64 + lane) * 16);
                ar = __builtin_amdgcn_mfma_f32_32x32x16_bf16(Af[s], Br, ar, 0, 0, 0);
                ai = __builtin_amdgcn_mfma_f32_32x32x16_bf16(Af[s], Bi, ai, 0, 0, 0);
            }
#pragma unroll
            for (int i = 0; i < 16; ++i) {
                const float rg = sigm(ar[i] + brv[dir]), ig = sigm(ai[i] + biv[dir]);
                const float aa = __expf(k8[dir] * rg);
                av[dir][i] = aa;
                bv[dir][i] = __builtin_amdgcn_sqrtf(fmaxf(1.0f - aa * aa, 0.f)) * ig * xlv[i];
            }
            float oA[4], oB[4];
#pragma unroll
            for (int g = 0; g < 4; ++g) {
                const float a0 = av[dir][4 * g], a1 = av[dir][4 * g + 1], a2 = av[dir][4 * g + 2], a3 = av[dir][4 * g + 3];
                const float b0 = bv[dir][4 * g], b1 = bv[dir][4 * g + 1], b2 = bv[dir][4 * g + 2], b3 = bv[dir][4 * g + 3];
                oA[g] = (a0 * a1) * (a2 * a3);
                oB[g] = dir == 0 ? ((b0 * a1 + b1) * a2 + b2) * a3 + b3 : ((b3 * a2 + b2) * a1 + b1) * a0 + b0;
            }
#pragma unroll
            for (int g = 0; g < 4; ++g) {
                const float pA = __shfl_xor(oA[g], 32), pB = __shfl_xor(oB[g], 32);
                GA[dir][2 * g] = hh ? pA : oA[g]; GA[dir][2 * g + 1] = hh ? oA[g] : pA;
                GB[dir][2 * g] = hh ? pB : oB[g]; GB[dir][2 * g + 1] = hh ? oB[g] : pB;
            }
            float tA = 1.f, tB = 0.f;
            if (dir == 0) {
#pragma unroll
                for (int gq = 0; gq < 8; ++gq) { tB = GA[dir][gq] * tB + GB[dir][gq]; tA *= GA[dir][gq]; }
            } else {
#pragma unroll
                for (int gq = 7; gq >= 0; --gq) { tB = GA[dir][gq] * tB + GB[dir][gq]; tA *= GA[dir][gq]; }
            }
            if (hh == 0) TAGG[(tw * 2 + dir) * 64 + cin] = (f32x2){tA, tB};
        }
        if (has_next) LRU_STORE_RAW(cur ^ 1);
        __syncthreads();
        if constexpr (!PASSC) {
            if (tid < 128) {
                const int dir = tid >> 6, c = tid & 63;
                float cA = 1.f, cB = 0.f;
#pragma unroll
                for (int k = 0; k < 4; ++k) { const int t2 = dir == 0 ? k : 3 - k; const f32x2 v = TAGG[(t2 * 2 + dir) * 64 + c]; cB = v[0] * cB + v[1]; cA *= v[0]; }
                f32x2* AGG = (f32x2*)(ws + WS_AGG);
                AGG[((size_t)dir * NCHK + chunk) * 1024 + hd * 64 + c] = (f32x2){cA, cB};
            }
        } else {
            float yv[16];
#pragma unroll
            for (int dir = 0; dir < 2; ++dir) {
                float st = cry[dir];
                if (dir == 0) {
#pragma unroll
                    for (int t2 = 0; t2 < 3; ++t2) if (t2 < tw) { const f32x2 v = TAGG[(t2 * 2 + 0) * 64 + cin]; st = v[0] * st + v[1]; }
                } else {
#pragma unroll
                    for (int t2 = 3; t2 > 0; --t2) if (t2 > tw) { const f32x2 v = TAGG[(t2 * 2 + 1) * 64 + cin]; st = v[0] * st + v[1]; }
                }
                float hst[4];
                if (dir == 0) {
                    float s = st;
#pragma unroll
                    for (int g = 0; g < 4; ++g) { const float sE = s; s = GA[0][2 * g] * s + GB[0][2 * g]; const float sO = s; s = GA[0][2 * g + 1] * s + GB[0][2 * g + 1]; hst[g] = hh ? sO : sE; }
                } else {
                    float s = st;
#pragma unroll
                    for (int g = 3; g >= 0; --g) { const float sO = s; s = GA[1][2 * g + 1] * s + GB[1][2 * g + 1]; const float sE = s; s = GA[1][2 * g] * s + GB[1][2 * g]; hst[g] = hh ? sO : sE; }
                }
#pragma unroll
                for (int g = 0; g < 4; ++g) {
                    float h = hst[g];
                    if (dir == 0) {
#pragma unroll
                        for (int k = 0; k < 4; ++k) { h = av[0][4 * g + k] * h + bv[0][4 * g + k]; yv[4 * g + k] = h; }
                    } else {
#pragma unroll
                        for (int k = 3; k >= 0; --k) { h = av[1][4 * g + k] * h + bv[1][4 * g + k]; yv[4 * g + k] += h; }
                    }
                }
            }
            LAS bf16_t* YB = (LAS bf16_t*)(lds + L2_RAW + cur * RAW_BUFB);
#pragma unroll
            for (int i = 0; i < 16; ++i) YB[(32 * tw + (i & 3) + 8 * (i >> 2) + 4 * hh) * 72 + cin] = f2bf(yv[i]);
            __syncthreads();
            {
                const u32x4 y0 = *(LAS u32x4*)(YB + t * 72 + 16 * q), y1 = *(LAS u32x4*)(YB + t * 72 + 16 * q + 8);
                const unsigned yw[8] = {y0.x, y0.y, y0.z, y0.w, y1.x, y1.y, y1.z, y1.w};
                const unsigned gw_[8] = {g0.x, g0.y, g0.z, g0.w, g1.x, g1.y, g1.z, g1.w};
                unsigned ow[8];
#pragma unroll
                for (int j = 0; j < 8; ++j) ow[j] = pk2(bflo(yw[j]) * silu(bflo(gw_[j])), bfhi(yw[j]) * silu(bfhi(gw_[j])));
                bf16_t* yp = (bf16_t*)(ws + WS_Y) + (size_t)(chunk * 128 + t) * D + ch0;
                *(u32x4*)yp = (u32x4){ow[0], ow[1], ow[2], ow[3]}; *(u32x4*)(yp + 8) = (u32x4){ow[4], ow[5], ow[6], ow[7]};
            }
        }
        cur ^= 1;
    }
#undef LRU_LOAD_RAW
#undef LRU_STORE_RAW
}

constexpr int CV_ZT = 0;
constexpr int CV_CB = 94 * 1024;
static_assert(CV_CB + 16 * 512 * 4 <= LDS_BYTES, "conv lds map");
__device__ __forceinline__ void conv_item2(const Args a, int l, int ct, LAS unsigned char* lds) {
    const int tid = tid_fresh(), lane = tid & 63, wave = tid >> 6, c = tid;
    unsigned char* ws = ptr_fresh(a.ws);
    const bf16_t* PX = (const bf16_t*)(ws + WS_PX); bf16_t* Y = (bf16_t*)(ws + WS_Y);
    LAS bf16_t* ZT = (LAS bf16_t*)(lds + CV_ZT);
    LAS float* CB = (LAS float*)(lds + CV_CB);
    const int t0 = ct * 64, seg_lo = t0 < CL ? 0 : CL, seg_hi = t0 < CL ? CL : R;
    __syncthreads();
#pragma unroll 4
    for (int it = 0; it < 12; ++it) {
        const int pid = tid + 512 * it, e = pid >> 6, pc = pid & 63;
        if (e < 94) {
            const int rr = t0 - 15 + e, rc = rr < seg_lo ? seg_lo : (rr >= seg_hi ? seg_hi - 1 : rr);
            const u32x4 v = *(const u32x4*)(PX + (size_t)rc * DIN + 2048 + 8 * pc), g = *(const u32x4*)(PX + (size_t)rc * DIN + 2560 + 8 * pc);
            const unsigned vw[4] = {v.x, v.y, v.z, v.w}, gw_[4] = {g.x, g.y, g.z, g.w};
            u32x4 o;
            unsigned ow[4];
#pragma unroll
            for (int j = 0; j < 4; ++j) ow[j] = pk2(bflo(vw[j]) * sigm(bflo(gw_[j])), bfhi(vw[j]) * sigm(bfhi(gw_[j])));
            const bool ok = rr == rc;
            o.x = ok ? ow[0] : 0u; o.y = ok ? ow[1] : 0u; o.z = ok ? ow[2] : 0u; o.w = ok ? ow[3] : 0u;
            *(LAS u32x4*)(ZT + e * 512 + 8 * pc) = o;
        }
    }
    float w[31];
#pragma unroll
    for (int j = 0; j < 31; ++j) w[j] = a.in[16][((size_t)l * 31 + j) * 512 + c];
    const float bias = a.in[17][l * 512 + c];
    float lg[8], lb[8];
    { const f32x4 x0 = *(const f32x4*)(a.in[18] + l * 512 + 8 * lane), x1 = *(const f32x4*)(a.in[18] + l * 512 + 8 * lane + 4), y0 = *(const f32x4*)(a.in[19] + l * 512 + 8 * lane), y1 = *(const f32x4*)(a.in[19] + l * 512 + 8 * lane + 4);
#pragma unroll
      for (int k = 0; k < 4; ++k) { lg[k] = x0[k]; lg[4 + k] = x1[k]; lb[k] = y0[k]; lb[4 + k] = y1[k]; } }
    __syncthreads();
    float win[32];
#pragma unroll
    for (int e = 0; e < 30; ++e) win[e] = bf1(ZT[e * 512 + c]);
    win[30] = 0.f; win[31] = 0.f;
#pragma unroll 1
    for (int bb = 0; bb < 2; ++bb) {
#pragma unroll
        for (int hb = 0; hb < 2; ++hb) {
            u32x4 gt[2];
#pragma unroll
            for (int uu = 0; uu < 2; ++uu) gt[uu] = *(const u32x4*)(PX + (size_t)(t0 + 32 * bb + 16 * hb + wave * 2 + uu) * DIN + 3072 + 8 * lane);
#pragma unroll
            for (int u16 = 0; u16 < 16; ++u16) {
                const int u = 16 * hb + u16;
                win[(u + 30) & 31] = bf1(ZT[(32 * bb + u + 30) * 512 + c]);
                float acc = bias;
#pragma unroll
                for (int j = 0; j < 31; ++j) acc += w[j] * win[(u + j) & 31];
                CB[u16 * 512 + c] = acc;
            }
            __syncthreads();
#pragma unroll
            for (int uu = 0; uu < 2; ++uu) {
                const int u = wave * 2 + uu, row = t0 + 32 * bb + 16 * hb + u;
                float v[8]; float s = 0.f;
                { const f32x4 c0 = *(LAS f32x4*)(CB + u * 512 + 8 * lane), c1 = *(LAS f32x4*)(CB + u * 512 + 8 * lane + 4);
#pragma unroll
                  for (int k = 0; k < 4; ++k) { v[k] = c0[k]; v[4 + k] = c1[k]; } }
#pragma unroll
                for (int k = 0; k < 8; ++k) s += v[k];
                const float mean = wave_sum(s) * (1.0f / 512.0f);
                float s2 = 0.f;
#pragma unroll
                for (int k = 0; k < 8; ++k) { v[k] -= mean; s2 += v[k] * v[k]; }
                const float rstd = 1.0f / sqrtf(wave_sum(s2) * (1.0f / 512.0f) + EPS);
                const unsigned gw_[4] = {gt[uu].x, gt[uu].y, gt[uu].z, gt[uu].w};
                unsigned ow[4];
#pragma unroll
                for (int k = 0; k < 4; ++k) {
                    const float y0 = silu(v[2 * k] * rstd * lg[2 * k] + lb[2 * k]) * silu(bflo(gw_[k]));
                    const float y1 = silu(v[2 * k + 1] * rstd * lg[2 * k + 1] + lb[2 * k + 1]) * silu(bfhi(gw_[k]));
                    ow[k] = pk2(y0, y1);
                }
                *(u32x4*)(Y + (size_t)row * D + 1024 + 8 * lane) = (u32x4){ow[0], ow[1], ow[2], ow[3]};
            }
            __syncthreads();
        }
    }
}

__device__ __forceinline__ void sgu_item2(const Args a, int l, int item, LAS unsigned char* lds) {
    const int tid = tid_fresh(), lane = tid & 63, wave = tid >> 6;
    unsigned char* ws = ptr_fresh(a.ws);
    const bf16_t* PX = (const bf16_t*)(ws + WS_PX); bf16_t* Y = (bf16_t*)(ws + WS_Y);
    const bf16_t* SW = (const bf16_t*)(ws + WS_SW) + (size_t)l * 8 * 128 * 128;
    LAS f32x2* ST = (LAS f32x2*)lds;
    LAS bf16_t* TT = (LAS bf16_t*)(lds + 1024);
    const int sc = item >> 1, hg = item & 1, t0 = sc * 128;
    __syncthreads();
#pragma unroll
    for (int kb = 0; kb < 2; ++kb) {
        u32x4 p[8];
#pragma unroll
        for (int k = 0; k < 8; ++k) p[k] = *(const u32x4*)(PX + (size_t)(t0 + wave * 16 + kb * 8 + k) * DIN + 4096 + 8 * lane);
#pragma unroll
        for (int k = 0; k < 8; ++k) {
            float g[8] = {gelu_t(bflo(p[k].x)), gelu_t(bfhi(p[k].x)), gelu_t(bflo(p[k].y)), gelu_t(bfhi(p[k].y)), gelu_t(bflo(p[k].z)), gelu_t(bfhi(p[k].z)), gelu_t(bflo(p[k].w)), gelu_t(bfhi(p[k].w))};
            float s = 0.f;
#pragma unroll
            for (int j = 0; j < 8; ++j) s += g[j];
            const float mean = wave_sum(s) * (1.0f / 512.0f);
            float s2 = 0.f;
#pragma unroll
            for (int j = 0; j < 8; ++j) { const float d = g[j] - mean; s2 += d * d; }
            const float rstd = 1.0f / sqrtf(wave_sum(s2) * (1.0f / 512.0f) + EPS);
            if (lane == 0) ST[wave * 16 + kb * 8 + k] = (f32x2){mean, rstd};
        }
    }
    __syncthreads();
    const int p_ = tid >> 2, dq = tid & 3;
    const f32x2 st = ST[p_];
    const int fr = lane & 15, fq = lane >> 4;
    LAS float* SO = (LAS float*)(lds + 1024 + 2 * 64 * TT_STRIDE * 2);
    u32x4 Lq0[2], Lq1[2], Lu0[2], Lu1[2], Lg0[2], Lg1[2]; bf16x8 LA[2][4]; f32x4 Llg[2][4], Llb[2][4]; float Lbs[2];
#define SGU_LOAD(sl, h_) do { const int _ch = 64 * (h_) + 16 * dq; const bf16_t* _pr = PX + (size_t)(t0 + p_) * DIN + _ch; \
        Lq0[sl] = *(const u32x4*)(_pr + 4096); Lq1[sl] = *(const u32x4*)(_pr + 4096 + 8); Lu0[sl] = *(const u32x4*)(_pr + 3584); Lu1[sl] = *(const u32x4*)(_pr + 3584 + 8); \
        Lg0[sl] = *(const u32x4*)(_pr + 4608); Lg1[sl] = *(const u32x4*)(_pr + 4608 + 8); \
        _Pragma("unroll") for (int s = 0; s < 4; ++s) LA[sl][s] = *(const bf16x8*)(SW + ((size_t)(h_) * 128 + 16 * wave + fr) * 128 + 32 * s + 8 * fq); \
        Lbs[sl] = a.in[23][((size_t)l * 8 + (h_)) * 128 + p_]; \
        _Pragma("unroll") for (int j = 0; j < 4; ++j) { Llg[sl][j] = *(const f32x4*)(a.in[20] + l * 512 + _ch + 4 * j); Llb[sl][j] = *(const f32x4*)(a.in[21] + l * 512 + _ch + 4 * j); } } while (0)
    SGU_LOAD(0, 4 * hg);
#pragma unroll
    for (int h4 = 0; h4 < 4; ++h4) {
        const int h = 4 * hg + h4, sl = h4 & 1;
        LAS bf16_t* tt = TT + (h4 & 1) * (64 * TT_STRIDE);
        if (h4 + 1 < 4) SGU_LOAD(sl ^ 1, h + 1);
        const int ch = 64 * h + 16 * dq;
        const u32x4 q0 = Lq0[sl], q1 = Lq1[sl], u0 = Lu0[sl], u1 = Lu1[sl], g0 = Lg0[sl], g1 = Lg1[sl];
        bf16x8 Afr[4];
#pragma unroll
        for (int s = 0; s < 4; ++s) Afr[s] = LA[sl][s];
        const float bs = Lbs[sl];
        f32x4 lgv[4], lbv[4];
#pragma unroll
        for (int j = 0; j < 4; ++j) { lgv[j] = Llg[sl][j]; lbv[j] = Llb[sl][j]; }
        {
            const unsigned pw[8] = {q0.x, q0.y, q0.z, q0.w, q1.x, q1.y, q1.z, q1.w};
#pragma unroll
            for (int j = 0; j < 8; ++j) {
                const float v0 = (gelu_t(bflo(pw[j])) - st[0]) * st[1] * lgv[j >> 1][(2 * j) & 3] + lbv[j >> 1][(2 * j) & 3];
                const float v1 = (gelu_t(bfhi(pw[j])) - st[0]) * st[1] * lgv[j >> 1][(2 * j + 1) & 3] + lbv[j >> 1][(2 * j + 1) & 3];
                tt[(16 * dq + 2 * j) * TT_STRIDE + p_] = f2bf(v0);
                tt[(16 * dq + 2 * j + 1) * TT_STRIDE + p_] = f2bf(v1);
            }
        }
        __syncthreads();
        f32x4 acc[4];
#pragma unroll
        for (int nt = 0; nt < 4; ++nt) acc[nt] = (f32x4){0.f, 0.f, 0.f, 0.f};
#pragma unroll
        for (int s = 0; s < 4; ++s)
#pragma unroll
            for (int nt = 0; nt < 4; ++nt) {
                const bf16x8 Bfr = *(const LAS bf16x8*)(tt + (16 * nt + fr) * TT_STRIDE + 32 * s + 8 * fq);
                acc[nt] = __builtin_amdgcn_mfma_f32_16x16x32_bf16(Afr[s], Bfr, acc[nt], 0, 0, 0);
            }
#pragma unroll
        for (int reg = 0; reg < 4; ++reg)
#pragma unroll
            for (int nt = 0; nt < 4; ++nt) SO[(16 * wave + 4 * fq + reg) * 68 + 16 * nt + fr] = acc[nt][reg];
        __syncthreads();
        {
            const unsigned uw[8] = {u0.x, u0.y, u0.z, u0.w, u1.x, u1.y, u1.z, u1.w}, gw_[8] = {g0.x, g0.y, g0.z, g0.w, g1.x, g1.y, g1.z, g1.w};
            unsigned ow[8];
#pragma unroll
            for (int j4 = 0; j4 < 4; ++j4) {
                const f32x4 sv = *(LAS f32x4*)(SO + p_ * 68 + 16 * dq + 4 * j4);
                ow[2 * j4] = pk2(gelu_t(bflo(uw[2 * j4])) * (sv[0] + bs) * silu(bflo(gw_[2 * j4])), gelu_t(bfhi(uw[2 * j4])) * (sv[1] + bs) * silu(bfhi(gw_[2 * j4])));
                ow[2 * j4 + 1] = pk2(gelu_t(bflo(uw[2 * j4 + 1])) * (sv[2] + bs) * silu(bflo(gw_[2 * j4 + 1])), gelu_t(bfhi(uw[2 * j4 + 1])) * (sv[3] + bs) * silu(bfhi(gw_[2 * j4 + 1])));
            }
            bf16_t* yp = Y + (size_t)(t0 + p_) * D + 1536 + ch;
            *(u32x4*)yp = (u32x4){ow[0], ow[1], ow[2], ow[3]}; *(u32x4*)(yp + 8) = (u32x4){ow[4], ow[5], ow[6], ow[7]};
        }
    }
#undef SGU_LOAD
}

__device__ __forceinline__ int scan_chunk(int dir, int o) { return dir == 0 ? o : (o == 0 ? 1 : (o == 1 ? 0 : (NCHK + 1 - o))); }
__device__ __forceinline__ void phase_carry(const Args a, LAS unsigned char* lds) {
    const int tid = tid_fresh(), b = blockIdx.x, G = gridDim.x;
    unsigned char* ws = ptr_fresh(a.ws);
    const f32x2* AGG = (const f32x2*)(ws + WS_AGG); float* CARRY = (float*)(ws + WS_CARRY);
    LAS f32x2* SEG = (LAS f32x2*)lds;
    for (int u = b; u < 64; u += G) {
        const int dir = u >> 5, ch = (u & 31) * 32 + (tid & 31), sg = tid >> 5;
        f32x2 ab[10];
        if (sg < 13) {
#pragma unroll
            for (int k = 0; k < 10; ++k) ab[k] = AGG[((size_t)dir * NCHK + scan_chunk(dir, 10 * sg + k)) * 1024 + ch];
            float sA = 1.f, sB = 0.f;
#pragma unroll
            for (int k = 0; k < 10; ++k) { sB = ab[k][0] * sB + ab[k][1]; sA *= ab[k][0]; }
            SEG[sg * 32 + (tid & 31)] = (f32x2){sA, sB};
        }
        __syncthreads();
        if (sg < 13) {
            float st = 0.f;
            for (int s2 = 0; s2 < sg; ++s2) { const f32x2 v = SEG[s2 * 32 + (tid & 31)]; st = v[0] * st + v[1]; }
#pragma unroll
            for (int k = 0; k < 10; ++k) { CARRY[((size_t)dir * NCHK + scan_chunk(dir, 10 * sg + k)) * 1024 + ch] = st; st = ab[k][0] * st + ab[k][1]; }
        }
        __syncthreads();
    }
}

__device__ __forceinline__ void phase_resid0(const Args a) {
    const int tid = tid_fresh(), lane = tid & 63, wave = tid >> 6, b = blockIdx.x, G = gridDim.x;
    unsigned char* ws = ptr_fresh(a.ws);
    const bf16_t* DL0 = (const bf16_t*)(ws + WS_DL0);
    const float* gg0 = (const float*)(ws + WS_GG);
    const float* gg = (const float*)(ws + WS_GG) + (size_t)2 * D;
    bf16_t* XG = (bf16_t*)(ws + WS_XG) + (size_t)CL * D; float* rss1 = (float*)(ws + WS_RSS) + R + CL;
    f32x4 g[8], rg0[8];
#pragma unroll
    for (int j = 0; j < 4; ++j) { g[2 * j] = *(const f32x4*)(gg + 8 * (lane + 64 * j)); g[2 * j + 1] = *(const f32x4*)(gg + 8 * (lane + 64 * j) + 4);
        const f32x4 h0 = *(const f32x4*)(gg0 + 8 * (lane + 64 * j)), h1 = *(const f32x4*)(gg0 + 8 * (lane + 64 * j) + 4);
        rg0[2 * j] = (f32x4){1.0f / h0[0], 1.0f / h0[1], 1.0f / h0[2], 1.0f / h0[3]}; rg0[2 * j + 1] = (f32x4){1.0f / h1[0], 1.0f / h1[1], 1.0f / h1[2], 1.0f / h1[3]}; }
    u32x4 xr[4], dr[4];
#define RS_LOAD(t_, X, Dd) do { _Pragma("unroll") for (int j = 0; j < 4; ++j) { X[j] = *(const u32x4*)(XG + (size_t)(t_) * D + 8 * (lane + 64 * j)); Dd[j] = *(const u32x4*)(DL0 + (size_t)(t_) * D + 8 * (lane + 64 * j)); } } while (0)
    int t = b * 8 + wave;
    if (t < T) RS_LOAD(t, xr, dr);
    for (; t < T; t += G * 8) {
        u32x4 xn[4], dn[4];
        const int tn = t + G * 8;
        if (tn < T) RS_LOAD(tn, xn, dn);
        f32x4 v[8]; float ss = 0.f;
#pragma unroll
        for (int j = 0; j < 4; ++j) {
            v[2 * j] = (f32x4){bflo(xr[j].x), bfhi(xr[j].x), bflo(xr[j].y), bfhi(xr[j].y)} * rg0[2 * j] + (f32x4){bflo(dr[j].x), bfhi(dr[j].x), bflo(dr[j].y), bfhi(dr[j].y)};
            v[2 * j + 1] = (f32x4){bflo(xr[j].z), bfhi(xr[j].z), bflo(xr[j].w), bfhi(xr[j].w)} * rg0[2 * j + 1] + (f32x4){bflo(dr[j].z), bfhi(dr[j].z), bflo(dr[j].w), bfhi(dr[j].w)};
        }
#pragma unroll
        for (int j = 0; j < 8; ++j) ss += (v[j][0] * v[j][0] + v[j][1] * v[j][1]) + (v[j][2] * v[j][2] + v[j][3] * v[j][3]);
#pragma unroll
        for (int j = 0; j < 4; ++j) {
            const f32x4 p0 = v[2 * j] * g[2 * j], p1 = v[2 * j + 1] * g[2 * j + 1];
            u32x4 w; w.x = pk2(p0[0], p0[1]); w.y = pk2(p0[2], p0[3]); w.z = pk2(p1[0], p1[1]); w.w = pk2(p1[2], p1[3]);
            *(u32x4*)(XG + (size_t)t * D + 8 * (lane + 64 * j)) = w;
        }
        ss = wave_sum(ss);
        if (lane == 0) rss1[t] = ss;
        if (tn < T) {
#pragma unroll
            for (int j = 0; j < 4; ++j) { xr[j] = xn[j]; dr[j] = dn[j]; }
        }
    }
#undef RS_LOAD
}
__device__ __forceinline__ void phase_final(const Args a) {
    const int tid = tid_fresh(), lane = tid & 63, wave = tid >> 6, b = blockIdx.x, G = gridDim.x;
    unsigned char* ws = ptr_fresh(a.ws);
    const bf16_t* XG1 = (const bf16_t*)(ws + WS_XG) + (size_t)CL * D;
    const bf16_t* DL1 = (const bf16_t*)(ws + WS_DL0);
    const float* fg = a.in[24];
    const float* gg = (const float*)(ws + WS_GG) + (size_t)2 * D;
    u32x4 xr[4], er[4];
#define FN_LOAD(t_, X, Ee) do { _Pragma("unroll") for (int j = 0; j < 4; ++j) { X[j] = *(const u32x4*)(XG1 + (size_t)(t_) * D + 8 * (lane + 64 * j)); Ee[j] = *(const u32x4*)(DL1 + (size_t)(t_) * D + 8 * (lane + 64 * j)); } } while (0)
    f32x4 fgv[8], rg[8];
#pragma unroll
    for (int j = 0; j < 4; ++j) { fgv[2 * j] = *(const f32x4*)(fg + 8 * (lane + 64 * j)); fgv[2 * j + 1] = *(const f32x4*)(fg + 8 * (lane + 64 * j) + 4);
        const f32x4 g0 = *(const f32x4*)(gg + 8 * (lane + 64 * j)), g1 = *(const f32x4*)(gg + 8 * (lane + 64 * j) + 4);
        rg[2 * j] = (f32x4){1.0f / g0[0], 1.0f / g0[1], 1.0f / g0[2], 1.0f / g0[3]}; rg[2 * j + 1] = (f32x4){1.0f / g1[0], 1.0f / g1[1], 1.0f / g1[2], 1.0f / g1[3]}; }
    int t = b * 8 + wave;
    if (t < T) FN_LOAD(t, xr, er);
    for (; t < T; t += G * 8) {
        u32x4 xn[4], en[4];
        const int tn = t + G * 8;
        if (tn < T) FN_LOAD(tn, xn, en);
        float* orow = a.out + (size_t)t * D;
        f32x4 v[8]; float ss = 0.f;
#pragma unroll
        for (int j = 0; j < 4; ++j) {
            v[2 * j] = (f32x4){bflo(xr[j].x), bfhi(xr[j].x), bflo(xr[j].y), bfhi(xr[j].y)} * rg[2 * j] + (f32x4){bflo(er[j].x), bfhi(er[j].x), bflo(er[j].y), bfhi(er[j].y)};
            v[2 * j + 1] = (f32x4){bflo(xr[j].z), bfhi(xr[j].z), bflo(xr[j].w), bfhi(xr[j].w)} * rg[2 * j + 1] + (f32x4){bflo(er[j].z), bfhi(er[j].z), bflo(er[j].w), bfhi(er[j].w)};
        }
#pragma unroll
        for (int j = 0; j < 8; ++j) ss += (v[j][0] * v[j][0] + v[j][1] * v[j][1]) + (v[j][2] * v[j][2] + v[j][3] * v[j][3]);
        const float rs = 1.0f / sqrtf(wave_sum(ss) * (1.0f / D) + EPS);
#pragma unroll
        for (int j = 0; j < 4; ++j) {
            *(f32x4*)(orow + 8 * (lane + 64 * j)) = v[2 * j] * rs * fgv[2 * j]; *(f32x4*)(orow + 8 * (lane + 64 * j) + 4) = v[2 * j + 1] * rs * fgv[2 * j + 1];
        }
        if (tn < T) {
#pragma unroll
            for (int j = 0; j < 4; ++j) { xr[j] = xn[j]; er[j] = en[j]; }
        }
    }
#undef FN_LOAD
}

template <int NT, int MODE>
__device__ __forceinline__ void ctx_gemm(const Args a, int l, LAS unsigned char* lds) {
    const int tid = tid_fresh(), lane = tid & 63, wave = tid >> 6, b = blockIdx.x, G = gridDim.x;
    unsigned char* ws = ptr_fresh(a.ws);
    constexpr int TN = 16 * NT, N = 64 * TN, TS = TN + 4;
    const bf16_t* A = (const bf16_t*)(ws + (MODE == 0 ? WS_XG : WS_Y));
    const bf16_t* Bt = MODE == 0 ? (const bf16_t*)(ws + WS_WINT) + (size_t)l * DIN * D : (const bf16_t*)(ws + WS_WOUTT) + (size_t)l * D * D;
    LAS float* CT = (LAS float*)lds;
    const int fr = lane & 15, fq = lane >> 4;
#pragma unroll 1
    for (int tile = b; tile < 256; tile += G) {
        const int r0 = (tile >> 6) * 64, n0 = (tile & 63) * TN;
        __syncthreads();
        f32x4 acc[4][NT];
#pragma unroll
        for (int m = 0; m < 4; ++m)
#pragma unroll
            for (int n = 0; n < NT; ++n) acc[m][n] = (f32x4){0.f, 0.f, 0.f, 0.f};
        const bf16_t* ap = A + (size_t)(r0 + fr) * D + wave * 256 + 8 * fq;
        const bf16_t* bp = Bt + (size_t)(n0 + fr) * D + wave * 256 + 8 * fq;
        bf16x8 af[2][4], bfr[2][NT];
#define CTXG_LOAD(buf, ks_) do { _Pragma("unroll") for (int m = 0; m < 4; ++m) af[buf][m] = *(const bf16x8*)(ap + (size_t)(16 * m) * D + 32 * (ks_)); \
        _Pragma("unroll") for (int n = 0; n < NT; ++n) bfr[buf][n] = *(const bf16x8*)(bp + (size_t)(16 * n) * D + 32 * (ks_)); } while (0)
#define CTXG_MMA(buf) do { _Pragma("unroll") for (int m = 0; m < 4; ++m) _Pragma("unroll") for (int n = 0; n < NT; ++n) \
        acc[m][n] = __builtin_amdgcn_mfma_f32_16x16x32_bf16(af[buf][m], bfr[buf][n], acc[m][n], 0, 0, 0); } while (0)
        CTXG_LOAD(0, 0);
#pragma unroll
        for (int ks = 0; ks < 8; ks += 2) {
            CTXG_LOAD(1, ks + 1);
            __builtin_amdgcn_sched_barrier(0);
            CTXG_MMA(0);
            __builtin_amdgcn_sched_barrier(0);
            if (ks + 2 < 8) CTXG_LOAD(0, ks + 2);
            __builtin_amdgcn_sched_barrier(0);
            CTXG_MMA(1);
            __builtin_amdgcn_sched_barrier(0);
        }
#undef CTXG_LOAD
#undef CTXG_MMA
#pragma unroll
        for (int ps = 0; ps < 2; ++ps) {
#pragma unroll
            for (int m2 = 0; m2 < 2; ++m2)
#pragma unroll
                for (int n = 0; n < NT; ++n)
#pragma unroll
                    for (int reg = 0; reg < 4; ++reg) CT[(wave * 32 + 16 * m2 + 4 * fq + reg) * TS + 16 * n + fr] = acc[2 * ps + m2][n][reg];
            __syncthreads();
            for (int wi = tid; wi < 32 * (TN / 8); wi += 512) {
                const int rr = wi / (TN / 8), cgp = wi % (TN / 8), row = r0 + 32 * ps + rr, col = n0 + 8 * cgp;
                f32x4 c0 = {0.f, 0.f, 0.f, 0.f}, c1 = {0.f, 0.f, 0.f, 0.f};
#pragma unroll
                for (int w8 = 0; w8 < 8; ++w8) { c0 += *(LAS f32x4*)(CT + (w8 * 32 + rr) * TS + 8 * cgp); c1 += *(LAS f32x4*)(CT + (w8 * 32 + rr) * TS + 8 * cgp + 4); }
                if (MODE == 0) {
                    const float* rss = (const float*)(ws + WS_RSS) + (size_t)l * R;
                    const float* shw = (const float*)(ws + WS_SHW) + (size_t)(l * 2 + 1) * DIN;
                    bf16_t* PXo = (bf16_t*)(ws + WS_PX);
                    const float rs = 1.0f / sqrtf(rss[row] * (1.0f / D) + EPS);
                    const f32x4 s0 = *(const f32x4*)(shw + col), s1 = *(const f32x4*)(shw + col + 4);
                    const f32x4 v0 = c0 * rs + s0, v1 = c1 * rs + s1;
                    u32x4 w; w.x = pk2(v0[0], v0[1]); w.y = pk2(v0[2], v0[3]); w.z = pk2(v1[0], v1[1]); w.w = pk2(v1[2], v1[3]);
                    *(u32x4*)(PXo + (size_t)row * DIN + col) = w;
                } else {
                    const float* gp = (const float*)(ws + WS_MOD) + (size_t)(l * 2 + 1) * 6144 + 4096;
                    const float* ggp = (const float*)(ws + WS_GG) + (size_t)((l + 1) * 2 + 1) * D;
                    float* rssn = (float*)(ws + WS_RSS) + (size_t)(l + 1) * R;
                    float* xn = (float*)(ws + WS_X1C); bf16_t* XG = (bf16_t*)(ws + WS_XG);
                    const f32x4 o0 = *(const f32x4*)(a.in[2] + (size_t)row * D + col), o1 = *(const f32x4*)(a.in[2] + (size_t)row * D + col + 4);
                    const f32x4 g0 = *(const f32x4*)(gp + col), g1 = *(const f32x4*)(gp + col + 4);
                    const f32x4 v0 = o0 + g0 * c0, v1 = o1 + g1 * c1;
                    *(f32x4*)(xn + (size_t)row * D + col) = v0; *(f32x4*)(xn + (size_t)row * D + col + 4) = v1;
                    const f32x4 q0 = *(const f32x4*)(ggp + col), q1 = *(const f32x4*)(ggp + col + 4);
                    const f32x4 a0 = v0 * q0, a1 = v1 * q1;
                    u32x4 w; w.x = pk2(a0[0], a0[1]); w.y = pk2(a0[2], a0[3]); w.z = pk2(a1[0], a1[1]); w.w = pk2(a1[2], a1[3]);
                    *(u32x4*)(XG + (size_t)row * D + col) = w;
                    const float ss = (v0[0] * v0[0] + v0[1] * v0[1]) + (v0[2] * v0[2] + v0[3] * v0[3]) + (v1[0] * v1[0] + v1[1] * v1[1]) + (v1[2] * v1[2] + v1[3] * v1[3]);
                    unsafeAtomicAdd(rssn + row, ss);
                }
            }
            __syncthreads();
        }
    }
    __syncthreads();
}

#define XB_TMO      128
#define XB_XCNT(j)  (256  + 64 * (j))
#define XB_XSUB(j)  (1280 + 64 * (j))
#define XB_XGEN(j)  (2304 + 64 * (j))
#define XB_TOP      3328
#define XB_TOPGEN   3392
#define XCD_BAR_WORDS 3456
#define XB_SPIN_CAP (1u << 18)

__device__ __forceinline__ unsigned xb_ld(unsigned* p)              { return __hip_atomic_load(p, __ATOMIC_RELAXED, __HIP_MEMORY_SCOPE_AGENT); }
__device__ __forceinline__ unsigned xb_add(unsigned* p, unsigned v) { return __hip_atomic_fetch_add(p, v, __ATOMIC_RELAXED, __HIP_MEMORY_SCOPE_AGENT); }
__device__ __forceinline__ unsigned xb_xcc_id() { return (unsigned)__builtin_amdgcn_s_getreg((3 << 11) | 20) & 0xFu; }
#define XB_SPIN(cond, bar) do { unsigned _sp = 0; while (cond) { __builtin_amdgcn_s_sleep(1); \
    if ((++_sp & 255u) == 0u) { if (xb_ld(&(bar)[XB_TMO])) break; if (_sp > XB_SPIN_CAP) { atomicAdd(&(bar)[XB_TMO], 1u); break; } } } } while (0)

struct XcdBarrier {
    unsigned* bar; unsigned x;
    volatile LAS unsigned* st;
};

__device__ __forceinline__ XcdBarrier xcd_barrier_post(unsigned* bar, volatile LAS unsigned* st) {
    XcdBarrier b; b.bar = bar; b.x = xb_xcc_id(); b.st = st;
    if (threadIdx.x == 0) (void)xb_add(&bar[XB_XCNT(b.x)], 1u);
    return b;
}
__device__ __forceinline__ void xcd_barrier_complete(unsigned* bar, unsigned x, unsigned& nloc, unsigned& nx) {
    const unsigned G = gridDim.x * gridDim.y * gridDim.z;
    unsigned sum, cnt, mine, sp = 0u;
    for (;;) {
        sum = 0u; cnt = 0u; mine = 0u;
#pragma unroll
        for (unsigned j = 0; j < 16; ++j) { const unsigned c = xb_ld(&bar[XB_XCNT(j)]); sum += c; cnt += (c > 0u) ? 1u : 0u; mine = (j == x) ? c : mine; }
        if (sum == G) break;
        __builtin_amdgcn_s_sleep(1);
        if ((++sp & 255u) == 0u) { if (xb_ld(&bar[XB_TMO])) break; if (sp > XB_SPIN_CAP) { atomicAdd(&bar[XB_TMO], 1u); break; } }
    }
    nloc = mine > 0u ? mine : 1u; nx = cnt > 0u ? cnt : 1u;
}

__device__ __forceinline__ void xcd_barrier(const XcdBarrier& b) {
    asm volatile("s_waitcnt vmcnt(0)" ::: "memory");
    __syncthreads();
    if (threadIdx.x == 0) {
        unsigned* bar = b.bar;
        __builtin_amdgcn_s_waitcnt(0);
        unsigned nloc = b.st[0], nx = b.st[1];
        if (nloc == 0u) { xcd_barrier_complete(bar, b.x, nloc, nx); b.st[0] = nloc; b.st[1] = nx; }
        const unsigned old = xb_add(&bar[XB_XSUB(b.x)], 1u);
        const unsigned gen = old / nloc;
        if (old + 1u == (gen + 1u) * nloc) {
            __builtin_amdgcn_fence(__ATOMIC_RELEASE, "agent");
            asm volatile("s_waitcnt vmcnt(0)" ::: "memory");
            const unsigned og = xb_add(&bar[XB_TOP], 1u);
            const unsigned tg = og / nx;
            if (og + 1u == (tg + 1u) * nx) xb_add(&bar[XB_TOPGEN], 1u);
            else XB_SPIN(xb_ld(&bar[XB_TOPGEN]) == tg, bar);
            __builtin_amdgcn_fence(__ATOMIC_ACQUIRE, "agent");
            xb_add(&bar[XB_XGEN(b.x)], 1u);
            asm volatile("s_waitcnt vmcnt(0)" ::: "memory");
        } else {
            XB_SPIN(xb_ld(&bar[XB_XGEN(b.x)]) == gen, bar);
            __builtin_amdgcn_fence(__ATOMIC_ACQUIRE, "agent");
            asm volatile("s_waitcnt vmcnt(0)" ::: "memory");
        }
    }
    __syncthreads();
}


__global__ void __launch_bounds__(512, 2) mega_fwd(Args a) {
    extern __shared__ __attribute__((aligned(16))) unsigned char lds_raw[];
    LAS unsigned char* lds = (LAS unsigned char*)lds_raw;
    cg::grid_group grid = cg::this_grid();
    const int lo = a.ph_lo, hi = a.ph_hi;
    const int b = blockIdx.x, G = gridDim.x;
    unsigned char* ws = ptr_fresh(a.ws);
    { volatile LAS unsigned* xst = (volatile LAS unsigned*)(lds + LDS_BYTES - 16); if (threadIdx.x < 4) xst[threadIdx.x] = 0u; }
    __syncthreads();
    const XcdBarrier xbar = xcd_barrier_post((unsigned*)(a.ws + WS_BAR), (volatile LAS unsigned*)(lds + LDS_BYTES - 16));
#ifndef PHMASK
#define PHMASK 0x1fff
#endif
#define IN(k) (((PHMASK >> (k)) & 1) && lo <= (k) && (k) < hi)
#ifndef DUPMASK
#define DUPMASK 0
#endif
#define DUP(k) ((DUPMASK >> (k)) & 1)
#define GSYNC(k) do { if (a.ph_lo < 0) grid.sync();     \
    xcd_barrier(xbar); } while (0)
#define SEAM(k) do { if (IN(k) && IN((k) + 1)) GSYNC(k); } while (0)
#define REPB(k) for (int rep_ = 0; rep_ <= DUP(k); ++rep_) { if (rep_) xcd_barrier(xbar);
#define REPE }
    if (IN(0)) { REPB(0) phase0a(a, lds); REPE }
    SEAM(0);
    if (IN(1)) { REPB(1) phase0b(a, lds); REPE }
    SEAM(1);
#pragma unroll 1
    for (int l = 0; l < 2; ++l) {
        const int pb = 2 + 5 * l; const bool last = (l == 1);
        if (IN(pb) && (PHMASK & 0x84)) { REPB(pb)
            pg8::Gemm g{(const bf16_t*)(ws + WS_XG) + (size_t)CL * D, (const bf16_t*)(ws + WS_WINT) + (size_t)l * DIN * D, T, DIN, D};
            pg8::StaticOrder S; S.init(T, DIN, G, b);
            EpiIn E{(bf16_t*)(ws + WS_PX), (const float*)(ws + WS_RSS) + (size_t)l * R, (const float*)(ws + WS_SHW) + (size_t)l * 2 * DIN};
            const bool ctx_first = (b & 1) != 0;
            if (ctx_first) ctx_gemm<5, 0>(a, l, lds);
            pg8::gemm_phase<EpiIn, pg8::StaticOrder, GEMM_ALIGN, GEMM_SP2>(lds, g, S, E);
            if (!ctx_first) ctx_gemm<5, 0>(a, l, lds);
        REPE }
        SEAM(pb);
        if (IN(pb + 1) && (PHMASK & 0x108)) { REPB(pb + 1)
            const int c_lo = last ? 2 : 0, n_cv = 2 * (NCHK - c_lo);
            lru_phase<false>(a, l, 0, lds);
            unsigned* qctr = (unsigned*)(a.ws + WS_BAR) + 16 + 2 * l + rep_;
            volatile LAS int* qslot = (volatile LAS int*)(lds + LDS_BYTES - 32);
            for (;;) {
                __syncthreads();
                if (threadIdx.x == 0) *qslot = (int)__hip_atomic_fetch_add(qctr, 1u, __ATOMIC_RELAXED, __HIP_MEMORY_SCOPE_AGENT);
                __syncthreads();
                const int it = *qslot;
                if (it >= 2 * n_cv) break;
                if (it < n_cv) sgu_item2(a, l, 2 * c_lo + it, lds); else conv_item2(a, l, 2 * c_lo + it - n_cv, lds);
            }
        REPE }
        SEAM(pb + 1);
        if (IN(pb + 2) && (PHMASK & 0x210)) { REPB(pb + 2) phase_carry(a, lds); REPE }
        SEAM(pb + 2);
        if (IN(pb + 3) && (PHMASK & 0x420)) { REPB(pb + 3)
            lru_phase<true>(a, l, last ? 2 : 0, lds);
            __syncthreads();
        REPE }
        SEAM(pb + 3);
        if (IN(pb + 4) && (PHMASK & 0x840)) {
            const int roff = CL, M = T;
            pg8::Gemm g{(const bf16_t*)(ws + WS_Y) + (size_t)roff * D, (const bf16_t*)(ws + WS_WOUTT) + (size_t)l * D * D, M, D, D};
            pg8::StaticOrder S; S.init(M, D, G, b);
            EpiDelta E{(bf16_t*)(ws + WS_DL0),
                        (const float*)(ws + WS_MOD) + (size_t)l * 2 * 6144 + 4096};
            const bool ctx_first = !last && (b & 1) != 0;
            if (ctx_first) ctx_gemm<2, 1>(a, l, lds);
            pg8::gemm_phase<EpiDelta, pg8::StaticOrder, GEMM_ALIGN, GEMM_SP2>(lds, g, S, E);
            if (!last) { if (!ctx_first) ctx_gemm<2, 1>(a, l, lds); xcd_barrier(xbar); phase_resid0(a); }
        }
        SEAM(pb + 4);
    }
    if (IN(12)) phase_final(a);
#undef IN
#undef SEAM
}

extern "C" void kernel_launch(void* const* d_in, const int* in_sizes, int n_in, void* d_out, int out_size, void* d_ws, size_t ws_size, hipStream_t stream) {
    static int grid = 0;
    if (grid == 0) {
        int dev = 0, cus = 0, per_cu = 0;
        if (n_in != 25 || ws_size < WS_END) { fprintf(stderr, "kernel_launch: unexpected inputs (n_in %d, ws %zu < %zu)\n", n_in, ws_size, (size_t)WS_END); grid = -1; return; }
        hipGetDevice(&dev);
        hipDeviceGetAttribute(&cus, hipDeviceAttributeMultiprocessorCount, dev);
        if (hipFuncSetAttribute((const void*)mega_fwd, hipFuncAttributeMaxDynamicSharedMemorySize, LDS_BYTES) != hipSuccess) { fprintf(stderr, "kernel_launch: hipFuncSetAttribute failed\n"); grid = -1; return; }
        hipOccupancyMaxActiveBlocksPerMultiprocessor(&per_cu, (const void*)mega_fwd, 512, LDS_BYTES);
        (void)hipGetLastError();
        if (per_cu < 1) { fprintf(stderr, "kernel_launch: occupancy query says %d blocks per CU\n", per_cu); per_cu = 1; }
        grid = cus;
    }
    if (grid < 0) return;
    if (hipMemsetAsync((char*)d_ws + WS_BAR, 0, 16384, stream) != hipSuccess) { fprintf(stderr, "kernel_launch: memset of the barrier words failed\n"); return; }
    Args a{};
    for (int i = 0; i < 25; ++i) a.in[i] = (const float*)d_in[i];
    a.out = (float*)d_out; a.ws = (unsigned char*)d_ws;
#if N_LAUNCH_MODE == 1
    a.ph_lo = 0; a.ph_hi = NPHASE;
    void* args[] = {&a};
    hipError_t e = hipLaunchCooperativeKernel((const void*)mega_fwd, dim3(grid), dim3(512), args, LDS_BYTES, stream);
    if (e != hipSuccess) fprintf(stderr, "kernel_launch: cooperative launch failed: %s (grid %d)\n", hipGetErrorString(e), grid);
#else
    for (int p = 0; p < NPHASE; ++p) {
        a.ph_lo = p; a.ph_hi = p + 1;
        hipLaunchKernelGGL(mega_fwd, dim3(grid), dim3(512), LDS_BYTES, stream, a);
    }
#endif
}
```

```cpp
#include <hip/hip_runtime.h>
#include <hip/hip_cooperative_groups.h>
#include <cstdio>
#include <cstdint>
namespace cg = cooperative_groups;
namespace pg8 {
#define PG8_LAS __attribute__((address_space(3)))
typedef unsigned short bf16_t;
typedef short bf16x8 __attribute__((ext_vector_type(8)));
typedef float f32x4 __attribute__((ext_vector_type(4)));
typedef unsigned u32x4 __attribute__((ext_vector_type(4)));
constexpr int BM = 256, BK = 64, HALF = 128, HTB = HALF * BK * 2  , STAGE_BYTES = 8 * HTB, NXCD = 8, WGM = 8;

__host__ __device__ __forceinline__ int lds_byte(int r, int c) { const int st = (r >> 4) * 2 + (c >> 5), rr = r & 15, cc = c & 31, ob = rr * 64 + cc * 2; return st * 1024 + (ob ^ (((ob >> 9) & 1) << 5)); }
__host__ __device__ __forceinline__ void stage_rc(int b, int& R, int& C) { const int st = b / 1024, sb = b % 1024, swz = sb ^ (((sb >> 9) & 1) << 5); R = (st >> 1) * 16 + swz / 64; C = (st & 1) * 32 + (swz % 64) / 2; }
__host__ __device__ __forceinline__ int perm32(int rho) { const int n = rho >> 4, i = rho & 15; return 8 * (i >> 2) + 4 * n + (i & 3); }

struct Unit { int pm, pn; };
struct Gemm { const bf16_t* A; const bf16_t* Bt; int M, N, K; };

struct StaticOrder {
    int nM, nN, nwg, G, c;
    __host__ __device__ void init(int M, int N, int G_, int c_) { nM = M / BM; nN = N / BM; nwg = nM * nN; G = G_; c = c_; }
    __host__ __device__ bool next(int i, Unit& u) const {
        const long L = (long)i * G + c; if (L >= nwg) return false;
        int wgid = (int)L; { const int q = nwg / NXCD, r = nwg % NXCD, xcd = wgid % NXCD, off = wgid / NXCD; wgid = (xcd < r ? xcd * (q + 1) : r * (q + 1) + (xcd - r) * q) + off; }
        const int nig = WGM * nN, gid = wgid / nig, fm = gid * WGM, gsz = (nM - fm) < WGM ? (nM - fm) : WGM;
        u.pm = fm + ((wgid % nig) % gsz); u.pn = (wgid % nig) / gsz; return true;
    }
    __device__ __forceinline__ void a_ready(const Unit&) const {}
    __device__ __forceinline__ void done(const Unit&) const {}
};
__device__ __forceinline__ unsigned cvt_pk_bf16(float lo, float hi) { unsigned r; asm volatile("v_cvt_pk_bf16_f32 %0, %1, %2" : "=v"(r) : "v"(lo), "v"(hi)); return r; }
template <class Epi, class Sched, bool ALIGN_EPI = false, bool SP2 = false>
__device__ __forceinline__ void gemm_phase(PG8_LAS unsigned char* lds, const Gemm g, const Sched& S, const Epi& E) {
    int tid_ = threadIdx.x; asm volatile("" : "+v"(tid_)); const int tid = tid_, wid = __builtin_amdgcn_readfirstlane(tid >> 6), lane = tid & 63, wr = wid >> 2, wc = wid & 3, fr = lane & 15, fq = lane >> 4;
    const int K = g.K, nt = K / BK;
    unsigned voffA[2], voffB[2];
#pragma unroll
    for (int i = 0; i < 2; ++i) { int R, C; stage_rc(tid * 16 + i * 8192, R, C); const int Rb = Epi::PERM ? ((R & ~31) + perm32(R & 31)) : R;
        voffA[i] = (unsigned)(R * K + C) * 2u; voffB[i] = (unsigned)(Rb * K + C) * 2u; }
    const size_t kstep = (size_t)(BK * 2);
    const size_t hstep = (size_t)HALF * K * 2;
    const size_t tstep = 2 * hstep;
    const unsigned ldsw = (unsigned)wid * 1024u;
    const int aoff = lds_byte(wr * 64 + fr, fq * 8), boff = lds_byte(wc * 32 + fr, fq * 8);
#define PG8_SA(b, h) (((b) * 2 + (h)) * HTB)
#define PG8_SB(b, h) ((4 + (b) * 2 + (h)) * HTB)
#define PG8_STAGE(bufoff, gbase, voff) do { _Pragma("unroll") for (int _i = 0; _i < 2; ++_i) \
        __builtin_amdgcn_global_load_lds((const unsigned*)((const char*)(gbase) + (voff)[_i]), (PG8_LAS unsigned*)(lds + (bufoff) + ldsw + _i * 8192), 16, 0, 0); } while (0)
#define PG8_LDA(dst, b, h) do { _Pragma("unroll") for (int m = 0; m < 4; ++m) _Pragma("unroll") for (int k = 0; k < 2; ++k) dst[m][k] = *(const PG8_LAS bf16x8*)(lds + PG8_SA(b, h) + aoff + m * 2048 + k * 1024); } while (0)
#define PG8_LDB(dst, b, h) do { _Pragma("unroll") for (int n = 0; n < 2; ++n) _Pragma("unroll") for (int k = 0; k < 2; ++k) dst[n][k] = *(const PG8_LAS bf16x8*)(lds + PG8_SB(b, h) + boff + n * 2048 + k * 1024); } while (0)
#define PG8_MMA(ai, bj, At, Bt) do { __builtin_amdgcn_s_setprio(1); _Pragma("unroll") for (int m = 0; m < 4; ++m) _Pragma("unroll") for (int n = 0; n < 2; ++n) _Pragma("unroll") for (int k = 0; k < 2; ++k) \
        acc[ai][bj][m][n] = __builtin_amdgcn_mfma_f32_16x16x32_bf16(Bt[n][k], At[m][k], acc[ai][bj][m][n], 0, 0, 0); __builtin_amdgcn_s_setprio(0); } while (0)
#define PG8_WAIT_V(n) asm volatile("s_waitcnt vmcnt(" #n ")" ::: "memory")
#define PG8_WAIT_L(n) asm volatile("s_waitcnt lgkmcnt(" #n ")" ::: "memory")
#define PG8_BAR __builtin_amdgcn_s_barrier()
#define PG8_SCHED __builtin_amdgcn_sched_barrier(0)
    Unit cur, nxt; int ui = 0;
    if (!S.next(0, cur)) return;
    f32x4 acc[2][2][4][2];
#pragma unroll
    for (int a = 0; a < 2; ++a)
#pragma unroll
        for (int b = 0; b < 2; ++b)
#pragma unroll
            for (int m = 0; m < 4; ++m)
#pragma unroll
                for (int n = 0; n < 2; ++n) acc[a][b][m][n] = (f32x4){0.f, 0.f, 0.f, 0.f};
    bf16x8 At[4][2], B0[2][2], B1[2][2];
    const char* cA = (const char*)g.A + (size_t)cur.pm * tstep; const char* cB = (const char*)g.Bt + (size_t)cur.pn * tstep;
    S.a_ready(cur);
    if constexpr (SP2) {
        PG8_STAGE(PG8_SB(0, 0), cB, voffB); PG8_STAGE(PG8_SB(0, 1), cB + hstep, voffB); PG8_STAGE(PG8_SA(0, 0), cA, voffA); PG8_STAGE(PG8_SA(0, 1), cA + hstep, voffA);
        if (wr == 1) PG8_BAR;
        PG8_WAIT_V(2); PG8_BAR;
        PG8_STAGE(PG8_SB(1, 0), cB + kstep, voffB); PG8_STAGE(PG8_SA(1, 0), cA + kstep, voffA); PG8_STAGE(PG8_SB(1, 1), cB + hstep + kstep, voffB);
        PG8_WAIT_V(6); PG8_BAR;
    } else {
        PG8_STAGE(PG8_SB(0, 0), cB, voffB); PG8_STAGE(PG8_SA(0, 0), cA, voffA); PG8_STAGE(PG8_SB(0, 1), cB + hstep, voffB); PG8_STAGE(PG8_SA(0, 1), cA + hstep, voffA);
        if (wr == 1) PG8_BAR;
        PG8_WAIT_V(4); PG8_BAR;
        PG8_STAGE(PG8_SB(1, 0), cB + kstep, voffB); PG8_STAGE(PG8_SA(1, 0), cA + kstep, voffA); PG8_STAGE(PG8_SB(1, 1), cB + hstep + kstep, voffB);
        PG8_WAIT_V(6); PG8_BAR;
    }
    for (;;) {
        const bool has_next = S.next(ui + 1, nxt);
        const char* nA = has_next ? (const char*)g.A + (size_t)nxt.pm * tstep : cA; const char* nB = has_next ? (const char*)g.Bt + (size_t)nxt.pn * tstep : cB;
        for (int t = 0; t < nt; t += 2) {
            const bool last = (t == nt - 2);
            const char* a1 = cA + (size_t)(t + 1) * kstep;
            const char* a2 = last ? nA : cA + (size_t)(t + 2) * kstep; const char* b2 = last ? nB : cB + (size_t)(t + 2) * kstep;
            const char* a3 = a2 + kstep; const char* b3 = b2 + kstep;
            if (last && has_next) S.a_ready(nxt);
            if constexpr (SP2) {
            PG8_LDB(B0, 0, 0); PG8_LDB(B1, 0, 1); PG8_SCHED; PG8_LDA(At, 0, 0); PG8_STAGE(PG8_SA(1, 1), a1 + hstep, voffA);
            PG8_WAIT_V(8); PG8_WAIT_L(0); PG8_BAR; PG8_MMA(0, 0, At, B0); PG8_MMA(0, 1, At, B1); PG8_BAR; PG8_SCHED;
            PG8_LDA(At, 0, 1); PG8_STAGE(PG8_SB(0, 0), b2, voffB); PG8_STAGE(PG8_SB(0, 1), b2 + hstep, voffB); PG8_STAGE(PG8_SA(0, 0), a2, voffA);
            PG8_WAIT_V(8); PG8_WAIT_L(0); PG8_BAR; PG8_MMA(1, 0, At, B0); PG8_MMA(1, 1, At, B1); PG8_BAR; PG8_SCHED;
            PG8_LDB(B0, 1, 0); PG8_LDB(B1, 1, 1); PG8_SCHED; PG8_LDA(At, 1, 0); PG8_STAGE(PG8_SA(0, 1), a2 + hstep, voffA);
            PG8_WAIT_V(8); PG8_WAIT_L(0); PG8_BAR; PG8_MMA(0, 0, At, B0); PG8_MMA(0, 1, At, B1); PG8_BAR; PG8_SCHED;
            PG8_LDA(At, 1, 1); PG8_STAGE(PG8_SB(1, 0), b3, voffB); PG8_STAGE(PG8_SB(1, 1), b3 + hstep, voffB); PG8_STAGE(PG8_SA(1, 0), a3, voffA);
            PG8_WAIT_V(8); PG8_WAIT_L(0); PG8_BAR; PG8_MMA(1, 0, At, B0); PG8_MMA(1, 1, At, B1); PG8_BAR; PG8_SCHED;
            } else {
            PG8_LDB(B0, 0, 0); PG8_SCHED; PG8_LDA(At, 0, 0); PG8_STAGE(PG8_SA(1, 1), a1 + hstep, voffA);
            PG8_WAIT_L(8); PG8_BAR; PG8_WAIT_L(0); PG8_MMA(0, 0, At, B0); PG8_BAR; PG8_SCHED;
            PG8_LDB(B1, 0, 1); PG8_STAGE(PG8_SB(0, 0), b2, voffB);
            PG8_BAR; PG8_WAIT_L(0); PG8_MMA(0, 1, At, B1); PG8_BAR;
            PG8_LDA(At, 0, 1); PG8_STAGE(PG8_SA(0, 0), a2, voffA);
            PG8_BAR; PG8_WAIT_L(0); PG8_MMA(1, 0, At, B0); PG8_BAR; PG8_SCHED;
            PG8_STAGE(PG8_SB(0, 1), b2 + hstep, voffB);
            PG8_WAIT_V(6); PG8_BAR; PG8_MMA(1, 1, At, B1); PG8_BAR;
            PG8_LDB(B0, 1, 0); PG8_SCHED; PG8_LDA(At, 1, 0); PG8_STAGE(PG8_SA(0, 1), a2 + hstep, voffA);
            PG8_WAIT_L(8); PG8_BAR; PG8_WAIT_L(0); PG8_MMA(0, 0, At, B0); PG8_BAR; PG8_SCHED;
            PG8_LDB(B1, 1, 1); PG8_STAGE(PG8_SB(1, 0), b3, voffB);
            PG8_BAR; PG8_WAIT_L(0); PG8_MMA(0, 1, At, B1); PG8_BAR;
            PG8_LDA(At, 1, 1); PG8_STAGE(PG8_SA(1, 0), a3, voffA);
            PG8_BAR; PG8_WAIT_L(0); PG8_MMA(1, 0, At, B0); PG8_BAR; PG8_SCHED;
            PG8_STAGE(PG8_SB(1, 1), b3 + hstep, voffB);
            PG8_WAIT_V(6); PG8_BAR; PG8_MMA(1, 1, At, B1); PG8_BAR;
            }
        }
        if constexpr (ALIGN_EPI) { if (wr == 0) PG8_BAR; }
        if constexpr (!Epi::AFTER_DRAIN) { E(acc, cur, wr, wc, fr, fq); S.done(cur); }
        if (!has_next) break;
#pragma unroll
        for (int a = 0; a < 2; ++a)
#pragma unroll
            for (int b = 0; b < 2; ++b)
#pragma unroll
                for (int m = 0; m < 4; ++m)
#pragma unroll
                    for (int n = 0; n < 2; ++n) acc[a][b][m][n] = (f32x4){0.f, 0.f, 0.f, 0.f};
        cur = nxt; cA = nA; cB = nB; ++ui;
        if constexpr (ALIGN_EPI) { if (wr == 1) PG8_BAR; }
    }
    PG8_WAIT_V(0);
    if constexpr (!ALIGN_EPI) { if (wr == 0) PG8_BAR; }
    PG8_BAR;
    if constexpr (Epi::AFTER_DRAIN) { E.fused(acc, cur, wr, wc, fr, fq, lds, wid, lane); S.done(cur); }
#undef PG8_SA
#undef PG8_SB
#undef PG8_STAGE
#undef PG8_LDA
#undef PG8_LDB
#undef PG8_MMA
#undef PG8_WAIT_V
#undef PG8_WAIT_L
#undef PG8_BAR
#undef PG8_SCHED
}
}

#define LAS __attribute__((address_space(3)))
typedef unsigned short bf16_t;
typedef short bf16x8 __attribute__((ext_vector_type(8)));
typedef float f32x4 __attribute__((ext_vector_type(4)));
typedef float f32x2 __attribute__((ext_vector_type(2)));
typedef float f32x16 __attribute__((ext_vector_type(16)));
typedef unsigned u32x4 __attribute__((ext_vector_type(4)));
typedef unsigned u32x2 __attribute__((ext_vector_type(2)));

#ifndef GEMM_ALIGN
#define GEMM_ALIGN true
#endif
#ifndef GEMM_SP2
#define GEMM_SP2 true
#endif
#ifndef N_LAUNCH_MODE
#define N_LAUNCH_MODE 1
#endif

constexpr int D = 2048, T = 16384, CL = 256, R = T + CL, DIN = 5120, NCHK = R / 128;
constexpr int NPHASE = 13;
constexpr float EPS = 1e-6f;
constexpr int LDS_BYTES = 131072 + 4096;

constexpr size_t WS_WINT = 0;
constexpr size_t WS_WOUTT = WS_WINT + (size_t)2 * DIN * D * 2;
constexpr size_t WS_XG = WS_WOUTT + (size_t)2 * D * D * 2;
constexpr size_t WS_PX = WS_XG + (size_t)R * D * 2;
constexpr size_t WS_Y = WS_PX + (size_t)R * DIN * 2;
constexpr size_t WS_X1C = WS_Y + (size_t)R * D * 2;
constexpr size_t WS_MOD = WS_X1C + (size_t)CL * D * 4;
constexpr size_t WS_GG = WS_MOD + (size_t)2 * 2 * 6144 * 4;
constexpr size_t WS_SHW = WS_GG + (size_t)2 * 2 * D * 4;
constexpr size_t WS_RSS = WS_SHW + (size_t)2 * 2 * DIN * 4;
constexpr size_t WS_GW = WS_RSS + (size_t)3 * R * 4 + 64;
constexpr size_t WS_SW = WS_GW + (size_t)2 * 16 * 2 * 2 * 2 * 4 * 64 * 8 * 2;
constexpr size_t WS_AGG = WS_SW + (size_t)2 * 8 * 128 * 128 * 2;
constexpr size_t WS_CARRY = WS_AGG + (size_t)2 * NCHK * 1024 * 8;
constexpr size_t WS_BAR = (WS_CARRY + (size_t)2 * NCHK * 1024 * 4 + 255) / 256 * 256;
constexpr size_t WS_DL0 = WS_BAR + 16384;
constexpr size_t WS_END = WS_DL0 + (size_t)T * D * 2;

struct Args { const float* in[25]; float* out; unsigned char* ws; int ph_lo, ph_hi; };

__device__ __forceinline__ float bflo(unsigned w) { return __uint_as_float(w << 16); }
__device__ __forceinline__ float bfhi(unsigned w) { return __uint_as_float(w & 0xffff0000u); }
__device__ __forceinline__ float bf1(bf16_t h) { return __uint_as_float((unsigned)h << 16); }
__device__ __forceinline__ unsigned pk2(float lo, float hi) { return pg8::cvt_pk_bf16(lo, hi); }
__device__ __forceinline__ bf16_t f2bf(float f) { return (bf16_t)(pk2(f, 0.f) & 0xffffu); }
__device__ __forceinline__ float rcpf_(float x) { return __builtin_amdgcn_rcpf(x); }
__device__ __forceinline__ float sigm(float x) { return rcpf_(1.0f + __expf(-x)); }
__device__ __forceinline__ float silu(float x) { return x * sigm(x); }
__device__ __forceinline__ float gelu_t(float x) { return x * sigm(1.5957691216f * (x + 0.044715f * x * x * x)); }
template <int CTRL> __device__ __forceinline__ float dpp_mov(float v) { return __int_as_float(__builtin_amdgcn_update_dpp(0, __float_as_int(v), CTRL, 0xf, 0xf, true)); }
__device__ __forceinline__ float wave_sum(float v) {
    v += dpp_mov<0xB1>(v);
    v += dpp_mov<0x4E>(v);
    v += dpp_mov<0x141>(v);
    v += dpp_mov<0x140>(v);
    const int iv = __float_as_int(v);
    return (__int_as_float(__builtin_amdgcn_readlane(iv, 0)) + __int_as_float(__builtin_amdgcn_readlane(iv, 16))) + (__int_as_float(__builtin_amdgcn_readlane(iv, 32)) + __int_as_float(__builtin_amdgcn_readlane(iv, 48)));
}
__device__ __forceinline__ int tid_fresh() { int t = threadIdx.x; asm volatile("" : "+v"(t)); return t; }
#define GAS __attribute__((address_space(1)))
__device__ __forceinline__ unsigned char* ptr_fresh(unsigned char* p) {
#ifdef FLAT_WS
    asm volatile("" : "+s"(p)); return p; }
#else
    unsigned long long v = (unsigned long long)p; asm volatile("" : "+s"(v)); return (unsigned char*)(GAS unsigned char*)v; }
#endif
#define LDS_WAIT() asm volatile("s_waitcnt lgkmcnt(0)" ::: "memory")

struct EpiIn {
    static constexpr bool PERM = true, AFTER_DRAIN = false;
    bf16_t* PX; const float* rss; const float* shw;
    __device__ __forceinline__ void operator()(const f32x4 (&acc)[2][2][4][2], const pg8::Unit& u, int wr, int wc, int fr, int fq) const {
        const int row0 = CL + u.pm * 256 + wr * 64 + fr, col0 = u.pn * 256 + wc * 32 + 8 * fq;
        const float* sw = shw + col0;
        f32x4 bv[2][2];
#pragma unroll
        for (int bj = 0; bj < 2; ++bj)
#pragma unroll
            for (int n = 0; n < 2; ++n) bv[bj][n] = *(const f32x4*)(sw + bj * 128 + 4 * n);
#pragma unroll
        for (int ai = 0; ai < 2; ++ai)
#pragma unroll
            for (int m = 0; m < 4; ++m) {
                const int r = row0 + ai * 128 + m * 16;
                const float rs = 1.0f / sqrtf(rss[r] * (1.0f / D) + EPS);
                bf16_t* rowp = PX + (size_t)r * DIN + col0;
#pragma unroll
                for (int bj = 0; bj < 2; ++bj) {
                    const f32x4 v0 = acc[ai][bj][m][0] * rs + bv[bj][0], v1 = acc[ai][bj][m][1] * rs + bv[bj][1];
                    u32x4 w; w.x = pk2(v0[0], v0[1]); w.y = pk2(v0[2], v0[3]); w.z = pk2(v1[0], v1[1]); w.w = pk2(v1[2], v1[3]);
                    *(u32x4*)(rowp + bj * 128) = w;
                }
            }
    }
};
struct EpiOut {
    static constexpr bool PERM = true, AFTER_DRAIN = false;
    int row_off, last;
    const float* xold_lat; const float* xold_ctx; float* xnew_lat; float* xnew_ctx;
    const float* gvec;
    const float* ggn;
    bf16_t* XG; float* rssn;
    __device__ __forceinline__ void operator()(const f32x4 (&acc)[2][2][4][2], const pg8::Unit& u, int wr, int wc, int fr, int fq) const {
        const int gbase = row_off + u.pm * 256;
        const bool isctx = gbase < CL;
        const int seg = isctx ? 1 : 0;
        const int grow0 = gbase + wr * 64 + fr, col0 = u.pn * 256 + wc * 32 + 8 * fq;
        const float* xo = isctx ? xold_ctx : (xold_lat - (size_t)CL * D);
        float* xn = isctx ? xnew_ctx : (xnew_lat - (size_t)CL * D);
        const float* gp = gvec + seg * 6144 + 4096 + col0;
        const float* ggp = ggn + seg * D + col0;
        f32x4 gv[2][2], gg[2][2];
#pragma unroll
        for (int bj = 0; bj < 2; ++bj)
#pragma unroll
            for (int n = 0; n < 2; ++n) { gv[bj][n] = *(const f32x4*)(gp + bj * 128 + 4 * n); gg[bj][n] = last ? (f32x4){0.f, 0.f, 0.f, 0.f} : *(const f32x4*)(ggp + bj * 128 + 4 * n); }
#pragma unroll
        for (int ai = 0; ai < 2; ++ai)
#pragma unroll
            for (int m = 0; m < 4; ++m) {
                const int r = grow0 + ai * 128 + m * 16;
                const size_t ro = (size_t)r * D + col0;
                float ss = 0.f;
#pragma unroll
                for (int bj = 0; bj < 2; ++bj) {
                    const f32x4 o0 = *(const f32x4*)(xo + ro + bj * 128), o1 = *(const f32x4*)(xo + ro + bj * 128 + 4);
                    const f32x4 v0 = o0 + gv[bj][0] * acc[ai][bj][m][0], v1 = o1 + gv[bj][1] * acc[ai][bj][m][1];
                    *(f32x4*)(xn + ro + bj * 128) = v0; *(f32x4*)(xn + ro + bj * 128 + 4) = v1;
                    ss += (v0[0] * v0[0] + v0[1] * v0[1]) + (v0[2] * v0[2] + v0[3] * v0[3]) + (v1[0] * v1[0] + v1[1] * v1[1]) + (v1[2] * v1[2] + v1[3] * v1[3]);
                    if (!last) {
                        const f32x4 a0 = v0 * gg[bj][0], a1 = v1 * gg[bj][1];
                        u32x4 w; w.x = pk2(a0[0], a0[1]); w.y = pk2(a0[2], a0[3]); w.z = pk2(a1[0], a1[1]); w.w = pk2(a1[2], a1[3]);
                        *(u32x4*)(XG + ro + bj * 128) = w;
                    }
                }
                ss += __shfl_xor(ss, 16); ss += __shfl_xor(ss, 32);
                if (fq == 0) unsafeAtomicAdd(rssn + r, ss);
            }
    }
};

struct EpiDelta {
    static constexpr bool PERM = true, AFTER_DRAIN = false;
    bf16_t* DL; const float* gvec;
    __device__ __forceinline__ void operator()(const f32x4 (&acc)[2][2][4][2], const pg8::Unit& u, int wr, int wc, int fr, int fq) const {
        const int row0 = u.pm * 256 + wr * 64 + fr, col0 = u.pn * 256 + wc * 32 + 8 * fq;
        f32x4 gv[2][2];
#pragma unroll
        for (int bj = 0; bj < 2; ++bj)
#pragma unroll
            for (int n = 0; n < 2; ++n) gv[bj][n] = *(const f32x4*)(gvec + col0 + bj * 128 + 4 * n);
#pragma unroll
        for (int ai = 0; ai < 2; ++ai)
#pragma unroll
            for (int m = 0; m < 4; ++m) {
                bf16_t* rowp = DL + (size_t)(row0 + ai * 128 + m * 16) * D + col0;
#pragma unroll
                for (int bj = 0; bj < 2; ++bj) {
                    const f32x4 v0 = acc[ai][bj][m][0] * gv[bj][0], v1 = acc[ai][bj][m][1] * gv[bj][1];
                    u32x4 w; w.x = pk2(v0[0], v0[1]); w.y = pk2(v0[2], v0[3]); w.z = pk2(v1[0], v1[1]); w.w = pk2(v1[2], v1[3]);
                    *(u32x4*)(rowp + bj * 128) = w;
                }
            }
    }
};

__device__ __forceinline__ void transpose_item(const float* W, int K, int N, bf16_t* WT, LAS float* scr, int item, int lane) {
    const int nblk = N / 32, kb = item / nblk, nb = item % nblk, k0 = 64 * kb, n0 = 32 * nb;
#pragma unroll 8
    for (int i = 0; i < 32; ++i) { const int kk = 2 * i + (lane >> 5); scr[kk * 33 + (lane & 31)] = W[(size_t)(k0 + kk) * N + n0 + (lane & 31)]; }
    LDS_WAIT();
    const int c = lane & 7;
#pragma unroll
    for (int j = 0; j < 4; ++j) { const int n = (lane >> 3) + 8 * j; const LAS float* s = scr + (8 * c) * 33 + n;
        u32x4 o; o.x = pk2(s[0 * 33], s[1 * 33]); o.y = pk2(s[2 * 33], s[3 * 33]); o.z = pk2(s[4 * 33], s[5 * 33]); o.w = pk2(s[6 * 33], s[7 * 33]);
        *(u32x4*)(WT + (size_t)(n0 + n) * K + k0 + 8 * c) = o; }
    LDS_WAIT();
}

__device__ __forceinline__ void phase0a(const Args a, LAS unsigned char* lds) {
    const int tid = tid_fresh(), lane = tid & 63, wave = tid >> 6, b = blockIdx.x, G = gridDim.x;
    unsigned char* ws = ptr_fresh(a.ws);
    { float* rss = (float*)(ws + WS_RSS); for (int i = b * 512 + tid; i < 2 * R; i += G * 512) rss[R + i] = 0.f; }
    { bf16_t* GW = (bf16_t*)(ws + WS_GW);
      for (int gid = b * 512 + tid; gid < 2 * 16 * 2 * 2 * 2 * 4 * 64; gid += G * 512) {
          int x = gid; const int ln = x & 63; x >>= 6; const int s = x & 3; x >>= 2; const int half = x & 1; x >>= 1; const int gate = x & 1; x >>= 1; const int dir = x & 1; x >>= 1; const int hd = x & 15; x >>= 4; const int l = x;
          const float* w = (gate ? a.in[14] : a.in[12]) + ((size_t)((l * 2 + dir) * 16 + hd)) * 4096;
          const int col = 32 * half + (ln & 31), k0 = 16 * s + 8 * (ln >> 5);
          float v[8];
#pragma unroll
          for (int j = 0; j < 8; ++j) v[j] = w[(k0 + j) * 64 + col];
          u32x4 o; o.x = pk2(v[0], v[1]); o.y = pk2(v[2], v[3]); o.z = pk2(v[4], v[5]); o.w = pk2(v[6], v[7]);
          *(u32x4*)(GW + (size_t)gid * 8) = o;
      } }
    { bf16_t* SW = (bf16_t*)(ws + WS_SW); const float* sw = a.in[22];
      for (int i = b * 512 + tid; i < 2 * 8 * 128 * 128 / 4; i += G * 512) { const f32x4 v = *(const f32x4*)(sw + (size_t)i * 4); u32x2 o; o.x = pk2(v[0], v[1]); o.y = pk2(v[2], v[3]); *(u32x2*)(SW + (size_t)i * 4) = o; } }
    { const float* c = a.in[1]; const float* cc = a.in[3]; float* MOD = (float*)(ws + WS_MOD);
      LAS float* red = (LAS float*)lds;
      for (int u = b; u < 192; u += G) {
          const int l = u / 96, n0 = (u % 96) * 64, q = tid & 15, ks = tid >> 4;
          const float* W = a.in[4] + (size_t)l * D * 6144 + n0 + 4 * q;
          f32x4 a0 = {0.f, 0.f, 0.f, 0.f}, a1 = {0.f, 0.f, 0.f, 0.f};
#pragma unroll 8
          for (int kk = 0; kk < 64; ++kk) { const int k = ks * 64 + kk; const f32x4 wv = *(const f32x4*)(W + (size_t)k * 6144); const float ca = silu(c[k]), cb = silu(cc[k]); a0 += wv * ca; a1 += wv * cb; }
          LAS float* rp = red + (ks * 16 + q) * 8;
          *(LAS f32x4*)rp = a0; *(LAS f32x4*)(rp + 4) = a1;
          __syncthreads();
          if (tid < 128) { const int qq = tid >> 3, e = tid & 7; float s = 0.f;
#pragma unroll 8
              for (int k2 = 0; k2 < 32; ++k2) s += red[(k2 * 16 + qq) * 8 + e];
              const int seg = e >> 2, col = n0 + 4 * qq + (e & 3);
              MOD[(l * 2 + seg) * 6144 + col] = s + a.in[5][l * 6144 + col]; }
          __syncthreads();
      } }
    { LAS float* scr = (LAS float*)(lds + wave * 16384);
      const int gw = b * 8 + wave, NGW = G * 8;
      constexpr int I_IN = (D / 64) * (DIN / 32), I_OUT = (D / 64) * (D / 32);
      for (int it = gw; it < 2 * I_IN + 2 * I_OUT; it += NGW) {
          int r = it;
          if (r < 2 * I_IN) { const int l = r / I_IN; transpose_item(a.in[7] + (size_t)l * D * DIN, D, DIN, (bf16_t*)(ws + WS_WINT) + (size_t)l * DIN * D, scr, r % I_IN, lane); continue; }
          r -= 2 * I_IN; { const int l = r / I_OUT; transpose_item(a.in[8] + (size_t)l * D * D, D, D, (bf16_t*)(ws + WS_WOUTT) + (size_t)l * D * D, scr, r % I_OUT, lane); }
      } }
}

__device__ __forceinline__ void phase0b(const Args a, LAS unsigned char* lds) {
    const int tid = tid_fresh(), lane = tid & 63, wave = tid >> 6, b = blockIdx.x, G = gridDim.x;
    unsigned char* ws = ptr_fresh(a.ws);
    const float* MOD = (const float*)(ws + WS_MOD);
    LAS float* GG0 = (LAS float*)lds;
    LAS float* SH = (LAS float*)(lds + 16384);
    for (int i = tid; i < 2 * D; i += 512) { const int seg = i >> 11, k = i & 2047; float gv_ = a.in[6][k] * (1.0f + MOD[seg * 6144 + 2048 + k]); if (gv_ == 0.f) gv_ = 1e-30f; GG0[i] = gv_; }
    for (int i = tid; i < 4 * D; i += 512) { const int ls = i >> 11, k = i & 2047; SH[i] = MOD[ls * 6144 + k]; }
    { float* GGt = (float*)(ws + WS_GG); for (int i = b * 512 + tid; i < 4 * D; i += G * 512) { const int ls = i >> 11, l = ls >> 1, k = i & 2047; float gv_ = a.in[6][l * D + k] * (1.0f + MOD[ls * 6144 + 2048 + k]); if (gv_ == 0.f) gv_ = 1e-30f; GGt[i] = gv_; } }
    __syncthreads();
    const int gw = b * 8 + wave, NGW = G * 8;
    { bf16_t* XG = (bf16_t*)(ws + WS_XG); float* rss = (float*)(ws + WS_RSS);
      f32x4 vr[8];
#define P0B_LOAD(r_, V) do { const float* _src = (r_) < CL ? a.in[2] + (size_t)(r_) * D : a.in[0] + (size_t)((r_) - CL) * D; \
          _Pragma("unroll") for (int j = 0; j < 8; ++j) V[j] = *(const f32x4*)(_src + 4 * (lane + 64 * j)); } while (0)
      int r = gw;
      if (r < R) P0B_LOAD(r, vr);
      for (; r < R; r += NGW) {
          f32x4 vn[8];
          const int rn = r + NGW;
          if (rn < R) P0B_LOAD(rn, vn);
          const int seg = r < CL ? 1 : 0;
          float ss = 0.f;
#pragma unroll
          for (int j = 0; j < 8; ++j) ss += (vr[j][0] * vr[j][0] + vr[j][1] * vr[j][1]) + (vr[j][2] * vr[j][2] + vr[j][3] * vr[j][3]);
#pragma unroll
          for (int j = 0; j < 8; ++j) { const f32x4 g = *(LAS f32x4*)(GG0 + seg * D + 4 * (lane + 64 * j)); const f32x4 p = vr[j] * g; u32x2 o; o.x = pk2(p[0], p[1]); o.y = pk2(p[2], p[3]); *(u32x2*)(XG + (size_t)r * D + 4 * (lane + 64 * j)) = o; }
          ss = wave_sum(ss);
          if (lane == 0) rss[r] = ss;
          if (rn < R) {
#pragma unroll
              for (int j = 0; j < 8; ++j) vr[j] = vn[j];
          }
      }
#undef P0B_LOAD
    }
    { float* SHW = (float*)(ws + WS_SHW); const bf16_t* WinT = (const bf16_t*)(ws + WS_WINT);
      for (int idx = gw; idx < 2 * DIN; idx += NGW) {
          const int l = idx / DIN, n = idx % DIN;
          const bf16_t* row = WinT + ((size_t)l * DIN + n) * D;
          float d0 = 0.f, d1 = 0.f;
#pragma unroll
          for (int j = 0; j < 4; ++j) { const int k = 8 * (lane + 64 * j); const u32x4 w = *(const u32x4*)(row + k);
              const LAS float* s0 = SH + (l * 2 + 0) * D + k; const LAS float* s1 = SH + (l * 2 + 1) * D + k;
              const f32x4 x0 = *(LAS f32x4*)s0, x1 = *(LAS f32x4*)(s0 + 4), y0 = *(LAS f32x4*)s1, y1 = *(LAS f32x4*)(s1 + 4);
              const float w0 = bflo(w.x), w1 = bfhi(w.x), w2 = bflo(w.y), w3 = bfhi(w.y), w4 = bflo(w.z), w5 = bfhi(w.z), w6 = bflo(w.w), w7 = bfhi(w.w);
              d0 += (w0 * x0[0] + w1 * x0[1]) + (w2 * x0[2] + w3 * x0[3]) + (w4 * x1[0] + w5 * x1[1]) + (w6 * x1[2] + w7 * x1[3]);
              d1 += (w0 * y0[0] + w1 * y0[1]) + (w2 * y0[2] + w3 * y0[3]) + (w4 * y1[0] + w5 * y1[1]) + (w6 * y1[2] + w7 * y1[3]); }
          d0 = wave_sum(d0); d1 = wave_sum(d1);
          if (lane == 0) { SHW[(l * 2 + 0) * DIN + n] = d0; SHW[(l * 2 + 1) * DIN + n] = d1; }
      } }
    __syncthreads();
}

constexpr int XLF_STRIDE = 68, XLB_STRIDE = 72;
constexpr int LRU_XLF = 0, LRU_XLB = 128 * XLF_STRIDE * 4, LRU_TAGG = LRU_XLB + 128 * XLB_STRIDE * 2;

template <bool PASSC>
__device__ __forceinline__ void lru_item(const Args a, int l, int chunk, int hd, LAS unsigned char* lds) {
    const int tid = tid_fresh(), lane = tid & 63, wave = tid >> 6;
    unsigned char* ws = ptr_fresh(a.ws);
    const bf16_t* PX = (const bf16_t*)(ws + WS_PX);
    LAS float* XLF = (LAS float*)(lds + LRU_XLF);
    LAS bf16_t* XLB = (LAS bf16_t*)(lds + LRU_XLB);
    LAS f32x2* TAGG = (LAS f32x2*)(lds + LRU_TAGG);
    __syncthreads();
    {
        const int t = tid >> 2, q = tid & 3, ch0 = hd * 64 + q * 16;
        const int grow = chunk * 128 + t, seg_lo = chunk < 2 ? 0 : CL, seg_hi = chunk < 2 ? CL : R;
        const float* cw = a.in[9] + (size_t)l * 4 * 1024 + ch0; const float* cb = a.in[10] + (size_t)l * 1024 + ch0;
        float xl[16];
#pragma unroll
        for (int c4 = 0; c4 < 4; ++c4) { const f32x4 bb = *(const f32x4*)(cb + 4 * c4); xl[4 * c4] = bb[0]; xl[4 * c4 + 1] = bb[1]; xl[4 * c4 + 2] = bb[2]; xl[4 * c4 + 3] = bb[3]; }
#pragma unroll
        for (int j = 0; j < 4; ++j) {
            const int rr = grow + j - 2;
            if (rr >= seg_lo && rr < seg_hi) {
                const u32x4 p0 = *(const u32x4*)(PX + (size_t)rr * DIN + ch0), p1 = *(const u32x4*)(PX + (size_t)rr * DIN + ch0 + 8);
                const unsigned pw[8] = {p0.x, p0.y, p0.z, p0.w, p1.x, p1.y, p1.z, p1.w};
#pragma unroll
                for (int c4 = 0; c4 < 4; ++c4) { const f32x4 wv = *(const f32x4*)(cw + j * 1024 + 4 * c4);
                    xl[4 * c4 + 0] += wv[0] * bflo(pw[2 * c4]); xl[4 * c4 + 1] += wv[1] * bfhi(pw[2 * c4]); xl[4 * c4 + 2] += wv[2] * bflo(pw[2 * c4 + 1]); xl[4 * c4 + 3] += wv[3] * bfhi(pw[2 * c4 + 1]); }
            }
        }
        LAS float* xf = XLF + t * XLF_STRIDE + q * 16;
#pragma unroll
        for (int c4 = 0; c4 < 4; ++c4) *(LAS f32x4*)(xf + 4 * c4) = (f32x4){xl[4 * c4], xl[4 * c4 + 1], xl[4 * c4 + 2], xl[4 * c4 + 3]};
        LAS bf16_t* xb = XLB + t * XLB_STRIDE + q * 16;
        u32x4 o0, o1; o0.x = pk2(xl[0], xl[1]); o0.y = pk2(xl[2], xl[3]); o0.z = pk2(xl[4], xl[5]); o0.w = pk2(xl[6], xl[7]); o1.x = pk2(xl[8], xl[9]); o1.y = pk2(xl[10], xl[11]); o1.z = pk2(xl[12], xl[13]); o1.w = pk2(xl[14], xl[15]);
        *(LAS u32x4*)xb = o0; *(LAS u32x4*)(xb + 8) = o1;
    }
    __syncthreads();
    const int tw = wave >> 1, chh = wave & 1, cl = lane & 31, hh = lane >> 5;
    const int cin = 32 * chh + cl, cg_ = hd * 64 + cin;
    bf16x8 Af[4];
#pragma unroll
    for (int s = 0; s < 4; ++s) Af[s] = *(const LAS bf16x8*)(XLB + (32 * tw + cl) * XLB_STRIDE + 16 * s + 8 * hh);
    float xlv[16];
#pragma unroll
    for (int i = 0; i < 16; ++i) xlv[i] = XLF[(32 * tw + (i & 3) + 8 * (i >> 2) + 4 * hh) * XLF_STRIDE + cin];
    float av[2][16], bv[2][16];
    float GA[2][8], GB[2][8];
    const bf16_t* GW = (const bf16_t*)(ws + WS_GW);
#pragma unroll
    for (int dir = 0; dir < 2; ++dir) {
        f32x16 ar, ai;
#pragma unroll
        for (int i = 0; i < 16; ++i) { ar[i] = 0.f; ai[i] = 0.f; }
#pragma unroll
        for (int s = 0; s < 4; ++s) {
            const size_t gr = ((((((size_t)(l * 16 + hd) * 2 + dir) * 2 + 0) * 2 + chh) * 4 + s) * 64 + lane) * 8;
            const size_t gi = ((((((size_t)(l * 16 + hd) * 2 + dir) * 2 + 1) * 2 + chh) * 4 + s) * 64 + lane) * 8;
            const bf16x8 Br = *(const bf16x8*)(GW + gr), Bi = *(const bf16x8*)(GW + gi);
            ar = __builtin_amdgcn_mfma_f32_32x32x16_bf16(Af[s], Br, ar, 0, 0, 0);
            ai = __builtin_amdgcn_mfma_f32_32x32x16_bf16(Af[s], Bi, ai, 0, 0, 0);
        }
        const float brv = a.in[13][(size_t)(l * 2 + dir) * 1024 + cg_], biv = a.in[15][(size_t)(l * 2 + dir) * 1024 + cg_];
        const float lam = a.in[11][(size_t)(l * 2 + dir) * 1024 + cg_];
        const float k8 = -8.0f * log1pf(__expf(-lam));
#pragma unroll
        for (int i = 0; i < 16; ++i) {
            const float rg = sigm(ar[i] + brv), ig = sigm(ai[i] + biv);
            const float la = k8 * rg;
            av[dir][i] = __expf(la);
            const float aa = av[dir][i]; bv[dir][i] = __builtin_amdgcn_sqrtf(fmaxf(1.0f - aa * aa, 0.f)) * ig * xlv[i];
        }
        float oA[4], oB[4];
#pragma unroll
        for (int g = 0; g < 4; ++g) {
            const float a0 = av[dir][4 * g], a1 = av[dir][4 * g + 1], a2 = av[dir][4 * g + 2], a3 = av[dir][4 * g + 3];
            const float b0 = bv[dir][4 * g], b1 = bv[dir][4 * g + 1], b2 = bv[dir][4 * g + 2], b3 = bv[dir][4 * g + 3];
            oA[g] = (a0 * a1) * (a2 * a3);
            oB[g] = dir == 0 ? ((b0 * a1 + b1) * a2 + b2) * a3 + b3 : ((b3 * a2 + b2) * a1 + b1) * a0 + b0;
        }
#pragma unroll
        for (int g = 0; g < 4; ++g) {
            const float pA = __shfl_xor(oA[g], 32), pB = __shfl_xor(oB[g], 32);
            GA[dir][2 * g] = hh ? pA : oA[g]; GA[dir][2 * g + 1] = hh ? oA[g] : pA;
            GB[dir][2 * g] = hh ? pB : oB[g]; GB[dir][2 * g + 1] = hh ? oB[g] : pB;
        }
        float tA = 1.f, tB = 0.f;
        if (dir == 0) {
#pragma unroll
            for (int gq = 0; gq < 8; ++gq) { tB = GA[dir][gq] * tB + GB[dir][gq]; tA *= GA[dir][gq]; }
        } else {
#pragma unroll
            for (int gq = 7; gq >= 0; --gq) { tB = GA[dir][gq] * tB + GB[dir][gq]; tA *= GA[dir][gq]; }
        }
        if (hh == 0) TAGG[(tw * 2 + dir) * 64 + cin] = (f32x2){tA, tB};
    }
    __syncthreads();
    if constexpr (!PASSC) {
        if (tid < 128) {
            const int dir = tid >> 6, c = tid & 63;
            float cA = 1.f, cB = 0.f;
#pragma unroll
            for (int k = 0; k < 4; ++k) { const int t2 = dir == 0 ? k : 3 - k; const f32x2 v = TAGG[(t2 * 2 + dir) * 64 + c]; cB = v[0] * cB + v[1]; cA *= v[0]; }
            f32x2* AGG = (f32x2*)(ws + WS_AGG);
            AGG[((size_t)dir * NCHK + chunk) * 1024 + hd * 64 + c] = (f32x2){cA, cB};
        }
    } else {
        const float* CARRY = (const float*)(ws + WS_CARRY);
        float yv[16];
#pragma unroll
        for (int dir = 0; dir < 2; ++dir) {
            float st = CARRY[((size_t)dir * NCHK + chunk) * 1024 + cg_];
            if (dir == 0) {
#pragma unroll
                for (int t2 = 0; t2 < 3; ++t2) if (t2 < tw) { const f32x2 v = TAGG[(t2 * 2 + 0) * 64 + cin]; st = v[0] * st + v[1]; }
            } else {
#pragma unroll
                for (int t2 = 3; t2 > 0; --t2) if (t2 > tw) { const f32x2 v = TAGG[(t2 * 2 + 1) * 64 + cin]; st = v[0] * st + v[1]; }
            }
            float hst[4];
            if (dir == 0) {
                float s = st;
#pragma unroll
                for (int g = 0; g < 4; ++g) { const float sE = s; s = GA[0][2 * g] * s + GB[0][2 * g]; const float sO = s; s = GA[0][2 * g + 1] * s + GB[0][2 * g + 1]; hst[g] = hh ? sO : sE; }
            } else {
                float s = st;
#pragma unroll
                for (int g = 3; g >= 0; --g) { const float sO = s; s = GA[1][2 * g + 1] * s + GB[1][2 * g + 1]; const float sE = s; s = GA[1][2 * g] * s + GB[1][2 * g]; hst[g] = hh ? sO : sE; }
            }
#pragma unroll
            for (int g = 0; g < 4; ++g) {
                float h = hst[g];
                if (dir == 0) {
#pragma unroll
                    for (int k = 0; k < 4; ++k) { h = av[0][4 * g + k] * h + bv[0][4 * g + k]; yv[4 * g + k] = h; }
                } else {
#pragma unroll
                    for (int k = 3; k >= 0; --k) { h = av[1][4 * g + k] * h + bv[1][4 * g + k]; yv[4 * g + k] += h; }
                }
            }
        }
        bf16_t* Y = (bf16_t*)(ws + WS_Y);
#pragma unroll
        for (int i = 0; i < 16; ++i) {
            const int row = chunk * 128 + 32 * tw + (i & 3) + 8 * (i >> 2) + 4 * hh;
            const float gt = bf1(PX[(size_t)row * DIN + 1024 + cg_]);
            Y[(size_t)row * D + cg_] = f2bf(yv[i] * silu(gt));
        }
    }
}

__device__ __forceinline__ void conv_item(const Args a, int l, int ct, LAS unsigned char* lds) {
    const int tid = tid_fresh(), lane = tid & 63, wave = tid >> 6, c = tid;
    unsigned char* ws = ptr_fresh(a.ws);
    const bf16_t* PX = (const bf16_t*)(ws + WS_PX); bf16_t* Y = (bf16_t*)(ws + WS_Y);
    LAS float* CB = (LAS float*)lds;
    const int t0 = ct * 128, seg_lo = ct < 2 ? 0 : CL, seg_hi = ct < 2 ? CL : R;
    float w[31];
#pragma unroll
    for (int j = 0; j < 31; ++j) w[j] = a.in[16][((size_t)l * 31 + j) * 512 + c];
    const float bias = a.in[17][l * 512 + c];
    float win[32];
#define CONV_Z(dst, rr_) do { const int _rr = (rr_); const int _rc = _rr < seg_lo ? seg_lo : (_rr >= seg_hi ? seg_hi - 1 : _rr); const float _v = bf1(PX[(size_t)_rc * DIN + 2048 + c]), _g = bf1(PX[(size_t)_rc * DIN + 2560 + c]); const float _z = _v * sigm(_g); dst = (_rr == _rc) ? _z : 0.f; } while (0)
#pragma unroll
    for (int e = 0; e < 30; ++e) CONV_Z(win[e], t0 - 15 + e);
    win[30] = 0.f; win[31] = 0.f;
    __syncthreads();
#pragma unroll 1
    for (int bb = 0; bb < 4; ++bb) {
        LAS float* cbuf = CB + (bb & 1) * (32 * 512);
#pragma unroll
        for (int u = 0; u < 32; ++u) {
            if ((u & 7) == 0) asm volatile("" ::: "memory");
            CONV_Z(win[(u + 30) & 31], t0 - 15 + 32 * bb + u + 30);
            float acc = bias;
#pragma unroll
            for (int j = 0; j < 31; ++j) acc += w[j] * win[(u + j) & 31];
            cbuf[u * 512 + c] = acc;
        }
        __syncthreads();
#pragma unroll 1
        for (int uu = 0; uu < 4; ++uu) {
            const int u = wave * 4 + uu, row = t0 + 32 * bb + u;
            float v[8]; float s = 0.f;
#pragma unroll
            for (int k = 0; k < 8; ++k) { v[k] = cbuf[u * 512 + lane + 64 * k]; s += v[k]; }
            const float mean = wave_sum(s) * (1.0f / 512.0f);
            float s2 = 0.f;
#pragma unroll
            for (int k = 0; k < 8; ++k) { v[k] -= mean; s2 += v[k] * v[k]; }
            const float rstd = 1.0f / sqrtf(wave_sum(s2) * (1.0f / 512.0f) + EPS);
#pragma unroll
            for (int k = 0; k < 8; ++k) {
                const int ch = lane + 64 * k;
                const float y = silu(v[k] * rstd * a.in[18][l * 512 + ch] + a.in[19][l * 512 + ch]);
                const float gt = bf1(PX[(size_t)row * DIN + 3072 + ch]);
                Y[(size_t)row * D + 1024 + ch] = f2bf(y * silu(gt));
            }
        }
    }
#undef CONV_Z
}

constexpr int TT_STRIDE = 136;
__device__ __forceinline__ void sgu_item(const Args a, int l, int sc, LAS unsigned char* lds) {
    const int tid = tid_fresh(), lane = tid & 63, wave = tid >> 6;
    unsigned char* ws = ptr_fresh(a.ws);
    const bf16_t* PX = (const bf16_t*)(ws + WS_PX); bf16_t* Y = (bf16_t*)(ws + WS_Y);
    const bf16_t* SW = (const bf16_t*)(ws + WS_SW) + (size_t)l * 8 * 128 * 128;
    LAS f32x2* ST = (LAS f32x2*)lds;
    LAS bf16_t* TT = (LAS bf16_t*)(lds + 1024);
    const int t0 = sc * 128;
    __syncthreads();
#pragma unroll 1
    for (int k = 0; k < 16; ++k) {
        const int tok = wave * 16 + k;
        const u32x4 p = *(const u32x4*)(PX + (size_t)(t0 + tok) * DIN + 4096 + 8 * lane);
        float g[8] = {gelu_t(bflo(p.x)), gelu_t(bfhi(p.x)), gelu_t(bflo(p.y)), gelu_t(bfhi(p.y)), gelu_t(bflo(p.z)), gelu_t(bfhi(p.z)), gelu_t(bflo(p.w)), gelu_t(bfhi(p.w))};
        float s = 0.f;
#pragma unroll
        for (int j = 0; j < 8; ++j) s += g[j];
        const float mean = wave_sum(s) * (1.0f / 512.0f);
        float s2 = 0.f;
#pragma unroll
        for (int j = 0; j < 8; ++j) { const float d = g[j] - mean; s2 += d * d; }
        const float rstd = 1.0f / sqrtf(wave_sum(s2) * (1.0f / 512.0f) + EPS);
        if (lane == 0) ST[tok] = (f32x2){mean, rstd};
    }
    __syncthreads();
    const int p_ = tid >> 2, dq = tid & 3;
    const f32x2 st = ST[p_];
    const int fr = lane & 15, fq = lane >> 4;
#pragma unroll 1
    for (int h = 0; h < 8; ++h) {
        LAS bf16_t* tt = TT + (h & 1) * (64 * TT_STRIDE);
        {
            const int ch = 64 * h + 16 * dq;
            const u32x4 q0 = *(const u32x4*)(PX + (size_t)(t0 + p_) * DIN + 4096 + ch), q1 = *(const u32x4*)(PX + (size_t)(t0 + p_) * DIN + 4096 + ch + 8);
            const unsigned pw[8] = {q0.x, q0.y, q0.z, q0.w, q1.x, q1.y, q1.z, q1.w};
            const float* lg = a.in[20] + l * 512 + ch; const float* lb = a.in[21] + l * 512 + ch;
#pragma unroll
            for (int j = 0; j < 8; ++j) {
                const float v0 = (gelu_t(bflo(pw[j])) - st[0]) * st[1] * lg[2 * j] + lb[2 * j];
                const float v1 = (gelu_t(bfhi(pw[j])) - st[0]) * st[1] * lg[2 * j + 1] + lb[2 * j + 1];
                tt[(16 * dq + 2 * j) * TT_STRIDE + p_] = f2bf(v0);
                tt[(16 * dq + 2 * j + 1) * TT_STRIDE + p_] = f2bf(v1);
            }
        }
        __syncthreads();
        f32x4 acc[4];
#pragma unroll
        for (int nt = 0; nt < 4; ++nt) acc[nt] = (f32x4){0.f, 0.f, 0.f, 0.f};
#pragma unroll
        for (int s = 0; s < 4; ++s) {
            const bf16x8 Afr = *(const bf16x8*)(SW + ((size_t)h * 128 + 16 * wave + fr) * 128 + 32 * s + 8 * fq);
#pragma unroll
            for (int nt = 0; nt < 4; ++nt) {
                const bf16x8 Bfr = *(const LAS bf16x8*)(tt + (16 * nt + fr) * TT_STRIDE + 32 * s + 8 * fq);
                acc[nt] = __builtin_amdgcn_mfma_f32_16x16x32_bf16(Afr, Bfr, acc[nt], 0, 0, 0);
            }
        }
#pragma unroll
        for (int reg = 0; reg < 4; ++reg) {
            const int q = 16 * wave + 4 * fq + reg, row = t0 + q;
            const float bs = a.in[23][((size_t)l * 8 + h) * 128 + q];
#pragma unroll
            for (int nt = 0; nt < 4; ++nt) {
                const int ch = 64 * h + 16 * nt + fr;
                const float uu = gelu_t(bf1(PX[(size_t)row * DIN + 3584 + ch]));
                const float gt = bf1(PX[(size_t)row * DIN + 4608 + ch]);
                Y[(size_t)row * D + 1536 + ch] = f2bf(uu * (acc[nt][reg] + bs) * silu(gt));
            }
        }
    }
}


constexpr int L2_GWL = 0;
constexpr int L2_CW = 32768;
constexpr int L2_RAW = 34816;
constexpr int RAW_ROWB = 144, RAW_BUFB = 132 * RAW_ROWB;
constexpr int L2_XLF = L2_RAW + 2 * RAW_BUFB;
constexpr int L2_XLB = L2_XLF + 128 * XLF_STRIDE * 4;
constexpr int L2_TAGG = L2_XLB + 128 * XLB_STRIDE * 2;
static_assert(L2_TAGG + 4096 <= LDS_BYTES, "lds map");

template <bool PASSC>
__device__ __forceinline__ void lru_phase(const Args a, int l, int c_lo, LAS unsigned char* lds) {
    const int tid = tid_fresh(), lane = tid & 63, wave = tid >> 6, b = blockIdx.x, G = gridDim.x;
    unsigned char* ws = ptr_fresh(a.ws);
    const bf16_t* PX = (const bf16_t*)(ws + WS_PX);
    const int hd = b & 15, cstep = G >> 4;
    int chunk = c_lo + (b >> 4);
    if (chunk >= NCHK) return;
    LAS float* CW = (LAS float*)(lds + L2_CW);
    LAS float* XLF = (LAS float*)(lds + L2_XLF);
    LAS bf16_t* XLB = (LAS bf16_t*)(lds + L2_XLB);
    LAS f32x2* TAGG = (LAS f32x2*)(lds + L2_TAGG);
    __syncthreads();
    {
        const bf16_t* GW = (const bf16_t*)(ws + WS_GW) + (size_t)(l * 16 + hd) * 16384;
#pragma unroll
        for (int i = 0; i < 4; ++i) *(LAS u32x4*)(lds + L2_GWL + (tid + 512 * i) * 16) = *(const u32x4*)(GW + (size_t)(tid + 512 * i) * 8);
        if (tid < 320) { const int j = tid >> 6, c = tid & 63; CW[tid] = j < 4 ? a.in[9][((size_t)l * 4 + j) * 1024 + hd * 64 + c] : a.in[10][(size_t)l * 1024 + hd * 64 + c]; }
    }
    const int tw = wave >> 1, chh = wave & 1, cl = lane & 31, hh = lane >> 5;
    const int cin = 32 * chh + cl, cg_ = hd * 64 + cin;
    float brv[2], biv[2], k8[2];
#pragma unroll
    for (int dir = 0; dir < 2; ++dir) {
        brv[dir] = a.in[13][(size_t)(l * 2 + dir) * 1024 + cg_]; biv[dir] = a.in[15][(size_t)(l * 2 + dir) * 1024 + cg_];
        k8[dir] = -8.0f * log1pf(__expf(-a.in[11][(size_t)(l * 2 + dir) * 1024 + cg_]));
    }
    const int t = tid >> 2, q = tid & 3, ch0 = hd * 64 + q * 16;
    const int hrow = (tid >> 2) < 2 ? (tid >> 2) : 130;
    u32x4 r0, r1, h0, h1;
    const u32x4 zero4 = {0u, 0u, 0u, 0u};
#define LRU_LOAD_RAW(ck) do { const int _t0 = (ck) * 128, _lo = (ck) < 2 ? 0 : CL, _hi = (ck) < 2 ? CL : R; \
        const bf16_t* _p = PX + (size_t)(_t0 + t) * DIN + ch0; r0 = *(const u32x4*)_p; r1 = *(const u32x4*)(_p + 8); \
        h0 = zero4; h1 = zero4; \
        if (tid < 12) { const int _gr = _t0 - 2 + hrow; if (_gr >= _lo && _gr < _hi) { const bf16_t* _ph = PX + (size_t)_gr * DIN + ch0; h0 = *(const u32x4*)_ph; h1 = *(const u32x4*)(_ph + 8); } } } while (0)
#define LRU_STORE_RAW(buf) do { LAS unsigned char* _rb = lds + L2_RAW + (buf) * RAW_BUFB; \
        *(LAS u32x4*)(_rb + (t + 2) * RAW_ROWB + 32 * q) = r0; *(LAS u32x4*)(_rb + (t + 2) * RAW_ROWB + 32 * q + 16) = r1; \
        if (tid < 12) { *(LAS u32x4*)(_rb + hrow * RAW_ROWB + 32 * q) = h0; *(LAS u32x4*)(_rb + hrow * RAW_ROWB + 32 * q + 16) = h1; } } while (0)
    LRU_LOAD_RAW(chunk);
    LRU_STORE_RAW(0);
    int cur = 0;
    __syncthreads();
#pragma unroll 1
    for (; chunk < NCHK; chunk += cstep) {
        const int nchunk = chunk + cstep;
        const bool has_next = nchunk < NCHK;
        u32x4 g0 = zero4, g1 = zero4; float cry[2] = {0.f, 0.f};
        if (PASSC) {
            const bf16_t* gp = PX + (size_t)(chunk * 128 + t) * DIN + 1024 + ch0;
            g0 = *(const u32x4*)gp; g1 = *(const u32x4*)(gp + 8);
            const float* CARRY = (const float*)(ws + WS_CARRY);
            cry[0] = CARRY[((size_t)0 * NCHK + chunk) * 1024 + cg_]; cry[1] = CARRY[((size_t)1 * NCHK + chunk) * 1024 + cg_];
        }
        if (has_next) LRU_LOAD_RAW(nchunk);
        {
            LAS unsigned char* rb = lds + L2_RAW + cur * RAW_BUFB;
            const int tg = tid >> 4, c4 = (tid & 15) * 4;
            f32x4 wv[4];
#pragma unroll
            for (int j = 0; j < 4; ++j) wv[j] = *(LAS f32x4*)(CW + j * 64 + c4);
            const f32x4 bb = *(LAS f32x4*)(CW + 256 + c4);
            f32x4 xr[7];
#pragma unroll
            for (int r = 0; r < 7; ++r) { const u32x2 pr = *(LAS u32x2*)(rb + (4 * tg + r) * RAW_ROWB + c4 * 2); xr[r] = (f32x4){bflo(pr.x), bfhi(pr.x), bflo(pr.y), bfhi(pr.y)}; }
#pragma unroll
            for (int tt = 0; tt < 4; ++tt) {
                const f32x4 xl = bb + wv[0] * xr[tt] + wv[1] * xr[tt + 1] + wv[2] * xr[tt + 2] + wv[3] * xr[tt + 3];
                *(LAS f32x4*)(XLF + (4 * tg + tt) * XLF_STRIDE + c4) = xl;
                u32x2 o; o.x = pk2(xl[0], xl[1]); o.y = pk2(xl[2], xl[3]);
                *(LAS u32x2*)(XLB + (4 * tg + tt) * XLB_STRIDE + c4) = o;
            }
        }
        __syncthreads();
        bf16x8 Af[4];
#pragma unroll
        for (int s = 0; s < 4; ++s) Af[s] = *(const LAS bf16x8*)(XLB + (32 * tw + cl) * XLB_STRIDE + 16 * s + 8 * hh);
        float xlv[16];
#pragma unroll
        for (int i = 0; i < 16; ++i) xlv[i] = XLF[(32 * tw + (i & 3) + 8 * (i >> 2) + 4 * hh) * XLF_STRIDE + cin];
        float av[2][16], bv[2][16], GA[2][8], GB[2][8];
#pragma unroll
        for (int dir = 0; dir < 2; ++dir) {
            f32x16 ar, ai;
#pragma unroll
            for (int i = 0; i < 16; ++i) { ar[i] = 0.f; ai[i] = 0.f; }
#pragma unroll
            for (int s = 0; s < 4; ++s) {
                const bf16x8 Br = *(const LAS bf16x8*)(lds + L2_GWL + ((((dir * 2 + 0) * 2 + chh) * 4 + s) * 64 + lane) * 16);
                const bf16x8 Bi = *(const LAS bf16x8*)(lds + L2_GWL + ((((dir * 2 + 1) * 2 + chh) * 4 + s) * 64 + lane) * 16);
                ar = __builtin_amdgcn_mfma_f32_32x32x16_bf16(Af[s], Br, ar, 0, 0, 0);
                ai = __builtin_amdgcn_mfma_f32_32x32x16_bf16(Af[s], Bi, ai, 0, 0, 0);
            }
#pragma unroll
            for (int i = 0; i < 16; ++i) {
                const float rg = sigm(ar[i] + brv[dir]), ig = sigm(ai[i] + biv[dir]);
                const float aa = __expf(k8[dir] * rg);
                av[dir][i] = aa;
                bv[dir][i] = __builtin_amdgcn_sqrtf(fmaxf(1.0f - aa * aa, 0.f)) * ig * xlv[i];
            }
            float oA[4], oB[4];
#pragma unroll
            for (int g = 0; g < 4; ++g) {
                const float a0 = av[dir][4 * g], a1 = av[dir][4 * g + 1], a2 = av[dir][4 * g + 2], a3 = av[dir][4 * g + 3];
                const float b0 = bv[dir][4 * g], b1 = bv[dir][4 * g + 1], b2 = bv[dir][4 * g + 2], b3 = bv[dir][4 * g + 3];
                oA[g] = (a0 * a1) * (a2 * a3);
                oB[g] = dir == 0 ? ((b0 * a1 + b1) * a2 + b2) * a3 + b3 : ((b3 * a2 + b2) * a1 + b1) * a0 + b0;
            }
#pragma unroll
            for (int g = 0; g < 4; ++g) {
                const float pA = __shfl_xor(oA[g], 32), pB = __shfl_xor(oB[g], 32);
                GA[dir][2 * g] = hh ? pA : oA[g]; GA[dir][2 * g + 1] = hh ? oA[g] : pA;
                GB[dir][2 * g] = hh ? pB : oB[g]; GB[dir][2 * g + 1] = hh ? oB[g] : pB;
            }
            float tA = 1.f, tB = 0.f;
            if (dir == 0) {
#pragma unroll
                for (int gq = 0; gq < 8; ++gq) { tB = GA[dir][gq] * tB + GB[dir][gq]; tA *= GA[dir][gq]; }
            } else {
#pragma unroll
                for (int gq = 7; gq >= 0; --gq) { tB = GA[dir][gq] * tB + GB[dir][gq]; tA *= GA[dir][gq]; }
            }
            if (hh == 0) TAGG[(tw * 2 + dir) * 64 + cin] = (f32x2){tA, tB};
        }
        if (has_next) LRU_STORE_RAW(cur ^ 1);
        __syncthreads();
        if constexpr (!PASSC) {
            if (tid < 128) {
                const int dir = tid >> 6, c = tid & 63;
                float cA = 1.f, cB = 0.f;
#pragma unroll
                for (int k = 0; k < 4; ++k) { const int t2 = dir == 0 ? k : 3 - k; const f32x2 v = TAGG[(t2 * 2 + dir) * 64 + c]; cB = v[0] * cB + v[1]; cA *= v[0]; }
                f32x2* AGG = (f32x2*)(ws + WS_AGG);
                AGG[((size_t)dir * NCHK + chunk) * 1024 + hd * 64 + c] = (f32x2){cA, cB};
            }
        } else {
            float yv[16];
#pragma unroll
            for (int dir = 0; dir < 2; ++dir) {
                float st = cry[dir];
                if (dir == 0) {
#pragma unroll
                    for (int t2 = 0; t2 < 3; ++t2) if (t2 < tw) { const f32x2 v = TAGG[(t2 * 2 + 0) * 64 + cin]; st = v[0] * st + v[1]; }
                } else {
#pragma unroll
                    for (int t2 = 3; t2 > 0; --t2) if (t2 > tw) { const f32x2 v = TAGG[(t2 * 2 + 1) * 64 + cin]; st = v[0] * st + v[1]; }
                }
                float hst[4];
                if (dir == 0) {
                    float s = st;
#pragma unroll
                    for (int g = 0; g < 4; ++g) { const float sE = s; s = GA[0][2 * g] * s + GB[0][2 * g]; const float sO = s; s = GA[0][2 * g + 1] * s + GB[0][2 * g + 1]; hst[g] = hh ? sO : sE; }
                } else {
                    float s = st;
#pragma unroll
                    for (int g = 3; g >= 0; --g) { const float sO = s; s = GA[1][2 * g + 1] * s + GB[1][2 * g + 1]; const float sE = s; s = GA[1][2 * g] * s + GB[1][2 * g]; hst[g] = hh ? sO : sE; }
                }
#pragma unroll
                for (int g = 0; g < 4; ++g) {
                    float h = hst[g];
                    if (dir == 0) {
#pragma unroll
                        for (int k = 0; k < 4; ++k) { h = av[0][4 * g + k] * h + bv[0][4 * g + k]; yv[4 * g + k] = h; }
                    } else {
#pragma unroll
                        for (int k = 3; k >= 0; --k) { h = av[1][4 * g + k] * h + bv[1][4 * g + k]; yv[4 * g + k] += h; }
                    }
                }
            }
            LAS bf16_t* YB = (LAS bf16_t*)(lds + L2_RAW + cur * RAW_BUFB);
#pragma unroll
            for (int i = 0; i < 16; ++i) YB[(32 * tw + (i & 3) + 8 * (i >> 2) + 4 * hh) * 72 + cin] = f2bf(yv[i]);
            __syncthreads();
            {
                const u32x4 y0 = *(LAS u32x4*)(YB + t * 72 + 16 * q), y1 = *(LAS u32x4*)(YB + t * 72 + 16 * q + 8);
                const unsigned yw[8] = {y0.x, y0.y, y0.z, y0.w, y1.x, y1.y, y1.z, y1.w};
                const unsigned gw_[8] = {g0.x, g0.y, g0.z, g0.w, g1.x, g1.y, g1.z, g1.w};
                unsigned ow[8];
#pragma unroll
                for (int j = 0; j < 8; ++j) ow[j] = pk2(bflo(yw[j]) * silu(bflo(gw_[j])), bfhi(yw[j]) * silu(bfhi(gw_[j])));
                bf16_t* yp = (bf16_t*)(ws + WS_Y) + (size_t)(chunk * 128 + t) * D + ch0;
                *(u32x4*)yp = (u32x4){ow[0], ow[1], ow[2], ow[3]}; *(u32x4*)(yp + 8) = (u32x4){ow[4], ow[5], ow[6], ow[7]};
            }
        }
        cur ^= 1;
    }
#undef LRU_LOAD_RAW
#undef LRU_STORE_RAW
}

constexpr int CV_ZT = 0;
constexpr int CV_CB = 94 * 1024;
static_assert(CV_CB + 16 * 512 * 4 <= LDS_BYTES, "conv lds map");
__device__ __forceinline__ void conv_item2(const Args a, int l, int ct, LAS unsigned char* lds) {
    const int tid = tid_fresh(), lane = tid & 63, wave = tid >> 6, c = tid;
    unsigned char* ws = ptr_fresh(a.ws);
    const bf16_t* PX = (const bf16_t*)(ws + WS_PX); bf16_t* Y = (bf16_t*)(ws + WS_Y);
    LAS bf16_t* ZT = (LAS bf16_t*)(lds + CV_ZT);
    LAS float* CB = (LAS float*)(lds + CV_CB);
    const int t0 = ct * 64, seg_lo = t0 < CL ? 0 : CL, seg_hi = t0 < CL ? CL : R;
    __syncthreads();
    {
        u32x4 zv[12], zg[12];
#pragma unroll
        for (int it = 0; it < 12; ++it) {
            const int pid = tid + 512 * it, e = pid >> 6, pc = pid & 63, ec = e < 94 ? e : 93;
            const int rr = t0 - 15 + ec, rc = rr < seg_lo ? seg_lo : (rr >= seg_hi ? seg_hi - 1 : rr);
            zv[it] = *(const u32x4*)(PX + (size_t)rc * DIN + 2048 + 8 * pc); zg[it] = *(const u32x4*)(PX + (size_t)rc * DIN + 2560 + 8 * pc);
        }
#pragma unroll
        for (int it = 0; it < 12; ++it) {
            const int pid = tid + 512 * it, e = pid >> 6, pc = pid & 63;
            const int rr = t0 - 15 + e;
            const unsigned vw[4] = {zv[it].x, zv[it].y, zv[it].z, zv[it].w}, gw_[4] = {zg[it].x, zg[it].y, zg[it].z, zg[it].w};
            unsigned ow[4];
#pragma unroll
            for (int j = 0; j < 4; ++j) ow[j] = pk2(bflo(vw[j]) * sigm(bflo(gw_[j])), bfhi(vw[j]) * sigm(bfhi(gw_[j])));
            const bool ok = rr >= seg_lo && rr < seg_hi;
            u32x4 o;
            o.x = ok ? ow[0] : 0u; o.y = ok ? ow[1] : 0u; o.z = ok ? ow[2] : 0u; o.w = ok ? ow[3] : 0u;
            if (e < 94) *(LAS u32x4*)(ZT + e * 512 + 8 * pc) = o;
        }
    }
    float w[31];
#pragma unroll
    for (int j = 0; j < 31; ++j) w[j] = a.in[16][((size_t)l * 31 + j) * 512 + c];
    const float bias = a.in[17][l * 512 + c];
    float lg[8], lb[8];
    { const f32x4 x0 = *(const f32x4*)(a.in[18] + l * 512 + 8 * lane), x1 = *(const f32x4*)(a.in[18] + l * 512 + 8 * lane + 4), y0 = *(const f32x4*)(a.in[19] + l * 512 + 8 * lane), y1 = *(const f32x4*)(a.in[19] + l * 512 + 8 * lane + 4);
#pragma unroll
      for (int k = 0; k < 4; ++k) { lg[k] = x0[k]; lg[4 + k] = x1[k]; lb[k] = y0[k]; lb[4 + k] = y1[k]; } }
    __syncthreads();
    float win[32];
#pragma unroll
    for (int e = 0; e < 30; ++e) win[e] = bf1(ZT[e * 512 + c]);
    win[30] = 0.f; win[31] = 0.f;
#pragma unroll 1
    for (int bb = 0; bb < 2; ++bb) {
#pragma unroll
        for (int hb = 0; hb < 2; ++hb) {
            u32x4 gt[2];
#pragma unroll
            for (int uu = 0; uu < 2; ++uu) gt[uu] = *(const u32x4*)(PX + (size_t)(t0 + 32 * bb + 16 * hb + wave * 2 + uu) * DIN + 3072 + 8 * lane);
#pragma unroll
            for (int u16 = 0; u16 < 16; ++u16) {
                const int u = 16 * hb + u16;
                win[(u + 30) & 31] = bf1(ZT[(32 * bb + u + 30) * 512 + c]);
                float acc = bias;
#pragma unroll
                for (int j = 0; j < 31; ++j) acc += w[j] * win[(u + j) & 31];
                CB[u16 * 512 + c] = acc;
            }
            __syncthreads();
#pragma unroll
            for (int uu = 0; uu < 2; ++uu) {
                const int u = wave * 2 + uu, row = t0 + 32 * bb + 16 * hb + u;
                float v[8]; float s = 0.f;
                { const f32x4 c0 = *(LAS f32x4*)(CB + u * 512 + 8 * lane), c1 = *(LAS f32x4*)(CB + u * 512 + 8 * lane + 4);
#pragma unroll
                  for (int k = 0; k < 4; ++k) { v[k] = c0[k]; v[4 + k] = c1[k]; } }
#pragma unroll
                for (int k = 0; k < 8; ++k) s += v[k];
                const float mean = wave_sum(s) * (1.0f / 512.0f);
                float s2 = 0.f;
#pragma unroll
                for (int k = 0; k < 8; ++k) { v[k] -= mean; s2 += v[k] * v[k]; }
                const float rstd = 1.0f / sqrtf(wave_sum(s2) * (1.0f / 512.0f) + EPS);
                const unsigned gw_[4] = {gt[uu].x, gt[uu].y, gt[uu].z, gt[uu].w};
                unsigned ow[4];
#pragma unroll
                for (int k = 0; k < 4; ++k) {
                    const float y0 = silu(v[2 * k] * rstd * lg[2 * k] + lb[2 * k]) * silu(bflo(gw_[k]));
                    const float y1 = silu(v[2 * k + 1] * rstd * lg[2 * k + 1] + lb[2 * k + 1]) * silu(bfhi(gw_[k]));
                    ow[k] = pk2(y0, y1);
                }
                *(u32x4*)(Y + (size_t)row * D + 1024 + 8 * lane) = (u32x4){ow[0], ow[1], ow[2], ow[3]};
            }
            __syncthreads();
        }
    }
}

__device__ __forceinline__ void sgu_item2(const Args a, int l, int item, LAS unsigned char* lds) {
    const int tid = tid_fresh(), lane = tid & 63, wave = tid >> 6;
    unsigned char* ws = ptr_fresh(a.ws);
    const bf16_t* PX = (const bf16_t*)(ws + WS_PX); bf16_t* Y = (bf16_t*)(ws + WS_Y);
    const bf16_t* SW = (const bf16_t*)(ws + WS_SW) + (size_t)l * 8 * 128 * 128;
    LAS f32x2* ST = (LAS f32x2*)lds;
    LAS bf16_t* TT = (LAS bf16_t*)(lds + 1024);
    const int sc = item >> 1, hg = item & 1, t0 = sc * 128;
    __syncthreads();
#pragma unroll
    for (int kb = 0; kb < 2; ++kb) {
        u32x4 p[8];
#pragma unroll
        for (int k = 0; k < 8; ++k) p[k] = *(const u32x4*)(PX + (size_t)(t0 + wave * 16 + kb * 8 + k) * DIN + 4096 + 8 * lane);
#pragma unroll
        for (int k = 0; k < 8; ++k) {
            float g[8] = {gelu_t(bflo(p[k].x)), gelu_t(bfhi(p[k].x)), gelu_t(bflo(p[k].y)), gelu_t(bfhi(p[k].y)), gelu_t(bflo(p[k].z)), gelu_t(bfhi(p[k].z)), gelu_t(bflo(p[k].w)), gelu_t(bfhi(p[k].w))};
            float s = 0.f;
#pragma unroll
            for (int j = 0; j < 8; ++j) s += g[j];
            const float mean = wave_sum(s) * (1.0f / 512.0f);
            float s2 = 0.f;
#pragma unroll
            for (int j = 0; j < 8; ++j) { const float d = g[j] - mean; s2 += d * d; }
            const float rstd = 1.0f / sqrtf(wave_sum(s2) * (1.0f / 512.0f) + EPS);
            if (lane == 0) ST[wave * 16 + kb * 8 + k] = (f32x2){mean, rstd};
        }
    }
    __syncthreads();
    const int p_ = tid >> 2, dq = tid & 3;
    const f32x2 st = ST[p_];
    const int fr = lane & 15, fq = lane >> 4;
    LAS float* SO = (LAS float*)(lds + 1024 + 2 * 64 * TT_STRIDE * 2);
    u32x4 Lq0[2], Lq1[2], Lu0[2], Lu1[2], Lg0[2], Lg1[2]; bf16x8 LA[2][4]; f32x4 Llg[2][4], Llb[2][4]; float Lbs[2];
#define SGU_LOAD(sl, h_) do { const int _ch = 64 * (h_) + 16 * dq; const bf16_t* _pr = PX + (size_t)(t0 + p_) * DIN + _ch; \
        Lq0[sl] = *(const u32x4*)(_pr + 4096); Lq1[sl] = *(const u32x4*)(_pr + 4096 + 8); Lu0[sl] = *(const u32x4*)(_pr + 3584); Lu1[sl] = *(const u32x4*)(_pr + 3584 + 8); \
        Lg0[sl] = *(const u32x4*)(_pr + 4608); Lg1[sl] = *(const u32x4*)(_pr + 4608 + 8); \
        _Pragma("unroll") for (int s = 0; s < 4; ++s) LA[sl][s] = *(const bf16x8*)(SW + ((size_t)(h_) * 128 + 16 * wave + fr) * 128 + 32 * s + 8 * fq); \
        Lbs[sl] = a.in[23][((size_t)l * 8 + (h_)) * 128 + p_]; \
        _Pragma("unroll") for (int j = 0; j < 4; ++j) { Llg[sl][j] = *(const f32x4*)(a.in[20] + l * 512 + _ch + 4 * j); Llb[sl][j] = *(const f32x4*)(a.in[21] + l * 512 + _ch + 4 * j); } } while (0)
    SGU_LOAD(0, 4 * hg);
#pragma unroll
    for (int h4 = 0; h4 < 4; ++h4) {
        const int h = 4 * hg + h4, sl = h4 & 1;
        LAS bf16_t* tt = TT + (h4 & 1) * (64 * TT_STRIDE);
        if (h4 + 1 < 4) SGU_LOAD(sl ^ 1, h + 1);
        const int ch = 64 * h + 16 * dq;
        const u32x4 q0 = Lq0[sl], q1 = Lq1[sl], u0 = Lu0[sl], u1 = Lu1[sl], g0 = Lg0[sl], g1 = Lg1[sl];
        bf16x8 Afr[4];
#pragma unroll
        for (int s = 0; s < 4; ++s) Afr[s] = LA[sl][s];
        const float bs = Lbs[sl];
        f32x4 lgv[4], lbv[4];
#pragma unroll
        for (int j = 0; j < 4; ++j) { lgv[j] = Llg[sl][j]; lbv[j] = Llb[sl][j]; }
        {
            const unsigned pw[8] = {q0.x, q0.y, q0.z, q0.w, q1.x, q1.y, q1.z, q1.w};
#pragma unroll
            for (int j = 0; j < 8; ++j) {
                const float v0 = (gelu_t(bflo(pw[j])) - st[0]) * st[1] * lgv[j >> 1][(2 * j) & 3] + lbv[j >> 1][(2 * j) & 3];
                const float v1 = (gelu_t(bfhi(pw[j])) - st[0]) * st[1] * lgv[j >> 1][(2 * j + 1) & 3] + lbv[j >> 1][(2 * j + 1) & 3];
                tt[(16 * dq + 2 * j) * TT_STRIDE + p_] = f2bf(v0);
                tt[(16 * dq + 2 * j + 1) * TT_STRIDE + p_] = f2bf(v1);
            }
        }
        __syncthreads();
        f32x4 acc[4];
#pragma unroll
        for (int nt = 0; nt < 4; ++nt) acc[nt] = (f32x4){0.f, 0.f, 0.f, 0.f};
#pragma unroll
        for (int s = 0; s < 4; ++s)
#pragma unroll
            for (int nt = 0; nt < 4; ++nt) {
                const bf16x8 Bfr = *(const LAS bf16x8*)(tt + (16 * nt + fr) * TT_STRIDE + 32 * s + 8 * fq);
                acc[nt] = __builtin_amdgcn_mfma_f32_16x16x32_bf16(Afr[s], Bfr, acc[nt], 0, 0, 0);
            }
#pragma unroll
        for (int reg = 0; reg < 4; ++reg)
#pragma unroll
            for (int nt = 0; nt < 4; ++nt) SO[(16 * wave + 4 * fq + reg) * 68 + 16 * nt + fr] = acc[nt][reg];
        __syncthreads();
        {
            const unsigned uw[8] = {u0.x, u0.y, u0.z, u0.w, u1.x, u1.y, u1.z, u1.w}, gw_[8] = {g0.x, g0.y, g0.z, g0.w, g1.x, g1.y, g1.z, g1.w};
            unsigned ow[8];
#pragma unroll
            for (int j4 = 0; j4 < 4; ++j4) {
                const f32x4 sv = *(LAS f32x4*)(SO + p_ * 68 + 16 * dq + 4 * j4);
                ow[2 * j4] = pk2(gelu_t(bflo(uw[2 * j4])) * (sv[0] + bs) * silu(bflo(gw_[2 * j4])), gelu_t(bfhi(uw[2 * j4])) * (sv[1] + bs) * silu(bfhi(gw_[2 * j4])));
                ow[2 * j4 + 1] = pk2(gelu_t(bflo(uw[2 * j4 + 1])) * (sv[2] + bs) * silu(bflo(gw_[2 * j4 + 1])), gelu_t(bfhi(uw[2 * j4 + 1])) * (sv[3] + bs) * silu(bfhi(gw_[2 * j4 + 1])));
            }
            bf16_t* yp = Y + (size_t)(t0 + p_) * D + 1536 + ch;
            *(u32x4*)yp = (u32x4){ow[0], ow[1], ow[2], ow[3]}; *(u32x4*)(yp + 8) = (u32x4){ow[4], ow[5], ow[6], ow[7]};
        }
    }
#undef SGU_LOAD
}

__device__ __forceinline__ int scan_chunk(int dir, int o) { return dir == 0 ? o : (o == 0 ? 1 : (o == 1 ? 0 : (NCHK + 1 - o))); }
__device__ __forceinline__ void phase_carry(const Args a, LAS unsigned char* lds) {
    const int tid = tid_fresh(), b = blockIdx.x, G = gridDim.x;
    unsigned char* ws = ptr_fresh(a.ws);
    const f32x2* AGG = (const f32x2*)(ws + WS_AGG); float* CARRY = (float*)(ws + WS_CARRY);
    LAS f32x2* SEG = (LAS f32x2*)lds;
    for (int u = b; u < 64; u += G) {
        const int dir = u >> 5, ch = (u & 31) * 32 + (tid & 31), sg = tid >> 5;
        f32x2 ab[10];
        if (sg < 13) {
#pragma unroll
            for (int k = 0; k < 10; ++k) ab[k] = AGG[((size_t)dir * NCHK + scan_chunk(dir, 10 * sg + k)) * 1024 + ch];
            float sA = 1.f, sB = 0.f;
#pragma unroll
            for (int k = 0; k < 10; ++k) { sB = ab[k][0] * sB + ab[k][1]; sA *= ab[k][0]; }
            SEG[sg * 32 + (tid & 31)] = (f32x2){sA, sB};
        }
        __syncthreads();
        if (sg < 13) {
            float st = 0.f;
            for (int s2 = 0; s2 < sg; ++s2) { const f32x2 v = SEG[s2 * 32 + (tid & 31)]; st = v[0] * st + v[1]; }
#pragma unroll
            for (int k = 0; k < 10; ++k) { CARRY[((size_t)dir * NCHK + scan_chunk(dir, 10 * sg + k)) * 1024 + ch] = st; st = ab[k][0] * st + ab[k][1]; }
        }
        __syncthreads();
    }
}

__device__ __forceinline__ void phase_resid0(const Args a) {
    const int tid = tid_fresh(), lane = tid & 63, wave = tid >> 6, b = blockIdx.x, G = gridDim.x;
    unsigned char* ws = ptr_fresh(a.ws);
    const bf16_t* DL0 = (const bf16_t*)(ws + WS_DL0);
    const float* gg0 = (const float*)(ws + WS_GG);
    const float* gg = (const float*)(ws + WS_GG) + (size_t)2 * D;
    bf16_t* XG = (bf16_t*)(ws + WS_XG) + (size_t)CL * D; float* rss1 = (float*)(ws + WS_RSS) + R + CL;
    f32x4 g[8], rg0[8];
#pragma unroll
    for (int j = 0; j < 4; ++j) { g[2 * j] = *(const f32x4*)(gg + 8 * (lane + 64 * j)); g[2 * j + 1] = *(const f32x4*)(gg + 8 * (lane + 64 * j) + 4);
        const f32x4 h0 = *(const f32x4*)(gg0 + 8 * (lane + 64 * j)), h1 = *(const f32x4*)(gg0 + 8 * (lane + 64 * j) + 4);
        rg0[2 * j] = (f32x4){1.0f / h0[0], 1.0f / h0[1], 1.0f / h0[2], 1.0f / h0[3]}; rg0[2 * j + 1] = (f32x4){1.0f / h1[0], 1.0f / h1[1], 1.0f / h1[2], 1.0f / h1[3]}; }
    u32x4 xr[4], dr[4];
#define RS_LOAD(t_, X, Dd) do { _Pragma("unroll") for (int j = 0; j < 4; ++j) { X[j] = *(const u32x4*)(XG + (size_t)(t_) * D + 8 * (lane + 64 * j)); Dd[j] = *(const u32x4*)(DL0 + (size_t)(t_) * D + 8 * (lane + 64 * j)); } } while (0)
    int t = b * 8 + wave;
    if (t < T) RS_LOAD(t, xr, dr);
    for (; t < T; t += G * 8) {
        u32x4 xn[4], dn[4];
        const int tn = t + G * 8;
        if (tn < T) RS_LOAD(tn, xn, dn);
        f32x4 v[8]; float ss = 0.f;
#pragma unroll
        for (int j = 0; j < 4; ++j) {
            v[2 * j] = (f32x4){bflo(xr[j].x), bfhi(xr[j].x), bflo(xr[j].y), bfhi(xr[j].y)} * rg0[2 * j] + (f32x4){bflo(dr[j].x), bfhi(dr[j].x), bflo(dr[j].y), bfhi(dr[j].y)};
            v[2 * j + 1] = (f32x4){bflo(xr[j].z), bfhi(xr[j].z), bflo(xr[j].w), bfhi(xr[j].w)} * rg0[2 * j + 1] + (f32x4){bflo(dr[j].z), bfhi(dr[j].z), bflo(dr[j].w), bfhi(dr[j].w)};
        }
#pragma unroll
        for (int j = 0; j < 8; ++j) ss += (v[j][0] * v[j][0] + v[j][1] * v[j][1]) + (v[j][2] * v[j][2] + v[j][3] * v[j][3]);
#pragma unroll
        for (int j = 0; j < 4; ++j) {
            const f32x4 p0 = v[2 * j] * g[2 * j], p1 = v[2 * j + 1] * g[2 * j + 1];
            u32x4 w; w.x = pk2(p0[0], p0[1]); w.y = pk2(p0[2], p0[3]); w.z = pk2(p1[0], p1[1]); w.w = pk2(p1[2], p1[3]);
            *(u32x4*)(XG + (size_t)t * D + 8 * (lane + 64 * j)) = w;
        }
        ss = wave_sum(ss);
        if (lane == 0) rss1[t] = ss;
        if (tn < T) {
#pragma unroll
            for (int j = 0; j < 4; ++j) { xr[j] = xn[j]; dr[j] = dn[j]; }
        }
    }
#undef RS_LOAD
}
__device__ __forceinline__ void phase_final(const Args a) {
    const int tid = tid_fresh(), lane = tid & 63, wave = tid >> 6, b = blockIdx.x, G = gridDim.x;
    unsigned char* ws = ptr_fresh(a.ws);
    const bf16_t* XG1 = (const bf16_t*)(ws + WS_XG) + (size_t)CL * D;
    const bf16_t* DL1 = (const bf16_t*)(ws + WS_DL0);
    const float* fg = a.in[24];
    const float* gg = (const float*)(ws + WS_GG) + (size_t)2 * D;
    u32x4 xr[4], er[4];
#define FN_LOAD(t_, X, Ee) do { _Pragma("unroll") for (int j = 0; j < 4; ++j) { X[j] = *(const u32x4*)(XG1 + (size_t)(t_) * D + 8 * (lane + 64 * j)); Ee[j] = *(const u32x4*)(DL1 + (size_t)(t_) * D + 8 * (lane + 64 * j)); } } while (0)
    f32x4 fgv[8], rg[8];
#pragma unroll
    for (int j = 0; j < 4; ++j) { fgv[2 * j] = *(const f32x4*)(fg + 8 * (lane + 64 * j)); fgv[2 * j + 1] = *(const f32x4*)(fg + 8 * (lane + 64 * j) + 4);
        const f32x4 g0 = *(const f32x4*)(gg + 8 * (lane + 64 * j)), g1 = *(const f32x4*)(gg + 8 * (lane + 64 * j) + 4);
        rg[2 * j] = (f32x4){1.0f / g0[0], 1.0f / g0[1], 1.0f / g0[2], 1.0f / g0[3]}; rg[2 * j + 1] = (f32x4){1.0f / g1[0], 1.0f / g1[1], 1.0f / g1[2], 1.0f / g1[3]}; }
    int t = b * 8 + wave;
    if (t < T) FN_LOAD(t, xr, er);
    for (; t < T; t += G * 8) {
        u32x4 xn[4], en[4];
        const int tn = t + G * 8;
        if (tn < T) FN_LOAD(tn, xn, en);
        float* orow = a.out + (size_t)t * D;
        f32x4 v[8]; float ss = 0.f;
#pragma unroll
        for (int j = 0; j < 4; ++j) {
            v[2 * j] = (f32x4){bflo(xr[j].x), bfhi(xr[j].x), bflo(xr[j].y), bfhi(xr[j].y)} * rg[2 * j] + (f32x4){bflo(er[j].x), bfhi(er[j].x), bflo(er[j].y), bfhi(er[j].y)};
            v[2 * j + 1] = (f32x4){bflo(xr[j].z), bfhi(xr[j].z), bflo(xr[j].w), bfhi(xr[j].w)} * rg[2 * j + 1] + (f32x4){bflo(er[j].z), bfhi(er[j].z), bflo(er[j].w), bfhi(er[j].w)};
        }
#pragma unroll
        for (int j = 0; j < 8; ++j) ss += (v[j][0] * v[j][0] + v[j][1] * v[j][1]) + (v[j][2] * v[j][2] + v[j][3] * v[j][3]);
        const float rs = 1.0f / sqrtf(wave_sum(ss) * (1.0f / D) + EPS);
#pragma unroll
        for (int j = 0; j < 4; ++j) {
            *(f32x4*)(orow + 8 * (lane + 64 * j)) = v[2 * j] * rs * fgv[2 * j]; *(f32x4*)(orow + 8 * (lane + 64 * j) + 4) = v[2 * j + 1] * rs * fgv[2 * j + 1];
        }
        if (tn < T) {
#pragma unroll
            for (int j = 0; j < 4; ++j) { xr[j] = xn[j]; er[j] = en[j]; }
        }
    }
#undef FN_LOAD
}

template <int NT, int MODE>
__device__ __forceinline__ void ctx_gemm(const Args a, int l, LAS unsigned char* lds) {
    const int tid = tid_fresh(), lane = tid & 63, wave = tid >> 6, b = blockIdx.x, G = gridDim.x;
    unsigned char* ws = ptr_fresh(a.ws);
    constexpr int TN = 16 * NT, N = 64 * TN, TS = TN + 4;
    const bf16_t* A = (const bf16_t*)(ws + (MODE == 0 ? WS_XG : WS_Y));
    const bf16_t* Bt = MODE == 0 ? (const bf16_t*)(ws + WS_WINT) + (size_t)l * DIN * D : (const bf16_t*)(ws + WS_WOUTT) + (size_t)l * D * D;
    LAS float* CT = (LAS float*)lds;
    const int fr = lane & 15, fq = lane >> 4;
#pragma unroll 1
    for (int tile = b; tile < 256; tile += G) {
        const int r0 = (tile >> 6) * 64, n0 = (tile & 63) * TN;
        __syncthreads();
        f32x4 acc[4][NT];
#pragma unroll
        for (int m = 0; m < 4; ++m)
#pragma unroll
            for (int n = 0; n < NT; ++n) acc[m][n] = (f32x4){0.f, 0.f, 0.f, 0.f};
        const bf16_t* ap = A + (size_t)(r0 + fr) * D + wave * 256 + 8 * fq;
        const bf16_t* bp = Bt + (size_t)(n0 + fr) * D + wave * 256 + 8 * fq;
        bf16x8 af[2][4], bfr[2][NT];
#define CTXG_LOAD(buf, ks_) do { _Pragma("unroll") for (int m = 0; m < 4; ++m) af[buf][m] = *(const bf16x8*)(ap + (size_t)(16 * m) * D + 32 * (ks_)); \
        _Pragma("unroll") for (int n = 0; n < NT; ++n) bfr[buf][n] = *(const bf16x8*)(bp + (size_t)(16 * n) * D + 32 * (ks_)); } while (0)
#define CTXG_MMA(buf) do { _Pragma("unroll") for (int m = 0; m < 4; ++m) _Pragma("unroll") for (int n = 0; n < NT; ++n) \
        acc[m][n] = __builtin_amdgcn_mfma_f32_16x16x32_bf16(af[buf][m], bfr[buf][n], acc[m][n], 0, 0, 0); } while (0)
        CTXG_LOAD(0, 0);
#pragma unroll
        for (int ks = 0; ks < 8; ks += 2) {
            CTXG_LOAD(1, ks + 1);
            __builtin_amdgcn_sched_barrier(0);
            CTXG_MMA(0);
            __builtin_amdgcn_sched_barrier(0);
            if (ks + 2 < 8) CTXG_LOAD(0, ks + 2);
            __builtin_amdgcn_sched_barrier(0);
            CTXG_MMA(1);
            __builtin_amdgcn_sched_barrier(0);
        }
#undef CTXG_LOAD
#undef CTXG_MMA
#pragma unroll
        for (int ps = 0; ps < 2; ++ps) {
#pragma unroll
            for (int m2 = 0; m2 < 2; ++m2)
#pragma unroll
                for (int n = 0; n < NT; ++n)
#pragma unroll
                    for (int reg = 0; reg < 4; ++reg) CT[(wave * 32 + 16 * m2 + 4 * fq + reg) * TS + 16 * n + fr] = acc[2 * ps + m2][n][reg];
            __syncthreads();
            for (int wi = tid; wi < 32 * (TN / 8); wi += 512) {
                const int rr = wi / (TN / 8), cgp = wi % (TN / 8), row = r0 + 32 * ps + rr, col = n0 + 8 * cgp;
                f32x4 c0 = {0.f, 0.f, 0.f, 0.f}, c1 = {0.f, 0.f, 0.f, 0.f};
#pragma unroll
                for (int w8 = 0; w8 < 8; ++w8) { c0 += *(LAS f32x4*)(CT + (w8 * 32 + rr) * TS + 8 * cgp); c1 += *(LAS f32x4*)(CT + (w8 * 32 + rr) * TS + 8 * cgp + 4); }
                if (MODE == 0) {
                    const float* rss = (const float*)(ws + WS_RSS) + (size_t)l * R;
                    const float* shw = (const float*)(ws + WS_SHW) + (size_t)(l * 2 + 1) * DIN;
                    bf16_t* PXo = (bf16_t*)(ws + WS_PX);
                    const float rs = 1.0f / sqrtf(rss[row] * (1.0f / D) + EPS);
                    const f32x4 s0 = *(const f32x4*)(shw + col), s1 = *(const f32x4*)(shw + col + 4);
                    const f32x4 v0 = c0 * rs + s0, v1 = c1 * rs + s1;
                    u32x4 w; w.x = pk2(v0[0], v0[1]); w.y = pk2(v0[2], v0[3]); w.z = pk2(v1[0], v1[1]); w.w = pk2(v1[2], v1[3]);
                    *(u32x4*)(PXo + (size_t)row * DIN + col) = w;
                } else {
                    const float* gp = (const float*)(ws + WS_MOD) + (size_t)(l * 2 + 1) * 6144 + 4096;
                    const float* ggp = (const float*)(ws + WS_GG) + (size_t)((l + 1) * 2 + 1) * D;
                    float* rssn = (float*)(ws + WS_RSS) + (size_t)(l + 1) * R;
                    float* xn = (float*)(ws + WS_X1C); bf16_t* XG = (bf16_t*)(ws + WS_XG);
                    const f32x4 o0 = *(const f32x4*)(a.in[2] + (size_t)row * D + col), o1 = *(const f32x4*)(a.in[2] + (size_t)row * D + col + 4);
                    const f32x4 g0 = *(const f32x4*)(gp + col), g1 = *(const f32x4*)(gp + col + 4);
                    const f32x4 v0 = o0 + g0 * c0, v1 = o1 + g1 * c1;
                    *(f32x4*)(xn + (size_t)row * D + col) = v0; *(f32x4*)(xn + (size_t)row * D + col + 4) = v1;
                    const f32x4 q0 = *(const f32x4*)(ggp + col), q1 = *(const f32x4*)(ggp + col + 4);
                    const f32x4 a0 = v0 * q0, a1 = v1 * q1;
                    u32x4 w; w.x = pk2(a0[0], a0[1]); w.y = pk2(a0[2], a0[3]); w.z = pk2(a1[0], a1[1]); w.w = pk2(a1[2], a1[3]);
                    *(u32x4*)(XG + (size_t)row * D + col) = w;
                    const float ss = (v0[0] * v0[0] + v0[1] * v0[1]) + (v0[2] * v0[2] + v0[3] * v0[3]) + (v1[0] * v1[0] + v1[1] * v1[1]) + (v1[2] * v1[2] + v1[3] * v1[3]);
                    unsafeAtomicAdd(rssn + row, ss);
                }
            }
            __syncthreads();
        }
    }
    __syncthreads();
}

#define XB_TMO      128
#define XB_XCNT(j)  (256  + 64 * (j))
#define XB_XSUB(j)  (1280 + 64 * (j))
#define XB_XGEN(j)  (2304 + 64 * (j))
#define XB_TOP      3328
#define XB_TOPGEN   3392
#define XCD_BAR_WORDS 3456
#define XB_SPIN_CAP (1u << 18)

__device__ __forceinline__ unsigned xb_ld(unsigned* p)              { return __hip_atomic_load(p, __ATOMIC_RELAXED, __HIP_MEMORY_SCOPE_AGENT); }
__device__ __forceinline__ unsigned xb_add(unsigned* p, unsigned v) { return __hip_atomic_fetch_add(p, v, __ATOMIC_RELAXED, __HIP_MEMORY_SCOPE_AGENT); }
__device__ __forceinline__ unsigned xb_xcc_id() { return (unsigned)__builtin_amdgcn_s_getreg((3 << 11) | 20) & 0xFu; }
#define XB_SPIN(cond, bar) do { unsigned _sp = 0; while (cond) { __builtin_amdgcn_s_sleep(1); \
    if ((++_sp & 255u) == 0u) { if (xb_ld(&(bar)[XB_TMO])) break; if (_sp > XB_SPIN_CAP) { atomicAdd(&(bar)[XB_TMO], 1u); break; } } } } while (0)

struct XcdBarrier {
    unsigned* bar; unsigned x;
    volatile LAS unsigned* st;
};

__device__ __forceinline__ XcdBarrier xcd_barrier_post(unsigned* bar, volatile LAS unsigned* st) {
    XcdBarrier b; b.bar = bar; b.x = xb_xcc_id(); b.st = st;
    if (threadIdx.x == 0) (void)xb_add(&bar[XB_XCNT(b.x)], 1u);
    return b;
}
__device__ __forceinline__ void xcd_barrier_complete(unsigned* bar, unsigned x, unsigned& nloc, unsigned& nx) {
    const unsigned G = gridDim.x * gridDim.y * gridDim.z;
    unsigned sum, cnt, mine, sp = 0u;
    for (;;) {
        sum = 0u; cnt = 0u; mine = 0u;
#pragma unroll
        for (unsigned j = 0; j < 16; ++j) { const unsigned c = xb_ld(&bar[XB_XCNT(j)]); sum += c; cnt += (c > 0u) ? 1u : 0u; mine = (j == x) ? c : mine; }
        if (sum == G) break;
        __builtin_amdgcn_s_sleep(1);
        if ((++sp & 255u) == 0u) { if (xb_ld(&bar[XB_TMO])) break; if (sp > XB_SPIN_CAP) { atomicAdd(&bar[XB_TMO], 1u); break; } }
    }
    nloc = mine > 0u ? mine : 1u; nx = cnt > 0u ? cnt : 1u;
}

__device__ __forceinline__ void xcd_barrier(const XcdBarrier& b) {
    asm volatile("s_waitcnt vmcnt(0)" ::: "memory");
    __syncthreads();
    if (threadIdx.x == 0) {
        unsigned* bar = b.bar;
        __builtin_amdgcn_s_waitcnt(0);
        unsigned nloc = b.st[0], nx = b.st[1];
        if (nloc == 0u) { xcd_barrier_complete(bar, b.x, nloc, nx); b.st[0] = nloc; b.st[1] = nx; }
        const unsigned old = xb_add(&bar[XB_XSUB(b.x)], 1u);
        const unsigned gen = old / nloc;
        if (old + 1u == (gen + 1u) * nloc) {
            __builtin_amdgcn_fence(__ATOMIC_RELEASE, "agent");
            asm volatile("s_waitcnt vmcnt(0)" ::: "memory");
            const unsigned og = xb_add(&bar[XB_TOP], 1u);
            const unsigned tg = og / nx;
            if (og + 1u == (tg + 1u) * nx) xb_add(&bar[XB_TOPGEN], 1u);
            else XB_SPIN(xb_ld(&bar[XB_TOPGEN]) == tg, bar);
            __builtin_amdgcn_fence(__ATOMIC_ACQUIRE, "agent");
            xb_add(&bar[XB_XGEN(b.x)], 1u);
            asm volatile("s_waitcnt vmcnt(0)" ::: "memory");
        } else {
            XB_SPIN(xb_ld(&bar[XB_XGEN(b.x)]) == gen, bar);
            __builtin_amdgcn_fence(__ATOMIC_ACQUIRE, "agent");
            asm volatile("s_waitcnt vmcnt(0)" ::: "memory");
        }
    }
    __syncthreads();
}


__global__ void __launch_bounds__(512, 2) mega_fwd(Args a) {
    extern __shared__ __attribute__((aligned(16))) unsigned char lds_raw[];
    LAS unsigned char* lds = (LAS unsigned char*)lds_raw;
    cg::grid_group grid = cg::this_grid();
    const int lo = a.ph_lo, hi = a.ph_hi;
    const int b = blockIdx.x, G = gridDim.x;
    unsigned char* ws = ptr_fresh(a.ws);
    { volatile LAS unsigned* xst = (volatile LAS unsigned*)(lds + LDS_BYTES - 16); if (threadIdx.x < 4) xst[threadIdx.x] = 0u; }
    __syncthreads();
    const XcdBarrier xbar = xcd_barrier_post((unsigned*)(a.ws + WS_BAR), (volatile LAS unsigned*)(lds + LDS_BYTES - 16));
#ifndef PHMASK
#define PHMASK 0x1fff
#endif
#define IN(k) (((PHMASK >> (k)) & 1) && lo <= (k) && (k) < hi)
#ifndef DUPMASK
#define DUPMASK 0
#endif
#define DUP(k) ((DUPMASK >> (k)) & 1)
#define GSYNC(k) do { if (a.ph_lo < 0) grid.sync();     \
    xcd_barrier(xbar); } while (0)
#define SEAM(k) do { if (IN(k) && IN((k) + 1)) GSYNC(k); } while (0)
#define REPB(k) for (int rep_ = 0; rep_ <= DUP(k); ++rep_) { if (rep_) xcd_barrier(xbar);
#define REPE }
    if (IN(0)) { REPB(0) phase0a(a, lds); REPE }
    SEAM(0);
    if (IN(1)) { REPB(1) phase0b(a, lds); REPE }
    SEAM(1);
#pragma unroll 1
    for (int l = 0; l < 2; ++l) {
        const int pb = 2 + 5 * l; const bool last = (l == 1);
        if (IN(pb) && (PHMASK & 0x84)) { REPB(pb)
            pg8::Gemm g{(const bf16_t*)(ws + WS_XG) + (size_t)CL * D, (const bf16_t*)(ws + WS_WINT) + (size_t)l * DIN * D, T, DIN, D};
            pg8::StaticOrder S; S.init(T, DIN, G, b);
            EpiIn E{(bf16_t*)(ws + WS_PX), (const float*)(ws + WS_RSS) + (size_t)l * R, (const float*)(ws + WS_SHW) + (size_t)l * 2 * DIN};
            const bool ctx_first = (b & 1) != 0;
            if (ctx_first) ctx_gemm<5, 0>(a, l, lds);
            pg8::gemm_phase<EpiIn, pg8::StaticOrder, GEMM_ALIGN, GEMM_SP2>(lds, g, S, E);
            if (!ctx_first) ctx_gemm<5, 0>(a, l, lds);
        REPE }
        SEAM(pb);
        if (IN(pb + 1) && (PHMASK & 0x108)) { REPB(pb + 1)
            const int c_lo = last ? 2 : 0, n_cv = 2 * (NCHK - c_lo);
            lru_phase<false>(a, l, 0, lds);
            unsigned* qctr = (unsigned*)(a.ws + WS_BAR) + 16 + 2 * l + rep_;
            volatile LAS int* qslot = (volatile LAS int*)(lds + LDS_BYTES - 32);
            for (;;) {
                __syncthreads();
                if (threadIdx.x == 0) *qslot = (int)__hip_atomic_fetch_add(qctr, 1u, __ATOMIC_RELAXED, __HIP_MEMORY_SCOPE_AGENT);
                __syncthreads();
                const int it = *qslot;
                if (it >= 2 * n_cv) break;
                if (it < n_cv) sgu_item2(a, l, 2 * c_lo + it, lds); else conv_item2(a, l, 2 * c_lo + it - n_cv, lds);
            }
        REPE }
        SEAM(pb + 1);
        if (IN(pb + 2) && (PHMASK & 0x210)) { REPB(pb + 2) phase_carry(a, lds); REPE }
        SEAM(pb + 2);
        if (IN(pb + 3) && (PHMASK & 0x420)) { REPB(pb + 3)
            lru_phase<true>(a, l, last ? 2 : 0, lds);
            __syncthreads();
        REPE }
        SEAM(pb + 3);
        if (IN(pb + 4) && (PHMASK & 0x840)) {
            const int roff = CL, M = T;
            pg8::Gemm g{(const bf16_t*)(ws + WS_Y) + (size_t)roff * D, (const bf16_t*)(ws + WS_WOUTT) + (size_t)l * D * D, M, D, D};
            pg8::StaticOrder S; S.init(M, D, G, b);
            EpiDelta E{(bf16_t*)(ws + WS_DL0),
                        (const float*)(ws + WS_MOD) + (size_t)l * 2 * 6144 + 4096};
            const bool ctx_first = !last && (b & 1) != 0;
            if (ctx_first) ctx_gemm<2, 1>(a, l, lds);
            pg8::gemm_phase<EpiDelta, pg8::StaticOrder, GEMM_ALIGN, GEMM_SP2>(lds, g, S, E);
            if (!last) { if (!ctx_first) ctx_gemm<2, 1>(a, l, lds); xcd_barrier(xbar); phase_resid0(a); }
        }
        SEAM(pb + 4);
    }
    if (IN(12)) phase_final(a);
#undef IN
#undef SEAM
}

extern "C" void kernel_launch(void* const* d_in, const int* in_sizes, int n_in, void* d_out, int out_size, void* d_ws, size_t ws_size, hipStream_t stream) {
    static int grid = 0;
    if (grid == 0) {
        int dev = 0, cus = 0, per_cu = 0;
        if (n_in != 25 || ws_size < WS_END) { fprintf(stderr, "kernel_launch: unexpected inputs (n_in %d, ws %zu < %zu)\n", n_in, ws_size, (size_t)WS_END); grid = -1; return; }
        hipGetDevice(&dev);
        hipDeviceGetAttribute(&cus, hipDeviceAttributeMultiprocessorCount, dev);
        if (hipFuncSetAttribute((const void*)mega_fwd, hipFuncAttributeMaxDynamicSharedMemorySize, LDS_BYTES) != hipSuccess) { fprintf(stderr, "kernel_launch: hipFuncSetAttribute failed\n"); grid = -1; return; }
        hipOccupancyMaxActiveBlocksPerMultiprocessor(&per_cu, (const void*)mega_fwd, 512, LDS_BYTES);
        (void)hipGetLastError();
        if (per_cu < 1) { fprintf(stderr, "kernel_launch: occupancy query says %d blocks per CU\n", per_cu); per_cu = 1; }
        grid = cus;
    }
    if (grid < 0) return;
    if (hipMemsetAsync((char*)d_ws + WS_BAR, 0, 16384, stream) != hipSuccess) { fprintf(stderr, "kernel_launch: memset of the barrier words failed\n"); return; }
    Args a{};
    for (int i = 0; i < 25; ++i) a.in[i] = (const float*)d_in[i];
    a.out = (float*)d_out; a.ws = (unsigned char*)d_ws;
#if N_LAUNCH_MODE == 1
    a.ph_lo = 0; a.ph_hi = NPHASE;
    void* args[] = {&a};
    hipError_t e = hipLaunchCooperativeKernel((const void*)mega_fwd, dim3(grid), dim3(512), args, LDS_BYTES, stream);
    if (e != hipSuccess) fprintf(stderr, "kernel_launch: cooperative launch failed: %s (grid %d)\n", hipGetErrorString(e), grid);
#else
    for (int p = 0; p < NPHASE; ++p) {
        a.ph_lo = p; a.ph_hi = p + 1;
        hipLaunchKernelGGL(mega_fwd, dim3(grid), dim3(512), LDS_BYTES, stream, a);
    }
#endif
}
```

```cpp
#include <hip/hip_runtime.h>
#include <hip/hip_cooperative_groups.h>
#include <cstdio>
#include <cstdint>
namespace cg = cooperative_groups;
namespace pg8 {
#define PG8_LAS __attribute__((address_space(3)))
typedef unsigned short bf16_t;
typedef short bf16x8 __attribute__((ext_vector_type(8)));
typedef float f32x4 __attribute__((ext_vector_type(4)));
typedef unsigned u32x4 __attribute__((ext_vector_type(4)));
constexpr int BM = 256, BK = 64, HALF = 128, HTB = HALF * BK * 2  , STAGE_BYTES = 8 * HTB, NXCD = 8, WGM = 8;

__host__ __device__ __forceinline__ int lds_byte(int r, int c) { const int st = (r >> 4) * 2 + (c >> 5), rr = r & 15, cc = c & 31, ob = rr * 64 + cc * 2; return st * 1024 + (ob ^ (((ob >> 9) & 1) << 5)); }
__host__ __device__ __forceinline__ void stage_rc(int b, int& R, int& C) { const int st = b / 1024, sb = b % 1024, swz = sb ^ (((sb >> 9) & 1) << 5); R = (st >> 1) * 16 + swz / 64; C = (st & 1) * 32 + (swz % 64) / 2; }
__host__ __device__ __forceinline__ int perm32(int rho) { const int n = rho >> 4, i = rho & 15; return 8 * (i >> 2) + 4 * n + (i & 3); }

struct Unit { int pm, pn; };
struct Gemm { const bf16_t* A; const bf16_t* Bt; int M, N, K; };

struct StaticOrder {
    int nM, nN, nwg, G, c;
    __host__ __device__ void init(int M, int N, int G_, int c_) { nM = M / BM; nN = N / BM; nwg = nM * nN; G = G_; c = c_; }
    __host__ __device__ bool next(int i, Unit& u) const {
        const long L = (long)i * G + c; if (L >= nwg) return false;
        int wgid = (int)L; { const int q = nwg / NXCD, r = nwg % NXCD, xcd = wgid % NXCD, off = wgid / NXCD; wgid = (xcd < r ? xcd * (q + 1) : r * (q + 1) + (xcd - r) * q) + off; }
        const int nig = WGM * nN, gid = wgid / nig, fm = gid * WGM, gsz = (nM - fm) < WGM ? (nM - fm) : WGM;
        u.pm = fm + ((wgid % nig) % gsz); u.pn = (wgid % nig) / gsz; return true;
    }
    __device__ __forceinline__ void a_ready(const Unit&) const {}
    __device__ __forceinline__ void done(const Unit&) const {}
};
__device__ __forceinline__ unsigned cvt_pk_bf16(float lo, float hi) { unsigned r; asm volatile("v_cvt_pk_bf16_f32 %0, %1, %2" : "=v"(r) : "v"(lo), "v"(hi)); return r; }
template <class Epi, class Sched, bool ALIGN_EPI = false, bool SP2 = false>
__device__ __forceinline__ void gemm_phase(PG8_LAS unsigned char* lds, const Gemm g, const Sched& S, const Epi& E) {
    int tid_ = threadIdx.x; asm volatile("" : "+v"(tid_)); const int tid = tid_, wid = __builtin_amdgcn_readfirstlane(tid >> 6), lane = tid & 63, wr = wid >> 2, wc = wid & 3, fr = lane & 15, fq = lane >> 4;
    const int K = g.K, nt = K / BK;
    unsigned voffA[2], voffB[2];
#pragma unroll
    for (int i = 0; i < 2; ++i) { int R, C; stage_rc(tid * 16 + i * 8192, R, C); const int Rb = Epi::PERM ? ((R & ~31) + perm32(R & 31)) : R;
        voffA[i] = (unsigned)(R * K + C) * 2u; voffB[i] = (unsigned)(Rb * K + C) * 2u; }
    const size_t kstep = (size_t)(BK * 2);
    const size_t hstep = (size_t)HALF * K * 2;
    const size_t tstep = 2 * hstep;
    const unsigned ldsw = (unsigned)wid * 1024u;
    const int aoff = lds_byte(wr * 64 + fr, fq * 8), boff = lds_byte(wc * 32 + fr, fq * 8);
#define PG8_SA(b, h) (((b) * 2 + (h)) * HTB)
#define PG8_SB(b, h) ((4 + (b) * 2 + (h)) * HTB)
#define PG8_STAGE(bufoff, gbase, voff) do { _Pragma("unroll") for (int _i = 0; _i < 2; ++_i) \
        __builtin_amdgcn_global_load_lds((const unsigned*)((const char*)(gbase) + (voff)[_i]), (PG8_LAS unsigned*)(lds + (bufoff) + ldsw + _i * 8192), 16, 0, 0); } while (0)
#define PG8_LDA(dst, b, h) do { _Pragma("unroll") for (int m = 0; m < 4; ++m) _Pragma("unroll") for (int k = 0; k < 2; ++k) dst[m][k] = *(const PG8_LAS bf16x8*)(lds + PG8_SA(b, h) + aoff + m * 2048 + k * 1024); } while (0)
#define PG8_LDB(dst, b, h) do { _Pragma("unroll") for (int n = 0; n < 2; ++n) _Pragma("unroll") for (int k = 0; k < 2; ++k) dst[n][k] = *(const PG8_LAS bf16x8*)(lds + PG8_SB(b, h) + boff + n * 2048 + k * 1024); } while (0)
#define PG8_MMA(ai, bj, At, Bt) do { __builtin_amdgcn_s_setprio(1); _Pragma("unroll") for (int m = 0; m < 4; ++m) _Pragma("unroll") for (int n = 0; n < 2; ++n) _Pragma("unroll") for (int k = 0; k < 2; ++k) \
        acc[ai][bj][m][n] = __builtin_amdgcn_mfma_f32_16x16x32_bf16(Bt[n][k], At[m][k], acc[ai][bj][m][n], 0, 0, 0); __builtin_amdgcn_s_setprio(0); } while (0)
#define PG8_WAIT_V(n) asm volatile("s_waitcnt vmcnt(" #n ")" ::: "memory")
#define PG8_WAIT_L(n) asm volatile("s_waitcnt lgkmcnt(" #n ")" ::: "memory")
#define PG8_BAR __builtin_amdgcn_s_barrier()
#define PG8_SCHED __builtin_amdgcn_sched_barrier(0)
    Unit cur, nxt; int ui = 0;
    if (!S.next(0, cur)) return;
    f32x4 acc[2][2][4][2];
#pragma unroll
    for (int a = 0; a < 2; ++a)
#pragma unroll
        for (int b = 0; b < 2; ++b)
#pragma unroll
            for (int m = 0; m < 4; ++m)
#pragma unroll
                for (int n = 0; n < 2; ++n) acc[a][b][m][n] = (f32x4){0.f, 0.f, 0.f, 0.f};
    bf16x8 At[4][2], B0[2][2], B1[2][2];
    const char* cA = (const char*)g.A + (size_t)cur.pm * tstep; const char* cB = (const char*)g.Bt + (size_t)cur.pn * tstep;
    S.a_ready(cur);
    if constexpr (SP2) {
        PG8_STAGE(PG8_SB(0, 0), cB, voffB); PG8_STAGE(PG8_SB(0, 1), cB + hstep, voffB); PG8_STAGE(PG8_SA(0, 0), cA, voffA); PG8_STAGE(PG8_SA(0, 1), cA + hstep, voffA);
        if (wr == 1) PG8_BAR;
        PG8_WAIT_V(2); PG8_BAR;
        PG8_STAGE(PG8_SB(1, 0), cB + kstep, voffB); PG8_STAGE(PG8_SA(1, 0), cA + kstep, voffA); PG8_STAGE(PG8_SB(1, 1), cB + hstep + kstep, voffB);
        PG8_WAIT_V(6); PG8_BAR;
    } else {
        PG8_STAGE(PG8_SB(0, 0), cB, voffB); PG8_STAGE(PG8_SA(0, 0), cA, voffA); PG8_STAGE(PG8_SB(0, 1), cB + hstep, voffB); PG8_STAGE(PG8_SA(0, 1), cA + hstep, voffA);
        if (wr == 1) PG8_BAR;
        PG8_WAIT_V(4); PG8_BAR;
        PG8_STAGE(PG8_SB(1, 0), cB + kstep, voffB); PG8_STAGE(PG8_SA(1, 0), cA + kstep, voffA); PG8_STAGE(PG8_SB(1, 1), cB + hstep + kstep, voffB);
        PG8_WAIT_V(6); PG8_BAR;
    }
    for (;;) {
        const bool has_next = S.next(ui + 1, nxt);
        const char* nA = has_next ? (const char*)g.A + (size_t)nxt.pm * tstep : cA; const char* nB = has_next ? (const char*)g.Bt + (size_t)nxt.pn * tstep : cB;
        for (int t = 0; t < nt; t += 2) {
            const bool last = (t == nt - 2);
            const char* a1 = cA + (size_t)(t + 1) * kstep;
            const char* a2 = last ? nA : cA + (size_t)(t + 2) * kstep; const char* b2 = last ? nB : cB + (size_t)(t + 2) * kstep;
            const char* a3 = a2 + kstep; const char* b3 = b2 + kstep;
            if (last && has_next) S.a_ready(nxt);
            if constexpr (SP2) {
            PG8_LDB(B0, 0, 0); PG8_LDB(B1, 0, 1); PG8_SCHED; PG8_LDA(At, 0, 0); PG8_STAGE(PG8_SA(1, 1), a1 + hstep, voffA);
            PG8_WAIT_V(8); PG8_WAIT_L(0); PG8_BAR; PG8_MMA(0, 0, At, B0); PG8_MMA(0, 1, At, B1); PG8_BAR; PG8_SCHED;
            PG8_LDA(At, 0, 1); PG8_STAGE(PG8_SB(0, 0), b2, voffB); PG8_STAGE(PG8_SB(0, 1), b2 + hstep, voffB); PG8_STAGE(PG8_SA(0, 0), a2, voffA);
            PG8_WAIT_V(8); PG8_WAIT_L(0); PG8_BAR; PG8_MMA(1, 0, At, B0); PG8_MMA(1, 1, At, B1); PG8_BAR; PG8_SCHED;
            PG8_LDB(B0, 1, 0); PG8_LDB(B1, 1, 1); PG8_SCHED; PG8_LDA(At, 1, 0); PG8_STAGE(PG8_SA(0, 1), a2 + hstep, voffA);
            PG8_WAIT_V(8); PG8_WAIT_L(0); PG8_BAR; PG8_MMA(0, 0, At, B0); PG8_MMA(0, 1, At, B1); PG8_BAR; PG8_SCHED;
            PG8_LDA(At, 1, 1); PG8_STAGE(PG8_SB(1, 0), b3, voffB); PG8_STAGE(PG8_SB(1, 1), b3 + hstep, voffB); PG8_STAGE(PG8_SA(1, 0), a3, voffA);
            PG8_WAIT_V(8); PG8_WAIT_L(0); PG8_BAR; PG8_MMA(1, 0, At, B0); PG8_MMA(1, 1, At, B1); PG8_BAR; PG8_SCHED;
            } else {
            PG8_LDB(B0, 0, 0); PG8_SCHED; PG8_LDA(At, 0, 0); PG8_STAGE(PG8_SA(1, 1), a1 + hstep, voffA);
            PG8_WAIT_L(8); PG8_BAR; PG8_WAIT_L(0); PG8_MMA(0, 0, At, B0); PG8_BAR; PG8_SCHED;
            PG8_LDB(B1, 0, 1); PG8_STAGE(PG8_SB(0, 0), b2, voffB);
            PG8_BAR; PG8_WAIT_L(0); PG8_MMA(0, 1, At, B1); PG8_BAR;
            PG8_LDA(At, 0, 1); PG8_STAGE(PG8_SA(0, 0), a2, voffA);
            PG8_BAR; PG8_WAIT_L(0); PG8_MMA(1, 0, At, B0); PG8_BAR; PG8_SCHED;
            PG8_STAGE(PG8_SB(0, 1), b2 + hstep, voffB);
            PG8_WAIT_V(6); PG8_BAR; PG8_MMA(1, 1, At, B1); PG8_BAR;
            PG8_LDB(B0, 1, 0); PG8_SCHED; PG8_LDA(At, 1, 0); PG8_STAGE(PG8_SA(0, 1), a2 + hstep, voffA);
            PG8_WAIT_L(8); PG8_BAR; PG8_WAIT_L(0); PG8_MMA(0, 0, At, B0); PG8_BAR; PG8_SCHED;
            PG8_LDB(B1, 1, 1); PG8_STAGE(PG8_SB(1, 0), b3, voffB);
            PG8_BAR; PG8_WAIT_L(0); PG8_MMA(0, 1, At, B1); PG8_BAR;
            PG8_LDA(At, 1, 1); PG8_STAGE(PG8_SA(1, 0), a3, voffA);
            PG8_BAR; PG8_WAIT_L(0); PG8_MMA(1, 0, At, B0); PG8_BAR; PG8_SCHED;
            PG8_STAGE(PG8_SB(1, 1), b3 + hstep, voffB);
            PG8_WAIT_V(6); PG8_BAR; PG8_MMA(1, 1, At, B1); PG8_BAR;
            }
        }
        if constexpr (ALIGN_EPI) { if (wr == 0) PG8_BAR; }
        if constexpr (!Epi::AFTER_DRAIN) { E(acc, cur, wr, wc, fr, fq); S.done(cur); }
        if (!has_next) break;
#pragma unroll
        for (int a = 0; a < 2; ++a)
#pragma unroll
            for (int b = 0; b < 2; ++b)
#pragma unroll
                for (int m = 0; m < 4; ++m)
#pragma unroll
                    for (int n = 0; n < 2; ++n) acc[a][b][m][n] = (f32x4){0.f, 0.f, 0.f, 0.f};
        cur = nxt; cA = nA; cB = nB; ++ui;
        if constexpr (ALIGN_EPI) { if (wr == 1) PG8_BAR; }
    }
    PG8_WAIT_V(0);
    if constexpr (!ALIGN_EPI) { if (wr == 0) PG8_BAR; }
    PG8_BAR;
    if constexpr (Epi::AFTER_DRAIN) { E.fused(acc, cur, wr, wc, fr, fq, lds, wid, lane); S.done(cur); }
#undef PG8_SA
#undef PG8_SB
#undef PG8_STAGE
#undef PG8_LDA
#undef PG8_LDB
#undef PG8_MMA
#undef PG8_WAIT_V
#undef PG8_WAIT_L
#undef PG8_BAR
#undef PG8_SCHED
}
}

#define LAS __attribute__((address_space(3)))
typedef unsigned short bf16_t;
typedef short bf16x8 __attribute__((ext_vector_type(8)));
typedef float f32x4 __attribute__((ext_vector_type(4)));
typedef float f32x2 __attribute__((ext_vector_type(2)));
typedef float f32x16 __attribute__((ext_vector_type(16)));
typedef unsigned u32x4 __attribute__((ext_vector_type(4)));
typedef unsigned u32x2 __attribute__((ext_vector_type(2)));

#ifndef GEMM_ALIGN
#define GEMM_ALIGN true
#endif
#ifndef GEMM_SP2
#define GEMM_SP2 true
#endif
#ifndef N_LAUNCH_MODE
#define N_LAUNCH_MODE 1
#endif

constexpr int D = 2048, T = 16384, CL = 256, R = T + CL, DIN = 5120, NCHK = R / 128;
constexpr int NPHASE = 13;
constexpr float EPS = 1e-6f;
constexpr int LDS_BYTES = 131072 + 4096;

constexpr size_t WS_WINT = 0;
constexpr size_t WS_WOUTT = WS_WINT + (size_t)2 * DIN * D * 2;
constexpr size_t WS_XG = WS_WOUTT + (size_t)2 * D * D * 2;
constexpr size_t WS_PX = WS_XG + (size_t)R * D * 2;
constexpr size_t WS_Y = WS_PX + (size_t)R * DIN * 2;
constexpr size_t WS_X1C = WS_Y + (size_t)R * D * 2;
constexpr size_t WS_MOD = WS_X1C + (size_t)CL * D * 4;
constexpr size_t WS_GG = WS_MOD + (size_t)2 * 2 * 6144 * 4;
constexpr size_t WS_SHW = WS_GG + (size_t)2 * 2 * D * 4;
constexpr size_t WS_RSS = WS_SHW + (size_t)2 * 2 * DIN * 4;
constexpr size_t WS_GW = WS_RSS + (size_t)3 * R * 4 + 64;
constexpr size_t WS_SW = WS_GW + (size_t)2 * 16 * 2 * 2 * 2 * 4 * 64 * 8 * 2;
constexpr size_t WS_AGG = WS_SW + (size_t)2 * 8 * 128 * 128 * 2;
constexpr size_t WS_CARRY = WS_AGG + (size_t)2 * NCHK * 1024 * 8;
constexpr size_t WS_BAR = (WS_CARRY + (size_t)2 * NCHK * 1024 * 4 + 255) / 256 * 256;
constexpr size_t WS_DL0 = WS_BAR + 16384;
constexpr size_t WS_END = WS_DL0 + (size_t)T * D * 2;

struct Args { const float* in[25]; float* out; unsigned char* ws; int ph_lo, ph_hi; };

__device__ __forceinline__ float bflo(unsigned w) { return __uint_as_float(w << 16); }
__device__ __forceinline__ float bfhi(unsigned w) { return __uint_as_float(w & 0xffff0000u); }
__device__ __forceinline__ float bf1(bf16_t h) { return __uint_as_float((unsigned)h << 16); }
__device__ __forceinline__ unsigned pk2(float lo, float hi) { return pg8::cvt_pk_bf16(lo, hi); }
__device__ __forceinline__ bf16_t f2bf(float f) { return (bf16_t)(pk2(f, 0.f) & 0xffffu); }
__device__ __forceinline__ float rcpf_(float x) { return __builtin_amdgcn_rcpf(x); }
__device__ __forceinline__ float sigm(float x) { return rcpf_(1.0f + __expf(-x)); }
__device__ __forceinline__ float silu(float x) { return x * sigm(x); }
__device__ __forceinline__ float gelu_t(float x) { return x * sigm(1.5957691216f * (x + 0.044715f * x * x * x)); }
template <int CTRL> __device__ __forceinline__ float dpp_mov(float v) { return __int_as_float(__builtin_amdgcn_update_dpp(0, __float_as_int(v), CTRL, 0xf, 0xf, true)); }
__device__ __forceinline__ float wave_sum(float v) {
    v += dpp_mov<0xB1>(v);
    v += dpp_mov<0x4E>(v);
    v += dpp_mov<0x141>(v);
    v += dpp_mov<0x140>(v);
    const int iv = __float_as_int(v);
    return (__int_as_float(__builtin_amdgcn_readlane(iv, 0)) + __int_as_float(__builtin_amdgcn_readlane(iv, 16))) + (__int_as_float(__builtin_amdgcn_readlane(iv, 32)) + __int_as_float(__builtin_amdgcn_readlane(iv, 48)));
}
__device__ __forceinline__ int tid_fresh() { int t = threadIdx.x; asm volatile("" : "+v"(t)); return t; }
#define GAS __attribute__((address_space(1)))
__device__ __forceinline__ unsigned char* ptr_fresh(unsigned char* p) {
#ifdef FLAT_WS
    asm volatile("" : "+s"(p)); return p; }
#else
    unsigned long long v = (unsigned long long)p; asm volatile("" : "+s"(v)); return (unsigned char*)(GAS unsigned char*)v; }
#endif
#define LDS_WAIT() asm volatile("s_waitcnt lgkmcnt(0)" ::: "memory")

struct EpiIn {
    static constexpr bool PERM = true, AFTER_DRAIN = false;
    bf16_t* PX; const float* rss; const float* shw;
    __device__ __forceinline__ void operator()(const f32x4 (&acc)[2][2][4][2], const pg8::Unit& u, int wr, int wc, int fr, int fq) const {
        const int row0 = CL + u.pm * 256 + wr * 64 + fr, col0 = u.pn * 256 + wc * 32 + 8 * fq;
        const float* sw = shw + col0;
        f32x4 bv[2][2];
#pragma unroll
        for (int bj = 0; bj < 2; ++bj)
#pragma unroll
            for (int n = 0; n < 2; ++n) bv[bj][n] = *(const f32x4*)(sw + bj * 128 + 4 * n);
#pragma unroll
        for (int ai = 0; ai < 2; ++ai)
#pragma unroll
            for (int m = 0; m < 4; ++m) {
                const int r = row0 + ai * 128 + m * 16;
                const float rs = 1.0f / sqrtf(rss[r] * (1.0f / D) + EPS);
                bf16_t* rowp = PX + (size_t)r * DIN + col0;
#pragma unroll
                for (int bj = 0; bj < 2; ++bj) {
                    const f32x4 v0 = acc[ai][bj][m][0] * rs + bv[bj][0], v1 = acc[ai][bj][m][1] * rs + bv[bj][1];
                    u32x4 w; w.x = pk2(v0[0], v0[1]); w.y = pk2(v0[2], v0[3]); w.z = pk2(v1[0], v1[1]); w.w = pk2(v1[2], v1[3]);
                    *(u32x4*)(rowp + bj * 128) = w;
                }
            }
    }
};
struct EpiOut {
    static constexpr bool PERM = true, AFTER_DRAIN = false;
    int row_off, last;
    const float* xold_lat; const float* xold_ctx; float* xnew_lat; float* xnew_ctx;
    const float* gvec;
    const float* ggn;
    bf16_t* XG; float* rssn;
    __device__ __forceinline__ void operator()(const f32x4 (&acc)[2][2][4][2], const pg8::Unit& u, int wr, int wc, int fr, int fq) const {
        const int gbase = row_off + u.pm * 256;
        const bool isctx = gbase < CL;
        const int seg = isctx ? 1 : 0;
        const int grow0 = gbase + wr * 64 + fr, col0 = u.pn * 256 + wc * 32 + 8 * fq;
        const float* xo = isctx ? xold_ctx : (xold_lat - (size_t)CL * D);
        float* xn = isctx ? xnew_ctx : (xnew_lat - (size_t)CL * D);
        const float* gp = gvec + seg * 6144 + 4096 + col0;
        const float* ggp = ggn + seg * D + col0;
        f32x4 gv[2][2], gg[2][2];
#pragma unroll
        for (int bj = 0; bj < 2; ++bj)
#pragma unroll
            for (int n = 0; n < 2; ++n) { gv[bj][n] = *(const f32x4*)(gp + bj * 128 + 4 * n); gg[bj][n] = last ? (f32x4){0.f, 0.f, 0.f, 0.f} : *(const f32x4*)(ggp + bj * 128 + 4 * n); }
#pragma unroll
        for (int ai = 0; ai < 2; ++ai)
#pragma unroll
            for (int m = 0; m < 4; ++m) {
                const int r = grow0 + ai * 128 + m * 16;
                const size_t ro = (size_t)r * D + col0;
                float ss = 0.f;
#pragma unroll
                for (int bj = 0; bj < 2; ++bj) {
                    const f32x4 o0 = *(const f32x4*)(xo + ro + bj * 128), o1 = *(const f32x4*)(xo + ro + bj * 128 + 4);
                    const f32x4 v0 = o0 + gv[bj][0] * acc[ai][bj][m][0], v1 = o1 + gv[bj][1] * acc[ai][bj][m][1];
                    *(f32x4*)(xn + ro + bj * 128) = v0; *(f32x4*)(xn + ro + bj * 128 + 4) = v1;
                    ss += (v0[0] * v0[0] + v0[1] * v0[1]) + (v0[2] * v0[2] + v0[3] * v0[3]) + (v1[0] * v1[0] + v1[1] * v1[1]) + (v1[2] * v1[2] + v1[3] * v1[3]);
                    if (!last) {
                        const f32x4 a0 = v0 * gg[bj][0], a1 = v1 * gg[bj][1];
                        u32x4 w; w.x = pk2(a0[0], a0[1]); w.y = pk2(a0[2], a0[3]); w.z = pk2(a1[0], a1[1]); w.w = pk2(a1[2], a1[3]);
                        *(u32x4*)(XG + ro + bj * 128) = w;
                    }
                }
                ss += __shfl_xor(ss, 16); ss += __shfl_xor(ss, 32);
                if (fq == 0) unsafeAtomicAdd(rssn + r, ss);
            }
    }
};

struct EpiDelta {
    static constexpr bool PERM = true, AFTER_DRAIN = false;
    bf16_t* DL; const float* gvec;
    __device__ __forceinline__ void operator()(const f32x4 (&acc)[2][2][4][2], const pg8::Unit& u, int wr, int wc, int fr, int fq) const {
        const int row0 = u.pm * 256 + wr * 64 + fr, col0 = u.pn * 256 + wc * 32 + 8 * fq;
        f32x4 gv[2][2];
#pragma unroll
        for (int bj = 0; bj < 2; ++bj)
#pragma unroll
            for (int n = 0; n < 2; ++n) gv[bj][n] = *(const f32x4*)(gvec + col0 + bj * 128 + 4 * n);
#pragma unroll
        for (int ai = 0; ai < 2; ++ai)
#pragma unroll
            for (int m = 0; m < 4; ++m) {
                bf16_t* rowp = DL + (size_t)(row0 + ai * 128 + m * 16) * D + col0;
#pragma unroll
                for (int bj = 0; bj < 2; ++bj) {
                    const f32x4 v0 = acc[ai][bj][m][0] * gv[bj][0], v1 = acc[ai][bj][m][1] * gv[bj][1];
                    u32x4 w; w.x = pk2(v0[0], v0[1]); w.y = pk2(v0[2], v0[3]); w.z = pk2(v1[0], v1[1]); w.w = pk2(v1[2], v1[3]);
                    *(u32x4*)(rowp + bj * 128) = w;
                }
            }
    }
};

__device__ __forceinline__ void transpose_item(const float* W, int K, int N, bf16_t* WT, LAS float* scr, int item, int lane) {
    const int nblk = N / 32, kb = item / nblk, nb = item % nblk, k0 = 64 * kb, n0 = 32 * nb;
#pragma unroll 8
    for (int i = 0; i < 32; ++i) { const int kk = 2 * i + (lane >> 5); scr[kk * 33 + (lane & 31)] = W[(size_t)(k0 + kk) * N + n0 + (lane & 31)]; }
    LDS_WAIT();
    const int c = lane & 7;
#pragma unroll
    for (int j = 0; j < 4; ++j) { const int n = (lane >> 3) + 8 * j; const LAS float* s = scr + (8 * c) * 33 + n;
        u32x4 o; o.x = pk2(s[0 * 33], s[1 * 33]); o.y = pk2(s[2 * 33], s[3 * 33]); o.z = pk2(s[4 * 33], s[5 * 33]); o.w = pk2(s[6 * 33], s[7 * 33]);
        *(u32x4*)(WT + (size_t)(n0 + n) * K + k0 + 8 * c) = o; }
    LDS_WAIT();
}

__device__ __forceinline__ void phase0a(const Args a, LAS unsigned char* lds) {
    const int tid = tid_fresh(), lane = tid & 63, wave = tid >> 6, b = blockIdx.x, G = gridDim.x;
    unsigned char* ws = ptr_fresh(a.ws);
    { float* rss = (float*)(ws + WS_RSS); for (int i = b * 512 + tid; i < 2 * R; i += G * 512) rss[R + i] = 0.f; }
    { bf16_t* GW = (bf16_t*)(ws + WS_GW);
      for (int gid = b * 512 + tid; gid < 2 * 16 * 2 * 2 * 2 * 4 * 64; gid += G * 512) {
          int x = gid; const int ln = x & 63; x >>= 6; const int s = x & 3; x >>= 2; const int half = x & 1; x >>= 1; const int gate = x & 1; x >>= 1; const int dir = x & 1; x >>= 1; const int hd = x & 15; x >>= 4; const int l = x;
          const float* w = (gate ? a.in[14] : a.in[12]) + ((size_t)((l * 2 + dir) * 16 + hd)) * 4096;
          const int col = 32 * half + (ln & 31), k0 = 16 * s + 8 * (ln >> 5);
          float v[8];
#pragma unroll
          for (int j = 0; j < 8; ++j) v[j] = w[(k0 + j) * 64 + col];
          u32x4 o; o.x = pk2(v[0], v[1]); o.y = pk2(v[2], v[3]); o.z = pk2(v[4], v[5]); o.w = pk2(v[6], v[7]);
          *(u32x4*)(GW + (size_t)gid * 8) = o;
      } }
    { bf16_t* SW = (bf16_t*)(ws + WS_SW); const float* sw = a.in[22];
      for (int i = b * 512 + tid; i < 2 * 8 * 128 * 128 / 4; i += G * 512) { const f32x4 v = *(const f32x4*)(sw + (size_t)i * 4); u32x2 o; o.x = pk2(v[0], v[1]); o.y = pk2(v[2], v[3]); *(u32x2*)(SW + (size_t)i * 4) = o; } }
    { const float* c = a.in[1]; const float* cc = a.in[3]; float* MOD = (float*)(ws + WS_MOD);
      LAS float* red = (LAS float*)lds;
      for (int u = b; u < 192; u += G) {
          const int l = u / 96, n0 = (u % 96) * 64, q = tid & 15, ks = tid >> 4;
          const float* W = a.in[4] + (size_t)l * D * 6144 + n0 + 4 * q;
          f32x4 a0 = {0.f, 0.f, 0.f, 0.f}, a1 = {0.f, 0.f, 0.f, 0.f};
#pragma unroll 8
          for (int kk = 0; kk < 64; ++kk) { const int k = ks * 64 + kk; const f32x4 wv = *(const f32x4*)(W + (size_t)k * 6144); const float ca = silu(c[k]), cb = silu(cc[k]); a0 += wv * ca; a1 += wv * cb; }
          LAS float* rp = red + (ks * 16 + q) * 8;
          *(LAS f32x4*)rp = a0; *(LAS f32x4*)(rp + 4) = a1;
          __syncthreads();
          if (tid < 128) { const int qq = tid >> 3, e = tid & 7; float s = 0.f;
#pragma unroll 8
              for (int k2 = 0; k2 < 32; ++k2) s += red[(k2 * 16 + qq) * 8 + e];
              const int seg = e >> 2, col = n0 + 4 * qq + (e & 3);
              MOD[(l * 2 + seg) * 6144 + col] = s + a.in[5][l * 6144 + col]; }
          __syncthreads();
      } }
    { LAS float* scr = (LAS float*)(lds + wave * 16384);
      const int gw = b * 8 + wave, NGW = G * 8;
      constexpr int I_IN = (D / 64) * (DIN / 32), I_OUT = (D / 64) * (D / 32);
      for (int it = gw; it < 2 * I_IN + 2 * I_OUT; it += NGW) {
          int r = it;
          if (r < 2 * I_IN) { const int l = r / I_IN; transpose_item(a.in[7] + (size_t)l * D * DIN, D, DIN, (bf16_t*)(ws + WS_WINT) + (size_t)l * DIN * D, scr, r % I_IN, lane); continue; }
          r -= 2 * I_IN; { const int l = r / I_OUT; transpose_item(a.in[8] + (size_t)l * D * D, D, D, (bf16_t*)(ws + WS_WOUTT) + (size_t)l * D * D, scr, r % I_OUT, lane); }
      } }
}

__device__ __forceinline__ void phase0b(const Args a, LAS unsigned char* lds) {
    const int tid = tid_fresh(), lane = tid & 63, wave = tid >> 6, b = blockIdx.x, G = gridDim.x;
    unsigned char* ws = ptr_fresh(a.ws);
    const float* MOD = (const float*)(ws + WS_MOD);
    LAS float* GG0 = (LAS float*)lds;
    LAS float* SH = (LAS float*)(lds + 16384);
    for (int i = tid; i < 2 * D; i += 512) { const int seg = i >> 11, k = i & 2047; float gv_ = a.in[6][k] * (1.0f + MOD[seg * 6144 + 2048 + k]); if (gv_ == 0.f) gv_ = 1e-30f; GG0[i] = gv_; }
    for (int i = tid; i < 4 * D; i += 512) { const int ls = i >> 11, k = i & 2047; SH[i] = MOD[ls * 6144 + k]; }
    { float* GGt = (float*)(ws + WS_GG); for (int i = b * 512 + tid; i < 4 * D; i += G * 512) { const int ls = i >> 11, l = ls >> 1, k = i & 2047; float gv_ = a.in[6][l * D + k] * (1.0f + MOD[ls * 6144 + 2048 + k]); if (gv_ == 0.f) gv_ = 1e-30f; GGt[i] = gv_; } }
    __syncthreads();
    const int gw = b * 8 + wave, NGW = G * 8;
    { bf16_t* XG = (bf16_t*)(ws + WS_XG); float* rss = (float*)(ws + WS_RSS);
      f32x4 vr[8];
#define P0B_LOAD(r_, V) do { const float* _src = (r_) < CL ? a.in[2] + (size_t)(r_) * D : a.in[0] + (size_t)((r_) - CL) * D; \
          _Pragma("unroll") for (int j = 0; j < 8; ++j) V[j] = *(const f32x4*)(_src + 4 * (lane + 64 * j)); } while (0)
      int r = gw;
      if (r < R) P0B_LOAD(r, vr);
      for (; r < R; r += NGW) {
          f32x4 vn[8];
          const int rn = r + NGW;
          if (rn < R) P0B_LOAD(rn, vn);
          const int seg = r < CL ? 1 : 0;
          float ss = 0.f;
#pragma unroll
          for (int j = 0; j < 8; ++j) ss += (vr[j][0] * vr[j][0] + vr[j][1] * vr[j][1]) + (vr[j][2] * vr[j][2] + vr[j][3] * vr[j][3]);
#pragma unroll
          for (int j = 0; j < 8; ++j) { const f32x4 g = *(LAS f32x4*)(GG0 + seg * D + 4 * (lane + 64 * j)); const f32x4 p = vr[j] * g; u32x2 o; o.x = pk2(p[0], p[1]); o.y = pk2(p[2], p[3]); *(u32x2*)(XG + (size_t)r * D + 4 * (lane + 64 * j)) = o; }
          ss = wave_sum(ss);
          if (lane == 0) rss[r] = ss;
          if (rn < R) {
#pragma unroll
              for (int j = 0; j < 8; ++j) vr[j] = vn[j];
          }
      }
#undef P0B_LOAD
    }
    { float* SHW = (float*)(ws + WS_SHW); const bf16_t* WinT = (const bf16_t*)(ws + WS_WINT);
      u32x4 wr[4];
#define SHW_LOAD(i_, W_) do { const bf16_t* _row = WinT + (size_t)(i_) * D; _Pragma("unroll") for (int j = 0; j < 4; ++j) W_[j] = *(const u32x4*)(_row + 8 * (lane + 64 * j)); } while (0)
      int idx = gw;
      if (idx < 2 * DIN) SHW_LOAD(idx, wr);
      for (; idx < 2 * DIN; idx += NGW) {
          u32x4 wn[4];
          const int idn = idx + NGW;
          if (idn < 2 * DIN) SHW_LOAD(idn, wn);
          const int l = idx / DIN, n = idx % DIN;
          float d0 = 0.f, d1 = 0.f;
#pragma unroll
          for (int j = 0; j < 4; ++j) { const int k = 8 * (lane + 64 * j); const u32x4 w = wr[j];
              const LAS float* s0 = SH + (l * 2 + 0) * D + k; const LAS float* s1 = SH + (l * 2 + 1) * D + k;
              const f32x4 x0 = *(LAS f32x4*)s0, x1 = *(LAS f32x4*)(s0 + 4), y0 = *(LAS f32x4*)s1, y1 = *(LAS f32x4*)(s1 + 4);
              const float w0 = bflo(w.x), w1 = bfhi(w.x), w2 = bflo(w.y), w3 = bfhi(w.y), w4 = bflo(w.z), w5 = bfhi(w.z), w6 = bflo(w.w), w7 = bfhi(w.w);
              d0 += (w0 * x0[0] + w1 * x0[1]) + (w2 * x0[2] + w3 * x0[3]) + (w4 * x1[0] + w5 * x1[1]) + (w6 * x1[2] + w7 * x1[3]);
              d1 += (w0 * y0[0] + w1 * y0[1]) + (w2 * y0[2] + w3 * y0[3]) + (w4 * y1[0] + w5 * y1[1]) + (w6 * y1[2] + w7 * y1[3]); }
          d0 = wave_sum(d0); d1 = wave_sum(d1);
          if (lane == 0) { SHW[(l * 2 + 0) * DIN + n] = d0; SHW[(l * 2 + 1) * DIN + n] = d1; }
          if (idn < 2 * DIN) {
#pragma unroll
              for (int j = 0; j < 4; ++j) wr[j] = wn[j];
          }
      }
#undef SHW_LOAD
    }
    __syncthreads();
}

constexpr int XLF_STRIDE = 68, XLB_STRIDE = 72;
constexpr int LRU_XLF = 0, LRU_XLB = 128 * XLF_STRIDE * 4, LRU_TAGG = LRU_XLB + 128 * XLB_STRIDE * 2;

template <bool PASSC>
__device__ __forceinline__ void lru_item(const Args a, int l, int chunk, int hd, LAS unsigned char* lds) {
    const int tid = tid_fresh(), lane = tid & 63, wave = tid >> 6;
    unsigned char* ws = ptr_fresh(a.ws);
    const bf16_t* PX = (const bf16_t*)(ws + WS_PX);
    LAS float* XLF = (LAS float*)(lds + LRU_XLF);
    LAS bf16_t* XLB = (LAS bf16_t*)(lds + LRU_XLB);
    LAS f32x2* TAGG = (LAS f32x2*)(lds + LRU_TAGG);
    __syncthreads();
    {
        const int t = tid >> 2, q = tid & 3, ch0 = hd * 64 + q * 16;
        const int grow = chunk * 128 + t, seg_lo = chunk < 2 ? 0 : CL, seg_hi = chunk < 2 ? CL : R;
        const float* cw = a.in[9] + (size_t)l * 4 * 1024 + ch0; const float* cb = a.in[10] + (size_t)l * 1024 + ch0;
        float xl[16];
#pragma unroll
        for (int c4 = 0; c4 < 4; ++c4) { const f32x4 bb = *(const f32x4*)(cb + 4 * c4); xl[4 * c4] = bb[0]; xl[4 * c4 + 1] = bb[1]; xl[4 * c4 + 2] = bb[2]; xl[4 * c4 + 3] = bb[3]; }
#pragma unroll
        for (int j = 0; j < 4; ++j) {
            const int rr = grow + j - 2;
            if (rr >= seg_lo && rr < seg_hi) {
                const u32x4 p0 = *(const u32x4*)(PX + (size_t)rr * DIN + ch0), p1 = *(const u32x4*)(PX + (size_t)rr * DIN + ch0 + 8);
                const unsigned pw[8] = {p0.x, p0.y, p0.z, p0.w, p1.x, p1.y, p1.z, p1.w};
#pragma unroll
                for (int c4 = 0; c4 < 4; ++c4) { const f32x4 wv = *(const f32x4*)(cw + j * 1024 + 4 * c4);
                    xl[4 * c4 + 0] += wv[0] * bflo(pw[2 * c4]); xl[4 * c4 + 1] += wv[1] * bfhi(pw[2 * c4]); xl[4 * c4 + 2] += wv[2] * bflo(pw[2 * c4 + 1]); xl[4 * c4 + 3] += wv[3] * bfhi(pw[2 * c4 + 1]); }
            }
        }
        LAS float* xf = XLF + t * XLF_STRIDE + q * 16;
#pragma unroll
        for (int c4 = 0; c4 < 4; ++c4) *(LAS f32x4*)(xf + 4 * c4) = (f32x4){xl[4 * c4], xl[4 * c4 + 1], xl[4 * c4 + 2], xl[4 * c4 + 3]};
        LAS bf16_t* xb = XLB + t * XLB_STRIDE + q * 16;
        u32x4 o0, o1; o0.x = pk2(xl[0], xl[1]); o0.y = pk2(xl[2], xl[3]); o0.z = pk2(xl[4], xl[5]); o0.w = pk2(xl[6], xl[7]); o1.x = pk2(xl[8], xl[9]); o1.y = pk2(xl[10], xl[11]); o1.z = pk2(xl[12], xl[13]); o1.w = pk2(xl[14], xl[15]);
        *(LAS u32x4*)xb = o0; *(LAS u32x4*)(xb + 8) = o1;
    }
    __syncthreads();
    const int tw = wave >> 1, chh = wave & 1, cl = lane & 31, hh = lane >> 5;
    const int cin = 32 * chh + cl, cg_ = hd * 64 + cin;
    bf16x8 Af[4];
#pragma unroll
    for (int s = 0; s < 4; ++s) Af[s] = *(const LAS bf16x8*)(XLB + (32 * tw + cl) * XLB_STRIDE + 16 * s + 8 * hh);
    float xlv[16];
#pragma unroll
    for (int i = 0; i < 16; ++i) xlv[i] = XLF[(32 * tw + (i & 3) + 8 * (i >> 2) + 4 * hh) * XLF_STRIDE + cin];
    float av[2][16], bv[2][16];
    float GA[2][8], GB[2][8];
    const bf16_t* GW = (const bf16_t*)(ws + WS_GW);
#pragma unroll
    for (int dir = 0; dir < 2; ++dir) {
        f32x16 ar, ai;
#pragma unroll
        for (int i = 0; i < 16; ++i) { ar[i] = 0.f; ai[i] = 0.f; }
#pragma unroll
        for (int s = 0; s < 4; ++s) {
            const size_t gr = ((((((size_t)(l * 16 + hd) * 2 + dir) * 2 + 0) * 2 + chh) * 4 + s) * 64 + lane) * 8;
            const size_t gi = ((((((size_t)(l * 16 + hd) * 2 + dir) * 2 + 1) * 2 + chh) * 4 + s) * 64 + lane) * 8;
            const bf16x8 Br = *(const bf16x8*)(GW + gr), Bi = *(const bf16x8*)(GW + gi);
            ar = __builtin_amdgcn_mfma_f32_32x32x16_bf16(Af[s], Br, ar, 0, 0, 0);
            ai = __builtin_amdgcn_mfma_f32_32x32x16_bf16(Af[s], Bi, ai, 0, 0, 0);
        }
        const float brv = a.in[13][(size_t)(l * 2 + dir) * 1024 + cg_], biv = a.in[15][(size_t)(l * 2 + dir) * 1024 + cg_];
        const float lam = a.in[11][(size_t)(l * 2 + dir) * 1024 + cg_];
        const float k8 = -8.0f * log1pf(__expf(-lam));
#pragma unroll
        for (int i = 0; i < 16; ++i) {
            const float rg = sigm(ar[i] + brv), ig = sigm(ai[i] + biv);
            const float la = k8 * rg;
            av[dir][i] = __expf(la);
            const float aa = av[dir][i]; bv[dir][i] = __builtin_amdgcn_sqrtf(fmaxf(1.0f - aa * aa, 0.f)) * ig * xlv[i];
        }
        float oA[4], oB[4];
#pragma unroll
        for (int g = 0; g < 4; ++g) {
            const float a0 = av[dir][4 * g], a1 = av[dir][4 * g + 1], a2 = av[dir][4 * g + 2], a3 = av[dir][4 * g + 3];
            const float b0 = bv[dir][4 * g], b1 = bv[dir][4 * g + 1], b2 = bv[dir][4 * g + 2], b3 = bv[dir][4 * g + 3];
            oA[g] = (a0 * a1) * (a2 * a3);
            oB[g] = dir == 0 ? ((b0 * a1 + b1) * a2 + b2) * a3 + b3 : ((b3 * a2 + b2) * a1 + b1) * a0 + b0;
        }
#pragma unroll
        for (int g = 0; g < 4; ++g) {
            const float pA = __shfl_xor(oA[g], 32), pB = __shfl_xor(oB[g], 32);
            GA[dir][2 * g] = hh ? pA : oA[g]; GA[dir][2 * g + 1] = hh ? oA[g] : pA;
            GB[dir][2 * g] = hh ? pB : oB[g]; GB[dir][2 * g + 1] = hh ? oB[g] : pB;
        }
        float tA = 1.f, tB = 0.f;
        if (dir == 0) {
#pragma unroll
            for (int gq = 0; gq < 8; ++gq) { tB = GA[dir][gq] * tB + GB[dir][gq]; tA *= GA[dir][gq]; }
        } else {
#pragma unroll
            for (int gq = 7; gq >= 0; --gq) { tB = GA[dir][gq] * tB + GB[dir][gq]; tA *= GA[dir][gq]; }
        }
        if (hh == 0) TAGG[(tw * 2 + dir) * 64 + cin] = (f32x2){tA, tB};
    }
    __syncthreads();
    if constexpr (!PASSC) {
        if (tid < 128) {
            const int dir = tid >> 6, c = tid & 63;
            float cA = 1.f, cB = 0.f;
#pragma unroll
            for (int k = 0; k < 4; ++k) { const int t2 = dir == 0 ? k : 3 - k; const f32x2 v = TAGG[(t2 * 2 + dir) * 64 + c]; cB = v[0] * cB + v[1]; cA *= v[0]; }
            f32x2* AGG = (f32x2*)(ws + WS_AGG);
            AGG[((size_t)dir * NCHK + chunk) * 1024 + hd * 64 + c] = (f32x2){cA, cB};
        }
    } else {
        const float* CARRY = (const float*)(ws + WS_CARRY);
        float yv[16];
#pragma unroll
        for (int dir = 0; dir < 2; ++dir) {
            float st = CARRY[((size_t)dir * NCHK + chunk) * 1024 + cg_];
            if (dir == 0) {
#pragma unroll
                for (int t2 = 0; t2 < 3; ++t2) if (t2 < tw) { const f32x2 v = TAGG[(t2 * 2 + 0) * 64 + cin]; st = v[0] * st + v[1]; }
            } else {
#pragma unroll
                for (int t2 = 3; t2 > 0; --t2) if (t2 > tw) { const f32x2 v = TAGG[(t2 * 2 + 1) * 64 + cin]; st = v[0] * st + v[1]; }
            }
            float hst[4];
            if (dir == 0) {
                float s = st;
#pragma unroll
                for (int g = 0; g < 4; ++g) { const float sE = s; s = GA[0][2 * g] * s + GB[0][2 * g]; const float sO = s; s = GA[0][2 * g + 1] * s + GB[0][2 * g + 1]; hst[g] = hh ? sO : sE; }
            } else {
                float s = st;
#pragma unroll
                for (int g = 3; g >= 0; --g) { const float sO = s; s = GA[1][2 * g + 1] * s + GB[1][2 * g + 1]; const float sE = s; s = GA[1][2 * g] * s + GB[1][2 * g]; hst[g] = hh ? sO : sE; }
            }
#pragma unroll
            for (int g = 0; g < 4; ++g) {
                float h = hst[g];
                if (dir == 0) {
#pragma unroll
                    for (int k = 0; k < 4; ++k) { h = av[0][4 * g + k] * h + bv[0][4 * g + k]; yv[4 * g + k] = h; }
                } else {
#pragma unroll
                    for (int k = 3; k >= 0; --k) { h = av[1][4 * g + k] * h + bv[1][4 * g + k]; yv[4 * g + k] += h; }
                }
            }
        }
        bf16_t* Y = (bf16_t*)(ws + WS_Y);
#pragma unroll
        for (int i = 0; i < 16; ++i) {
            const int row = chunk * 128 + 32 * tw + (i & 3) + 8 * (i >> 2) + 4 * hh;
            const float gt = bf1(PX[(size_t)row * DIN + 1024 + cg_]);
            Y[(size_t)row * D + cg_] = f2bf(yv[i] * silu(gt));
        }
    }
}

__device__ __forceinline__ void conv_item(const Args a, int l, int ct, LAS unsigned char* lds) {
    const int tid = tid_fresh(), lane = tid & 63, wave = tid >> 6, c = tid;
    unsigned char* ws = ptr_fresh(a.ws);
    const bf16_t* PX = (const bf16_t*)(ws + WS_PX); bf16_t* Y = (bf16_t*)(ws + WS_Y);
    LAS float* CB = (LAS float*)lds;
    const int t0 = ct * 128, seg_lo = ct < 2 ? 0 : CL, seg_hi = ct < 2 ? CL : R;
    float w[31];
#pragma unroll
    for (int j = 0; j < 31; ++j) w[j] = a.in[16][((size_t)l * 31 + j) * 512 + c];
    const float bias = a.in[17][l * 512 + c];
    float win[32];
#define CONV_Z(dst, rr_) do { const int _rr = (rr_); const int _rc = _rr < seg_lo ? seg_lo : (_rr >= seg_hi ? seg_hi - 1 : _rr); const float _v = bf1(PX[(size_t)_rc * DIN + 2048 + c]), _g = bf1(PX[(size_t)_rc * DIN + 2560 + c]); const float _z = _v * sigm(_g); dst = (_rr == _rc) ? _z : 0.f; } while (0)
#pragma unroll
    for (int e = 0; e < 30; ++e) CONV_Z(win[e], t0 - 15 + e);
    win[30] = 0.f; win[31] = 0.f;
    __syncthreads();
#pragma unroll 1
    for (int bb = 0; bb < 4; ++bb) {
        LAS float* cbuf = CB + (bb & 1) * (32 * 512);
#pragma unroll
        for (int u = 0; u < 32; ++u) {
            if ((u & 7) == 0) asm volatile("" ::: "memory");
            CONV_Z(win[(u + 30) & 31], t0 - 15 + 32 * bb + u + 30);
            float acc = bias;
#pragma unroll
            for (int j = 0; j < 31; ++j) acc += w[j] * win[(u + j) & 31];
            cbuf[u * 512 + c] = acc;
        }
        __syncthreads();
#pragma unroll 1
        for (int uu = 0; uu < 4; ++uu) {
            const int u = wave * 4 + uu, row = t0 + 32 * bb + u;
            float v[8]; float s = 0.f;
#pragma unroll
            for (int k = 0; k < 8; ++k) { v[k] = cbuf[u * 512 + lane + 64 * k]; s += v[k]; }
            const float mean = wave_sum(s) * (1.0f / 512.0f);
            float s2 = 0.f;
#pragma unroll
            for (int k = 0; k < 8; ++k) { v[k] -= mean; s2 += v[k] * v[k]; }
            const float rstd = 1.0f / sqrtf(wave_sum(s2) * (1.0f / 512.0f) + EPS);
#pragma unroll
            for (int k = 0; k < 8; ++k) {
                const int ch = lane + 64 * k;
                const float y = silu(v[k] * rstd * a.in[18][l * 512 + ch] + a.in[19][l * 512 + ch]);
                const float gt = bf1(PX[(size_t)row * DIN + 3072 + ch]);
                Y[(size_t)row * D + 1024 + ch] = f2bf(y * silu(gt));
            }
        }
    }
#undef CONV_Z
}

constexpr int TT_STRIDE = 136;
__device__ __forceinline__ void sgu_item(const Args a, int l, int sc, LAS unsigned char* lds) {
    const int tid = tid_fresh(), lane = tid & 63, wave = tid >> 6;
    unsigned char* ws = ptr_fresh(a.ws);
    const bf16_t* PX = (const bf16_t*)(ws + WS_PX); bf16_t* Y = (bf16_t*)(ws + WS_Y);
    const bf16_t* SW = (const bf16_t*)(ws + WS_SW) + (size_t)l * 8 * 128 * 128;
    LAS f32x2* ST = (LAS f32x2*)lds;
    LAS bf16_t* TT = (LAS bf16_t*)(lds + 1024);
    const int t0 = sc * 128;
    __syncthreads();
#pragma unroll 1
    for (int k = 0; k < 16; ++k) {
        const int tok = wave * 16 + k;
        const u32x4 p = *(const u32x4*)(PX + (size_t)(t0 + tok) * DIN + 4096 + 8 * lane);
        float g[8] = {gelu_t(bflo(p.x)), gelu_t(bfhi(p.x)), gelu_t(bflo(p.y)), gelu_t(bfhi(p.y)), gelu_t(bflo(p.z)), gelu_t(bfhi(p.z)), gelu_t(bflo(p.w)), gelu_t(bfhi(p.w))};
        float s = 0.f;
#pragma unroll
        for (int j = 0; j < 8; ++j) s += g[j];
        const float mean = wave_sum(s) * (1.0f / 512.0f);
        float s2 = 0.f;
#pragma unroll
        for (int j = 0; j < 8; ++j) { const float d = g[j] - mean; s2 += d * d; }
        const float rstd = 1.0f / sqrtf(wave_sum(s2) * (1.0f / 512.0f) + EPS);
        if (lane == 0) ST[tok] = (f32x2){mean, rstd};
    }
    __syncthreads();
    const int p_ = tid >> 2, dq = tid & 3;
    const f32x2 st = ST[p_];
    const int fr = lane & 15, fq = lane >> 4;
#pragma unroll 1
    for (int h = 0; h < 8; ++h) {
        LAS bf16_t* tt = TT + (h & 1) * (64 * TT_STRIDE);
        {
            const int ch = 64 * h + 16 * dq;
            const u32x4 q0 = *(const u32x4*)(PX + (size_t)(t0 + p_) * DIN + 4096 + ch), q1 = *(const u32x4*)(PX + (size_t)(t0 + p_) * DIN + 4096 + ch + 8);
            const unsigned pw[8] = {q0.x, q0.y, q0.z, q0.w, q1.x, q1.y, q1.z, q1.w};
            const float* lg = a.in[20] + l * 512 + ch; const float* lb = a.in[21] + l * 512 + ch;
#pragma unroll
            for (int j = 0; j < 8; ++j) {
                const float v0 = (gelu_t(bflo(pw[j])) - st[0]) * st[1] * lg[2 * j] + lb[2 * j];
                const float v1 = (gelu_t(bfhi(pw[j])) - st[0]) * st[1] * lg[2 * j + 1] + lb[2 * j + 1];
                tt[(16 * dq + 2 * j) * TT_STRIDE + p_] = f2bf(v0);
                tt[(16 * dq + 2 * j + 1) * TT_STRIDE + p_] = f2bf(v1);
            }
        }
        __syncthreads();
        f32x4 acc[4];
#pragma unroll
        for (int nt = 0; nt < 4; ++nt) acc[nt] = (f32x4){0.f, 0.f, 0.f, 0.f};
#pragma unroll
        for (int s = 0; s < 4; ++s) {
            const bf16x8 Afr = *(const bf16x8*)(SW + ((size_t)h * 128 + 16 * wave + fr) * 128 + 32 * s + 8 * fq);
#pragma unroll
            for (int nt = 0; nt < 4; ++nt) {
                const bf16x8 Bfr = *(const LAS bf16x8*)(tt + (16 * nt + fr) * TT_STRIDE + 32 * s + 8 * fq);
                acc[nt] = __builtin_amdgcn_mfma_f32_16x16x32_bf16(Afr, Bfr, acc[nt], 0, 0, 0);
            }
        }
#pragma unroll
        for (int reg = 0; reg < 4; ++reg) {
            const int q = 16 * wave + 4 * fq + reg, row = t0 + q;
            const float bs = a.in[23][((size_t)l * 8 + h) * 128 + q];
#pragma unroll
            for (int nt = 0; nt < 4; ++nt) {
                const int ch = 64 * h + 16 * nt + fr;
                const float uu = gelu_t(bf1(PX[(size_t)row * DIN + 3584 + ch]));
                const float gt = bf1(PX[(size_t)row * DIN + 4608 + ch]);
                Y[(size_t)row * D + 1536 + ch] = f2bf(uu * (acc[nt][reg] + bs) * silu(gt));
            }
        }
    }
}


constexpr int L2_GWL = 0;
constexpr int L2_CW = 32768;
constexpr int L2_RAW = 34816;
constexpr int RAW_ROWB = 144, RAW_BUFB = 132 * RAW_ROWB;
constexpr int L2_XLF = L2_RAW + 2 * RAW_BUFB;
constexpr int L2_XLB = L2_XLF + 128 * XLF_STRIDE * 4;
constexpr int L2_TAGG = L2_XLB + 128 * XLB_STRIDE * 2;
static_assert(L2_TAGG + 4096 <= LDS_BYTES, "lds map");

template <bool PASSC>
__device__ __forceinline__ void lru_phase(const Args a, int l, int c_lo, LAS unsigned char* lds) {
    const int tid = tid_fresh(), lane = tid & 63, wave = tid >> 6, b = blockIdx.x, G = gridDim.x;
    unsigned char* ws = ptr_fresh(a.ws);
    const bf16_t* PX = (const bf16_t*)(ws + WS_PX);
    const int hd = b & 15, cstep = G >> 4;
    int chunk = c_lo + (b >> 4);
    if (chunk >= NCHK) return;
    LAS float* CW = (LAS float*)(lds + L2_CW);
    LAS float* XLF = (LAS float*)(lds + L2_XLF);
    LAS bf16_t* XLB = (LAS bf16_t*)(lds + L2_XLB);
    LAS f32x2* TAGG = (LAS f32x2*)(lds + L2_TAGG);
    __syncthreads();
    {
        const bf16_t* GW = (const bf16_t*)(ws + WS_GW) + (size_t)(l * 16 + hd) * 16384;
#pragma unroll
        for (int i = 0; i < 4; ++i) *(LAS u32x4*)(lds + L2_GWL + (tid + 512 * i) * 16) = *(const u32x4*)(GW + (size_t)(tid + 512 * i) * 8);
        if (tid < 320) { const int j = tid >> 6, c = tid & 63; CW[tid] = j < 4 ? a.in[9][((size_t)l * 4 + j) * 1024 + hd * 64 + c] : a.in[10][(size_t)l * 1024 + hd * 64 + c]; }
    }
    const int tw = wave >> 1, chh = wave & 1, cl = lane & 31, hh = lane >> 5;
    const int cin = 32 * chh + cl, cg_ = hd * 64 + cin;
    float brv[2], biv[2], k8[2];
#pragma unroll
    for (int dir = 0; dir < 2; ++dir) {
        brv[dir] = a.in[13][(size_t)(l * 2 + dir) * 1024 + cg_]; biv[dir] = a.in[15][(size_t)(l * 2 + dir) * 1024 + cg_];
        k8[dir] = -8.0f * log1pf(__expf(-a.in[11][(size_t)(l * 2 + dir) * 1024 + cg_]));
    }
    const int t = tid >> 2, q = tid & 3, ch0 = hd * 64 + q * 16;
    const int hrow = (tid >> 2) < 2 ? (tid >> 2) : 130;
    u32x4 r0, r1, h0, h1;
    const u32x4 zero4 = {0u, 0u, 0u, 0u};
#define LRU_LOAD_RAW(ck) do { const int _t0 = (ck) * 128, _lo = (ck) < 2 ? 0 : CL, _hi = (ck) < 2 ? CL : R; \
        const bf16_t* _p = PX + (size_t)(_t0 + t) * DIN + ch0; r0 = *(const u32x4*)_p; r1 = *(const u32x4*)(_p + 8); \
        h0 = zero4; h1 = zero4; \
        if (tid < 12) { const int _gr = _t0 - 2 + hrow; if (_gr >= _lo && _gr < _hi) { const bf16_t* _ph = PX + (size_t)_gr * DIN + ch0; h0 = *(const u32x4*)_ph; h1 = *(const u32x4*)(_ph + 8); } } } while (0)
#define LRU_STORE_RAW(buf) do { LAS unsigned char* _rb = lds + L2_RAW + (buf) * RAW_BUFB; \
        *(LAS u32x4*)(_rb + (t + 2) * RAW_ROWB + 32 * q) = r0; *(LAS u32x4*)(_rb + (t + 2) * RAW_ROWB + 32 * q + 16) = r1; \
        if (tid < 12) { *(LAS u32x4*)(_rb + hrow * RAW_ROWB + 32 * q) = h0; *(LAS u32x4*)(_rb + hrow * RAW_ROWB + 32 * q + 16) = h1; } } while (0)
    LRU_LOAD_RAW(chunk);
    LRU_STORE_RAW(0);
    int cur = 0;
    __syncthreads();
#pragma unroll 1
    for (; chunk < NCHK; chunk += cstep) {
        const int nchunk = chunk + cstep;
        const bool has_next = nchunk < NCHK;
        u32x4 g0 = zero4, g1 = zero4; float cry[2] = {0.f, 0.f};
        if (PASSC) {
            const bf16_t* gp = PX + (size_t)(chunk * 128 + t) * DIN + 1024 + ch0;
            g0 = *(const u32x4*)gp; g1 = *(const u32x4*)(gp + 8);
            const float* CARRY = (const float*)(ws + WS_CARRY);
            cry[0] = CARRY[((size_t)0 * NCHK + chunk) * 1024 + cg_]; cry[1] = CARRY[((size_t)1 * NCHK + chunk) * 1024 + cg_];
        }
        if (has_next) LRU_LOAD_RAW(nchunk);
        {
            LAS unsigned char* rb = lds + L2_RAW + cur * RAW_BUFB;
            const int tg = tid >> 4, c4 = (tid & 15) * 4;
            f32x4 wv[4];
#pragma unroll
            for (int j = 0; j < 4; ++j) wv[j] = *(LAS f32x4*)(CW + j * 64 + c4);
            const f32x4 bb = *(LAS f32x4*)(CW + 256 + c4);
            f32x4 xr[7];
#pragma unroll
            for (int r = 0; r < 7; ++r) { const u32x2 pr = *(LAS u32x2*)(rb + (4 * tg + r) * RAW_ROWB + c4 * 2); xr[r] = (f32x4){bflo(pr.x), bfhi(pr.x), bflo(pr.y), bfhi(pr.y)}; }
#pragma unroll
            for (int tt = 0; tt < 4; ++tt) {
                const f32x4 xl = bb + wv[0] * xr[tt] + wv[1] * xr[tt + 1] + wv[2] * xr[tt + 2] + wv[3] * xr[tt + 3];
                *(LAS f32x4*)(XLF + (4 * tg + tt) * XLF_STRIDE + c4) = xl;
                u32x2 o; o.x = pk2(xl[0], xl[1]); o.y = pk2(xl[2], xl[3]);
                *(LAS u32x2*)(XLB + (4 * tg + tt) * XLB_STRIDE + c4) = o;
            }
        }
        __syncthreads();
        bf16x8 Af[4];
#pragma unroll
        for (int s = 0; s < 4; ++s) Af[s] = *(const LAS bf16x8*)(XLB + (32 * tw + cl) * XLB_STRIDE + 16 * s + 8 * hh);
        float xlv[16];
#pragma unroll
        for (int i = 0; i < 16; ++i) xlv[i] = XLF[(32 * tw + (i & 3) + 8 * (i >> 2) + 4 * hh) * XLF_STRIDE + cin];
        float av[2][16], bv[2][16], GA[2][8], GB[2][8];
#pragma unroll
        for (int dir = 0; dir < 2; ++dir) {
            f32x16 ar, ai;
#pragma unroll
            for (int i = 0; i < 16; ++i) { ar[i] = 0.f; ai[i] = 0.f; }
#pragma unroll
            for (int s = 0; s < 4; ++s) {
                const bf16x8 Br = *(const LAS bf16x8*)(lds + L2_GWL + ((((dir * 2 + 0) * 2 + chh) * 4 + s) * 64 + lane) * 16);
                const bf16x8 Bi = *(const LAS bf16x8*)(lds + L2_GWL + ((((dir * 2 + 1) * 2 + chh) * 4 + s) * 64 + lane) * 16);
                ar = __builtin_amdgcn_mfma_f32_32x32x16_bf16(Af[s], Br, ar, 0, 0, 0);
                ai = __builtin_amdgcn_mfma_f32_32x32x16_bf16(Af[s], Bi, ai, 0, 0, 0);
            }
#pragma unroll
            for (int i = 0; i < 16; ++i) {
                const float rg = sigm(ar[i] + brv[dir]), ig = sigm(ai[i] + biv[dir]);
                const float aa = __expf(k8[dir] * rg);
                av[dir][i] = aa;
                bv[dir][i] = __builtin_amdgcn_sqrtf(fmaxf(1.0f - aa * aa, 0.f)) * ig * xlv[i];
            }
            float oA[4], oB[4];
#pragma unroll
            for (int g = 0; g < 4; ++g) {
                const float a0 = av[dir][4 * g], a1 = av[dir][4 * g + 1], a2 = av[dir][4 * g + 2], a3 = av[dir][4 * g + 3];
                const float b0 = bv[dir][4 * g], b1 = bv[dir][4 * g + 1], b2 = bv[dir][4 * g + 2], b3 = bv[dir][4 * g + 3];
                oA[g] = (a0 * a1) * (a2 * a3);
                oB[g] = dir == 0 ? ((b0 * a1 + b1) * a2 + b2) * a3 + b3 : ((b3 * a2 + b2) * a1 + b1) * a0 + b0;
            }
#pragma unroll
            for (int g = 0; g < 4; ++g) {
                const float pA = __shfl_xor(oA[g], 32), pB = __shfl_xor(oB[g], 32);
                GA[dir][2 * g] = hh ? pA : oA[g]; GA[dir][2 * g + 1] = hh ? oA[g] : pA;
                GB[dir][2 * g] = hh ? pB : oB[g]; GB[dir][2 * g + 1] = hh ? oB[g] : pB;
            }
            float tA = 1.f, tB = 0.f;
            if (dir == 0) {
#pragma unroll
                for (int gq = 0; gq < 8; ++gq) { tB = GA[dir][gq] * tB + GB[dir][gq]; tA *= GA[dir][gq]; }
            } else {
#pragma unroll
                for (int gq = 7; gq >= 0; --gq) { tB = GA[dir][gq] * tB + GB[dir][gq]; tA *= GA[dir][gq]; }
            }
            if (hh == 0) TAGG[(tw * 2 + dir) * 64 + cin] = (f32x2){tA, tB};
        }
        if (has_next) LRU_STORE_RAW(cur ^ 1);
        __syncthreads();
        if constexpr (!PASSC) {
            if (tid < 128) {
                const int dir = tid >> 6, c = tid & 63;
                float cA = 1.f, cB = 0.f;
#pragma unroll
                for (int k = 0; k < 4; ++k) { const int t2 = dir == 0 ? k : 3 - k; const f32x2 v = TAGG[(t2 * 2 + dir) * 64 + c]; cB = v[0] * cB + v[1]; cA *= v[0]; }
                f32x2* AGG = (f32x2*)(ws + WS_AGG);
                AGG[((size_t)dir * NCHK + chunk) * 1024 + hd * 64 + c] = (f32x2){cA, cB};
            }
        } else {
            float yv[16];
#pragma unroll
            for (int dir = 0; dir < 2; ++dir) {
                float st = cry[dir];
                if (dir == 0) {
#pragma unroll
                    for (int t2 = 0; t2 < 3; ++t2) if (t2 < tw) { const f32x2 v = TAGG[(t2 * 2 + 0) * 64 + cin]; st = v[0] * st + v[1]; }
                } else {
#pragma unroll
                    for (int t2 = 3; t2 > 0; --t2) if (t2 > tw) { const f32x2 v = TAGG[(t2 * 2 + 1) * 64 + cin]; st = v[0] * st + v[1]; }
                }
                float hst[4];
                if (dir == 0) {
                    float s = st;
#pragma unroll
                    for (int g = 0; g < 4; ++g) { const float sE = s; s = GA[0][2 * g] * s + GB[0][2 * g]; const float sO = s; s = GA[0][2 * g + 1] * s + GB[0][2 * g + 1]; hst[g] = hh ? sO : sE; }
                } else {
                    float s = st;
#pragma unroll
                    for (int g = 3; g >= 0; --g) { const float sO = s; s = GA[1][2 * g + 1] * s + GB[1][2 * g + 1]; const float sE = s; s = GA[1][2 * g] * s + GB[1][2 * g]; hst[g] = hh ? sO : sE; }
                }
#pragma unroll
                for (int g = 0; g < 4; ++g) {
                    float h = hst[g];
                    if (dir == 0) {
#pragma unroll
                        for (int k = 0; k < 4; ++k) { h = av[0][4 * g + k] * h + bv[0][4 * g + k]; yv[4 * g + k] = h; }
                    } else {
#pragma unroll
                        for (int k = 3; k >= 0; --k) { h = av[1][4 * g + k] * h + bv[1][4 * g + k]; yv[4 * g + k] += h; }
                    }
                }
            }
            LAS bf16_t* YB = (LAS bf16_t*)(lds + L2_RAW + cur * RAW_BUFB);
#pragma unroll
            for (int i = 0; i < 16; ++i) YB[(32 * tw + (i & 3) + 8 * (i >> 2) + 4 * hh) * 72 + cin] = f2bf(yv[i]);
            __syncthreads();
            {
                const u32x4 y0 = *(LAS u32x4*)(YB + t * 72 + 16 * q), y1 = *(LAS u32x4*)(YB + t * 72 + 16 * q + 8);
                const unsigned yw[8] = {y0.x, y0.y, y0.z, y0.w, y1.x, y1.y, y1.z, y1.w};
                const unsigned gw_[8] = {g0.x, g0.y, g0.z, g0.w, g1.x, g1.y, g1.z, g1.w};
                unsigned ow[8];
#pragma unroll
                for (int j = 0; j < 8; ++j) ow[j] = pk2(bflo(yw[j]) * silu(bflo(gw_[j])), bfhi(yw[j]) * silu(bfhi(gw_[j])));
                bf16_t* yp = (bf16_t*)(ws + WS_Y) + (size_t)(chunk * 128 + t) * D + ch0;
                *(u32x4*)yp = (u32x4){ow[0], ow[1], ow[2], ow[3]}; *(u32x4*)(yp + 8) = (u32x4){ow[4], ow[5], ow[6], ow[7]};
            }
        }
        cur ^= 1;
    }
#undef LRU_LOAD_RAW
#undef LRU_STORE_RAW
}

constexpr int CV_ZT = 0;
constexpr int CV_CB = 94 * 1024;
static_assert(CV_CB + 16 * 512 * 4 <= LDS_BYTES, "conv lds map");
__device__ __forceinline__ void conv_item2(const Args a, int l, int ct, LAS unsigned char* lds) {
    const int tid = tid_fresh(), lane = tid & 63, wave = tid >> 6, c = tid;
    unsigned char* ws = ptr_fresh(a.ws);
    const bf16_t* PX = (const bf16_t*)(ws + WS_PX); bf16_t* Y = (bf16_t*)(ws + WS_Y);
    LAS bf16_t* ZT = (LAS bf16_t*)(lds + CV_ZT);
    LAS float* CB = (LAS float*)(lds + CV_CB);
    const int t0 = ct * 64, seg_lo = t0 < CL ? 0 : CL, seg_hi = t0 < CL ? CL : R;
    float w[31];
#pragma unroll
    for (int j = 0; j < 31; ++j) w[j] = a.in[16][((size_t)l * 31 + j) * 512 + c];
    const float bias = a.in[17][l * 512 + c];
    float lg[8], lb[8];
    { const f32x4 x0 = *(const f32x4*)(a.in[18] + l * 512 + 8 * lane), x1 = *(const f32x4*)(a.in[18] + l * 512 + 8 * lane + 4), y0 = *(const f32x4*)(a.in[19] + l * 512 + 8 * lane), y1 = *(const f32x4*)(a.in[19] + l * 512 + 8 * lane + 4);
#pragma unroll
      for (int k = 0; k < 4; ++k) { lg[k] = x0[k]; lg[4 + k] = x1[k]; lb[k] = y0[k]; lb[4 + k] = y1[k]; } }
    __syncthreads();
    {
        u32x4 zv[12], zg[12];
#pragma unroll
        for (int it = 0; it < 12; ++it) {
            const int pid = tid + 512 * it, e = pid >> 6, pc = pid & 63, ec = e < 94 ? e : 93;
            const int rr = t0 - 15 + ec, rc = rr < seg_lo ? seg_lo : (rr >= seg_hi ? seg_hi - 1 : rr);
            zv[it] = *(const u32x4*)(PX + (size_t)rc * DIN + 2048 + 8 * pc); zg[it] = *(const u32x4*)(PX + (size_t)rc * DIN + 2560 + 8 * pc);
        }
#pragma unroll
        for (int it = 0; it < 12; ++it) {
            const int pid = tid + 512 * it, e = pid >> 6, pc = pid & 63;
            const int rr = t0 - 15 + e;
            const unsigned vw[4] = {zv[it].x, zv[it].y, zv[it].z, zv[it].w}, gw_[4] = {zg[it].x, zg[it].y, zg[it].z, zg[it].w};
            unsigned ow[4];
#pragma unroll
            for (int j = 0; j < 4; ++j) ow[j] = pk2(bflo(vw[j]) * sigm(bflo(gw_[j])), bfhi(vw[j]) * sigm(bfhi(gw_[j])));
            const bool ok = rr >= seg_lo && rr < seg_hi;
            u32x4 o;
            o.x = ok ? ow[0] : 0u; o.y = ok ? ow[1] : 0u; o.z = ok ? ow[2] : 0u; o.w = ok ? ow[3] : 0u;
            if (e < 94) *(LAS u32x4*)(ZT + e * 512 + 8 * pc) = o;
        }
    }
    __syncthreads();
    float win[32];
#pragma unroll
    for (int e = 0; e < 30; ++e) win[e] = bf1(ZT[e * 512 + c]);
    win[30] = 0.f; win[31] = 0.f;
#pragma unroll 1
    for (int bb = 0; bb < 2; ++bb) {
#pragma unroll
        for (int hb = 0; hb < 2; ++hb) {
            u32x4 gt[2];
#pragma unroll
            for (int uu = 0; uu < 2; ++uu) gt[uu] = *(const u32x4*)(PX + (size_t)(t0 + 32 * bb + 16 * hb + wave * 2 + uu) * DIN + 3072 + 8 * lane);
#pragma unroll
            for (int u16 = 0; u16 < 16; ++u16) {
                const int u = 16 * hb + u16;
                win[(u + 30) & 31] = bf1(ZT[(32 * bb + u + 30) * 512 + c]);
                float acc = bias;
#pragma unroll
                for (int j = 0; j < 31; ++j) acc += w[j] * win[(u + j) & 31];
                CB[u16 * 512 + c] = acc;
            }
            __syncthreads();
#pragma unroll
            for (int uu = 0; uu < 2; ++uu) {
                const int u = wave * 2 + uu, row = t0 + 32 * bb + 16 * hb + u;
                float v[8]; float s = 0.f;
                { const f32x4 c0 = *(LAS f32x4*)(CB + u * 512 + 8 * lane), c1 = *(LAS f32x4*)(CB + u * 512 + 8 * lane + 4);
#pragma unroll
                  for (int k = 0; k < 4; ++k) { v[k] = c0[k]; v[4 + k] = c1[k]; } }
#pragma unroll
                for (int k = 0; k < 8; ++k) s += v[k];
                const float mean = wave_sum(s) * (1.0f / 512.0f);
                float s2 = 0.f;
#pragma unroll
                for (int k = 0; k < 8; ++k) { v[k] -= mean; s2 += v[k] * v[k]; }
                const float rstd = 1.0f / sqrtf(wave_sum(s2) * (1.0f / 512.0f) + EPS);
                const unsigned gw_[4] = {gt[uu].x, gt[uu].y, gt[uu].z, gt[uu].w};
                unsigned ow[4];
#pragma unroll
                for (int k = 0; k < 4; ++k) {
                    const float y0 = silu(v[2 * k] * rstd * lg[2 * k] + lb[2 * k]) * silu(bflo(gw_[k]));
                    const float y1 = silu(v[2 * k + 1] * rstd * lg[2 * k + 1] + lb[2 * k + 1]) * silu(bfhi(gw_[k]));
                    ow[k] = pk2(y0, y1);
                }
                *(u32x4*)(Y + (size_t)row * D + 1024 + 8 * lane) = (u32x4){ow[0], ow[1], ow[2], ow[3]};
            }
            __syncthreads();
        }
    }
}

__device__ __forceinline__ void sgu_item2(const Args a, int l, int item, LAS unsigned char* lds) {
    const int tid = tid_fresh(), lane = tid & 63, wave = tid >> 6;
    unsigned char* ws = ptr_fresh(a.ws);
    const bf16_t* PX = (const bf16_t*)(ws + WS_PX); bf16_t* Y = (bf16_t*)(ws + WS_Y);
    const bf16_t* SW = (const bf16_t*)(ws + WS_SW) + (size_t)l * 8 * 128 * 128;
    LAS f32x2* ST = (LAS f32x2*)lds;
    LAS bf16_t* TT = (LAS bf16_t*)(lds + 1024);
    const int sc = item >> 1, hg = item & 1, t0 = sc * 128;
    __syncthreads();
#pragma unroll
    for (int kb = 0; kb < 2; ++kb) {
        u32x4 p[8];
#pragma unroll
        for (int k = 0; k < 8; ++k) p[k] = *(const u32x4*)(PX + (size_t)(t0 + wave * 16 + kb * 8 + k) * DIN + 4096 + 8 * lane);
#pragma unroll
        for (int k = 0; k < 8; ++k) {
            float g[8] = {gelu_t(bflo(p[k].x)), gelu_t(bfhi(p[k].x)), gelu_t(bflo(p[k].y)), gelu_t(bfhi(p[k].y)), gelu_t(bflo(p[k].z)), gelu_t(bfhi(p[k].z)), gelu_t(bflo(p[k].w)), gelu_t(bfhi(p[k].w))};
            float s = 0.f;
#pragma unroll
            for (int j = 0; j < 8; ++j) s += g[j];
            const float mean = wave_sum(s) * (1.0f / 512.0f);
            float s2 = 0.f;
#pragma unroll
            for (int j = 0; j < 8; ++j) { const float d = g[j] - mean; s2 += d * d; }
            const float rstd = 1.0f / sqrtf(wave_sum(s2) * (1.0f / 512.0f) + EPS);
            if (lane == 0) ST[wave * 16 + kb * 8 + k] = (f32x2){mean, rstd};
        }
    }
    __syncthreads();
    const int p_ = tid >> 2, dq = tid & 3;
    const f32x2 st = ST[p_];
    const int fr = lane & 15, fq = lane >> 4;
    LAS float* SO = (LAS float*)(lds + 1024 + 2 * 64 * TT_STRIDE * 2);
    u32x4 Lq0[2], Lq1[2], Lu0[2], Lu1[2], Lg0[2], Lg1[2]; bf16x8 LA[2][4]; f32x4 Llg[2][4], Llb[2][4]; float Lbs[2];
#define SGU_LOAD(sl, h_) do { const int _ch = 64 * (h_) + 16 * dq; const bf16_t* _pr = PX + (size_t)(t0 + p_) * DIN + _ch; \
        Lq0[sl] = *(const u32x4*)(_pr + 4096); Lq1[sl] = *(const u32x4*)(_pr + 4096 + 8); Lu0[sl] = *(const u32x4*)(_pr + 3584); Lu1[sl] = *(const u32x4*)(_pr + 3584 + 8); \
        Lg0[sl] = *(const u32x4*)(_pr + 4608); Lg1[sl] = *(const u32x4*)(_pr + 4608 + 8); \
        _Pragma("unroll") for (int s = 0; s < 4; ++s) LA[sl][s] = *(const bf16x8*)(SW + ((size_t)(h_) * 128 + 16 * wave + fr) * 128 + 32 * s + 8 * fq); \
        Lbs[sl] = a.in[23][((size_t)l * 8 + (h_)) * 128 + p_]; \
        _Pragma("unroll") for (int j = 0; j < 4; ++j) { Llg[sl][j] = *(const f32x4*)(a.in[20] + l * 512 + _ch + 4 * j); Llb[sl][j] = *(const f32x4*)(a.in[21] + l * 512 + _ch + 4 * j); } } while (0)
    SGU_LOAD(0, 4 * hg);
#pragma unroll
    for (int h4 = 0; h4 < 4; ++h4) {
        const int h = 4 * hg + h4, sl = h4 & 1;
        LAS bf16_t* tt = TT + (h4 & 1) * (64 * TT_STRIDE);
        if (h4 + 1 < 4) SGU_LOAD(sl ^ 1, h + 1);
        const int ch = 64 * h + 16 * dq;
        const u32x4 q0 = Lq0[sl], q1 = Lq1[sl], u0 = Lu0[sl], u1 = Lu1[sl], g0 = Lg0[sl], g1 = Lg1[sl];
        bf16x8 Afr[4];
#pragma unroll
        for (int s = 0; s < 4; ++s) Afr[s] = LA[sl][s];
        const float bs = Lbs[sl];
        f32x4 lgv[4], lbv[4];
#pragma unroll
        for (int j = 0; j < 4; ++j) { lgv[j] = Llg[sl][j]; lbv[j] = Llb[sl][j]; }
        {
            const unsigned pw[8] = {q0.x, q0.y, q0.z, q0.w, q1.x, q1.y, q1.z, q1.w};
#pragma unroll
            for (int j = 0; j < 8; ++j) {
                const float v0 = (gelu_t(bflo(pw[j])) - st[0]) * st[1] * lgv[j >> 1][(2 * j) & 3] + lbv[j >> 1][(2 * j) & 3];
                const float v1 = (gelu_t(bfhi(pw[j])) - st[0]) * st[1] * lgv[j >> 1][(2 * j + 1) & 3] + lbv[j >> 1][(2 * j + 1) & 3];
                tt[(16 * dq + 2 * j) * TT_STRIDE + p_] = f2bf(v0);
                tt[(16 * dq + 2 * j + 1) * TT_STRIDE + p_] = f2bf(v1);
            }
        }
        __syncthreads();
        f32x4 acc[4];
#pragma unroll
        for (int nt = 0; nt < 4; ++nt) acc[nt] = (f32x4){0.f, 0.f, 0.f, 0.f};
#pragma unroll
        for (int s = 0; s < 4; ++s)
#pragma unroll
            for (int nt = 0; nt < 4; ++nt) {
                const bf16x8 Bfr = *(const LAS bf16x8*)(tt + (16 * nt + fr) * TT_STRIDE + 32 * s + 8 * fq);
                acc[nt] = __builtin_amdgcn_mfma_f32_16x16x32_bf16(Afr[s], Bfr, acc[nt], 0, 0, 0);
            }
#pragma unroll
        for (int reg = 0; reg < 4; ++reg)
#pragma unroll
            for (int nt = 0; nt < 4; ++nt) SO[(16 * wave + 4 * fq + reg) * 68 + 16 * nt + fr] = acc[nt][reg];
        __syncthreads();
        {
            const unsigned uw[8] = {u0.x, u0.y, u0.z, u0.w, u1.x, u1.y, u1.z, u1.w}, gw_[8] = {g0.x, g0.y, g0.z, g0.w, g1.x, g1.y, g1.z, g1.w};
            unsigned ow[8];
#pragma unroll
            for (int j4 = 0; j4 < 4; ++j4) {
                const f32x4 sv = *(LAS f32x4*)(SO + p_ * 68 + 16 * dq + 4 * j4);
                ow[2 * j4] = pk2(gelu_t(bflo(uw[2 * j4])) * (sv[0] + bs) * silu(bflo(gw_[2 * j4])), gelu_t(bfhi(uw[2 * j4])) * (sv[1] + bs) * silu(bfhi(gw_[2 * j4])));
                ow[2 * j4 + 1] = pk2(gelu_t(bflo(uw[2 * j4 + 1])) * (sv[2] + bs) * silu(bflo(gw_[2 * j4 + 1])), gelu_t(bfhi(uw[2 * j4 + 1])) * (sv[3] + bs) * silu(bfhi(gw_[2 * j4 + 1])));
            }
            bf16_t* yp = Y + (size_t)(t0 + p_) * D + 1536 + ch;
            *(u32x4*)yp = (u32x4){ow[0], ow[1], ow[2], ow[3]}; *(u32x4*)(yp + 8) = (u32x4){ow[4], ow[5], ow[6], ow[7]};
        }
    }
#undef SGU_LOAD
}

__device__ __forceinline__ int scan_chunk(int dir, int o) { return dir == 0 ? o : (o == 0 ? 1 : (o == 1 ? 0 : (NCHK + 1 - o))); }
__device__ __forceinline__ void phase_carry(const Args a, LAS unsigned char* lds) {
    const int tid = tid_fresh(), b = blockIdx.x, G = gridDim.x;
    unsigned char* ws = ptr_fresh(a.ws);
    const f32x2* AGG = (const f32x2*)(ws + WS_AGG); float* CARRY = (float*)(ws + WS_CARRY);
    LAS f32x2* SEG = (LAS f32x2*)lds;
    for (int u = b; u < 64; u += G) {
        const int dir = u >> 5, ch = (u & 31) * 32 + (tid & 31), sg = tid >> 5;
        f32x2 ab[10];
        if (sg < 13) {
#pragma unroll
            for (int k = 0; k < 10; ++k) ab[k] = AGG[((size_t)dir * NCHK + scan_chunk(dir, 10 * sg + k)) * 1024 + ch];
            float sA = 1.f, sB = 0.f;
#pragma unroll
            for (int k = 0; k < 10; ++k) { sB = ab[k][0] * sB + ab[k][1]; sA *= ab[k][0]; }
            SEG[sg * 32 + (tid & 31)] = (f32x2){sA, sB};
        }
        __syncthreads();
        if (sg < 13) {
            float st = 0.f;
            for (int s2 = 0; s2 < sg; ++s2) { const f32x2 v = SEG[s2 * 32 + (tid & 31)]; st = v[0] * st + v[1]; }
#pragma unroll
            for (int k = 0; k < 10; ++k) { CARRY[((size_t)dir * NCHK + scan_chunk(dir, 10 * sg + k)) * 1024 + ch] = st; st = ab[k][0] * st + ab[k][1]; }
        }
        __syncthreads();
    }
}

__device__ __forceinline__ void phase_resid0(const Args a) {
    const int tid = tid_fresh(), lane = tid & 63, wave = tid >> 6, b = blockIdx.x, G = gridDim.x;
    unsigned char* ws = ptr_fresh(a.ws);
    const bf16_t* DL0 = (const bf16_t*)(ws + WS_DL0);
    const float* gg0 = (const float*)(ws + WS_GG);
    const float* gg = (const float*)(ws + WS_GG) + (size_t)2 * D;
    bf16_t* XG = (bf16_t*)(ws + WS_XG) + (size_t)CL * D; float* rss1 = (float*)(ws + WS_RSS) + R + CL;
    f32x4 g[8], rg0[8];
#pragma unroll
    for (int j = 0; j < 4; ++j) { g[2 * j] = *(const f32x4*)(gg + 8 * (lane + 64 * j)); g[2 * j + 1] = *(const f32x4*)(gg + 8 * (lane + 64 * j) + 4);
        const f32x4 h0 = *(const f32x4*)(gg0 + 8 * (lane + 64 * j)), h1 = *(const f32x4*)(gg0 + 8 * (lane + 64 * j) + 4);
        rg0[2 * j] = (f32x4){1.0f / h0[0], 1.0f / h0[1], 1.0f / h0[2], 1.0f / h0[3]}; rg0[2 * j + 1] = (f32x4){1.0f / h1[0], 1.0f / h1[1], 1.0f / h1[2], 1.0f / h1[3]}; }
    u32x4 xr[4], dr[4];
#define RS_LOAD(t_, X, Dd) do { _Pragma("unroll") for (int j = 0; j < 4; ++j) { X[j] = *(const u32x4*)(XG + (size_t)(t_) * D + 8 * (lane + 64 * j)); Dd[j] = *(const u32x4*)(DL0 + (size_t)(t_) * D + 8 * (lane + 64 * j)); } } while (0)
    int t = b * 8 + wave;
    if (t < T) RS_LOAD(t, xr, dr);
    for (; t < T; t += G * 8) {
        u32x4 xn[4], dn[4];
        const int tn = t + G * 8;
        if (tn < T) RS_LOAD(tn, xn, dn);
        f32x4 v[8]; float ss = 0.f;
#pragma unroll
        for (int j = 0; j < 4; ++j) {
            v[2 * j] = (f32x4){bflo(xr[j].x), bfhi(xr[j].x), bflo(xr[j].y), bfhi(xr[j].y)} * rg0[2 * j] + (f32x4){bflo(dr[j].x), bfhi(dr[j].x), bflo(dr[j].y), bfhi(dr[j].y)};
            v[2 * j + 1] = (f32x4){bflo(xr[j].z), bfhi(xr[j].z), bflo(xr[j].w), bfhi(xr[j].w)} * rg0[2 * j + 1] + (f32x4){bflo(dr[j].z), bfhi(dr[j].z), bflo(dr[j].w), bfhi(dr[j].w)};
        }
#pragma unroll
        for (int j = 0; j < 8; ++j) ss += (v[j][0] * v[j][0] + v[j][1] * v[j][1]) + (v[j][2] * v[j][2] + v[j][3] * v[j][3]);
#pragma unroll
        for (int j = 0; j < 4; ++j) {
            const f32x4 p0 = v[2 * j] * g[2 * j], p1 = v[2 * j + 1] * g[2 * j + 1];
            u32x4 w; w.x = pk2(p0[0], p0[1]); w.y = pk2(p0[2], p0[3]); w.z = pk2(p1[0], p1[1]); w.w = pk2(p1[2], p1[3]);
            *(u32x4*)(XG + (size_t)t * D + 8 * (lane + 64 * j)) = w;
        }
        ss = wave_sum(ss);
        if (lane == 0) rss1[t] = ss;
        if (tn < T) {
#pragma unroll
            for (int j = 0; j < 4; ++j) { xr[j] = xn[j]; dr[j] = dn[j]; }
        }
    }
#undef RS_LOAD
}
__device__ __forceinline__ void phase_final(const Args a) {
    const int tid = tid_fresh(), lane = tid & 63, wave = tid >> 6, b = blockIdx.x, G = gridDim.x;
    unsigned char* ws = ptr_fresh(a.ws);
    const bf16_t* XG1 = (const bf16_t*)(ws + WS_XG) + (size_t)CL * D;
    const bf16_t* DL1 = (const bf16_t*)(ws + WS_DL0);
    const float* fg = a.in[24];
    const float* gg = (const float*)(ws + WS_GG) + (size_t)2 * D;
    u32x4 xr[4], er[4];
#define FN_LOAD(t_, X, Ee) do { _Pragma("unroll") for (int j = 0; j < 4; ++j) { X[j] = *(const u32x4*)(XG1 + (size_t)(t_) * D + 8 * (lane + 64 * j)); Ee[j] = *(const u32x4*)(DL1 + (size_t)(t_) * D + 8 * (lane + 64 * j)); } } while (0)
    f32x4 fgv[8], rg[8];
#pragma unroll
    for (int j = 0; j < 4; ++j) { fgv[2 * j] = *(const f32x4*)(fg + 8 * (lane + 64 * j)); fgv[2 * j + 1] = *(const f32x4*)(fg + 8 * (lane + 64 * j) + 4);
        const f32x4 g0 = *(const f32x4*)(gg + 8 * (lane + 64 * j)), g1 = *(const f32x4*)(gg + 8 * (lane + 64 * j) + 4);
        rg[2 * j] = (f32x4){1.0f / g0[0], 1.0f / g0[1], 1.0f / g0[2], 1.0f / g0[3]}; rg[2 * j + 1] = (f32x4){1.0f / g1[0], 1.0f / g1[1], 1.0f / g1[2], 1.0f / g1[3]}; }
    int t = b * 8 + wave;
    if (t < T) FN_LOAD(t, xr, er);
    for (; t < T; t += G * 8) {
        u32x4 xn[4], en[4];
        const int tn = t + G * 8;
        if (tn < T) FN_LOAD(tn, xn, en);
        float* orow = a.out + (size_t)t * D;
        f32x4 v[8]; float ss = 0.f;
#pragma unroll
        for (int j = 0; j < 4; ++j) {
            v[2 * j] = (f32x4){bflo(xr[j].x), bfhi(xr[j].x), bflo(xr[j].y), bfhi(xr[j].y)} * rg[2 * j] + (f32x4){bflo(er[j].x), bfhi(er[j].x), bflo(er[j].y), bfhi(er[j].y)};
            v[2 * j + 1] = (f32x4){bflo(xr[j].z), bfhi(xr[j].z), bflo(xr[j].w), bfhi(xr[j].w)} * rg[2 * j + 1] + (f32x4){bflo(er[j].z), bfhi(er[j].z), bflo(er[j].w), bfhi(er[j].w)};
        }
#pragma unroll
        for (int j = 0; j < 8; ++j) ss += (v[j][0] * v[j][0] + v[j][1] * v[j][1]) + (v[j][2] * v[j][2] + v[j][3] * v[j][3]);
        const float rs = 1.0f / sqrtf(wave_sum(ss) * (1.0f / D) + EPS);
#pragma unroll
        for (int j = 0; j < 4; ++j) {
            *(f32x4*)(orow + 8 * (lane + 64 * j)) = v[2 * j] * rs * fgv[2 * j]; *(f32x4*)(orow + 8 * (lane + 64 * j) + 4) = v[2 * j + 1] * rs * fgv[2 * j + 1];
        }
        if (tn < T) {
#pragma unroll
            for (int j = 0; j < 4; ++j) { xr[j] = xn[j]; er[j] = en[j]; }
        }
    }
#undef FN_LOAD
}

template <int NT, int MODE>
__device__ __forceinline__ void ctx_gemm(const Args a, int l, LAS unsigned char* lds) {
    const int tid = tid_fresh(), lane = tid & 63, wave = tid >> 6, b = blockIdx.x, G = gridDim.x;
    unsigned char* ws = ptr_fresh(a.ws);
    constexpr int TN = 16 * NT, N = 64 * TN, TS = TN + 4;
    const bf16_t* A = (const bf16_t*)(ws + (MODE == 0 ? WS_XG : WS_Y));
    const bf16_t* Bt = MODE == 0 ? (const bf16_t*)(ws + WS_WINT) + (size_t)l * DIN * D : (const bf16_t*)(ws + WS_WOUTT) + (size_t)l * D * D;
    LAS float* CT = (LAS float*)lds;
    const int fr = lane & 15, fq = lane >> 4;
#pragma unroll 1
    for (int tile = b; tile < 256; tile += G) {
        const int r0 = (tile >> 6) * 64, n0 = (tile & 63) * TN;
        __syncthreads();
        f32x4 acc[4][NT];
#pragma unroll
        for (int m = 0; m < 4; ++m)
#pragma unroll
            for (int n = 0; n < NT; ++n) acc[m][n] = (f32x4){0.f, 0.f, 0.f, 0.f};
        const bf16_t* ap = A + (size_t)(r0 + fr) * D + wave * 256 + 8 * fq;
        const bf16_t* bp = Bt + (size_t)(n0 + fr) * D + wave * 256 + 8 * fq;
        bf16x8 af[2][4], bfr[2][NT];
#define CTXG_LOAD(buf, ks_) do { _Pragma("unroll") for (int m = 0; m < 4; ++m) af[buf][m] = *(const bf16x8*)(ap + (size_t)(16 * m) * D + 32 * (ks_)); \
        _Pragma("unroll") for (int n = 0; n < NT; ++n) bfr[buf][n] = *(const bf16x8*)(bp + (size_t)(16 * n) * D + 32 * (ks_)); } while (0)
#define CTXG_MMA(buf) do { _Pragma("unroll") for (int m = 0; m < 4; ++m) _Pragma("unroll") for (int n = 0; n < NT; ++n) \
        acc[m][n] = __builtin_amdgcn_mfma_f32_16x16x32_bf16(af[buf][m], bfr[buf][n], acc[m][n], 0, 0, 0); } while (0)
        CTXG_LOAD(0, 0);
#pragma unroll
        for (int ks = 0; ks < 8; ks += 2) {
            CTXG_LOAD(1, ks + 1);
            __builtin_amdgcn_sched_barrier(0);
            CTXG_MMA(0);
            __builtin_amdgcn_sched_barrier(0);
            if (ks + 2 < 8) CTXG_LOAD(0, ks + 2);
            __builtin_amdgcn_sched_barrier(0);
            CTXG_MMA(1);
            __builtin_amdgcn_sched_barrier(0);
        }
#undef CTXG_LOAD
#undef CTXG_MMA
#pragma unroll
        for (int ps = 0; ps < 2; ++ps) {
#pragma unroll
            for (int m2 = 0; m2 < 2; ++m2)
#pragma unroll
                for (int n = 0; n < NT; ++n)
#pragma unroll
                    for (int reg = 0; reg < 4; ++reg) CT[(wave * 32 + 16 * m2 + 4 * fq + reg) * TS + 16 * n + fr] = acc[2 * ps + m2][n][reg];
            __syncthreads();
            for (int wi = tid; wi < 32 * (TN / 8); wi += 512) {
                const int rr = wi / (TN / 8), cgp = wi % (TN / 8), row = r0 + 32 * ps + rr, col = n0 + 8 * cgp;
                f32x4 c0 = {0.f, 0.f, 0.f, 0.f}, c1 = {0.f, 0.f, 0.f, 0.f};
#pragma unroll
                for (int w8 = 0; w8 < 8; ++w8) { c0 += *(LAS f32x4*)(CT + (w8 * 32 + rr) * TS + 8 * cgp); c1 += *(LAS f32x4*)(CT + (w8 * 32 + rr) * TS + 8 * cgp + 4); }
                if (MODE == 0) {
                    const float* rss = (const float*)(ws + WS_RSS) + (size_t)l * R;
                    const float* shw = (const float*)(ws + WS_SHW) + (size_t)(l * 2 + 1) * DIN;
                    bf16_t* PXo = (bf16_t*)(ws + WS_PX);
                    const float rs = 1.0f / sqrtf(rss[row] * (1.0f / D) + EPS);
                    const f32x4 s0 = *(const f32x4*)(shw + col), s1 = *(const f32x4*)(shw + col + 4);
                    const f32x4 v0 = c0 * rs + s0, v1 = c1 * rs + s1;
                    u32x4 w; w.x = pk2(v0[0], v0[1]); w.y = pk2(v0[2], v0[3]); w.z = pk2(v1[0], v1[1]); w.w = pk2(v1[2], v1[3]);
                    *(u32x4*)(PXo + (size_t)row * DIN + col) = w;
                } else {
                    const float* gp = (const float*)(ws + WS_MOD) + (size_t)(l * 2 + 1) * 6144 + 4096;
                    const float* ggp = (const float*)(ws + WS_GG) + (size_t)((l + 1) * 2 + 1) * D;
                    float* rssn = (float*)(ws + WS_RSS) + (size_t)(l + 1) * R;
                    float* xn = (float*)(ws + WS_X1C); bf16_t* XG = (bf16_t*)(ws + WS_XG);
                    const f32x4 o0 = *(const f32x4*)(a.in[2] + (size_t)row * D + col), o1 = *(const f32x4*)(a.in[2] + (size_t)row * D + col + 4);
                    const f32x4 g0 = *(const f32x4*)(gp + col), g1 = *(const f32x4*)(gp + col + 4);
                    const f32x4 v0 = o0 + g0 * c0, v1 = o1 + g1 * c1;
                    *(f32x4*)(xn + (size_t)row * D + col) = v0; *(f32x4*)(xn + (size_t)row * D + col + 4) = v1;
                    const f32x4 q0 = *(const f32x4*)(ggp + col), q1 = *(const f32x4*)(ggp + col + 4);
                    const f32x4 a0 = v0 * q0, a1 = v1 * q1;
                    u32x4 w; w.x = pk2(a0[0], a0[1]); w.y = pk2(a0[2], a0[3]); w.z = pk2(a1[0], a1[1]); w.w = pk2(a1[2], a1[3]);
                    *(u32x4*)(XG + (size_t)row * D + col) = w;
                    const float ss = (v0[0] * v0[0] + v0[1] * v0[1]) + (v0[2] * v0[2] + v0[3] * v0[3]) + (v1[0] * v1[0] + v1[1] * v1[1]) + (v1[2] * v1[2] + v1[3] * v1[3]);
                    unsafeAtomicAdd(rssn + row, ss);
                }
            }
            __syncthreads();
        }
    }
    __syncthreads();
}

#define XB_TMO      128
#define XB_XCNT(j)  (256  + 64 * (j))
#define XB_XSUB(j)  (1280 + 64 * (j))
#define XB_XGEN(j)  (2304 + 64 * (j))
#define XB_TOP      3328
#define XB_TOPGEN   3392
#define XCD_BAR_WORDS 3456
#define XB_SPIN_CAP (1u << 18)

__device__ __forceinline__ unsigned xb_ld(unsigned* p)              { return __hip_atomic_load(p, __ATOMIC_RELAXED, __HIP_MEMORY_SCOPE_AGENT); }
__device__ __forceinline__ unsigned xb_add(unsigned* p, unsigned v) { return __hip_atomic_fetch_add(p, v, __ATOMIC_RELAXED, __HIP_MEMORY_SCOPE_AGENT); }
__device__ __forceinline__ unsigned xb_xcc_id() { return (unsigned)__builtin_amdgcn_s_getreg((3 << 11) | 20) & 0xFu; }
#define XB_SPIN(cond, bar) do { unsigned _sp = 0; while (cond) { __builtin_amdgcn_s_sleep(1); \
    if ((++_sp & 255u) == 0u) { if (xb_ld(&(bar)[XB_TMO])) break; if (_sp > XB_SPIN_CAP) { atomicAdd(&(bar)[XB_TMO], 1u); break; } } } } while (0)

struct XcdBarrier {
    unsigned* bar; unsigned x;
    volatile LAS unsigned* st;
};

__device__ __forceinline__ XcdBarrier xcd_barrier_post(unsigned* bar, volatile LAS unsigned* st) {
    XcdBarrier b; b.bar = bar; b.x = xb_xcc_id(); b.st = st;
    if (threadIdx.x == 0) (void)xb_add(&bar[XB_XCNT(b.x)], 1u);
    return b;
}
__device__ __forceinline__ void xcd_barrier_complete(unsigned* bar, unsigned x, unsigned& nloc, unsigned& nx) {
    const unsigned G = gridDim.x * gridDim.y * gridDim.z;
    unsigned sum, cnt, mine, sp = 0u;
    for (;;) {
        sum = 0u; cnt = 0u; mine = 0u;
#pragma unroll
        for (unsigned j = 0; j < 16; ++j) { const unsigned c = xb_ld(&bar[XB_XCNT(j)]); sum += c; cnt += (c > 0u) ? 1u : 0u; mine = (j == x) ? c : mine; }
        if (sum == G) break;
        __builtin_amdgcn_s_sleep(1);
        if ((++sp & 255u) == 0u) { if (xb_ld(&bar[XB_TMO])) break; if (sp > XB_SPIN_CAP) { atomicAdd(&bar[XB_TMO], 1u); break; } }
    }
    nloc = mine > 0u ? mine : 1u; nx = cnt > 0u ? cnt : 1u;
}

__device__ __forceinline__ void xcd_barrier(const XcdBarrier& b) {
    asm volatile("s_waitcnt vmcnt(0)" ::: "memory");
    __syncthreads();
    if (threadIdx.x == 0) {
        unsigned* bar = b.bar;
        __builtin_amdgcn_s_waitcnt(0);
        unsigned nloc = b.st[0], nx = b.st[1];
        if (nloc == 0u) { xcd_barrier_complete(bar, b.x, nloc, nx); b.st[0] = nloc; b.st[1] = nx; }
        const unsigned old = xb_add(&bar[XB_XSUB(b.x)], 1u);
        const unsigned gen = old / nloc;
        if (old + 1u == (gen + 1u) * nloc) {
            __builtin_amdgcn_fence(__ATOMIC_RELEASE, "agent");
            asm volatile("s_waitcnt vmcnt(0)" ::: "memory");
            const unsigned og = xb_add(&bar[XB_TOP], 1u);
            const unsigned tg = og / nx;
            if (og + 1u == (tg + 1u) * nx) xb_add(&bar[XB_TOPGEN], 1u);
            else XB_SPIN(xb_ld(&bar[XB_TOPGEN]) == tg, bar);
            __builtin_amdgcn_fence(__ATOMIC_ACQUIRE, "agent");
            xb_add(&bar[XB_XGEN(b.x)], 1u);
            asm volatile("s_waitcnt vmcnt(0)" ::: "memory");
        } else {
            XB_SPIN(xb_ld(&bar[XB_XGEN(b.x)]) == gen, bar);
            __builtin_amdgcn_fence(__ATOMIC_ACQUIRE, "agent");
            asm volatile("s_waitcnt vmcnt(0)" ::: "memory");
        }
    }
    __syncthreads();
}


__global__ void __launch_bounds__(512, 2) mega_fwd(Args a) {
    extern __shared__ __attribute__((aligned(16))) unsigned char lds_raw[];
    LAS unsigned char* lds = (LAS unsigned char*)lds_raw;
    cg::grid_group grid = cg::this_grid();
    const int lo = a.ph_lo, hi = a.ph_hi;
    const int b = blockIdx.x, G = gridDim.x;
    unsigned char* ws = ptr_fresh(a.ws);
    { volatile LAS unsigned* xst = (volatile LAS unsigned*)(lds + LDS_BYTES - 16); if (threadIdx.x < 4) xst[threadIdx.x] = 0u; }
    __syncthreads();
    const XcdBarrier xbar = xcd_barrier_post((unsigned*)(a.ws + WS_BAR), (volatile LAS unsigned*)(lds + LDS_BYTES - 16));
#ifndef PHMASK
#define PHMASK 0x1fff
#endif
#define IN(k) (((PHMASK >> (k)) & 1) && lo <= (k) && (k) < hi)
#ifndef DUPMASK
#define DUPMASK 0
#endif
#define DUP(k) ((DUPMASK >> (k)) & 1)
#define GSYNC(k) do { if (a.ph_lo < 0) grid.sync();     \
    xcd_barrier(xbar); } while (0)
#define SEAM(k) do { if (IN(k) && IN((k) + 1)) GSYNC(k); } while (0)
#define REPB(k) for (int rep_ = 0; rep_ <= DUP(k); ++rep_) { if (rep_) xcd_barrier(xbar);
#define REPE }
    if (IN(0)) { REPB(0) phase0a(a, lds); REPE }
    SEAM(0);
    if (IN(1)) { REPB(1) phase0b(a, lds); REPE }
    SEAM(1);
#pragma unroll 1
    for (int l = 0; l < 2; ++l) {
        const int pb = 2 + 5 * l; const bool last = (l == 1);
        if (IN(pb) && (PHMASK & 0x84)) { REPB(pb)
            pg8::Gemm g{(const bf16_t*)(ws + WS_XG) + (size_t)CL * D, (const bf16_t*)(ws + WS_WINT) + (size_t)l * DIN * D, T, DIN, D};
            pg8::StaticOrder S; S.init(T, DIN, G, b);
            EpiIn E{(bf16_t*)(ws + WS_PX), (const float*)(ws + WS_RSS) + (size_t)l * R, (const float*)(ws + WS_SHW) + (size_t)l * 2 * DIN};
            const bool ctx_first = (b & 1) != 0;
            if (ctx_first) ctx_gemm<5, 0>(a, l, lds);
            pg8::gemm_phase<EpiIn, pg8::StaticOrder, GEMM_ALIGN, GEMM_SP2>(lds, g, S, E);
            if (!ctx_first) ctx_gemm<5, 0>(a, l, lds);
        REPE }
        SEAM(pb);
        if (IN(pb + 1) && (PHMASK & 0x108)) { REPB(pb + 1)
            const int c_lo = last ? 2 : 0, n_cv = 2 * (NCHK - c_lo);
            lru_phase<false>(a, l, 0, lds);
            unsigned* qctr = (unsigned*)(a.ws + WS_BAR) + 16 + 2 * l + rep_;
            volatile LAS int* qslot = (volatile LAS int*)(lds + LDS_BYTES - 32);
            for (;;) {
                __syncthreads();
                if (threadIdx.x == 0) *qslot = (int)__hip_atomic_fetch_add(qctr, 1u, __ATOMIC_RELAXED, __HIP_MEMORY_SCOPE_AGENT);
                __syncthreads();
                const int it = *qslot;
                if (it >= 2 * n_cv) break;
                if (it < n_cv) sgu_item2(a, l, 2 * c_lo + it, lds); else conv_item2(a, l, 2 * c_lo + it - n_cv, lds);
            }
        REPE }
        SEAM(pb + 1);
        if (IN(pb + 2) && (PHMASK & 0x210)) { REPB(pb + 2) phase_carry(a, lds); REPE }
        SEAM(pb + 2);
        if (IN(pb + 3) && (PHMASK & 0x420)) { REPB(pb + 3)
            lru_phase<true>(a, l, last ? 2 : 0, lds);
            __syncthreads();
        REPE }
        SEAM(pb + 3);
        if (IN(pb + 4) && (PHMASK & 0x840)) {
            const int roff = CL, M = T;
            pg8::Gemm g{(const bf16_t*)(ws + WS_Y) + (size_t)roff * D, (const bf16_t*)(ws + WS_WOUTT) + (size_t)l * D * D, M, D, D};
            pg8::StaticOrder S; S.init(M, D, G, b);
            EpiDelta E{(bf16_t*)(ws + WS_DL0),
                        (const float*)(ws + WS_MOD) + (size_t)l * 2 * 6144 + 4096};
            const bool ctx_first = !last && (b & 1) != 0;
            if (ctx_first) ctx_gemm<2, 1>(a, l, lds);
            pg8::gemm_phase<EpiDelta, pg8::StaticOrder, GEMM_ALIGN, GEMM_SP2>(lds, g, S, E);
            if (!last) { if (!ctx_first) ctx_gemm<2, 1>(a, l, lds); xcd_barrier(xbar); phase_resid0(a); }
        }
        SEAM(pb + 4);
    }
    if (IN(12)) phase_final(a);
#undef IN
#undef SEAM
}

extern "C" void kernel_launch(void* const* d_in, const int* in_sizes, int n_in, void* d_out, int out_size, void* d_ws, size_t ws_size, hipStream_t stream) {
    static int grid = 0;
    if (grid == 0) {
        int dev = 0, cus = 0, per_cu = 0;
        if (n_in != 25 || ws_size < WS_END) { fprintf(stderr, "kernel_launch: unexpected inputs (n_in %d, ws %zu < %zu)\n", n_in, ws_size, (size_t)WS_END); grid = -1; return; }
        hipGetDevice(&dev);
        hipDeviceGetAttribute(&cus, hipDeviceAttributeMultiprocessorCount, dev);
        if (hipFuncSetAttribute((const void*)mega_fwd, hipFuncAttributeMaxDynamicSharedMemorySize, LDS_BYTES) != hipSuccess) { fprintf(stderr, "kernel_launch: hipFuncSetAttribute failed\n"); grid = -1; return; }
        hipOccupancyMaxActiveBlocksPerMultiprocessor(&per_cu, (const void*)mega_fwd, 512, LDS_BYTES);
        (void)hipGetLastError();
        if (per_cu < 1) { fprintf(stderr, "kernel_launch: occupancy query says %d blocks per CU\n", per_cu); per_cu = 1; }
        grid = cus;
    }
    if (grid < 0) return;
    if (hipMemsetAsync((char*)d_ws + WS_BAR, 0, 16384, stream) != hipSuccess) { fprintf(stderr, "kernel_launch: memset of the barrier words failed\n"); return; }
    Args a{};
    for (int i = 0; i < 25; ++i) a.in[i] = (const float*)d_in[i];
    a.out = (float*)d_out; a.ws = (unsigned char*)d_ws;
#if N_LAUNCH_MODE == 1
    a.ph_lo = 0; a.ph_hi = NPHASE;
    void* args[] = {&a};
    hipError_t e = hipLaunchCooperativeKernel((const void*)mega_fwd, dim3(grid), dim3(512), args, LDS_BYTES, stream);
    if (e != hipSuccess) fprintf(stderr, "kernel_launch: cooperative launch failed: %s (grid %d)\n", hipGetErrorString(e), grid);
#else
    for (int p = 0; p < NPHASE; ++p) {
        a.ph_lo = p; a.ph_hi = p + 1;
        hipLaunchKernelGGL(mega_fwd, dim3(grid), dim3(512), LDS_BYTES, stream, a);
    }
#endif
}
```

```cpp
#include <hip/hip_runtime.h>
#include <hip/hip_cooperative_groups.h>
#include <cstdio>
#include <cstdint>
namespace cg = cooperative_groups;
namespace pg8 {
#define PG8_LAS __attribute__((address_space(3)))
typedef unsigned short bf16_t;
typedef short bf16x8 __attribute__((ext_vector_type(8)));
typedef float f32x4 __attribute__((ext_vector_type(4)));
typedef unsigned u32x4 __attribute__((ext_vector_type(4)));
constexpr int BM = 256, BK = 64, HALF = 128, HTB = HALF * BK * 2  , STAGE_BYTES = 8 * HTB, NXCD = 8, WGM = 8;

__host__ __device__ __forceinline__ int lds_byte(int r, int c) { const int st = (r >> 4) * 2 + (c >> 5), rr = r & 15, cc = c & 31, ob = rr * 64 + cc * 2; return st * 1024 + (ob ^ (((ob >> 9) & 1) << 5)); }
__host__ __device__ __forceinline__ void stage_rc(int b, int& R, int& C) { const int st = b / 1024, sb = b % 1024, swz = sb ^ (((sb >> 9) & 1) << 5); R = (st >> 1) * 16 + swz / 64; C = (st & 1) * 32 + (swz % 64) / 2; }
__host__ __device__ __forceinline__ int perm32(int rho) { const int n = rho >> 4, i = rho & 15; return 8 * (i >> 2) + 4 * n + (i & 3); }

struct Unit { int pm, pn; };
struct Gemm { const bf16_t* A; const bf16_t* Bt; int M, N, K; };

struct StaticOrder {
    int nM, nN, nwg, G, c;
    __host__ __device__ void init(int M, int N, int G_, int c_) { nM = M / BM; nN = N / BM; nwg = nM * nN; G = G_; c = c_; }
    __host__ __device__ bool next(int i, Unit& u) const {
        const long L = (long)i * G + c; if (L >= nwg) return false;
        int wgid = (int)L; { const int q = nwg / NXCD, r = nwg % NXCD, xcd = wgid % NXCD, off = wgid / NXCD; wgid = (xcd < r ? xcd * (q + 1) : r * (q + 1) + (xcd - r) * q) + off; }
        const int nig = WGM * nN, gid = wgid / nig, fm = gid * WGM, gsz = (nM - fm) < WGM ? (nM - fm) : WGM;
        u.pm = fm + ((wgid % nig) % gsz); u.pn = (wgid % nig) / gsz; return true;
    }
    __device__ __forceinline__ void a_ready(const Unit&) const {}
    __device__ __forceinline__ void done(const Unit&) const {}
};
__device__ __forceinline__ unsigned cvt_pk_bf16(float lo, float hi) { unsigned r; asm volatile("v_cvt_pk_bf16_f32 %0, %1, %2" : "=v"(r) : "v"(lo), "v"(hi)); return r; }
template <class Epi, class Sched, bool ALIGN_EPI = false, bool SP2 = false>
__device__ __forceinline__ void gemm_phase(PG8_LAS unsigned char* lds, const Gemm g, const Sched& S, const Epi& E) {
    int tid_ = threadIdx.x; asm volatile("" : "+v"(tid_)); const int tid = tid_, wid = __builtin_amdgcn_readfirstlane(tid >> 6), lane = tid & 63, wr = wid >> 2, wc = wid & 3, fr = lane & 15, fq = lane >> 4;
    const int K = g.K, nt = K / BK;
    unsigned voffA[2], voffB[2];
#pragma unroll
    for (int i = 0; i < 2; ++i) { int R, C; stage_rc(tid * 16 + i * 8192, R, C); const int Rb = Epi::PERM ? ((R & ~31) + perm32(R & 31)) : R;
        voffA[i] = (unsigned)(R * K + C) * 2u; voffB[i] = (unsigned)(Rb * K + C) * 2u; }
    const size_t kstep = (size_t)(BK * 2);
    const size_t hstep = (size_t)HALF * K * 2;
    const size_t tstep = 2 * hstep;
    const unsigned ldsw = (unsigned)wid * 1024u;
    const int aoff = lds_byte(wr * 64 + fr, fq * 8), boff = lds_byte(wc * 32 + fr, fq * 8);
#define PG8_SA(b, h) (((b) * 2 + (h)) * HTB)
#define PG8_SB(b, h) ((4 + (b) * 2 + (h)) * HTB)
#define PG8_STAGE(bufoff, gbase, voff) do { _Pragma("unroll") for (int _i = 0; _i < 2; ++_i) \
        __builtin_amdgcn_global_load_lds((const unsigned*)((const char*)(gbase) + (voff)[_i]), (PG8_LAS unsigned*)(lds + (bufoff) + ldsw + _i * 8192), 16, 0, 0); } while (0)
#define PG8_LDA(dst, b, h) do { _Pragma("unroll") for (int m = 0; m < 4; ++m) _Pragma("unroll") for (int k = 0; k < 2; ++k) dst[m][k] = *(const PG8_LAS bf16x8*)(lds + PG8_SA(b, h) + aoff + m * 2048 + k * 1024); } while (0)
#define PG8_LDB(dst, b, h) do { _Pragma("unroll") for (int n = 0; n < 2; ++n) _Pragma("unroll") for (int k = 0; k < 2; ++k) dst[n][k] = *(const PG8_LAS bf16x8*)(lds + PG8_SB(b, h) + boff + n * 2048 + k * 1024); } while (0)
#define PG8_MMA(ai, bj, At, Bt) do { __builtin_amdgcn_s_setprio(1); _Pragma("unroll") for (int m = 0; m < 4; ++m) _Pragma("unroll") for (int n = 0; n < 2; ++n) _Pragma("unroll") for (int k = 0; k < 2; ++k) \
        acc[ai][bj][m][n] = __builtin_amdgcn_mfma_f32_16x16x32_bf16(Bt[n][k], At[m][k], acc[ai][bj][m][n], 0, 0, 0); __builtin_amdgcn_s_setprio(0); } while (0)
#define PG8_WAIT_V(n) asm volatile("s_waitcnt vmcnt(" #n ")" ::: "memory")
#define PG8_WAIT_L(n) asm volatile("s_waitcnt lgkmcnt(" #n ")" ::: "memory")
#define PG8_BAR __builtin_amdgcn_s_barrier()
#define PG8_SCHED __builtin_amdgcn_sched_barrier(0)
    Unit cur, nxt; int ui = 0;
    if (!S.next(0, cur)) return;
    f32x4 acc[2][2][4][2];
#pragma unroll
    for (int a = 0; a < 2; ++a)
#pragma unroll
        for (int b = 0; b < 2; ++b)
#pragma unroll
            for (int m = 0; m < 4; ++m)
#pragma unroll
                for (int n = 0; n < 2; ++n) acc[a][b][m][n] = (f32x4){0.f, 0.f, 0.f, 0.f};
    bf16x8 At[4][2], B0[2][2], B1[2][2];
    const char* cA = (const char*)g.A + (size_t)cur.pm * tstep; const char* cB = (const char*)g.Bt + (size_t)cur.pn * tstep;
    S.a_ready(cur);
    if constexpr (SP2) {
        PG8_STAGE(PG8_SB(0, 0), cB, voffB); PG8_STAGE(PG8_SB(0, 1), cB + hstep, voffB); PG8_STAGE(PG8_SA(0, 0), cA, voffA); PG8_STAGE(PG8_SA(0, 1), cA + hstep, voffA);
        if (wr == 1) PG8_BAR;
        PG8_WAIT_V(2); PG8_BAR;
        PG8_STAGE(PG8_SB(1, 0), cB + kstep, voffB); PG8_STAGE(PG8_SA(1, 0), cA + kstep, voffA); PG8_STAGE(PG8_SB(1, 1), cB + hstep + kstep, voffB);
        PG8_WAIT_V(6); PG8_BAR;
    } else {
        PG8_STAGE(PG8_SB(0, 0), cB, voffB); PG8_STAGE(PG8_SA(0, 0), cA, voffA); PG8_STAGE(PG8_SB(0, 1), cB + hstep, voffB); PG8_STAGE(PG8_SA(0, 1), cA + hstep, voffA);
        if (wr == 1) PG8_BAR;
        PG8_WAIT_V(4); PG8_BAR;
        PG8_STAGE(PG8_SB(1, 0), cB + kstep, voffB); PG8_STAGE(PG8_SA(1, 0), cA + kstep, voffA); PG8_STAGE(PG8_SB(1, 1), cB + hstep + kstep, voffB);
        PG8_WAIT_V(6); PG8_BAR;
    }
    for (;;) {
        const bool has_next = S.next(ui + 1, nxt);
        const char* nA = has_next ? (const char*)g.A + (size_t)nxt.pm * tstep : cA; const char* nB = has_next ? (const char*)g.Bt + (size_t)nxt.pn * tstep : cB;
        for (int t = 0; t < nt; t += 2) {
            const bool last = (t == nt - 2);
            const char* a1 = cA + (size_t)(t + 1) * kstep;
            const char* a2 = last ? nA : cA + (size_t)(t + 2) * kstep; const char* b2 = last ? nB : cB + (size_t)(t + 2) * kstep;
            const char* a3 = a2 + kstep; const char* b3 = b2 + kstep;
            if (last && has_next) S.a_ready(nxt);
            if constexpr (SP2) {
            PG8_LDB(B0, 0, 0); PG8_LDB(B1, 0, 1); PG8_SCHED; PG8_LDA(At, 0, 0); PG8_STAGE(PG8_SA(1, 1), a1 + hstep, voffA);
            PG8_WAIT_V(8); PG8_WAIT_L(0); PG8_BAR; PG8_MMA(0, 0, At, B0); PG8_MMA(0, 1, At, B1); PG8_BAR; PG8_SCHED;
            PG8_LDA(At, 0, 1); PG8_STAGE(PG8_SB(0, 0), b2, voffB); PG8_STAGE(PG8_SB(0, 1), b2 + hstep, voffB); PG8_STAGE(PG8_SA(0, 0), a2, voffA);
            PG8_WAIT_V(8); PG8_WAIT_L(0); PG8_BAR; PG8_MMA(1, 0, At, B0); PG8_MMA(1, 1, At, B1); PG8_BAR; PG8_SCHED;
            PG8_LDB(B0, 1, 0); PG8_LDB(B1, 1, 1); PG8_SCHED; PG8_LDA(At, 1, 0); PG8_STAGE(PG8_SA(0, 1), a2 + hstep, voffA);
            PG8_WAIT_V(8); PG8_WAIT_L(0); PG8_BAR; PG8_MMA(0, 0, At, B0); PG8_MMA(0, 1, At, B1); PG8_BAR; PG8_SCHED;
            PG8_LDA(At, 1, 1); PG8_STAGE(PG8_SB(1, 0), b3, voffB); PG8_STAGE(PG8_SB(1, 1), b3 + hstep, voffB); PG8_STAGE(PG8_SA(1, 0), a3, voffA);
            PG8_WAIT_V(8); PG8_WAIT_L(0); PG8_BAR; PG8_MMA(1, 0, At, B0); PG8_MMA(1, 1, At, B1); PG8_BAR; PG8_SCHED;
            } else {
            PG8_LDB(B0, 0, 0); PG8_SCHED; PG8_LDA(At, 0, 0); PG8_STAGE(PG8_SA(1, 1), a1 + hstep, voffA);
            PG8_WAIT_L(8); PG8_BAR; PG8_WAIT_L(0); PG8_MMA(0, 0, At, B0); PG8_BAR; PG8_SCHED;
            PG8_LDB(B1, 0, 1); PG8_STAGE(PG8_SB(0, 0), b2, voffB);
            PG8_BAR; PG8_WAIT_L(0); PG8_MMA(0, 1, At, B1); PG8_BAR;
            PG8_LDA(At, 0, 1); PG8_STAGE(PG8_SA(0, 0), a2, voffA);
            PG8_BAR; PG8_WAIT_L(0); PG8_MMA(1, 0, At, B0); PG8_BAR; PG8_SCHED;
            PG8_STAGE(PG8_SB(0, 1), b2 + hstep, voffB);
            PG8_WAIT_V(6); PG8_BAR; PG8_MMA(1, 1, At, B1); PG8_BAR;
            PG8_LDB(B0, 1, 0); PG8_SCHED; PG8_LDA(At, 1, 0); PG8_STAGE(PG8_SA(0, 1), a2 + hstep, voffA);
            PG8_WAIT_L(8); PG8_BAR; PG8_WAIT_L(0); PG8_MMA(0, 0, At, B0); PG8_BAR; PG8_SCHED;
            PG8_LDB(B1, 1, 1); PG8_STAGE(PG8_SB(1, 0), b3, voffB);
            PG8_BAR; PG8_WAIT_L(0); PG8_MMA(0, 1, At, B1); PG8_BAR;
            PG8_LDA(At, 1, 1); PG8_STAGE(PG8_SA(1, 0), a3, voffA);
            PG8_BAR; PG8_WAIT_L(0); PG8_MMA(1, 0, At, B0); PG8_BAR; PG8_SCHED;
            PG8_STAGE(PG8_SB(1, 1), b3 + hstep, voffB);
            PG8_WAIT_V(6); PG8_BAR; PG8_MMA(1, 1, At, B1); PG8_BAR;
            }
        }
        if constexpr (ALIGN_EPI) { if (wr == 0) PG8_BAR; }
        if constexpr (!Epi::AFTER_DRAIN) { E(acc, cur, wr, wc, fr, fq); S.done(cur); }
        if (!has_next) break;
#pragma unroll
        for (int a = 0; a < 2; ++a)
#pragma unroll
            for (int b = 0; b < 2; ++b)
#pragma unroll
                for (int m = 0; m < 4; ++m)
#pragma unroll
                    for (int n = 0; n < 2; ++n) acc[a][b][m][n] = (f32x4){0.f, 0.f, 0.f, 0.f};
        cur = nxt; cA = nA; cB = nB; ++ui;
        if constexpr (ALIGN_EPI) { if (wr == 1) PG8_BAR; }
    }
    PG8_WAIT_V(0);
    if constexpr (!ALIGN_EPI) { if (wr == 0) PG8_BAR; }
    PG8_BAR;
    if constexpr (Epi::AFTER_DRAIN) { E.fused(acc, cur, wr, wc, fr, fq, lds, wid, lane); S.done(cur); }
#undef PG8_SA
#undef PG8_SB
#undef PG8_STAGE
#undef PG8_LDA
#undef PG8_LDB
#undef PG8_MMA
#undef PG8_WAIT_V
#undef PG8_WAIT_L
#undef PG8_BAR
#undef PG8_SCHED
}
}

#define LAS __attribute__((address_space(3)))
typedef unsigned short bf16_t;
typedef short bf16x8 __attribute__((ext_vector_type(8)));
typedef float f32x4 __attribute__((ext_vector_type(4)));
typedef float f32x2 __attribute__((ext_vector_type(2)));
typedef float f32x16 __attribute__((ext_vector_type(16)));
typedef unsigned u32x4 __attribute__((ext_vector_type(4)));
typedef unsigned u32x2 __attribute__((ext_vector_type(2)));

#ifndef GEMM_ALIGN
#define GEMM_ALIGN true
#endif
#ifndef GEMM_SP2
#define GEMM_SP2 true
#endif
#ifndef N_LAUNCH_MODE
#define N_LAUNCH_MODE 1
#endif

constexpr int D = 2048, T = 16384, CL = 256, R = T + CL, DIN = 5120, NCHK = R / 128;
constexpr int NPHASE = 13;
constexpr float EPS = 1e-6f;
constexpr int LDS_BYTES = 131072 + 4096;

constexpr size_t WS_WINT = 0;
constexpr size_t WS_WOUTT = WS_WINT + (size_t)2 * DIN * D * 2;
constexpr size_t WS_XG = WS_WOUTT + (size_t)2 * D * D * 2;
constexpr size_t WS_PX = WS_XG + (size_t)R * D * 2;
constexpr size_t WS_Y = WS_PX + (size_t)R * DIN * 2;
constexpr size_t WS_X1C = WS_Y + (size_t)R * D * 2;
constexpr size_t WS_MOD = WS_X1C + (size_t)CL * D * 4;
constexpr size_t WS_GG = WS_MOD + (size_t)2 * 2 * 6144 * 4;
constexpr size_t WS_SHW = WS_GG + (size_t)2 * 2 * D * 4;
constexpr size_t WS_RSS = WS_SHW + (size_t)2 * 2 * DIN * 4;
constexpr size_t WS_GW = WS_RSS + (size_t)3 * R * 4 + 64;
constexpr size_t WS_SW = WS_GW + (size_t)2 * 16 * 2 * 2 * 2 * 4 * 64 * 8 * 2;
constexpr size_t WS_AGG = WS_SW + (size_t)2 * 8 * 128 * 128 * 2;
constexpr size_t WS_CARRY = WS_AGG + (size_t)2 * NCHK * 1024 * 8;
constexpr size_t WS_BAR = (WS_CARRY + (size_t)2 * NCHK * 1024 * 4 + 255) / 256 * 256;
constexpr size_t WS_DL0 = WS_BAR + 16384;
constexpr size_t WS_END = WS_DL0 + (size_t)T * D * 2;

struct Args { const float* in[25]; float* out; unsigned char* ws; int ph_lo, ph_hi; };

__device__ __forceinline__ float bflo(unsigned w) { return __uint_as_float(w << 16); }
__device__ __forceinline__ float bfhi(unsigned w) { return __uint_as_float(w & 0xffff0000u); }
__device__ __forceinline__ float bf1(bf16_t h) { return __uint_as_float((unsigned)h << 16); }
__device__ __forceinline__ unsigned pk2(float lo, float hi) { return pg8::cvt_pk_bf16(lo, hi); }
__device__ __forceinline__ bf16_t f2bf(float f) { return (bf16_t)(pk2(f, 0.f) & 0xffffu); }
__device__ __forceinline__ float rcpf_(float x) { return __builtin_amdgcn_rcpf(x); }
__device__ __forceinline__ float sigm(float x) { return rcpf_(1.0f + __expf(-x)); }
__device__ __forceinline__ float silu(float x) { return x * sigm(x); }
__device__ __forceinline__ float gelu_t(float x) { return x * sigm(1.5957691216f * (x + 0.044715f * x * x * x)); }
template <int CTRL> __device__ __forceinline__ float dpp_mov(float v) { return __int_as_float(__builtin_amdgcn_update_dpp(0, __float_as_int(v), CTRL, 0xf, 0xf, true)); }
__device__ __forceinline__ float wave_sum(float v) {
    v += dpp_mov<0xB1>(v);
    v += dpp_mov<0x4E>(v);
    v += dpp_mov<0x141>(v);
    v += dpp_mov<0x140>(v);
    const int iv = __float_as_int(v);
    return (__int_as_float(__builtin_amdgcn_readlane(iv, 0)) + __int_as_float(__builtin_amdgcn_readlane(iv, 16))) + (__int_as_float(__builtin_amdgcn_readlane(iv, 32)) + __int_as_float(__builtin_amdgcn_readlane(iv, 48)));
}
__device__ __forceinline__ int tid_fresh() { int t = threadIdx.x; asm volatile("" : "+v"(t)); return t; }
#define GAS __attribute__((address_space(1)))
__device__ __forceinline__ unsigned char* ptr_fresh(unsigned char* p) {
#ifdef FLAT_WS
    asm volatile("" : "+s"(p)); return p; }
#else
    unsigned long long v = (unsigned long long)p; asm volatile("" : "+s"(v)); return (unsigned char*)(GAS unsigned char*)v; }
#endif
#define LDS_WAIT() asm volatile("s_waitcnt lgkmcnt(0)" ::: "memory")

struct EpiIn {
    static constexpr bool PERM = true, AFTER_DRAIN = false;
    bf16_t* PX; const float* rss; const float* shw;
    __device__ __forceinline__ void operator()(const f32x4 (&acc)[2][2][4][2], const pg8::Unit& u, int wr, int wc, int fr, int fq) const {
        const int row0 = CL + u.pm * 256 + wr * 64 + fr, col0 = u.pn * 256 + wc * 32 + 8 * fq;
        const float* sw = shw + col0;
        f32x4 bv[2][2];
#pragma unroll
        for (int bj = 0; bj < 2; ++bj)
#pragma unroll
            for (int n = 0; n < 2; ++n) bv[bj][n] = *(const f32x4*)(sw + bj * 128 + 4 * n);
#pragma unroll
        for (int ai = 0; ai < 2; ++ai)
#pragma unroll
            for (int m = 0; m < 4; ++m) {
                const int r = row0 + ai * 128 + m * 16;
                const float rs = 1.0f / sqrtf(rss[r] * (1.0f / D) + EPS);
                bf16_t* rowp = PX + (size_t)r * DIN + col0;
#pragma unroll
                for (int bj = 0; bj < 2; ++bj) {
                    const f32x4 v0 = acc[ai][bj][m][0] * rs + bv[bj][0], v1 = acc[ai][bj][m][1] * rs + bv[bj][1];
                    u32x4 w; w.x = pk2(v0[0], v0[1]); w.y = pk2(v0[2], v0[3]); w.z = pk2(v1[0], v1[1]); w.w = pk2(v1[2], v1[3]);
                    *(u32x4*)(rowp + bj * 128) = w;
                }
            }
    }
};
struct EpiOut {
    static constexpr bool PERM = true, AFTER_DRAIN = false;
    int row_off, last;
    const float* xold_lat; const float* xold_ctx; float* xnew_lat; float* xnew_ctx;
    const float* gvec;
    const float* ggn;
    bf16_t* XG; float* rssn;
    __device__ __forceinline__ void operator()(const f32x4 (&acc)[2][2][4][2], const pg8::Unit& u, int wr, int wc, int fr, int fq) const {
        const int gbase = row_off + u.pm * 256;
        const bool isctx = gbase < CL;
        const int seg = isctx ? 1 : 0;
        const int grow0 = gbase + wr * 64 + fr, col0 = u.pn * 256 + wc * 32 + 8 * fq;
        const float* xo = isctx ? xold_ctx : (xold_lat - (size_t)CL * D);
        float* xn = isctx ? xnew_ctx : (xnew_lat - (size_t)CL * D);
        const float* gp = gvec + seg * 6144 + 4096 + col0;
        const float* ggp = ggn + seg * D + col0;
        f32x4 gv[2][2], gg[2][2];
#pragma unroll
        for (int bj = 0; bj < 2; ++bj)
#pragma unroll
            for (int n = 0; n < 2; ++n) { gv[bj][n] = *(const f32x4*)(gp + bj * 128 + 4 * n); gg[bj][n] = last ? (f32x4){0.f, 0.f, 0.f, 0.f} : *(const f32x4*)(ggp + bj * 128 + 4 * n); }
#pragma unroll
        for (int ai = 0; ai < 2; ++ai)
#pragma unroll
            for (int m = 0; m < 4; ++m) {
                const int r = grow0 + ai * 128 + m * 16;
                const size_t ro = (size_t)r * D + col0;
                float ss = 0.f;
#pragma unroll
                for (int bj = 0; bj < 2; ++bj) {
                    const f32x4 o0 = *(const f32x4*)(xo + ro + bj * 128), o1 = *(const f32x4*)(xo + ro + bj * 128 + 4);
                    const f32x4 v0 = o0 + gv[bj][0] * acc[ai][bj][m][0], v1 = o1 + gv[bj][1] * acc[ai][bj][m][1];
                    *(f32x4*)(xn + ro + bj * 128) = v0; *(f32x4*)(xn + ro + bj * 128 + 4) = v1;
                    ss += (v0[0] * v0[0] + v0[1] * v0[1]) + (v0[2] * v0[2] + v0[3] * v0[3]) + (v1[0] * v1[0] + v1[1] * v1[1]) + (v1[2] * v1[2] + v1[3] * v1[3]);
                    if (!last) {
                        const f32x4 a0 = v0 * gg[bj][0], a1 = v1 * gg[bj][1];
                        u32x4 w; w.x = pk2(a0[0], a0[1]); w.y = pk2(a0[2], a0[3]); w.z = pk2(a1[0], a1[1]); w.w = pk2(a1[2], a1[3]);
                        *(u32x4*)(XG + ro + bj * 128) = w;
                    }
                }
                ss += __shfl_xor(ss, 16); ss += __shfl_xor(ss, 32);
                if (fq == 0) unsafeAtomicAdd(rssn + r, ss);
            }
    }
};

struct EpiDelta {
    static constexpr bool PERM = true, AFTER_DRAIN = false;
    bf16_t* DL; const float* gvec;
    __device__ __forceinline__ void operator()(const f32x4 (&acc)[2][2][4][2], const pg8::Unit& u, int wr, int wc, int fr, int fq) const {
        const int row0 = u.pm * 256 + wr * 64 + fr, col0 = u.pn * 256 + wc * 32 + 8 * fq;
        f32x4 gv[2][2];
#pragma unroll
        for (int bj = 0; bj < 2; ++bj)
#pragma unroll
            for (int n = 0; n < 2; ++n) gv[bj][n] = *(const f32x4*)(gvec + col0 + bj * 128 + 4 * n);
#pragma unroll
        for (int ai = 0; ai < 2; ++ai)
#pragma unroll
            for (int m = 0; m < 4; ++m) {
                bf16_t* rowp = DL + (size_t)(row0 + ai * 128 + m * 16) * D + col0;
#pragma unroll
                for (int bj = 0; bj < 2; ++bj) {
                    const f32x4 v0 = acc[ai][bj][m][0] * gv[bj][0], v1 = acc[ai][bj][m][1] * gv[bj][1];
                    u32x4 w; w.x = pk2(v0[0], v0[1]); w.y = pk2(v0[2], v0[3]); w.z = pk2(v1[0], v1[1]); w.w = pk2(v1[2], v1[3]);
                    *(u32x4*)(rowp + bj * 128) = w;
                }
            }
    }
};

__device__ __forceinline__ void transpose_item(const float* W, int K, int N, bf16_t* WT, LAS float* scr, int item, int lane) {
    const int nblk = N / 32, kb = item / nblk, nb = item % nblk, k0 = 64 * kb, n0 = 32 * nb;
#pragma unroll 8
    for (int i = 0; i < 32; ++i) { const int kk = 2 * i + (lane >> 5); scr[kk * 33 + (lane & 31)] = __builtin_nontemporal_load(W + (size_t)(k0 + kk) * N + n0 + (lane & 31)); }
    LDS_WAIT();
    const int c = lane & 7;
#pragma unroll
    for (int j = 0; j < 4; ++j) { const int n = (lane >> 3) + 8 * j; const LAS float* s = scr + (8 * c) * 33 + n;
        u32x4 o; o.x = pk2(s[0 * 33], s[1 * 33]); o.y = pk2(s[2 * 33], s[3 * 33]); o.z = pk2(s[4 * 33], s[5 * 33]); o.w = pk2(s[6 * 33], s[7 * 33]);
        *(u32x4*)(WT + (size_t)(n0 + n) * K + k0 + 8 * c) = o; }
    LDS_WAIT();
}

__device__ __forceinline__ void phase0a(const Args a, LAS unsigned char* lds) {
    const int tid = tid_fresh(), lane = tid & 63, wave = tid >> 6, b = blockIdx.x, G = gridDim.x;
    unsigned char* ws = ptr_fresh(a.ws);
    { float* rss = (float*)(ws + WS_RSS); for (int i = b * 512 + tid; i < 2 * R; i += G * 512) rss[R + i] = 0.f; }
    { bf16_t* GW = (bf16_t*)(ws + WS_GW);
      for (int gid = b * 512 + tid; gid < 2 * 16 * 2 * 2 * 2 * 4 * 64; gid += G * 512) {
          int x = gid; const int ln = x & 63; x >>= 6; const int s = x & 3; x >>= 2; const int half = x & 1; x >>= 1; const int gate = x & 1; x >>= 1; const int dir = x & 1; x >>= 1; const int hd = x & 15; x >>= 4; const int l = x;
          const float* w = (gate ? a.in[14] : a.in[12]) + ((size_t)((l * 2 + dir) * 16 + hd)) * 4096;
          const int col = 32 * half + (ln & 31), k0 = 16 * s + 8 * (ln >> 5);
          float v[8];
#pragma unroll
          for (int j = 0; j < 8; ++j) v[j] = w[(k0 + j) * 64 + col];
          u32x4 o; o.x = pk2(v[0], v[1]); o.y = pk2(v[2], v[3]); o.z = pk2(v[4], v[5]); o.w = pk2(v[6], v[7]);
          *(u32x4*)(GW + (size_t)gid * 8) = o;
      } }
    { bf16_t* SW = (bf16_t*)(ws + WS_SW); const float* sw = a.in[22];
      for (int i = b * 512 + tid; i < 2 * 8 * 128 * 128 / 4; i += G * 512) { const f32x4 v = *(const f32x4*)(sw + (size_t)i * 4); u32x2 o; o.x = pk2(v[0], v[1]); o.y = pk2(v[2], v[3]); *(u32x2*)(SW + (size_t)i * 4) = o; } }
    { const float* c = a.in[1]; const float* cc = a.in[3]; float* MOD = (float*)(ws + WS_MOD);
      LAS float* red = (LAS float*)lds;
      for (int u = b; u < 192; u += G) {
          const int l = u / 96, n0 = (u % 96) * 64, q = tid & 15, ks = tid >> 4;
          const float* W = a.in[4] + (size_t)l * D * 6144 + n0 + 4 * q;
          f32x4 a0 = {0.f, 0.f, 0.f, 0.f}, a1 = {0.f, 0.f, 0.f, 0.f};
#pragma unroll 8
          for (int kk = 0; kk < 64; ++kk) { const int k = ks * 64 + kk; const f32x4 wv = __builtin_nontemporal_load((const f32x4*)(W + (size_t)k * 6144)); const float ca = silu(c[k]), cb = silu(cc[k]); a0 += wv * ca; a1 += wv * cb; }
          LAS float* rp = red + (ks * 16 + q) * 8;
          *(LAS f32x4*)rp = a0; *(LAS f32x4*)(rp + 4) = a1;
          __syncthreads();
          if (tid < 128) { const int qq = tid >> 3, e = tid & 7; float s = 0.f;
#pragma unroll 8
              for (int k2 = 0; k2 < 32; ++k2) s += red[(k2 * 16 + qq) * 8 + e];
              const int seg = e >> 2, col = n0 + 4 * qq + (e & 3);
              MOD[(l * 2 + seg) * 6144 + col] = s + a.in[5][l * 6144 + col]; }
          __syncthreads();
      } }
    { LAS float* scr = (LAS float*)(lds + wave * 16384);
      const int gw = b * 8 + wave, NGW = G * 8;
      constexpr int I_IN = (D / 64) * (DIN / 32), I_OUT = (D / 64) * (D / 32);
      for (int it = gw; it < 2 * I_IN + 2 * I_OUT; it += NGW) {
          int r = it;
          if (r < 2 * I_IN) { const int l = r / I_IN; transpose_item(a.in[7] + (size_t)l * D * DIN, D, DIN, (bf16_t*)(ws + WS_WINT) + (size_t)l * DIN * D, scr, r % I_IN, lane); continue; }
          r -= 2 * I_IN; { const int l = r / I_OUT; transpose_item(a.in[8] + (size_t)l * D * D, D, D, (bf16_t*)(ws + WS_WOUTT) + (size_t)l * D * D, scr, r % I_OUT, lane); }
      } }
}

__device__ __forceinline__ void phase0b(const Args a, LAS unsigned char* lds) {
    const int tid = tid_fresh(), lane = tid & 63, wave = tid >> 6, b = blockIdx.x, G = gridDim.x;
    unsigned char* ws = ptr_fresh(a.ws);
    const float* MOD = (const float*)(ws + WS_MOD);
    LAS float* GG0 = (LAS float*)lds;
    LAS float* SH = (LAS float*)(lds + 16384);
    for (int i = tid; i < 2 * D; i += 512) { const int seg = i >> 11, k = i & 2047; float gv_ = a.in[6][k] * (1.0f + MOD[seg * 6144 + 2048 + k]); if (gv_ == 0.f) gv_ = 1e-30f; GG0[i] = gv_; }
    for (int i = tid; i < 4 * D; i += 512) { const int ls = i >> 11, k = i & 2047; SH[i] = MOD[ls * 6144 + k]; }
    { float* GGt = (float*)(ws + WS_GG); for (int i = b * 512 + tid; i < 4 * D; i += G * 512) { const int ls = i >> 11, l = ls >> 1, k = i & 2047; float gv_ = a.in[6][l * D + k] * (1.0f + MOD[ls * 6144 + 2048 + k]); if (gv_ == 0.f) gv_ = 1e-30f; GGt[i] = gv_; } }
    __syncthreads();
    const int gw = b * 8 + wave, NGW = G * 8;
    { bf16_t* XG = (bf16_t*)(ws + WS_XG); float* rss = (float*)(ws + WS_RSS);
      f32x4 vr[8];
#define P0B_LOAD(r_, V) do { const float* _src = (r_) < CL ? a.in[2] + (size_t)(r_) * D : a.in[0] + (size_t)((r_) - CL) * D; \
          _Pragma("unroll") for (int j = 0; j < 8; ++j) V[j] = __builtin_nontemporal_load((const f32x4*)(_src + 4 * (lane + 64 * j))); } while (0)
      int r = gw;
      if (r < R) P0B_LOAD(r, vr);
      for (; r < R; r += NGW) {
          f32x4 vn[8];
          const int rn = r + NGW;
          if (rn < R) P0B_LOAD(rn, vn);
          const int seg = r < CL ? 1 : 0;
          float ss = 0.f;
#pragma unroll
          for (int j = 0; j < 8; ++j) ss += (vr[j][0] * vr[j][0] + vr[j][1] * vr[j][1]) + (vr[j][2] * vr[j][2] + vr[j][3] * vr[j][3]);
#pragma unroll
          for (int j = 0; j < 8; ++j) { const f32x4 g = *(LAS f32x4*)(GG0 + seg * D + 4 * (lane + 64 * j)); const f32x4 p = vr[j] * g; u32x2 o; o.x = pk2(p[0], p[1]); o.y = pk2(p[2], p[3]); *(u32x2*)(XG + (size_t)r * D + 4 * (lane + 64 * j)) = o; }
          ss = wave_sum(ss);
          if (lane == 0) rss[r] = ss;
          if (rn < R) {
#pragma unroll
              for (int j = 0; j < 8; ++j) vr[j] = vn[j];
          }
      }
#undef P0B_LOAD
    }
    { float* SHW = (float*)(ws + WS_SHW); const bf16_t* WinT = (const bf16_t*)(ws + WS_WINT);
      u32x4 wr[4];
#define SHW_LOAD(i_, W_) do { const bf16_t* _row = WinT + (size_t)(i_) * D; _Pragma("unroll") for (int j = 0; j < 4; ++j) W_[j] = *(const u32x4*)(_row + 8 * (lane + 64 * j)); } while (0)
      int idx = gw;
      if (idx < 2 * DIN) SHW_LOAD(idx, wr);
      for (; idx < 2 * DIN; idx += NGW) {
          u32x4 wn[4];
          const int idn = idx + NGW;
          if (idn < 2 * DIN) SHW_LOAD(idn, wn);
          const int l = idx / DIN, n = idx % DIN;
          float d0 = 0.f, d1 = 0.f;
#pragma unroll
          for (int j = 0; j < 4; ++j) { const int k = 8 * (lane + 64 * j); const u32x4 w = wr[j];
              const LAS float* s0 = SH + (l * 2 + 0) * D + k; const LAS float* s1 = SH + (l * 2 + 1) * D + k;
              const f32x4 x0 = *(LAS f32x4*)s0, x1 = *(LAS f32x4*)(s0 + 4), y0 = *(LAS f32x4*)s1, y1 = *(LAS f32x4*)(s1 + 4);
              const float w0 = bflo(w.x), w1 = bfhi(w.x), w2 = bflo(w.y), w3 = bfhi(w.y), w4 = bflo(w.z), w5 = bfhi(w.z), w6 = bflo(w.w), w7 = bfhi(w.w);
              d0 += (w0 * x0[0] + w1 * x0[1]) + (w2 * x0[2] + w3 * x0[3]) + (w4 * x1[0] + w5 * x1[1]) + (w6 * x1[2] + w7 * x1[3]);
              d1 += (w0 * y0[0] + w1 * y0[1]) + (w2 * y0[2] + w3 * y0[3]) + (w4 * y1[0] + w5 * y1[1]) + (w6 * y1[2] + w7 * y1[3]); }
          d0 = wave_sum(d0); d1 = wave_sum(d1);
          if (lane == 0) { SHW[(l * 2 + 0) * DIN + n] = d0; SHW[(l * 2 + 1) * DIN + n] = d1; }
          if (idn < 2 * DIN) {
#pragma unroll
              for (int j = 0; j < 4; ++j) wr[j] = wn[j];
          }
      }
#undef SHW_LOAD
    }
    __syncthreads();
}

constexpr int XLF_STRIDE = 68, XLB_STRIDE = 72;
constexpr int LRU_XLF = 0, LRU_XLB = 128 * XLF_STRIDE * 4, LRU_TAGG = LRU_XLB + 128 * XLB_STRIDE * 2;

template <bool PASSC>
__device__ __forceinline__ void lru_item(const Args a, int l, int chunk, int hd, LAS unsigned char* lds) {
    const int tid = tid_fresh(), lane = tid & 63, wave = tid >> 6;
    unsigned char* ws = ptr_fresh(a.ws);
    const bf16_t* PX = (const bf16_t*)(ws + WS_PX);
    LAS float* XLF = (LAS float*)(lds + LRU_XLF);
    LAS bf16_t* XLB = (LAS bf16_t*)(lds + LRU_XLB);
    LAS f32x2* TAGG = (LAS f32x2*)(lds + LRU_TAGG);
    __syncthreads();
    {
        const int t = tid >> 2, q = tid & 3, ch0 = hd * 64 + q * 16;
        const int grow = chunk * 128 + t, seg_lo = chunk < 2 ? 0 : CL, seg_hi = chunk < 2 ? CL : R;
        const float* cw = a.in[9] + (size_t)l * 4 * 1024 + ch0; const float* cb = a.in[10] + (size_t)l * 1024 + ch0;
        float xl[16];
#pragma unroll
        for (int c4 = 0; c4 < 4; ++c4) { const f32x4 bb = *(const f32x4*)(cb + 4 * c4); xl[4 * c4] = bb[0]; xl[4 * c4 + 1] = bb[1]; xl[4 * c4 + 2] = bb[2]; xl[4 * c4 + 3] = bb[3]; }
#pragma unroll
        for (int j = 0; j < 4; ++j) {
            const int rr = grow + j - 2;
            if (rr >= seg_lo && rr < seg_hi) {
                const u32x4 p0 = *(const u32x4*)(PX + (size_t)rr * DIN + ch0), p1 = *(const u32x4*)(PX + (size_t)rr * DIN + ch0 + 8);
                const unsigned pw[8] = {p0.x, p0.y, p0.z, p0.w, p1.x, p1.y, p1.z, p1.w};
#pragma unroll
                for (int c4 = 0; c4 < 4; ++c4) { const f32x4 wv = *(const f32x4*)(cw + j * 1024 + 4 * c4);
                    xl[4 * c4 + 0] += wv[0] * bflo(pw[2 * c4]); xl[4 * c4 + 1] += wv[1] * bfhi(pw[2 * c4]); xl[4 * c4 + 2] += wv[2] * bflo(pw[2 * c4 + 1]); xl[4 * c4 + 3] += wv[3] * bfhi(pw[2 * c4 + 1]); }
            }
        }
        LAS float* xf = XLF + t * XLF_STRIDE + q * 16;
#pragma unroll
        for (int c4 = 0; c4 < 4; ++c4) *(LAS f32x4*)(xf + 4 * c4) = (f32x4){xl[4 * c4], xl[4 * c4 + 1], xl[4 * c4 + 2], xl[4 * c4 + 3]};
        LAS bf16_t* xb = XLB + t * XLB_STRIDE + q * 16;
        u32x4 o0, o1; o0.x = pk2(xl[0], xl[1]); o0.y = pk2(xl[2], xl[3]); o0.z = pk2(xl[4], xl[5]); o0.w = pk2(xl[6], xl[7]); o1.x = pk2(xl[8], xl[9]); o1.y = pk2(xl[10], xl[11]); o1.z = pk2(xl[12], xl[13]); o1.w = pk2(xl[14], xl[15]);
        *(LAS u32x4*)xb = o0; *(LAS u32x4*)(xb + 8) = o1;
    }
    __syncthreads();
    const int tw = wave >> 1, chh = wave & 1, cl = lane & 31, hh = lane >> 5;
    const int cin = 32 * chh + cl, cg_ = hd * 64 + cin;
    bf16x8 Af[4];
#pragma unroll
    for (int s = 0; s < 4; ++s) Af[s] = *(const LAS bf16x8*)(XLB + (32 * tw + cl) * XLB_STRIDE + 16 * s + 8 * hh);
    float xlv[16];
#pragma unroll
    for (int i = 0; i < 16; ++i) xlv[i] = XLF[(32 * tw + (i & 3) + 8 * (i >> 2) + 4 * hh) * XLF_STRIDE + cin];
    float av[2][16], bv[2][16];
    float GA[2][8], GB[2][8];
    const bf16_t* GW = (const bf16_t*)(ws + WS_GW);
#pragma unroll
    for (int dir = 0; dir < 2; ++dir) {
        f32x16 ar, ai;
#pragma unroll
        for (int i = 0; i < 16; ++i) { ar[i] = 0.f; ai[i] = 0.f; }
#pragma unroll
        for (int s = 0; s < 4; ++s) {
            const size_t gr = ((((((size_t)(l * 16 + hd) * 2 + dir) * 2 + 0) * 2 + chh) * 4 + s) * 64 + lane) * 8;
            const size_t gi = ((((((size_t)(l * 16 + hd) * 2 + dir) * 2 + 1) * 2 + chh) * 4 + s) * 64 + lane) * 8;
            const bf16x8 Br = *(const bf16x8*)(GW + gr), Bi = *(const bf16x8*)(GW + gi);
            ar = __builtin_amdgcn_mfma_f32_32x32x16_bf16(Af[s], Br, ar, 0, 0, 0);
            ai = __builtin_amdgcn_mfma_f32_32x32x16_bf16(Af[s], Bi, ai, 0, 0, 0);
        }
        const float brv = a.in[13][(size_t)(l * 2 + dir) * 1024 + cg_], biv = a.in[15][(size_t)(l * 2 + dir) * 1024 + cg_];
        const float lam = a.in[11][(size_t)(l * 2 + dir) * 1024 + cg_];
        const float k8 = -8.0f * log1pf(__expf(-lam));
#pragma unroll
        for (int i = 0; i < 16; ++i) {
            const float rg = sigm(ar[i] + brv), ig = sigm(ai[i] + biv);
            const float la = k8 * rg;
            av[dir][i] = __expf(la);
            const float aa = av[dir][i]; bv[dir][i] = __builtin_amdgcn_sqrtf(fmaxf(1.0f - aa * aa, 0.f)) * ig * xlv[i];
        }
        float oA[4], oB[4];
#pragma unroll
        for (int g = 0; g < 4; ++g) {
            const float a0 = av[dir][4 * g], a1 = av[dir][4 * g + 1], a2 = av[dir][4 * g + 2], a3 = av[dir][4 * g + 3];
            const float b0 = bv[dir][4 * g], b1 = bv[dir][4 * g + 1], b2 = bv[dir][4 * g + 2], b3 = bv[dir][4 * g + 3];
            oA[g] = (a0 * a1) * (a2 * a3);
            oB[g] = dir == 0 ? ((b0 * a1 + b1) * a2 + b2) * a3 + b3 : ((b3 * a2 + b2) * a1 + b1) * a0 + b0;
        }
#pragma unroll
        for (int g = 0; g < 4; ++g) {
            const float pA = __shfl_xor(oA[g], 32), pB = __shfl_xor(oB[g], 32);
            GA[dir][2 * g] = hh ? pA : oA[g]; GA[dir][2 * g + 1] = hh ? oA[g] : pA;
            GB[dir][2 * g] = hh ? pB : oB[g]; GB[dir][2 * g + 1] = hh ? oB[g] : pB;
        }
        float tA = 1.f, tB = 0.f;
        if (dir == 0) {
#pragma unroll
            for (int gq = 0; gq < 8; ++gq) { tB = GA[dir][gq] * tB + GB[dir][gq]; tA *= GA[dir][gq]; }
        } else {
#pragma unroll
            for (int gq = 7; gq >= 0; --gq) { tB = GA[dir][gq] * tB + GB[dir][gq]; tA *= GA[dir][gq]; }
        }
        if (hh == 0) TAGG[(tw * 2 + dir) * 64 + cin] = (f32x2){tA, tB};
    }
    __syncthreads();
    if constexpr (!PASSC) {
        if (tid < 128) {
            const int dir = tid >> 6, c = tid & 63;
            float cA = 1.f, cB = 0.f;
#pragma unroll
            for (int k = 0; k < 4; ++k) { const int t2 = dir == 0 ? k : 3 - k; const f32x2 v = TAGG[(t2 * 2 + dir) * 64 + c]; cB = v[0] * cB + v[1]; cA *= v[0]; }
            f32x2* AGG = (f32x2*)(ws + WS_AGG);
            AGG[((size_t)dir * NCHK + chunk) * 1024 + hd * 64 + c] = (f32x2){cA, cB};
        }
    } else {
        const float* CARRY = (const float*)(ws + WS_CARRY);
        float yv[16];
#pragma unroll
        for (int dir = 0; dir < 2; ++dir) {
            float st = CARRY[((size_t)dir * NCHK + chunk) * 1024 + cg_];
            if (dir == 0) {
#pragma unroll
                for (int t2 = 0; t2 < 3; ++t2) if (t2 < tw) { const f32x2 v = TAGG[(t2 * 2 + 0) * 64 + cin]; st = v[0] * st + v[1]; }
            } else {
#pragma unroll
                for (int t2 = 3; t2 > 0; --t2) if (t2 > tw) { const f32x2 v = TAGG[(t2 * 2 + 1) * 64 + cin]; st = v[0] * st + v[1]; }
            }
            float hst[4];
            if (dir == 0) {
                float s = st;
#pragma unroll
                for (int g = 0; g < 4; ++g) { const float sE = s; s = GA[0][2 * g] * s + GB[0][2 * g]; const float sO = s; s = GA[0][2 * g + 1] * s + GB[0][2 * g + 1]; hst[g] = hh ? sO : sE; }
            } else {
                float s = st;
#pragma unroll
                for (int g = 3; g >= 0; --g) { const float sO = s; s = GA[1][2 * g + 1] * s + GB[1][2 * g + 1]; const float sE = s; s = GA[1][2 * g] * s + GB[1][2 * g]; hst[g] = hh ? sO : sE; }
            }
#pragma unroll
            for (int g = 0; g < 4; ++g) {
                float h = hst[g];
                if (dir == 0) {
#pragma unroll
                    for (int k = 0; k < 4; ++k) { h = av[0][4 * g + k] * h + bv[0][4 * g + k]; yv[4 * g + k] = h; }
                } else {
#pragma unroll
                    for (int k = 3; k >= 0; --k) { h = av[1][4 * g + k] * h + bv[1][4 * g + k]; yv[4 * g + k] += h; }
                }
            }
        }
        bf16_t* Y = (bf16_t*)(ws + WS_Y);
#pragma unroll
        for (int i = 0; i < 16; ++i) {
            const int row = chunk * 128 + 32 * tw + (i & 3) + 8 * (i >> 2) + 4 * hh;
            const float gt = bf1(PX[(size_t)row * DIN + 1024 + cg_]);
            Y[(size_t)row * D + cg_] = f2bf(yv[i] * silu(gt));
        }
    }
}

__device__ __forceinline__ void conv_item(const Args a, int l, int ct, LAS unsigned char* lds) {
    const int tid = tid_fresh(), lane = tid & 63, wave = tid >> 6, c = tid;
    unsigned char* ws = ptr_fresh(a.ws);
    const bf16_t* PX = (const bf16_t*)(ws + WS_PX); bf16_t* Y = (bf16_t*)(ws + WS_Y);
    LAS float* CB = (LAS float*)lds;
    const int t0 = ct * 128, seg_lo = ct < 2 ? 0 : CL, seg_hi = ct < 2 ? CL : R;
    float w[31];
#pragma unroll
    for (int j = 0; j < 31; ++j) w[j] = a.in[16][((size_t)l * 31 + j) * 512 + c];
    const float bias = a.in[17][l * 512 + c];
    float win[32];
#define CONV_Z(dst, rr_) do { const int _rr = (rr_); const int _rc = _rr < seg_lo ? seg_lo : (_rr >= seg_hi ? seg_hi - 1 : _rr); const float _v = bf1(PX[(size_t)_rc * DIN + 2048 + c]), _g = bf1(PX[(size_t)_rc * DIN + 2560 + c]); const float _z = _v * sigm(_g); dst = (_rr == _rc) ? _z : 0.f; } while (0)
#pragma unroll
    for (int e = 0; e < 30; ++e) CONV_Z(win[e], t0 - 15 + e);
    win[30] = 0.f; win[31] = 0.f;
    __syncthreads();
#pragma unroll 1
    for (int bb = 0; bb < 4; ++bb) {
        LAS float* cbuf = CB + (bb & 1) * (32 * 512);
#pragma unroll
        for (int u = 0; u < 32; ++u) {
            if ((u & 7) == 0) asm volatile("" ::: "memory");
            CONV_Z(win[(u + 30) & 31], t0 - 15 + 32 * bb + u + 30);
            float acc = bias;
#pragma unroll
            for (int j = 0; j < 31; ++j) acc += w[j] * win[(u + j) & 31];
            cbuf[u * 512 + c] = acc;
        }
        __syncthreads();
#pragma unroll 1
        for (int uu = 0; uu < 4; ++uu) {
            const int u = wave * 4 + uu, row = t0 + 32 * bb + u;
            float v[8]; float s = 0.f;
#pragma unroll
            for (int k = 0; k < 8; ++k) { v[k] = cbuf[u * 512 + lane + 64 * k]; s += v[k]; }
            const float mean = wave_sum(s) * (1.0f / 512.0f);
            float s2 = 0.f;
#pragma unroll
            for (int k = 0; k < 8; ++k) { v[k] -= mean; s2 += v[k] * v[k]; }
            const float rstd = 1.0f / sqrtf(wave_sum(s2) * (1.0f / 512.0f) + EPS);
#pragma unroll
            for (int k = 0; k < 8; ++k) {
                const int ch = lane + 64 * k;
                const float y = silu(v[k] * rstd * a.in[18][l * 512 + ch] + a.in[19][l * 512 + ch]);
                const float gt = bf1(PX[(size_t)row * DIN + 3072 + ch]);
                Y[(size_t)row * D + 1024 + ch] = f2bf(y * silu(gt));
            }
        }
    }
#undef CONV_Z
}

constexpr int TT_STRIDE = 136;
__device__ __forceinline__ void sgu_item(const Args a, int l, int sc, LAS unsigned char* lds) {
    const int tid = tid_fresh(), lane = tid & 63, wave = tid >> 6;
    unsigned char* ws = ptr_fresh(a.ws);
    const bf16_t* PX = (const bf16_t*)(ws + WS_PX); bf16_t* Y = (bf16_t*)(ws + WS_Y);
    const bf16_t* SW = (const bf16_t*)(ws + WS_SW) + (size_t)l * 8 * 128 * 128;
    LAS f32x2* ST = (LAS f32x2*)lds;
    LAS bf16_t* TT = (LAS bf16_t*)(lds + 1024);
    const int t0 = sc * 128;
    __syncthreads();
#pragma unroll 1
    for (int k = 0; k < 16; ++k) {
        const int tok = wave * 16 + k;
        const u32x4 p = *(const u32x4*)(PX + (size_t)(t0 + tok) * DIN + 4096 + 8 * lane);
        float g[8] = {gelu_t(bflo(p.x)), gelu_t(bfhi(p.x)), gelu_t(bflo(p.y)), gelu_t(bfhi(p.y)), gelu_t(bflo(p.z)), gelu_t(bfhi(p.z)), gelu_t(bflo(p.w)), gelu_t(bfhi(p.w))};
        float s = 0.f;
#pragma unroll
        for (int j = 0; j < 8; ++j) s += g[j];
        const float mean = wave_sum(s) * (1.0f / 512.0f);
        float s2 = 0.f;
#pragma unroll
        for (int j = 0; j < 8; ++j) { const float d = g[j] - mean; s2 += d * d; }
        const float rstd = 1.0f / sqrtf(wave_sum(s2) * (1.0f / 512.0f) + EPS);
        if (lane == 0) ST[tok] = (f32x2){mean, rstd};
    }
    __syncthreads();
    const int p_ = tid >> 2, dq = tid & 3;
    const f32x2 st = ST[p_];
    const int fr = lane & 15, fq = lane >> 4;
#pragma unroll 1
    for (int h = 0; h < 8; ++h) {
        LAS bf16_t* tt = TT + (h & 1) * (64 * TT_STRIDE);
        {
            const int ch = 64 * h + 16 * dq;
            const u32x4 q0 = *(const u32x4*)(PX + (size_t)(t0 + p_) * DIN + 4096 + ch), q1 = *(const u32x4*)(PX + (size_t)(t0 + p_) * DIN + 4096 + ch + 8);
            const unsigned pw[8] = {q0.x, q0.y, q0.z, q0.w, q1.x, q1.y, q1.z, q1.w};
            const float* lg = a.in[20] + l * 512 + ch; const float* lb = a.in[21] + l * 512 + ch;
#pragma unroll
            for (int j = 0; j < 8; ++j) {
                const float v0 = (gelu_t(bflo(pw[j])) - st[0]) * st[1] * lg[2 * j] + lb[2 * j];
                const float v1 = (gelu_t(bfhi(pw[j])) - st[0]) * st[1] * lg[2 * j + 1] + lb[2 * j + 1];
                tt[(16 * dq + 2 * j) * TT_STRIDE + p_] = f2bf(v0);
                tt[(16 * dq + 2 * j + 1) * TT_STRIDE + p_] = f2bf(v1);
            }
        }
        __syncthreads();
        f32x4 acc[4];
#pragma unroll
        for (int nt = 0; nt < 4; ++nt) acc[nt] = (f32x4){0.f, 0.f, 0.f, 0.f};
#pragma unroll
        for (int s = 0; s < 4; ++s) {
            const bf16x8 Afr = *(const bf16x8*)(SW + ((size_t)h * 128 + 16 * wave + fr) * 128 + 32 * s + 8 * fq);
#pragma unroll
            for (int nt = 0; nt < 4; ++nt) {
                const bf16x8 Bfr = *(const LAS bf16x8*)(tt + (16 * nt + fr) * TT_STRIDE + 32 * s + 8 * fq);
                acc[nt] = __builtin_amdgcn_mfma_f32_16x16x32_bf16(Afr, Bfr, acc[nt], 0, 0, 0);
            }
        }
#pragma unroll
        for (int reg = 0; reg < 4; ++reg) {
            const int q = 16 * wave + 4 * fq + reg, row = t0 + q;
            const float bs = a.in[23][((size_t)l * 8 + h) * 128 + q];
#pragma unroll
            for (int nt = 0; nt < 4; ++nt) {
                const int ch = 64 * h + 16 * nt + fr;
                const float uu = gelu_t(bf1(PX[(size_t)row * DIN + 3584 + ch]));
                const float gt = bf1(PX[(size_t)row * DIN + 4608 + ch]);
                Y[(size_t)row * D + 1536 + ch] = f2bf(uu * (acc[nt][reg] + bs) * silu(gt));
            }
        }
    }
}


constexpr int L2_GWL = 0;
constexpr int L2_CW = 32768;
constexpr int L2_RAW = 34816;
constexpr int RAW_ROWB = 144, RAW_BUFB = 132 * RAW_ROWB;
constexpr int L2_XLF = L2_RAW + 2 * RAW_BUFB;
constexpr int L2_XLB = L2_XLF + 128 * XLF_STRIDE * 4;
constexpr int L2_TAGG = L2_XLB + 128 * XLB_STRIDE * 2;
static_assert(L2_TAGG + 4096 <= LDS_BYTES, "lds map");

template <bool PASSC>
__device__ __forceinline__ void lru_phase(const Args a, int l, int c_lo, LAS unsigned char* lds) {
    const int tid = tid_fresh(), lane = tid & 63, wave = tid >> 6, b = blockIdx.x, G = gridDim.x;
    unsigned char* ws = ptr_fresh(a.ws);
    const bf16_t* PX = (const bf16_t*)(ws + WS_PX);
    const int hd = b & 15, cstep = G >> 4;
    int chunk = c_lo + (b >> 4);
    if (chunk >= NCHK) return;
    LAS float* CW = (LAS float*)(lds + L2_CW);
    LAS float* XLF = (LAS float*)(lds + L2_XLF);
    LAS bf16_t* XLB = (LAS bf16_t*)(lds + L2_XLB);
    LAS f32x2* TAGG = (LAS f32x2*)(lds + L2_TAGG);
    __syncthreads();
    {
        const bf16_t* GW = (const bf16_t*)(ws + WS_GW) + (size_t)(l * 16 + hd) * 16384;
#pragma unroll
        for (int i = 0; i < 4; ++i) *(LAS u32x4*)(lds + L2_GWL + (tid + 512 * i) * 16) = *(const u32x4*)(GW + (size_t)(tid + 512 * i) * 8);
        if (tid < 320) { const int j = tid >> 6, c = tid & 63; CW[tid] = j < 4 ? a.in[9][((size_t)l * 4 + j) * 1024 + hd * 64 + c] : a.in[10][(size_t)l * 1024 + hd * 64 + c]; }
    }
    const int tw = wave >> 1, chh = wave & 1, cl = lane & 31, hh = lane >> 5;
    const int cin = 32 * chh + cl, cg_ = hd * 64 + cin;
    float brv[2], biv[2], k8[2];
#pragma unroll
    for (int dir = 0; dir < 2; ++dir) {
        brv[dir] = a.in[13][(size_t)(l * 2 + dir) * 1024 + cg_]; biv[dir] = a.in[15][(size_t)(l * 2 + dir) * 1024 + cg_];
        k8[dir] = -8.0f * log1pf(__expf(-a.in[11][(size_t)(l * 2 + dir) * 1024 + cg_]));
    }
    const int t = tid >> 2, q = tid & 3, ch0 = hd * 64 + q * 16;
    const int hrow = (tid >> 2) < 2 ? (tid >> 2) : 130;
    u32x4 r0, r1, h0, h1;
    const u32x4 zero4 = {0u, 0u, 0u, 0u};
#define LRU_LOAD_RAW(ck) do { const int _t0 = (ck) * 128, _lo = (ck) < 2 ? 0 : CL, _hi = (ck) < 2 ? CL : R; \
        const bf16_t* _p = PX + (size_t)(_t0 + t) * DIN + ch0; r0 = *(const u32x4*)_p; r1 = *(const u32x4*)(_p + 8); \
        h0 = zero4; h1 = zero4; \
        if (tid < 12) { const int _gr = _t0 - 2 + hrow; if (_gr >= _lo && _gr < _hi) { const bf16_t* _ph = PX + (size_t)_gr * DIN + ch0; h0 = *(const u32x4*)_ph; h1 = *(const u32x4*)(_ph + 8); } } } while (0)
#define LRU_STORE_RAW(buf) do { LAS unsigned char* _rb = lds + L2_RAW + (buf) * RAW_BUFB; \
        *(LAS u32x4*)(_rb + (t + 2) * RAW_ROWB + 32 * q) = r0; *(LAS u32x4*)(_rb + (t + 2) * RAW_ROWB + 32 * q + 16) = r1; \
        if (tid < 12) { *(LAS u32x4*)(_rb + hrow * RAW_ROWB + 32 * q) = h0; *(LAS u32x4*)(_rb + hrow * RAW_ROWB + 32 * q + 16) = h1; } } while (0)
    LRU_LOAD_RAW(chunk);
    LRU_STORE_RAW(0);
    int cur = 0;
    __syncthreads();
#pragma unroll 1
    for (; chunk < NCHK; chunk += cstep) {
        const int nchunk = chunk + cstep;
        const bool has_next = nchunk < NCHK;
        u32x4 g0 = zero4, g1 = zero4; float cry[2] = {0.f, 0.f};
        if (PASSC) {
            const bf16_t* gp = PX + (size_t)(chunk * 128 + t) * DIN + 1024 + ch0;
            g0 = *(const u32x4*)gp; g1 = *(const u32x4*)(gp + 8);
            const float* CARRY = (const float*)(ws + WS_CARRY);
            cry[0] = CARRY[((size_t)0 * NCHK + chunk) * 1024 + cg_]; cry[1] = CARRY[((size_t)1 * NCHK + chunk) * 1024 + cg_];
        }
        if (has_next) LRU_LOAD_RAW(nchunk);
        {
            LAS unsigned char* rb = lds + L2_RAW + cur * RAW_BUFB;
            const int tg = tid >> 4, c4 = (tid & 15) * 4;
            f32x4 wv[4];
#pragma unroll
            for (int j = 0; j < 4; ++j) wv[j] = *(LAS f32x4*)(CW + j * 64 + c4);
            const f32x4 bb = *(LAS f32x4*)(CW + 256 + c4);
            f32x4 xr[7];
#pragma unroll
            for (int r = 0; r < 7; ++r) { const u32x2 pr = *(LAS u32x2*)(rb + (4 * tg + r) * RAW_ROWB + c4 * 2); xr[r] = (f32x4){bflo(pr.x), bfhi(pr.x), bflo(pr.y), bfhi(pr.y)}; }
#pragma unroll
            for (int tt = 0; tt < 4; ++tt) {
                const f32x4 xl = bb + wv[0] * xr[tt] + wv[1] * xr[tt + 1] + wv[2] * xr[tt + 2] + wv[3] * xr[tt + 3];
                *(LAS f32x4*)(XLF + (4 * tg + tt) * XLF_STRIDE + c4) = xl;
                u32x2 o; o.x = pk2(xl[0], xl[1]); o.y = pk2(xl[2], xl[3]);
                *(LAS u32x2*)(XLB + (4 * tg + tt) * XLB_STRIDE + c4) = o;
            }
        }
        __syncthreads();
        bf16x8 Af[4];
#pragma unroll
        for (int s = 0; s < 4; ++s) Af[s] = *(const LAS bf16x8*)(XLB + (32 * tw + cl) * XLB_STRIDE + 16 * s + 8 * hh);
        float xlv[16];
#pragma unroll
        for (int i = 0; i < 16; ++i) xlv[i] = XLF[(32 * tw + (i & 3) + 8 * (i >> 2) + 4 * hh) * XLF_STRIDE + cin];
        float av[2][16], bv[2][16], GA[2][8], GB[2][8];
#pragma unroll
        for (int dir = 0; dir < 2; ++dir) {
            f32x16 ar, ai;
#pragma unroll
            for (int i = 0; i < 16; ++i) { ar[i] = 0.f; ai[i] = 0.f; }
#pragma unroll
            for (int s = 0; s < 4; ++s) {
                const bf16x8 Br = *(const LAS bf16x8*)(lds + L2_GWL + ((((dir * 2 + 0) * 2 + chh) * 4 + s) * 64 + lane) * 16);
                const bf16x8 Bi = *(const LAS bf16x8*)(lds + L2_GWL + ((((dir * 2 + 1) * 2 + chh) * 4 + s) * 64 + lane) * 16);
                ar = __builtin_amdgcn_mfma_f32_32x32x16_bf16(Af[s], Br, ar, 0, 0, 0);
                ai = __builtin_amdgcn_mfma_f32_32x32x16_bf16(Af[s], Bi, ai, 0, 0, 0);
            }
#pragma unroll
            for (int i = 0; i < 16; ++i) {
                const float rg = sigm(ar[i] + brv[dir]), ig = sigm(ai[i] + biv[dir]);
                const float aa = __expf(k8[dir] * rg);
                av[dir][i] = aa;
                bv[dir][i] = __builtin_amdgcn_sqrtf(fmaxf(1.0f - aa * aa, 0.f)) * ig * xlv[i];
            }
            float oA[4], oB[4];
#pragma unroll
            for (int g = 0; g < 4; ++g) {
                const float a0 = av[dir][4 * g], a1 = av[dir][4 * g + 1], a2 = av[dir][4 * g + 2], a3 = av[dir][4 * g + 3];
                const float b0 = bv[dir][4 * g], b1 = bv[dir][4 * g + 1], b2 = bv[dir][4 * g + 2], b3 = bv[dir][4 * g + 3];
                oA[g] = (a0 * a1) * (a2 * a3);
                oB[g] = dir == 0 ? ((b0 * a1 + b1) * a2 + b2) * a3 + b3 : ((b3 * a2 + b2) * a1 + b1) * a0 + b0;
            }
#pragma unroll
            for (int g = 0; g < 4; ++g) {
                const float pA = __shfl_xor(oA[g], 32), pB = __shfl_xor(oB[g], 32);
                GA[dir][2 * g] = hh ? pA : oA[g]; GA[dir][2 * g + 1] = hh ? oA[g] : pA;
                GB[dir][2 * g] = hh ? pB : oB[g]; GB[dir][2 * g + 1] = hh ? oB[g] : pB;
            }
            float tA = 1.f, tB = 0.f;
            if (dir == 0) {
#pragma unroll
                for (int gq = 0; gq < 8; ++gq) { tB = GA[dir][gq] * tB + GB[dir][gq]; tA *= GA[dir][gq]; }
            } else {
#pragma unroll
                for (int gq = 7; gq >= 0; --gq) { tB = GA[dir][gq] * tB + GB[dir][gq]; tA *= GA[dir][gq]; }
            }
            if (hh == 0) TAGG[(tw * 2 + dir) * 64 + cin] = (f32x2){tA, tB};
        }
        if (has_next) LRU_STORE_RAW(cur ^ 1);
        __syncthreads();
        if constexpr (!PASSC) {
            if (tid < 128) {
                const int dir = tid >> 6, c = tid & 63;
                float cA = 1.f, cB = 0.f;
#pragma unroll
                for (int k = 0; k < 4; ++k) { const int t2 = dir == 0 ? k : 3 - k; const f32x2 v = TAGG[(t2 * 2 + dir) * 64 + c]; cB = v[0] * cB + v[1]; cA *= v[0]; }
                f32x2* AGG = (f32x2*)(ws + WS_AGG);
                AGG[((size_t)dir * NCHK + chunk) * 1024 + hd * 64 + c] = (f32x2){cA, cB};
            }
        } else {
            float yv[16];
#pragma unroll
            for (int dir = 0; dir < 2; ++dir) {
                float st = cry[dir];
                if (dir == 0) {
#pragma unroll
                    for (int t2 = 0; t2 < 3; ++t2) if (t2 < tw) { const f32x2 v = TAGG[(t2 * 2 + 0) * 64 + cin]; st = v[0] * st + v[1]; }
                } else {
#pragma unroll
                    for (int t2 = 3; t2 > 0; --t2) if (t2 > tw) { const f32x2 v = TAGG[(t2 * 2 + 1) * 64 + cin]; st = v[0] * st + v[1]; }
                }
                float hst[4];
                if (dir == 0) {
                    float s = st;
#pragma unroll
                    for (int g = 0; g < 4; ++g) { const float sE = s; s = GA[0][2 * g] * s + GB[0][2 * g]; const float sO = s; s = GA[0][2 * g + 1] * s + GB[0][2 * g + 1]; hst[g] = hh ? sO : sE; }
                } else {
                    float s = st;
#pragma unroll
                    for (int g = 3; g >= 0; --g) { const float sO = s; s = GA[1][2 * g + 1] * s + GB[1][2 * g + 1]; const float sE = s; s = GA[1][2 * g] * s + GB[1][2 * g]; hst[g] = hh ? sO : sE; }
                }
#pragma unroll
                for (int g = 0; g < 4; ++g) {
                    float h = hst[g];
                    if (dir == 0) {
#pragma unroll
                        for (int k = 0; k < 4; ++k) { h = av[0][4 * g + k] * h + bv[0][4 * g + k]; yv[4 * g + k] = h; }
                    } else {
#pragma unroll
                        for (int k = 3; k >= 0; --k) { h = av[1][4 * g + k] * h + bv[1][4 * g + k]; yv[4 * g + k] += h; }
                    }
                }
            }
            LAS bf16_t* YB = (LAS bf16_t*)(lds + L2_RAW + cur * RAW_BUFB);
#pragma unroll
            for (int i = 0; i < 16; ++i) YB[(32 * tw + (i & 3) + 8 * (i >> 2) + 4 * hh) * 72 + cin] = f2bf(yv[i]);
            __syncthreads();
            {
                const u32x4 y0 = *(LAS u32x4*)(YB + t * 72 + 16 * q), y1 = *(LAS u32x4*)(YB + t * 72 + 16 * q + 8);
                const unsigned yw[8] = {y0.x, y0.y, y0.z, y0.w, y1.x, y1.y, y1.z, y1.w};
                const unsigned gw_[8] = {g0.x, g0.y, g0.z, g0.w, g1.x, g1.y, g1.z, g1.w};
                unsigned ow[8];
#pragma unroll
                for (int j = 0; j < 8; ++j) ow[j] = pk2(bflo(yw[j]) * silu(bflo(gw_[j])), bfhi(yw[j]) * silu(bfhi(gw_[j])));
                bf16_t* yp = (bf16_t*)(ws + WS_Y) + (size_t)(chunk * 128 + t) * D + ch0;
                *(u32x4*)yp = (u32x4){ow[0], ow[1], ow[2], ow[3]}; *(u32x4*)(yp + 8) = (u32x4){ow[4], ow[5], ow[6], ow[7]};
            }
        }
        cur ^= 1;
    }
#undef LRU_LOAD_RAW
#undef LRU_STORE_RAW
}

constexpr int CV_ZT = 0;
constexpr int CV_CB = 94 * 1024;
static_assert(CV_CB + 16 * 512 * 4 <= LDS_BYTES, "conv lds map");
__device__ __forceinline__ void conv_item2(const Args a, int l, int ct, LAS unsigned char* lds) {
    const int tid = tid_fresh(), lane = tid & 63, wave = tid >> 6, c = tid;
    unsigned char* ws = ptr_fresh(a.ws);
    const bf16_t* PX = (const bf16_t*)(ws + WS_PX); bf16_t* Y = (bf16_t*)(ws + WS_Y);
    LAS bf16_t* ZT = (LAS bf16_t*)(lds + CV_ZT);
    LAS float* CB = (LAS float*)(lds + CV_CB);
    const int t0 = ct * 64, seg_lo = t0 < CL ? 0 : CL, seg_hi = t0 < CL ? CL : R;
    float w[31];
#pragma unroll
    for (int j = 0; j < 31; ++j) w[j] = a.in[16][((size_t)l * 31 + j) * 512 + c];
    const float bias = a.in[17][l * 512 + c];
    float lg[8], lb[8];
    { const f32x4 x0 = *(const f32x4*)(a.in[18] + l * 512 + 8 * lane), x1 = *(const f32x4*)(a.in[18] + l * 512 + 8 * lane + 4), y0 = *(const f32x4*)(a.in[19] + l * 512 + 8 * lane), y1 = *(const f32x4*)(a.in[19] + l * 512 + 8 * lane + 4);
#pragma unroll
      for (int k = 0; k < 4; ++k) { lg[k] = x0[k]; lg[4 + k] = x1[k]; lb[k] = y0[k]; lb[4 + k] = y1[k]; } }
    __syncthreads();
    {
        u32x4 zv[12], zg[12];
#pragma unroll
        for (int it = 0; it < 12; ++it) {
            const int pid = tid + 512 * it, e = pid >> 6, pc = pid & 63, ec = e < 94 ? e : 93;
            const int rr = t0 - 15 + ec, rc = rr < seg_lo ? seg_lo : (rr >= seg_hi ? seg_hi - 1 : rr);
            zv[it] = *(const u32x4*)(PX + (size_t)rc * DIN + 2048 + 8 * pc); zg[it] = *(const u32x4*)(PX + (size_t)rc * DIN + 2560 + 8 * pc);
        }
#pragma unroll
        for (int it = 0; it < 12; ++it) {
            const int pid = tid + 512 * it, e = pid >> 6, pc = pid & 63;
            const int rr = t0 - 15 + e;
            const unsigned vw[4] = {zv[it].x, zv[it].y, zv[it].z, zv[it].w}, gw_[4] = {zg[it].x, zg[it].y, zg[it].z, zg[it].w};
            unsigned ow[4];
#pragma unroll
            for (int j = 0; j < 4; ++j) ow[j] = pk2(bflo(vw[j]) * sigm(bflo(gw_[j])), bfhi(vw[j]) * sigm(bfhi(gw_[j])));
            const bool ok = rr >= seg_lo && rr < seg_hi;
            u32x4 o;
            o.x = ok ? ow[0] : 0u; o.y = ok ? ow[1] : 0u; o.z = ok ? ow[2] : 0u; o.w = ok ? ow[3] : 0u;
            if (e < 94) *(LAS u32x4*)(ZT + e * 512 + 8 * pc) = o;
        }
    }
    __syncthreads();
    float win[32];
#pragma unroll
    for (int e = 0; e < 30; ++e) win[e] = bf1(ZT[e * 512 + c]);
    win[30] = 0.f; win[31] = 0.f;
#pragma unroll 1
    for (int bb = 0; bb < 2; ++bb) {
#pragma unroll
        for (int hb = 0; hb < 2; ++hb) {
            u32x4 gt[2];
#pragma unroll
            for (int uu = 0; uu < 2; ++uu) gt[uu] = *(const u32x4*)(PX + (size_t)(t0 + 32 * bb + 16 * hb + wave * 2 + uu) * DIN + 3072 + 8 * lane);
#pragma unroll
            for (int u16 = 0; u16 < 16; ++u16) {
                const int u = 16 * hb + u16;
                win[(u + 30) & 31] = bf1(ZT[(32 * bb + u + 30) * 512 + c]);
                float acc = bias;
#pragma unroll
                for (int j = 0; j < 31; ++j) acc += w[j] * win[(u + j) & 31];
                CB[u16 * 512 + c] = acc;
            }
            __syncthreads();
#pragma unroll
            for (int uu = 0; uu < 2; ++uu) {
                const int u = wave * 2 + uu, row = t0 + 32 * bb + 16 * hb + u;
                float v[8]; float s = 0.f;
                { const f32x4 c0 = *(LAS f32x4*)(CB + u * 512 + 8 * lane), c1 = *(LAS f32x4*)(CB + u * 512 + 8 * lane + 4);
#pragma unroll
                  for (int k = 0; k < 4; ++k) { v[k] = c0[k]; v[4 + k] = c1[k]; } }
#pragma unroll
                for (int k = 0; k < 8; ++k) s += v[k];
                const float mean = wave_sum(s) * (1.0f / 512.0f);
                float s2 = 0.f;
#pragma unroll
                for (int k = 0; k < 8; ++k) { v[k] -= mean; s2 += v[k] * v[k]; }
                const float rstd = 1.0f / sqrtf(wave_sum(s2) * (1.0f / 512.0f) + EPS);
                const unsigned gw_[4] = {gt[uu].x, gt[uu].y, gt[uu].z, gt[uu].w};
                unsigned ow[4];
#pragma unroll
                for (int k = 0; k < 4; ++k) {
                    const float y0 = silu(v[2 * k] * rstd * lg[2 * k] + lb[2 * k]) * silu(bflo(gw_[k]));
                    const float y1 = silu(v[2 * k + 1] * rstd * lg[2 * k + 1] + lb[2 * k + 1]) * silu(bfhi(gw_[k]));
                    ow[k] = pk2(y0, y1);
                }
                *(u32x4*)(Y + (size_t)row * D + 1024 + 8 * lane) = (u32x4){ow[0], ow[1], ow[2], ow[3]};
            }
            __syncthreads();
        }
    }
}

__device__ __forceinline__ void sgu_item2(const Args a, int l, int item, LAS unsigned char* lds) {
    const int tid = tid_fresh(), lane = tid & 63, wave = tid >> 6;
    unsigned char* ws = ptr_fresh(a.ws);
    const bf16_t* PX = (const bf16_t*)(ws + WS_PX); bf16_t* Y = (bf16_t*)(ws + WS_Y);
    const bf16_t* SW = (const bf16_t*)(ws + WS_SW) + (size_t)l * 8 * 128 * 128;
    LAS f32x2* ST = (LAS f32x2*)lds;
    LAS bf16_t* TT = (LAS bf16_t*)(lds + 1024);
    const int sc = item >> 1, hg = item & 1, t0 = sc * 128;
    __syncthreads();
#pragma unroll
    for (int kb = 0; kb < 2; ++kb) {
        u32x4 p[8];
#pragma unroll
        for (int k = 0; k < 8; ++k) p[k] = *(const u32x4*)(PX + (size_t)(t0 + wave * 16 + kb * 8 + k) * DIN + 4096 + 8 * lane);
#pragma unroll
        for (int k = 0; k < 8; ++k) {
            float g[8] = {gelu_t(bflo(p[k].x)), gelu_t(bfhi(p[k].x)), gelu_t(bflo(p[k].y)), gelu_t(bfhi(p[k].y)), gelu_t(bflo(p[k].z)), gelu_t(bfhi(p[k].z)), gelu_t(bflo(p[k].w)), gelu_t(bfhi(p[k].w))};
            float s = 0.f;
#pragma unroll
            for (int j = 0; j < 8; ++j) s += g[j];
            const float mean = wave_sum(s) * (1.0f / 512.0f);
            float s2 = 0.f;
#pragma unroll
            for (int j = 0; j < 8; ++j) { const float d = g[j] - mean; s2 += d * d; }
            const float rstd = 1.0f / sqrtf(wave_sum(s2) * (1.0f / 512.0f) + EPS);
            if (lane == 0) ST[wave * 16 + kb * 8 + k] = (f32x2){mean, rstd};
        }
    }
    __syncthreads();
    const int p_ = tid >> 2, dq = tid & 3;
    const f32x2 st = ST[p_];
    const int fr = lane & 15, fq = lane >> 4;
    LAS float* SO = (LAS float*)(lds + 1024 + 2 * 64 * TT_STRIDE * 2);
    u32x4 Lq0[2], Lq1[2], Lu0[2], Lu1[2], Lg0[2], Lg1[2]; bf16x8 LA[2][4]; f32x4 Llg[2][4], Llb[2][4]; float Lbs[2];
#define SGU_LOAD(sl, h_) do { const int _ch = 64 * (h_) + 16 * dq; const bf16_t* _pr = PX + (size_t)(t0 + p_) * DIN + _ch; \
        Lq0[sl] = *(const u32x4*)(_pr + 4096); Lq1[sl] = *(const u32x4*)(_pr + 4096 + 8); Lu0[sl] = *(const u32x4*)(_pr + 3584); Lu1[sl] = *(const u32x4*)(_pr + 3584 + 8); \
        Lg0[sl] = *(const u32x4*)(_pr + 4608); Lg1[sl] = *(const u32x4*)(_pr + 4608 + 8); \
        _Pragma("unroll") for (int s = 0; s < 4; ++s) LA[sl][s] = *(const bf16x8*)(SW + ((size_t)(h_) * 128 + 16 * wave + fr) * 128 + 32 * s + 8 * fq); \
        Lbs[sl] = a.in[23][((size_t)l * 8 + (h_)) * 128 + p_]; \
        _Pragma("unroll") for (int j = 0; j < 4; ++j) { Llg[sl][j] = *(const f32x4*)(a.in[20] + l * 512 + _ch + 4 * j); Llb[sl][j] = *(const f32x4*)(a.in[21] + l * 512 + _ch + 4 * j); } } while (0)
    SGU_LOAD(0, 4 * hg);
#pragma unroll
    for (int h4 = 0; h4 < 4; ++h4) {
        const int h = 4 * hg + h4, sl = h4 & 1;
        LAS bf16_t* tt = TT + (h4 & 1) * (64 * TT_STRIDE);
        if (h4 + 1 < 4) SGU_LOAD(sl ^ 1, h + 1);
        const int ch = 64 * h + 16 * dq;
        const u32x4 q0 = Lq0[sl], q1 = Lq1[sl], u0 = Lu0[sl], u1 = Lu1[sl], g0 = Lg0[sl], g1 = Lg1[sl];
        bf16x8 Afr[4];
#pragma unroll
        for (int s = 0; s < 4; ++s) Afr[s] = LA[sl][s];
        const float bs = Lbs[sl];
        f32x4 lgv[4], lbv[4];
#pragma unroll
        for (int j = 0; j < 4; ++j) { lgv[j] = Llg[sl][j]; lbv[j] = Llb[sl][j]; }
        {
            const unsigned pw[8] = {q0.x, q0.y, q0.z, q0.w, q1.x, q1.y, q1.z, q1.w};
#pragma unroll
            for (int j = 0; j < 8; ++j) {
                const float v0 = (gelu_t(bflo(pw[j])) - st[0]) * st[1] * lgv[j >> 1][(2 * j) & 3] + lbv[j >> 1][(2 * j) & 3];
                const float v1 = (gelu_t(bfhi(pw[j])) - st[0]) * st[1] * lgv[j >> 1][(2 * j + 1) & 3] + lbv[j >> 1][(2 * j + 1) & 3];
                tt[(16 * dq + 2 * j) * TT_STRIDE + p_] = f2bf(v0);
                tt[(16 * dq + 2 * j + 1) * TT_STRIDE + p_] = f2bf(v1);
            }
        }
        __syncthreads();
        f32x4 acc[4];
#pragma unroll
        for (int nt = 0; nt < 4; ++nt) acc[nt] = (f32x4){0.f, 0.f, 0.f, 0.f};
#pragma unroll
        for (int s = 0; s < 4; ++s)
#pragma unroll
            for (int nt = 0; nt < 4; ++nt) {
                const bf16x8 Bfr = *(const LAS bf16x8*)(tt + (16 * nt + fr) * TT_STRIDE + 32 * s + 8 * fq);
                acc[nt] = __builtin_amdgcn_mfma_f32_16x16x32_bf16(Afr[s], Bfr, acc[nt], 0, 0, 0);
            }
#pragma unroll
        for (int reg = 0; reg < 4; ++reg)
#pragma unroll
            for (int nt = 0; nt < 4; ++nt) SO[(16 * wave + 4 * fq + reg) * 68 + 16 * nt + fr] = acc[nt][reg];
        __syncthreads();
        {
            const unsigned uw[8] = {u0.x, u0.y, u0.z, u0.w, u1.x, u1.y, u1.z, u1.w}, gw_[8] = {g0.x, g0.y, g0.z, g0.w, g1.x, g1.y, g1.z, g1.w};
            unsigned ow[8];
#pragma unroll
            for (int j4 = 0; j4 < 4; ++j4) {
                const f32x4 sv = *(LAS f32x4*)(SO + p_ * 68 + 16 * dq + 4 * j4);
                ow[2 * j4] = pk2(gelu_t(bflo(uw[2 * j4])) * (sv[0] + bs) * silu(bflo(gw_[2 * j4])), gelu_t(bfhi(uw[2 * j4])) * (sv[1] + bs) * silu(bfhi(gw_[2 * j4])));
                ow[2 * j4 + 1] = pk2(gelu_t(bflo(uw[2 * j4 + 1])) * (sv[2] + bs) * silu(bflo(gw_[2 * j4 + 1])), gelu_t(bfhi(uw[2 * j4 + 1])) * (sv[3] + bs) * silu(bfhi(gw_[2 * j4 + 1])));
            }
            bf16_t* yp = Y + (size_t)(t0 + p_) * D + 1536 + ch;
            *(u32x4*)yp = (u32x4){ow[0], ow[1], ow[2], ow[3]}; *(u32x4*)(yp + 8) = (u32x4){ow[4], ow[5], ow[6], ow[7]};
        }
    }
#undef SGU_LOAD
}

__device__ __forceinline__ int scan_chunk(int dir, int o) { return dir == 0 ? o : (o == 0 ? 1 : (o == 1 ? 0 : (NCHK + 1 - o))); }
__device__ __forceinline__ void phase_carry(const Args a, LAS unsigned char* lds) {
    const int tid = tid_fresh(), b = blockIdx.x, G = gridDim.x;
    unsigned char* ws = ptr_fresh(a.ws);
    const f32x2* AGG = (const f32x2*)(ws + WS_AGG); float* CARRY = (float*)(ws + WS_CARRY);
    LAS f32x2* SEG = (LAS f32x2*)lds;
    for (int u = b; u < 64; u += G) {
        const int dir = u >> 5, ch = (u & 31) * 32 + (tid & 31), sg = tid >> 5;
        f32x2 ab[10];
        if (sg < 13) {
#pragma unroll
            for (int k = 0; k < 10; ++k) ab[k] = AGG[((size_t)dir * NCHK + scan_chunk(dir, 10 * sg + k)) * 1024 + ch];
            float sA = 1.f, sB = 0.f;
#pragma unroll
            for (int k = 0; k < 10; ++k) { sB = ab[k][0] * sB + ab[k][1]; sA *= ab[k][0]; }
            SEG[sg * 32 + (tid & 31)] = (f32x2){sA, sB};
        }
        __syncthreads();
        if (sg < 13) {
            float st = 0.f;
            for (int s2 = 0; s2 < sg; ++s2) { const f32x2 v = SEG[s2 * 32 + (tid & 31)]; st = v[0] * st + v[1]; }
#pragma unroll
            for (int k = 0; k < 10; ++k) { CARRY[((size_t)dir * NCHK + scan_chunk(dir, 10 * sg + k)) * 1024 + ch] = st; st = ab[k][0] * st + ab[k][1]; }
        }
        __syncthreads();
    }
}

__device__ __forceinline__ void phase_resid0(const Args a) {
    const int tid = tid_fresh(), lane = tid & 63, wave = tid >> 6, b = blockIdx.x, G = gridDim.x;
    unsigned char* ws = ptr_fresh(a.ws);
    const bf16_t* DL0 = (const bf16_t*)(ws + WS_DL0);
    const float* gg0 = (const float*)(ws + WS_GG);
    const float* gg = (const float*)(ws + WS_GG) + (size_t)2 * D;
    bf16_t* XG = (bf16_t*)(ws + WS_XG) + (size_t)CL * D; float* rss1 = (float*)(ws + WS_RSS) + R + CL;
    f32x4 g[8], rg0[8];
#pragma unroll
    for (int j = 0; j < 4; ++j) { g[2 * j] = *(const f32x4*)(gg + 8 * (lane + 64 * j)); g[2 * j + 1] = *(const f32x4*)(gg + 8 * (lane + 64 * j) + 4);
        const f32x4 h0 = *(const f32x4*)(gg0 + 8 * (lane + 64 * j)), h1 = *(const f32x4*)(gg0 + 8 * (lane + 64 * j) + 4);
        rg0[2 * j] = (f32x4){1.0f / h0[0], 1.0f / h0[1], 1.0f / h0[2], 1.0f / h0[3]}; rg0[2 * j + 1] = (f32x4){1.0f / h1[0], 1.0f / h1[1], 1.0f / h1[2], 1.0f / h1[3]}; }
    u32x4 xr[4], dr[4];
#define RS_LOAD(t_, X, Dd) do { _Pragma("unroll") for (int j = 0; j < 4; ++j) { X[j] = *(const u32x4*)(XG + (size_t)(t_) * D + 8 * (lane + 64 * j)); Dd[j] = *(const u32x4*)(DL0 + (size_t)(t_) * D + 8 * (lane + 64 * j)); } } while (0)
    int t = b * 8 + wave;
    if (t < T) RS_LOAD(t, xr, dr);
    for (; t < T; t += G * 8) {
        u32x4 xn[4], dn[4];
        const int tn = t + G * 8;
        if (tn < T) RS_LOAD(tn, xn, dn);
        f32x4 v[8]; float ss = 0.f;
#pragma unroll
        for (int j = 0; j < 4; ++j) {
            v[2 * j] = (f32x4){bflo(xr[j].x), bfhi(xr[j].x), bflo(xr[j].y), bfhi(xr[j].y)} * rg0[2 * j] + (f32x4){bflo(dr[j].x), bfhi(dr[j].x), bflo(dr[j].y), bfhi(dr[j].y)};
            v[2 * j + 1] = (f32x4){bflo(xr[j].z), bfhi(xr[j].z), bflo(xr[j].w), bfhi(xr[j].w)} * rg0[2 * j + 1] + (f32x4){bflo(dr[j].z), bfhi(dr[j].z), bflo(dr[j].w), bfhi(dr[j].w)};
        }
#pragma unroll
        for (int j = 0; j < 8; ++j) ss += (v[j][0] * v[j][0] + v[j][1] * v[j][1]) + (v[j][2] * v[j][2] + v[j][3] * v[j][3]);
#pragma unroll
        for (int j = 0; j < 4; ++j) {
            const f32x4 p0 = v[2 * j] * g[2 * j], p1 = v[2 * j + 1] * g[2 * j + 1];
            u32x4 w; w.x = pk2(p0[0], p0[1]); w.y = pk2(p0[2], p0[3]); w.z = pk2(p1[0], p1[1]); w.w = pk2(p1[2], p1[3]);
            *(u32x4*)(XG + (size_t)t * D + 8 * (lane + 64 * j)) = w;
        }
        ss = wave_sum(ss);
        if (lane == 0) rss1[t] = ss;
        if (tn < T) {
#pragma unroll
            for (int j = 0; j < 4; ++j) { xr[j] = xn[j]; dr[j] = dn[j]; }
        }
    }
#undef RS_LOAD
}
__device__ __forceinline__ void phase_final(const Args a) {
    const int tid = tid_fresh(), lane = tid & 63, wave = tid >> 6, b = blockIdx.x, G = gridDim.x;
    unsigned char* ws = ptr_fresh(a.ws);
    const bf16_t* XG1 = (const bf16_t*)(ws + WS_XG) + (size_t)CL * D;
    const bf16_t* DL1 = (const bf16_t*)(ws + WS_DL0);
    const float* fg = a.in[24];
    const float* gg = (const float*)(ws + WS_GG) + (size_t)2 * D;
    u32x4 xr[4], er[4];
#define FN_LOAD(t_, X, Ee) do { _Pragma("unroll") for (int j = 0; j < 4; ++j) { X[j] = *(const u32x4*)(XG1 + (size_t)(t_) * D + 8 * (lane + 64 * j)); Ee[j] = *(const u32x4*)(DL1 + (size_t)(t_) * D + 8 * (lane + 64 * j)); } } while (0)
    f32x4 fgv[8], rg[8];
#pragma unroll
    for (int j = 0; j < 4; ++j) { fgv[2 * j] = *(const f32x4*)(fg + 8 * (lane + 64 * j)); fgv[2 * j + 1] = *(const f32x4*)(fg + 8 * (lane + 64 * j) + 4);
        const f32x4 g0 = *(const f32x4*)(gg + 8 * (lane + 64 * j)), g1 = *(const f32x4*)(gg + 8 * (lane + 64 * j) + 4);
        rg[2 * j] = (f32x4){1.0f / g0[0], 1.0f / g0[1], 1.0f / g0[2], 1.0f / g0[3]}; rg[2 * j + 1] = (f32x4){1.0f / g1[0], 1.0f / g1[1], 1.0f / g1[2], 1.0f / g1[3]}; }
    int t = b * 8 + wave;
    if (t < T) FN_LOAD(t, xr, er);
    for (; t < T; t += G * 8) {
        u32x4 xn[4], en[4];
        const int tn = t + G * 8;
        if (tn < T) FN_LOAD(tn, xn, en);
        float* orow = a.out + (size_t)t * D;
        f32x4 v[8]; float ss = 0.f;
#pragma unroll
        for (int j = 0; j < 4; ++j) {
            v[2 * j] = (f32x4){bflo(xr[j].x), bfhi(xr[j].x), bflo(xr[j].y), bfhi(xr[j].y)} * rg[2 * j] + (f32x4){bflo(er[j].x), bfhi(er[j].x), bflo(er[j].y), bfhi(er[j].y)};
            v[2 * j + 1] = (f32x4){bflo(xr[j].z), bfhi(xr[j].z), bflo(xr[j].w), bfhi(xr[j].w)} * rg[2 * j + 1] + (f32x4){bflo(er[j].z), bfhi(er[j].z), bflo(er[j].w), bfhi(er[j].w)};
        }
#pragma unroll
        for (int j = 0; j < 8; ++j) ss += (v[j][0] * v[j][0] + v[j][1] * v[j][1]) + (v[j][2] * v[j][2] + v[j][3] * v[j][3]);
        const float rs = 1.0f / sqrtf(wave_sum(ss) * (1.0f / D) + EPS);
#pragma unroll
        for (int j = 0; j < 4; ++j) {
            *(f32x4*)(orow + 8 * (lane + 64 * j)) = v[2 * j] * rs * fgv[2 * j]; *(f32x4*)(orow + 8 * (lane + 64 * j) + 4) = v[2 * j + 1] * rs * fgv[2 * j + 1];
        }
        if (tn < T) {
#pragma unroll
            for (int j = 0; j < 4; ++j) { xr[j] = xn[j]; er[j] = en[j]; }
        }
    }
#undef FN_LOAD
}

template <int NT, int MODE>
__device__ __forceinline__ void ctx_gemm(const Args a, int l, LAS unsigned char* lds) {
    const int tid = tid_fresh(), lane = tid & 63, wave = tid >> 6, b = blockIdx.x, G = gridDim.x;
    unsigned char* ws = ptr_fresh(a.ws);
    constexpr int TN = 16 * NT, N = 64 * TN, TS = TN + 4;
    const bf16_t* A = (const bf16_t*)(ws + (MODE == 0 ? WS_XG : WS_Y));
    const bf16_t* Bt = MODE == 0 ? (const bf16_t*)(ws + WS_WINT) + (size_t)l * DIN * D : (const bf16_t*)(ws + WS_WOUTT) + (size_t)l * D * D;
    LAS float* CT = (LAS float*)lds;
    const int fr = lane & 15, fq = lane >> 4;
#pragma unroll 1
    for (int tile = b; tile < 256; tile += G) {
        const int r0 = (tile >> 6) * 64, n0 = (tile & 63) * TN;
        __syncthreads();
        f32x4 acc[4][NT];
#pragma unroll
        for (int m = 0; m < 4; ++m)
#pragma unroll
            for (int n = 0; n < NT; ++n) acc[m][n] = (f32x4){0.f, 0.f, 0.f, 0.f};
        const bf16_t* ap = A + (size_t)(r0 + fr) * D + wave * 256 + 8 * fq;
        const bf16_t* bp = Bt + (size_t)(n0 + fr) * D + wave * 256 + 8 * fq;
        bf16x8 af[2][4], bfr[2][NT];
#define CTXG_LOAD(buf, ks_) do { _Pragma("unroll") for (int m = 0; m < 4; ++m) af[buf][m] = *(const bf16x8*)(ap + (size_t)(16 * m) * D + 32 * (ks_)); \
        _Pragma("unroll") for (int n = 0; n < NT; ++n) bfr[buf][n] = *(const bf16x8*)(bp + (size_t)(16 * n) * D + 32 * (ks_)); } while (0)
#define CTXG_MMA(buf) do { _Pragma("unroll") for (int m = 0; m < 4; ++m) _Pragma("unroll") for (int n = 0; n < NT; ++n) \
        acc[m][n] = __builtin_amdgcn_mfma_f32_16x16x32_bf16(af[buf][m], bfr[buf][n], acc[m][n], 0, 0, 0); } while (0)
        CTXG_LOAD(0, 0);
#pragma unroll
        for (int ks = 0; ks < 8; ks += 2) {
            CTXG_LOAD(1, ks + 1);
            __builtin_amdgcn_sched_barrier(0);
            CTXG_MMA(0);
            __builtin_amdgcn_sched_barrier(0);
            if (ks + 2 < 8) CTXG_LOAD(0, ks + 2);
            __builtin_amdgcn_sched_barrier(0);
            CTXG_MMA(1);
            __builtin_amdgcn_sched_barrier(0);
        }
#undef CTXG_LOAD
#undef CTXG_MMA
#pragma unroll
        for (int ps = 0; ps < 2; ++ps) {
#pragma unroll
            for (int m2 = 0; m2 < 2; ++m2)
#pragma unroll
                for (int n = 0; n < NT; ++n)
#pragma unroll
                    for (int reg = 0; reg < 4; ++reg) CT[(wave * 32 + 16 * m2 + 4 * fq + reg) * TS + 16 * n + fr] = acc[2 * ps + m2][n][reg];
            __syncthreads();
            for (int wi = tid; wi < 32 * (TN / 8); wi += 512) {
                const int rr = wi / (TN / 8), cgp = wi % (TN / 8), row = r0 + 32 * ps + rr, col = n0 + 8 * cgp;
                f32x4 c0 = {0.f, 0.f, 0.f, 0.f}, c1 = {0.f, 0.f, 0.f, 0.f};
#pragma unroll
                for (int w8 = 0; w8 < 8; ++w8) { c0 += *(LAS f32x4*)(CT + (w8 * 32 + rr) * TS + 8 * cgp); c1 += *(LAS f32x4*)(CT + (w8 * 32 + rr) * TS + 8 * cgp + 4); }
                if (MODE == 0) {
                    const float* rss = (const float*)(ws + WS_RSS) + (size_t)l * R;
                    const float* shw = (const float*)(ws + WS_SHW) + (size_t)(l * 2 + 1) * DIN;
                    bf16_t* PXo = (bf16_t*)(ws + WS_PX);
                    const float rs = 1.0f / sqrtf(rss[row] * (1.0f / D) + EPS);
                    const f32x4 s0 = *(const f32x4*)(shw + col), s1 = *(const f32x4*)(shw + col + 4);
                    const f32x4 v0 = c0 * rs + s0, v1 = c1 * rs + s1;
                    u32x4 w; w.x = pk2(v0[0], v0[1]); w.y = pk2(v0[2], v0[3]); w.z = pk2(v1[0], v1[1]); w.w = pk2(v1[2], v1[3]);
                    *(u32x4*)(PXo + (size_t)row * DIN + col) = w;
                } else {
                    const float* gp = (const float*)(ws + WS_MOD) + (size_t)(l * 2 + 1) * 6144 + 4096;
                    const float* ggp = (const float*)(ws + WS_GG) + (size_t)((l + 1) * 2 + 1) * D;
                    float* rssn = (float*)(ws + WS_RSS) + (size_t)(l + 1) * R;
                    float* xn = (float*)(ws + WS_X1C); bf16_t* XG = (bf16_t*)(ws + WS_XG);
                    const f32x4 o0 = *(const f32x4*)(a.in[2] + (size_t)row * D + col), o1 = *(const f32x4*)(a.in[2] + (size_t)row * D + col + 4);
                    const f32x4 g0 = *(const f32x4*)(gp + col), g1 = *(const f32x4*)(gp + col + 4);
                    const f32x4 v0 = o0 + g0 * c0, v1 = o1 + g1 * c1;
                    *(f32x4*)(xn + (size_t)row * D + col) = v0; *(f32x4*)(xn + (size_t)row * D + col + 4) = v1;
                    const f32x4 q0 = *(const f32x4*)(ggp + col), q1 = *(const f32x4*)(ggp + col + 4);
                    const f32x4 a0 = v0 * q0, a1 = v1 * q1;
                    u32x4 w; w.x = pk2(a0[0], a0[1]); w.y = pk2(a0[2], a0[3]); w.z = pk2(a1[0], a1[1]); w.w = pk2(a1[2], a1[3]);
                    *(u32x4*)(XG + (size_t)row * D + col) = w;
                    const float ss = (v0[0] * v0[0] + v0[1] * v0[1]) + (v0[2] * v0[2] + v0[3] * v0[3]) + (v1[0] * v1[0] + v1[1] * v1[1]) + (v1[2] * v1[2] + v1[3] * v1[3]);
                    unsafeAtomicAdd(rssn + row, ss);
                }
            }
            __syncthreads();
        }
    }
    __syncthreads();
}

#define XB_TMO      128
#define XB_XCNT(j)  (256  + 64 * (j))
#define XB_XSUB(j)  (1280 + 64 * (j))
#define XB_XGEN(j)  (2304 + 64 * (j))
#define XB_TOP      3328
#define XB_TOPGEN   3392
#define XCD_BAR_WORDS 3456
#define XB_SPIN_CAP (1u << 18)

__device__ __forceinline__ unsigned xb_ld(unsigned* p)              { return __hip_atomic_load(p, __ATOMIC_RELAXED, __HIP_MEMORY_SCOPE_AGENT); }
__device__ __forceinline__ unsigned xb_add(unsigned* p, unsigned v) { return __hip_atomic_fetch_add(p, v, __ATOMIC_RELAXED, __HIP_MEMORY_SCOPE_AGENT); }
__device__ __forceinline__ unsigned xb_xcc_id() { return (unsigned)__builtin_amdgcn_s_getreg((3 << 11) | 20) & 0xFu; }
#define XB_SPIN(cond, bar) do { unsigned _sp = 0; while (cond) { __builtin_amdgcn_s_sleep(1); \
    if ((++_sp & 255u) == 0u) { if (xb_ld(&(bar)[XB_TMO])) break; if (_sp > XB_SPIN_CAP) { atomicAdd(&(bar)[XB_TMO], 1u); break; } } } } while (0)

struct XcdBarrier {
    unsigned* bar; unsigned x;
    volatile LAS unsigned* st;
};

__device__ __forceinline__ XcdBarrier xcd_barrier_post(unsigned* bar, volatile LAS unsigned* st) {
    XcdBarrier b; b.bar = bar; b.x = xb_xcc_id(); b.st = st;
    if (threadIdx.x == 0) (void)xb_add(&bar[XB_XCNT(b.x)], 1u);
    return b;
}
__device__ __forceinline__ void xcd_barrier_complete(unsigned* bar, unsigned x, unsigned& nloc, unsigned& nx) {
    const unsigned G = gridDim.x * gridDim.y * gridDim.z;
    unsigned sum, cnt, mine, sp = 0u;
    for (;;) {
        sum = 0u; cnt = 0u; mine = 0u;
#pragma unroll
        for (unsigned j = 0; j < 16; ++j) { const unsigned c = xb_ld(&bar[XB_XCNT(j)]); sum += c; cnt += (c > 0u) ? 1u : 0u; mine = (j == x) ? c : mine; }
        if (sum == G) break;
        __builtin_amdgcn_s_sleep(1);
        if ((++sp & 255u) == 0u) { if (xb_ld(&bar[XB_TMO])) break; if (sp > XB_SPIN_CAP) { atomicAdd(&bar[XB_TMO], 1u); break; } }
    }
    nloc = mine > 0u ? mine : 1u; nx = cnt > 0u ? cnt : 1u;
}

__device__ __forceinline__ void xcd_barrier(const XcdBarrier& b) {
    asm volatile("s_waitcnt vmcnt(0)" ::: "memory");
    __syncthreads();
    if (threadIdx.x == 0) {
        unsigned* bar = b.bar;
        __builtin_amdgcn_s_waitcnt(0);
        unsigned nloc = b.st[0], nx = b.st[1];
        if (nloc == 0u) { xcd_barrier_complete(bar, b.x, nloc, nx); b.st[0] = nloc; b.st[1] = nx; }
        const unsigned old = xb_add(&bar[XB_XSUB(b.x)], 1u);
        const unsigned gen = old / nloc;
        if (old + 1u == (gen + 1u) * nloc) {
            __builtin_amdgcn_fence(__ATOMIC_RELEASE, "agent");
            asm volatile("s_waitcnt vmcnt(0)" ::: "memory");
            const unsigned og = xb_add(&bar[XB_TOP], 1u);
            const unsigned tg = og / nx;
            if (og + 1u == (tg + 1u) * nx) xb_add(&bar[XB_TOPGEN], 1u);
            else XB_SPIN(xb_ld(&bar[XB_TOPGEN]) == tg, bar);
            __builtin_amdgcn_fence(__ATOMIC_ACQUIRE, "agent");
            xb_add(&bar[XB_XGEN(b.x)], 1u);
            asm volatile("s_waitcnt vmcnt(0)" ::: "memory");
        } else {
            XB_SPIN(xb_ld(&bar[XB_XGEN(b.x)]) == gen, bar);
            __builtin_amdgcn_fence(__ATOMIC_ACQUIRE, "agent");
            asm volatile("s_waitcnt vmcnt(0)" ::: "memory");
        }
    }
    __syncthreads();
}


__global__ void __launch_bounds__(512, 2) mega_fwd(Args a) {
    extern __shared__ __attribute__((aligned(16))) unsigned char lds_raw[];
    LAS unsigned char* lds = (LAS unsigned char*)lds_raw;
    cg::grid_group grid = cg::this_grid();
    const int lo = a.ph_lo, hi = a.ph_hi;
    const int b = blockIdx.x, G = gridDim.x;
    unsigned char* ws = ptr_fresh(a.ws);
    { volatile LAS unsigned* xst = (volatile LAS unsigned*)(lds + LDS_BYTES - 16); if (threadIdx.x < 4) xst[threadIdx.x] = 0u; }
    __syncthreads();
    const XcdBarrier xbar = xcd_barrier_post((unsigned*)(a.ws + WS_BAR), (volatile LAS unsigned*)(lds + LDS_BYTES - 16));
#ifndef PHMASK
#define PHMASK 0x1fff
#endif
#define IN(k) (((PHMASK >> (k)) & 1) && lo <= (k) && (k) < hi)
#ifndef DUPMASK
#define DUPMASK 0
#endif
#define DUP(k) ((DUPMASK >> (k)) & 1)
#define GSYNC(k) do { if (a.ph_lo < 0) grid.sync();     \
    xcd_barrier(xbar); } while (0)
#define SEAM(k) do { if (IN(k) && IN((k) + 1)) GSYNC(k); } while (0)
#define REPB(k) for (int rep_ = 0; rep_ <= DUP(k); ++rep_) { if (rep_) xcd_barrier(xbar);
#define REPE }
    if (IN(0)) { REPB(0) phase0a(a, lds); REPE }
    SEAM(0);
    if (IN(1)) { REPB(1) phase0b(a, lds); REPE }
    SEAM(1);
#pragma unroll 1
    for (int l = 0; l < 2; ++l) {
        const int pb = 2 + 5 * l; const bool last = (l == 1);
        if (IN(pb) && (PHMASK & 0x84)) { REPB(pb)
            pg8::Gemm g{(const bf16_t*)(ws + WS_XG) + (size_t)CL * D, (const bf16_t*)(ws + WS_WINT) + (size_t)l * DIN * D, T, DIN, D};
            pg8::StaticOrder S; S.init(T, DIN, G, b);
            EpiIn E{(bf16_t*)(ws + WS_PX), (const float*)(ws + WS_RSS) + (size_t)l * R, (const float*)(ws + WS_SHW) + (size_t)l * 2 * DIN};
            const bool ctx_first = (b & 1) != 0;
            if (ctx_first) ctx_gemm<5, 0>(a, l, lds);
            pg8::gemm_phase<EpiIn, pg8::StaticOrder, GEMM_ALIGN, GEMM_SP2>(lds, g, S, E);
            if (!ctx_first) ctx_gemm<5, 0>(a, l, lds);
        REPE }
        SEAM(pb);
        if (IN(pb + 1) && (PHMASK & 0x108)) { REPB(pb + 1)
            const int c_lo = last ? 2 : 0, n_cv = 2 * (NCHK - c_lo);
            lru_phase<false>(a, l, 0, lds);
            unsigned* qctr = (unsigned*)(a.ws + WS_BAR) + 16 + 2 * l + rep_;
            volatile LAS int* qslot = (volatile LAS int*)(lds + LDS_BYTES - 32);
            for (;;) {
                __syncthreads();
                if (threadIdx.x == 0) *qslot = (int)__hip_atomic_fetch_add(qctr, 1u, __ATOMIC_RELAXED, __HIP_MEMORY_SCOPE_AGENT);
                __syncthreads();
                const int it = *qslot;
                if (it >= 2 * n_cv) break;
                if (it < n_cv) sgu_item2(a, l, 2 * c_lo + it, lds); else conv_item2(a, l, 2 * c_lo + it - n_cv, lds);
            }
        REPE }
        SEAM(pb + 1);
        if (IN(pb + 2) && (PHMASK & 0x210)) { REPB(pb + 2) phase_carry(a, lds); REPE }
        SEAM(pb + 2);
        if (IN(pb + 3) && (PHMASK & 0x420)) { REPB(pb + 3)
            lru_phase<true>(a, l, last ? 2 : 0, lds);
            __syncthreads();
        REPE }
        SEAM(pb + 3);
        if (IN(pb + 4) && (PHMASK & 0x840)) {
            const int roff = CL, M = T;
            pg8::Gemm g{(const bf16_t*)(ws + WS_Y) + (size_t)roff * D, (const bf16_t*)(ws + WS_WOUTT) + (size_t)l * D * D, M, D, D};
            pg8::StaticOrder S; S.init(M, D, G, b);
            EpiDelta E{(bf16_t*)(ws + WS_DL0),
                        (const float*)(ws + WS_MOD) + (size_t)l * 2 * 6144 + 4096};
            const bool ctx_first = !last && (b & 1) != 0;
            if (ctx_first) ctx_gemm<2, 1>(a, l, lds);
            pg8::gemm_phase<EpiDelta, pg8::StaticOrder, GEMM_ALIGN, GEMM_SP2>(lds, g, S, E);
            if (!last) { if (!ctx_first) ctx_gemm<2, 1>(a, l, lds); xcd_barrier(xbar); phase_resid0(a); }
        }
        SEAM(pb + 4);
    }
    if (IN(12)) phase_final(a);
#undef IN
#undef SEAM
}

extern "C" void kernel_launch(void* const* d_in, const int* in_sizes, int n_in, void* d_out, int out_size, void* d_ws, size_t ws_size, hipStream_t stream) {
    static int grid = 0;
    if (grid == 0) {
        int dev = 0, cus = 0, per_cu = 0;
        if (n_in != 25 || ws_size < WS_END) { fprintf(stderr, "kernel_launch: unexpected inputs (n_in %d, ws %zu < %zu)\n", n_in, ws_size, (size_t)WS_END); grid = -1; return; }
        hipGetDevice(&dev);
        hipDeviceGetAttribute(&cus, hipDeviceAttributeMultiprocessorCount, dev);
        if (hipFuncSetAttribute((const void*)mega_fwd, hipFuncAttributeMaxDynamicSharedMemorySize, LDS_BYTES) != hipSuccess) { fprintf(stderr, "kernel_launch: hipFuncSetAttribute failed\n"); grid = -1; return; }
        hipOccupancyMaxActiveBlocksPerMultiprocessor(&per_cu, (const void*)mega_fwd, 512, LDS_BYTES);
        (void)hipGetLastError();
        if (per_cu < 1) { fprintf(stderr, "kernel_launch: occupancy query says %d blocks per CU\n", per_cu); per_cu = 1; }
        grid = cus;
    }
    if (grid < 0) return;
    if (hipMemsetAsync((char*)d_ws + WS_BAR, 0, 16384, stream) != hipSuccess) { fprintf(stderr, "kernel_launch: memset of the barrier words failed\n"); return; }
    Args a{};
    for (int i = 0; i < 25; ++i) a.in[i] = (const float*)d_in[i];
    a.out = (float*)d_out; a.ws = (unsigned char*)d_ws;
#if N_LAUNCH_MODE == 1
    a.ph_lo = 0; a.ph_hi = NPHASE;
    void* args[] = {&a};
    hipError_t e = hipLaunchCooperativeKernel((const void*)mega_fwd, dim3(grid), dim3(512), args, LDS_BYTES, stream);
    if (e != hipSuccess) fprintf(stderr, "kernel_launch: cooperative launch failed: %s (grid %d)\n", hipGetErrorString(e), grid);
#else
    for (int p = 0; p < NPHASE; ++p) {
        a.ph_lo = p; a.ph_hi = p + 1;
        hipLaunchKernelGGL(mega_fwd, dim3(grid), dim3(512), LDS_BYTES, stream, a);
    }
#endif
}
```

```cpp
#include <hip/hip_runtime.h>
#include <hip/hip_cooperative_groups.h>
#include <cstdio>
#include <cstdint>
namespace cg = cooperative_groups;
namespace pg8 {
#define PG8_LAS __attribute__((address_space(3)))
typedef unsigned short bf16_t;
typedef short bf16x8 __attribute__((ext_vector_type(8)));
typedef float f32x4 __attribute__((ext_vector_type(4)));
typedef unsigned u32x4 __attribute__((ext_vector_type(4)));
constexpr int BM = 256, BK = 64, HALF = 128, HTB = HALF * BK * 2  , STAGE_BYTES = 8 * HTB, NXCD = 8, WGM = 8;

__host__ __device__ __forceinline__ int lds_byte(int r, int c) { const int st = (r >> 4) * 2 + (c >> 5), rr = r & 15, cc = c & 31, ob = rr * 64 + cc * 2; return st * 1024 + (ob ^ (((ob >> 9) & 1) << 5)); }
__host__ __device__ __forceinline__ void stage_rc(int b, int& R, int& C) { const int st = b / 1024, sb = b % 1024, swz = sb ^ (((sb >> 9) & 1) << 5); R = (st >> 1) * 16 + swz / 64; C = (st & 1) * 32 + (swz % 64) / 2; }
__host__ __device__ __forceinline__ int perm32(int rho) { const int n = rho >> 4, i = rho & 15; return 8 * (i >> 2) + 4 * n + (i & 3); }

struct Unit { int pm, pn; };
struct Gemm { const bf16_t* A; const bf16_t* Bt; int M, N, K; };

struct StaticOrder {
    int nM, nN, nwg, G, c;
    __host__ __device__ void init(int M, int N, int G_, int c_) { nM = M / BM; nN = N / BM; nwg = nM * nN; G = G_; c = c_; }
    __host__ __device__ bool next(int i, Unit& u) const {
        const long L = (long)i * G + c; if (L >= nwg) return false;
        int wgid = (int)L; { const int q = nwg / NXCD, r = nwg % NXCD, xcd = wgid % NXCD, off = wgid / NXCD; wgid = (xcd < r ? xcd * (q + 1) : r * (q + 1) + (xcd - r) * q) + off; }
        const int nig = WGM * nN, gid = wgid / nig, fm = gid * WGM, gsz = (nM - fm) < WGM ? (nM - fm) : WGM;
        u.pm = fm + ((wgid % nig) % gsz); u.pn = (wgid % nig) / gsz; return true;
    }
    __device__ __forceinline__ void a_ready(const Unit&) const {}
    __device__ __forceinline__ void done(const Unit&) const {}
};
__device__ __forceinline__ unsigned cvt_pk_bf16(float lo, float hi) { unsigned r; asm volatile("v_cvt_pk_bf16_f32 %0, %1, %2" : "=v"(r) : "v"(lo), "v"(hi)); return r; }
template <class Epi, class Sched, bool ALIGN_EPI = false, bool SP2 = false>
__device__ __forceinline__ void gemm_phase(PG8_LAS unsigned char* lds, const Gemm g, const Sched& S, const Epi& E) {
    int tid_ = threadIdx.x; asm volatile("" : "+v"(tid_)); const int tid = tid_, wid = __builtin_amdgcn_readfirstlane(tid >> 6), lane = tid & 63, wr = wid >> 2, wc = wid & 3, fr = lane & 15, fq = lane >> 4;
    const int K = g.K, nt = K / BK;
    unsigned voffA[2], voffB[2];
#pragma unroll
    for (int i = 0; i < 2; ++i) { int R, C; stage_rc(tid * 16 + i * 8192, R, C); const int Rb = Epi::PERM ? ((R & ~31) + perm32(R & 31)) : R;
        voffA[i] = (unsigned)(R * K + C) * 2u; voffB[i] = (unsigned)(Rb * K + C) * 2u; }
    const size_t kstep = (size_t)(BK * 2);
    const size_t hstep = (size_t)HALF * K * 2;
    const size_t tstep = 2 * hstep;
    const unsigned ldsw = (unsigned)wid * 1024u;
    const int aoff = lds_byte(wr * 64 + fr, fq * 8), boff = lds_byte(wc * 32 + fr, fq * 8);
#define PG8_SA(b, h) (((b) * 2 + (h)) * HTB)
#define PG8_SB(b, h) ((4 + (b) * 2 + (h)) * HTB)
#define PG8_STAGE(bufoff, gbase, voff) do { _Pragma("unroll") for (int _i = 0; _i < 2; ++_i) \
        __builtin_amdgcn_global_load_lds((const unsigned*)((const char*)(gbase) + (voff)[_i]), (PG8_LAS unsigned*)(lds + (bufoff) + ldsw + _i * 8192), 16, 0, 0); } while (0)
#define PG8_LDA(dst, b, h) do { _Pragma("unroll") for (int m = 0; m < 4; ++m) _Pragma("unroll") for (int k = 0; k < 2; ++k) dst[m][k] = *(const PG8_LAS bf16x8*)(lds + PG8_SA(b, h) + aoff + m * 2048 + k * 1024); } while (0)
#define PG8_LDB(dst, b, h) do { _Pragma("unroll") for (int n = 0; n < 2; ++n) _Pragma("unroll") for (int k = 0; k < 2; ++k) dst[n][k] = *(const PG8_LAS bf16x8*)(lds + PG8_SB(b, h) + boff + n * 2048 + k * 1024); } while (0)
#define PG8_MMA(ai, bj, At, Bt) do { __builtin_amdgcn_s_setprio(1); _Pragma("unroll") for (int m = 0; m < 4; ++m) _Pragma("unroll") for (int n = 0; n < 2; ++n) _Pragma("unroll") for (int k = 0; k < 2; ++k) \
        acc[ai][bj][m][n] = __builtin_amdgcn_mfma_f32_16x16x32_bf16(Bt[n][k], At[m][k], acc[ai][bj][m][n], 0, 0, 0); __builtin_amdgcn_s_setprio(0); } while (0)
#define PG8_WAIT_V(n) asm volatile("s_waitcnt vmcnt(" #n ")" ::: "memory")
#define PG8_WAIT_L(n) asm volatile("s_waitcnt lgkmcnt(" #n ")" ::: "memory")
#define PG8_BAR __builtin_amdgcn_s_barrier()
#define PG8_SCHED __builtin_amdgcn_sched_barrier(0)
    Unit cur, nxt; int ui = 0;
    if (!S.next(0, cur)) return;
    f32x4 acc[2][2][4][2];
#pragma unroll
    for (int a = 0; a < 2; ++a)
#pragma unroll
        for (int b = 0; b < 2; ++b)
#pragma unroll
            for (int m = 0; m < 4; ++m)
#pragma unroll
                for (int n = 0; n < 2; ++n) acc[a][b][m][n] = (f32x4){0.f, 0.f, 0.f, 0.f};
    bf16x8 At[4][2], B0[2][2], B1[2][2];
    const char* cA = (const char*)g.A + (size_t)cur.pm * tstep; const char* cB = (const char*)g.Bt + (size_t)cur.pn * tstep;
    S.a_ready(cur);
    if constexpr (SP2) {
        PG8_STAGE(PG8_SB(0, 0), cB, voffB); PG8_STAGE(PG8_SB(0, 1), cB + hstep, voffB); PG8_STAGE(PG8_SA(0, 0), cA, voffA); PG8_STAGE(PG8_SA(0, 1), cA + hstep, voffA);
        if (wr == 1) PG8_BAR;
        PG8_WAIT_V(2); PG8_BAR;
        PG8_STAGE(PG8_SB(1, 0), cB + kstep, voffB); PG8_STAGE(PG8_SA(1, 0), cA + kstep, voffA); PG8_STAGE(PG8_SB(1, 1), cB + hstep + kstep, voffB);
        PG8_WAIT_V(6); PG8_BAR;
    } else {
        PG8_STAGE(PG8_SB(0, 0), cB, voffB); PG8_STAGE(PG8_SA(0, 0), cA, voffA); PG8_STAGE(PG8_SB(0, 1), cB + hstep, voffB); PG8_STAGE(PG8_SA(0, 1), cA + hstep, voffA);
        if (wr == 1) PG8_BAR;
        PG8_WAIT_V(4); PG8_BAR;
        PG8_STAGE(PG8_SB(1, 0), cB + kstep, voffB); PG8_STAGE(PG8_SA(1, 0), cA + kstep, voffA); PG8_STAGE(PG8_SB(1, 1), cB + hstep + kstep, voffB);
        PG8_WAIT_V(6); PG8_BAR;
    }
    for (;;) {
        const bool has_next = S.next(ui + 1, nxt);
        const char* nA = has_next ? (const char*)g.A + (size_t)nxt.pm * tstep : cA; const char* nB = has_next ? (const char*)g.Bt + (size_t)nxt.pn * tstep : cB;
        for (int t = 0; t < nt; t += 2) {
            const bool last = (t == nt - 2);
            const char* a1 = cA + (size_t)(t + 1) * kstep;
            const char* a2 = last ? nA : cA + (size_t)(t + 2) * kstep; const char* b2 = last ? nB : cB + (size_t)(t + 2) * kstep;
            const char* a3 = a2 + kstep; const char* b3 = b2 + kstep;
            if (last && has_next) S.a_ready(nxt);
            if constexpr (SP2) {
            PG8_LDB(B0, 0, 0); PG8_LDB(B1, 0, 1); PG8_SCHED; PG8_LDA(At, 0, 0); PG8_STAGE(PG8_SA(1, 1), a1 + hstep, voffA);
            PG8_WAIT_V(8); PG8_WAIT_L(0); PG8_BAR; PG8_MMA(0, 0, At, B0); PG8_MMA(0, 1, At, B1); PG8_BAR; PG8_SCHED;
            PG8_LDA(At, 0, 1); PG8_STAGE(PG8_SB(0, 0), b2, voffB); PG8_STAGE(PG8_SB(0, 1), b2 + hstep, voffB); PG8_STAGE(PG8_SA(0, 0), a2, voffA);
            PG8_WAIT_V(8); PG8_WAIT_L(0); PG8_BAR; PG8_MMA(1, 0, At, B0); PG8_MMA(1, 1, At, B1); PG8_BAR; PG8_SCHED;
            PG8_LDB(B0, 1, 0); PG8_LDB(B1, 1, 1); PG8_SCHED; PG8_LDA(At, 1, 0); PG8_STAGE(PG8_SA(0, 1), a2 + hstep, voffA);
            PG8_WAIT_V(8); PG8_WAIT_L(0); PG8_BAR; PG8_MMA(0, 0, At, B0); PG8_MMA(0, 1, At, B1); PG8_BAR; PG8_SCHED;
            PG8_LDA(At, 1, 1); PG8_STAGE(PG8_SB(1, 0), b3, voffB); PG8_STAGE(PG8_SB(1, 1), b3 + hstep, voffB); PG8_STAGE(PG8_SA(1, 0), a3, voffA);
            PG8_WAIT_V(8); PG8_WAIT_L(0); PG8_BAR; PG8_MMA(1, 0, At, B0); PG8_MMA(1, 1, At, B1); PG8_BAR; PG8_SCHED;
            } else {
            PG8_LDB(B0, 0, 0); PG8_SCHED; PG8_LDA(At, 0, 0); PG8_STAGE(PG8_SA(1, 1), a1 + hstep, voffA);
            PG8_WAIT_L(8); PG8_BAR; PG8_WAIT_L(0); PG8_MMA(0, 0, At, B0); PG8_BAR; PG8_SCHED;
            PG8_LDB(B1, 0, 1); PG8_STAGE(PG8_SB(0, 0), b2, voffB);
            PG8_BAR; PG8_WAIT_L(0); PG8_MMA(0, 1, At, B1); PG8_BAR;
            PG8_LDA(At, 0, 1); PG8_STAGE(PG8_SA(0, 0), a2, voffA);
            PG8_BAR; PG8_WAIT_L(0); PG8_MMA(1, 0, At, B0); PG8_BAR; PG8_SCHED;
            PG8_STAGE(PG8_SB(0, 1), b2 + hstep, voffB);
            PG8_WAIT_V(6); PG8_BAR; PG8_MMA(1, 1, At, B1); PG8_BAR;
            PG8_LDB(B0, 1, 0); PG8_SCHED; PG8_LDA(At, 1, 0); PG8_STAGE(PG8_SA(0, 1), a2 + hstep, voffA);
            PG8_WAIT_L(8); PG8_BAR; PG8_WAIT_L(0); PG8_MMA(0, 0, At, B0); PG8_BAR; PG8_SCHED;
            PG8_LDB(B1, 1, 1); PG8_STAGE(PG8_SB(1, 0), b3, voffB);
            PG8_BAR; PG8_WAIT_L(0); PG8_MMA(0, 1, At, B1); PG8_BAR;
            PG8_LDA(At, 1, 1); PG8_STAGE(PG8_SA(1, 0), a3, voffA);
            PG8_BAR; PG8_WAIT_L(0); PG8_MMA(1, 0, At, B0); PG8_BAR; PG8_SCHED;
            PG8_STAGE(PG8_SB(1, 1), b3 + hstep, voffB);
            PG8_WAIT_V(6); PG8_BAR; PG8_MMA(1, 1, At, B1); PG8_BAR;
            }
        }
        if constexpr (ALIGN_EPI) { if (wr == 0) PG8_BAR; }
        if constexpr (!Epi::AFTER_DRAIN) { E(acc, cur, wr, wc, fr, fq); S.done(cur); }
        if (!has_next) break;
#pragma unroll
        for (int a = 0; a < 2; ++a)
#pragma unroll
            for (int b = 0; b < 2; ++b)
#pragma unroll
                for (int m = 0; m < 4; ++m)
#pragma unroll
                    for (int n = 0; n < 2; ++n) acc[a][b][m][n] = (f32x4){0.f, 0.f, 0.f, 0.f};
        cur = nxt; cA = nA; cB = nB; ++ui;
        if constexpr (ALIGN_EPI) { if (wr == 1) PG8_BAR; }
    }
    PG8_WAIT_V(0);
    if constexpr (!ALIGN_EPI) { if (wr == 0) PG8_BAR; }
    PG8_BAR;
    if constexpr (Epi::AFTER_DRAIN) { E.fused(acc, cur, wr, wc, fr, fq, lds, wid, lane); S.done(cur); }
#undef PG8_SA
#undef PG8_SB
#undef PG8_STAGE
#undef PG8_LDA
#undef PG8_LDB
#undef PG8_MMA
#undef PG8_WAIT_V
#undef PG8_WAIT_L
#undef PG8_BAR
#undef PG8_SCHED
}
}

#define LAS __attribute__((address_space(3)))
typedef unsigned short bf16_t;
typedef short bf16x8 __attribute__((ext_vector_type(8)));
typedef float f32x4 __attribute__((ext_vector_type(4)));
typedef float f32x2 __attribute__((ext_vector_type(2)));
typedef float f32x16 __attribute__((ext_vector_type(16)));
typedef unsigned u32x4 __attribute__((ext_vector_type(4)));
typedef unsigned u32x2 __attribute__((ext_vector_type(2)));

#ifndef GEMM_ALIGN
#define GEMM_ALIGN true
#endif
#ifndef GEMM_SP2
#define GEMM_SP2 true
#endif
#ifndef N_LAUNCH_MODE
#define N_LAUNCH_MODE 1
#endif

constexpr int D = 2048, T = 16384, CL = 256, R = T + CL, DIN = 5120, NCHK = R / 128;
constexpr int NPHASE = 13;
constexpr float EPS = 1e-6f;
constexpr int LDS_BYTES = 131072 + 4096;

constexpr size_t WS_WINT = 0;
constexpr size_t WS_WOUTT = WS_WINT + (size_t)2 * DIN * D * 2;
constexpr size_t WS_XG = WS_WOUTT + (size_t)2 * D * D * 2;
constexpr size_t WS_PX = WS_XG + (size_t)R * D * 2;
constexpr size_t WS_Y = WS_PX + (size_t)R * DIN * 2;
constexpr size_t WS_X1C = WS_Y + (size_t)R * D * 2;
constexpr size_t WS_MOD = WS_X1C + (size_t)CL * D * 4;
constexpr size_t WS_GG = WS_MOD + (size_t)2 * 2 * 6144 * 4;
constexpr size_t WS_SHW = WS_GG + (size_t)2 * 2 * D * 4;
constexpr size_t WS_RSS = WS_SHW + (size_t)2 * 2 * DIN * 4;
constexpr size_t WS_GW = WS_RSS + (size_t)3 * R * 4 + 64;
constexpr size_t WS_SW = WS_GW + (size_t)2 * 16 * 2 * 2 * 2 * 4 * 64 * 8 * 2;
constexpr size_t WS_AGG = WS_SW + (size_t)2 * 8 * 128 * 128 * 2;
constexpr size_t WS_CARRY = WS_AGG + (size_t)2 * NCHK * 1024 * 8;
constexpr size_t WS_BAR = (WS_CARRY + (size_t)2 * NCHK * 1024 * 4 + 255) / 256 * 256;
constexpr size_t WS_DL0 = WS_BAR + 16384;
constexpr size_t WS_END = WS_DL0 + (size_t)T * D * 2;

struct Args { const float* in[25]; float* out; unsigned char* ws; int ph_lo, ph_hi; };

__device__ __forceinline__ float bflo(unsigned w) { return __uint_as_float(w << 16); }
__device__ __forceinline__ float bfhi(unsigned w) { return __uint_as_float(w & 0xffff0000u); }
__device__ __forceinline__ float bf1(bf16_t h) { return __uint_as_float((unsigned)h << 16); }
__device__ __forceinline__ unsigned pk2(float lo, float hi) { return pg8::cvt_pk_bf16(lo, hi); }
__device__ __forceinline__ bf16_t f2bf(float f) { return (bf16_t)(pk2(f, 0.f) & 0xffffu); }
__device__ __forceinline__ float rcpf_(float x) { return __builtin_amdgcn_rcpf(x); }
__device__ __forceinline__ float sigm(float x) { return rcpf_(1.0f + __expf(-x)); }
__device__ __forceinline__ float silu(float x) { return x * sigm(x); }
__device__ __forceinline__ float gelu_t(float x) { return x * sigm(1.5957691216f * (x + 0.044715f * x * x * x)); }
template <int CTRL> __device__ __forceinline__ float dpp_mov(float v) { return __int_as_float(__builtin_amdgcn_update_dpp(0, __float_as_int(v), CTRL, 0xf, 0xf, true)); }
__device__ __forceinline__ float wave_sum(float v) {
    v += dpp_mov<0xB1>(v);
    v += dpp_mov<0x4E>(v);
    v += dpp_mov<0x141>(v);
    v += dpp_mov<0x140>(v);
    const int iv = __float_as_int(v);
    return (__int_as_float(__builtin_amdgcn_readlane(iv, 0)) + __int_as_float(__builtin_amdgcn_readlane(iv, 16))) + (__int_as_float(__builtin_amdgcn_readlane(iv, 32)) + __int_as_float(__builtin_amdgcn_readlane(iv, 48)));
}
__device__ __forceinline__ int tid_fresh() { int t = threadIdx.x; asm volatile("" : "+v"(t)); return t; }
#define GAS __attribute__((address_space(1)))
__device__ __forceinline__ unsigned char* ptr_fresh(unsigned char* p) {
#ifdef FLAT_WS
    asm volatile("" : "+s"(p)); return p; }
#else
    unsigned long long v = (unsigned long long)p; asm volatile("" : "+s"(v)); return (unsigned char*)(GAS unsigned char*)v; }
#endif
#define LDS_WAIT() asm volatile("s_waitcnt lgkmcnt(0)" ::: "memory")

struct EpiIn {
    static constexpr bool PERM = true, AFTER_DRAIN = false;
    bf16_t* PX; const float* rss; const float* shw;
    __device__ __forceinline__ void operator()(const f32x4 (&acc)[2][2][4][2], const pg8::Unit& u, int wr, int wc, int fr, int fq) const {
        const int row0 = CL + u.pm * 256 + wr * 64 + fr, col0 = u.pn * 256 + wc * 32 + 8 * fq;
        const float* sw = shw + col0;
        f32x4 bv[2][2];
#pragma unroll
        for (int bj = 0; bj < 2; ++bj)
#pragma unroll
            for (int n = 0; n < 2; ++n) bv[bj][n] = *(const f32x4*)(sw + bj * 128 + 4 * n);
#pragma unroll
        for (int ai = 0; ai < 2; ++ai)
#pragma unroll
            for (int m = 0; m < 4; ++m) {
                const int r = row0 + ai * 128 + m * 16;
                const float rs = 1.0f / sqrtf(rss[r] * (1.0f / D) + EPS);
                bf16_t* rowp = PX + (size_t)r * DIN + col0;
#pragma unroll
                for (int bj = 0; bj < 2; ++bj) {
                    const f32x4 v0 = acc[ai][bj][m][0] * rs + bv[bj][0], v1 = acc[ai][bj][m][1] * rs + bv[bj][1];
                    u32x4 w; w.x = pk2(v0[0], v0[1]); w.y = pk2(v0[2], v0[3]); w.z = pk2(v1[0], v1[1]); w.w = pk2(v1[2], v1[3]);
                    *(u32x4*)(rowp + bj * 128) = w;
                }
            }
    }
};
struct EpiOut {
    static constexpr bool PERM = true, AFTER_DRAIN = false;
    int row_off, last;
    const float* xold_lat; const float* xold_ctx; float* xnew_lat; float* xnew_ctx;
    const float* gvec;
    const float* ggn;
    bf16_t* XG; float* rssn;
    __device__ __forceinline__ void operator()(const f32x4 (&acc)[2][2][4][2], const pg8::Unit& u, int wr, int wc, int fr, int fq) const {
        const int gbase = row_off + u.pm * 256;
        const bool isctx = gbase < CL;
        const int seg = isctx ? 1 : 0;
        const int grow0 = gbase + wr * 64 + fr, col0 = u.pn * 256 + wc * 32 + 8 * fq;
        const float* xo = isctx ? xold_ctx : (xold_lat - (size_t)CL * D);
        float* xn = isctx ? xnew_ctx : (xnew_lat - (size_t)CL * D);
        const float* gp = gvec + seg * 6144 + 4096 + col0;
        const float* ggp = ggn + seg * D + col0;
        f32x4 gv[2][2], gg[2][2];
#pragma unroll
        for (int bj = 0; bj < 2; ++bj)
#pragma unroll
            for (int n = 0; n < 2; ++n) { gv[bj][n] = *(const f32x4*)(gp + bj * 128 + 4 * n); gg[bj][n] = last ? (f32x4){0.f, 0.f, 0.f, 0.f} : *(const f32x4*)(ggp + bj * 128 + 4 * n); }
#pragma unroll
        for (int ai = 0; ai < 2; ++ai)
#pragma unroll
            for (int m = 0; m < 4; ++m) {
                const int r = grow0 + ai * 128 + m * 16;
                const size_t ro = (size_t)r * D + col0;
                float ss = 0.f;
#pragma unroll
                for (int bj = 0; bj < 2; ++bj) {
                    const f32x4 o0 = *(const f32x4*)(xo + ro + bj * 128), o1 = *(const f32x4*)(xo + ro + bj * 128 + 4);
                    const f32x4 v0 = o0 + gv[bj][0] * acc[ai][bj][m][0], v1 = o1 + gv[bj][1] * acc[ai][bj][m][1];
                    *(f32x4*)(xn + ro + bj * 128) = v0; *(f32x4*)(xn + ro + bj * 128 + 4) = v1;
                    ss += (v0[0] * v0[0] + v0[1] * v0[1]) + (v0[2] * v0[2] + v0[3] * v0[3]) + (v1[0] * v1[0] + v1[1] * v1[1]) + (v1[2] * v1[2] + v1[3] * v1[3]);
                    if (!last) {
                        const f32x4 a0 = v0 * gg[bj][0], a1 = v1 * gg[bj][1];
                        u32x4 w; w.x = pk2(a0[0], a0[1]); w.y = pk2(a0[2], a0[3]); w.z = pk2(a1[0], a1[1]); w.w = pk2(a1[2], a1[3]);
                        *(u32x4*)(XG + ro + bj * 128) = w;
                    }
                }
                ss += __shfl_xor(ss, 16); ss += __shfl_xor(ss, 32);
                if (fq == 0) unsafeAtomicAdd(rssn + r, ss);
            }
    }
};

struct EpiDelta {
    static constexpr bool PERM = true, AFTER_DRAIN = false;
    bf16_t* DL; const float* gvec;
    __device__ __forceinline__ void operator()(const f32x4 (&acc)[2][2][4][2], const pg8::Unit& u, int wr, int wc, int fr, int fq) const {
        const int row0 = u.pm * 256 + wr * 64 + fr, col0 = u.pn * 256 + wc * 32 + 8 * fq;
        f32x4 gv[2][2];
#pragma unroll
        for (int bj = 0; bj < 2; ++bj)
#pragma unroll
            for (int n = 0; n < 2; ++n) gv[bj][n] = *(const f32x4*)(gvec + col0 + bj * 128 + 4 * n);
#pragma unroll
        for (int ai = 0; ai < 2; ++ai)
#pragma unroll
            for (int m = 0; m < 4; ++m) {
                bf16_t* rowp = DL + (size_t)(row0 + ai * 128 + m * 16) * D + col0;
#pragma unroll
                for (int bj = 0; bj < 2; ++bj) {
                    const f32x4 v0 = acc[ai][bj][m][0] * gv[bj][0], v1 = acc[ai][bj][m][1] * gv[bj][1];
                    u32x4 w; w.x = pk2(v0[0], v0[1]); w.y = pk2(v0[2], v0[3]); w.z = pk2(v1[0], v1[1]); w.w = pk2(v1[2], v1[3]);
                    *(u32x4*)(rowp + bj * 128) = w;
                }
            }
    }
};

__device__ __forceinline__ void transpose_item(const float* W, int K, int N, bf16_t* WT, LAS float* scr, int item, int lane) {
    const int nblk = N / 32, kb = item / nblk, nb = item % nblk, k0 = 64 * kb, n0 = 32 * nb;
#pragma unroll 8
    for (int i = 0; i < 32; ++i) { const int kk = 2 * i + (lane >> 5); scr[kk * 33 + (lane & 31)] = __builtin_nontemporal_load(W + (size_t)(k0 + kk) * N + n0 + (lane & 31)); }
    LDS_WAIT();
    const int c = lane & 7;
#pragma unroll
    for (int j = 0; j < 4; ++j) { const int n = (lane >> 3) + 8 * j; const LAS float* s = scr + (8 * c) * 33 + n;
        u32x4 o; o.x = pk2(s[0 * 33], s[1 * 33]); o.y = pk2(s[2 * 33], s[3 * 33]); o.z = pk2(s[4 * 33], s[5 * 33]); o.w = pk2(s[6 * 33], s[7 * 33]);
        *(u32x4*)(WT + (size_t)(n0 + n) * K + k0 + 8 * c) = o; }
    LDS_WAIT();
}

__device__ __forceinline__ void phase0a(const Args a, LAS unsigned char* lds) {
    const int tid = tid_fresh(), lane = tid & 63, wave = tid >> 6, b = blockIdx.x, G = gridDim.x;
    unsigned char* ws = ptr_fresh(a.ws);
    { float* rss = (float*)(ws + WS_RSS); for (int i = b * 512 + tid; i < 2 * R; i += G * 512) rss[R + i] = 0.f; }
    { bf16_t* GW = (bf16_t*)(ws + WS_GW);
      for (int gid = b * 512 + tid; gid < 2 * 16 * 2 * 2 * 2 * 4 * 64; gid += G * 512) {
          int x = gid; const int ln = x & 63; x >>= 6; const int s = x & 3; x >>= 2; const int half = x & 1; x >>= 1; const int gate = x & 1; x >>= 1; const int dir = x & 1; x >>= 1; const int hd = x & 15; x >>= 4; const int l = x;
          const float* w = (gate ? a.in[14] : a.in[12]) + ((size_t)((l * 2 + dir) * 16 + hd)) * 4096;
          const int col = 32 * half + (ln & 31), k0 = 16 * s + 8 * (ln >> 5);
          float v[8];
#pragma unroll
          for (int j = 0; j < 8; ++j) v[j] = w[(k0 + j) * 64 + col];
          u32x4 o; o.x = pk2(v[0], v[1]); o.y = pk2(v[2], v[3]); o.z = pk2(v[4], v[5]); o.w = pk2(v[6], v[7]);
          *(u32x4*)(GW + (size_t)gid * 8) = o;
      } }
    { bf16_t* SW = (bf16_t*)(ws + WS_SW); const float* sw = a.in[22];
      for (int i = b * 512 + tid; i < 2 * 8 * 128 * 128 / 4; i += G * 512) { const f32x4 v = *(const f32x4*)(sw + (size_t)i * 4); u32x2 o; o.x = pk2(v[0], v[1]); o.y = pk2(v[2], v[3]); *(u32x2*)(SW + (size_t)i * 4) = o; } }
    { const float* c = a.in[1]; const float* cc = a.in[3]; float* MOD = (float*)(ws + WS_MOD);
      LAS float* red = (LAS float*)lds;
      for (int u = b; u < 192; u += G) {
          const int l = u / 96, n0 = (u % 96) * 64, q = tid & 15, ks = tid >> 4;
          const float* W = a.in[4] + (size_t)l * D * 6144 + n0 + 4 * q;
          f32x4 a0 = {0.f, 0.f, 0.f, 0.f}, a1 = {0.f, 0.f, 0.f, 0.f};
#pragma unroll 8
          for (int kk = 0; kk < 64; ++kk) { const int k = ks * 64 + kk; const f32x4 wv = __builtin_nontemporal_load((const f32x4*)(W + (size_t)k * 6144)); const float ca = silu(c[k]), cb = silu(cc[k]); a0 += wv * ca; a1 += wv * cb; }
          LAS float* rp = red + (ks * 16 + q) * 8;
          *(LAS f32x4*)rp = a0; *(LAS f32x4*)(rp + 4) = a1;
          __syncthreads();
          if (tid < 128) { const int qq = tid >> 3, e = tid & 7; float s = 0.f;
#pragma unroll 8
              for (int k2 = 0; k2 < 32; ++k2) s += red[(k2 * 16 + qq) * 8 + e];
              const int seg = e >> 2, col = n0 + 4 * qq + (e & 3);
              MOD[(l * 2 + seg) * 6144 + col] = s + a.in[5][l * 6144 + col]; }
          __syncthreads();
      } }
    { LAS float* scr = (LAS float*)(lds + wave * 16384);
      const int gw = b * 8 + wave, NGW = G * 8;
      constexpr int I_IN = (D / 64) * (DIN / 32), I_OUT = (D / 64) * (D / 32);
      for (int it = gw; it < 2 * I_IN + 2 * I_OUT; it += NGW) {
          int r = it;
          if (r < 2 * I_IN) { const int l = r / I_IN; transpose_item(a.in[7] + (size_t)l * D * DIN, D, DIN, (bf16_t*)(ws + WS_WINT) + (size_t)l * DIN * D, scr, r % I_IN, lane); continue; }
          r -= 2 * I_IN; { const int l = r / I_OUT; transpose_item(a.in[8] + (size_t)l * D * D, D, D, (bf16_t*)(ws + WS_WOUTT) + (size_t)l * D * D, scr, r % I_OUT, lane); }
      } }
}

__device__ __forceinline__ void phase0b(const Args a, LAS unsigned char* lds) {
    const int tid = tid_fresh(), lane = tid & 63, wave = tid >> 6, b = blockIdx.x, G = gridDim.x;
    unsigned char* ws = ptr_fresh(a.ws);
    const float* MOD = (const float*)(ws + WS_MOD);
    LAS float* GG0 = (LAS float*)lds;
    LAS float* SH = (LAS float*)(lds + 16384);
    for (int i = tid; i < 2 * D; i += 512) { const int seg = i >> 11, k = i & 2047; float gv_ = a.in[6][k] * (1.0f + MOD[seg * 6144 + 2048 + k]); if (gv_ == 0.f) gv_ = 1e-30f; GG0[i] = gv_; }
    for (int i = tid; i < 4 * D; i += 512) { const int ls = i >> 11, k = i & 2047; SH[i] = MOD[ls * 6144 + k]; }
    { float* GGt = (float*)(ws + WS_GG); for (int i = b * 512 + tid; i < 4 * D; i += G * 512) { const int ls = i >> 11, l = ls >> 1, k = i & 2047; float gv_ = a.in[6][l * D + k] * (1.0f + MOD[ls * 6144 + 2048 + k]); if (gv_ == 0.f) gv_ = 1e-30f; GGt[i] = gv_; } }
    __syncthreads();
    const int gw = b * 8 + wave, NGW = G * 8;
    { bf16_t* XG = (bf16_t*)(ws + WS_XG); float* rss = (float*)(ws + WS_RSS);
      f32x4 vr[8];
#define P0B_LOAD(r_, V) do { const float* _src = (r_) < CL ? a.in[2] + (size_t)(r_) * D : a.in[0] + (size_t)((r_) - CL) * D; \
          _Pragma("unroll") for (int j = 0; j < 8; ++j) V[j] = __builtin_nontemporal_load((const f32x4*)(_src + 4 * (lane + 64 * j))); } while (0)
      int r = gw;
      if (r < R) P0B_LOAD(r, vr);
      for (; r < R; r += NGW) {
          f32x4 vn[8];
          const int rn = r + NGW;
          if (rn < R) P0B_LOAD(rn, vn);
          const int seg = r < CL ? 1 : 0;
          float ss = 0.f;
#pragma unroll
          for (int j = 0; j < 8; ++j) ss += (vr[j][0] * vr[j][0] + vr[j][1] * vr[j][1]) + (vr[j][2] * vr[j][2] + vr[j][3] * vr[j][3]);
#pragma unroll
          for (int j = 0; j < 8; ++j) { const f32x4 g = *(LAS f32x4*)(GG0 + seg * D + 4 * (lane + 64 * j)); const f32x4 p = vr[j] * g; u32x2 o; o.x = pk2(p[0], p[1]); o.y = pk2(p[2], p[3]); *(u32x2*)(XG + (size_t)r * D + 4 * (lane + 64 * j)) = o; }
          ss = wave_sum(ss);
          if (lane == 0) rss[r] = ss;
          if (rn < R) {
#pragma unroll
              for (int j = 0; j < 8; ++j) vr[j] = vn[j];
          }
      }
#undef P0B_LOAD
    }
    { float* SHW = (float*)(ws + WS_SHW); const bf16_t* WinT = (const bf16_t*)(ws + WS_WINT);
      u32x4 wr[4];
#define SHW_LOAD(i_, W_) do { const bf16_t* _row = WinT + (size_t)(i_) * D; _Pragma("unroll") for (int j = 0; j < 4; ++j) W_[j] = *(const u32x4*)(_row + 8 * (lane + 64 * j)); } while (0)
      int idx = gw;
      if (idx < 2 * DIN) SHW_LOAD(idx, wr);
      for (; idx < 2 * DIN; idx += NGW) {
          u32x4 wn[4];
          const int idn = idx + NGW;
          if (idn < 2 * DIN) SHW_LOAD(idn, wn);
          const int l = idx / DIN, n = idx % DIN;
          float d0 = 0.f, d1 = 0.f;
#pragma unroll
          for (int j = 0; j < 4; ++j) { const int k = 8 * (lane + 64 * j); const u32x4 w = wr[j];
              const LAS float* s0 = SH + (l * 2 + 0) * D + k; const LAS float* s1 = SH + (l * 2 + 1) * D + k;
              const f32x4 x0 = *(LAS f32x4*)s0, x1 = *(LAS f32x4*)(s0 + 4), y0 = *(LAS f32x4*)s1, y1 = *(LAS f32x4*)(s1 + 4);
              const float w0 = bflo(w.x), w1 = bfhi(w.x), w2 = bflo(w.y), w3 = bfhi(w.y), w4 = bflo(w.z), w5 = bfhi(w.z), w6 = bflo(w.w), w7 = bfhi(w.w);
              d0 += (w0 * x0[0] + w1 * x0[1]) + (w2 * x0[2] + w3 * x0[3]) + (w4 * x1[0] + w5 * x1[1]) + (w6 * x1[2] + w7 * x1[3]);
              d1 += (w0 * y0[0] + w1 * y0[1]) + (w2 * y0[2] + w3 * y0[3]) + (w4 * y1[0] + w5 * y1[1]) + (w6 * y1[2] + w7 * y1[3]); }
          d0 = wave_sum(d0); d1 = wave_sum(d1);
          if (lane == 0) { SHW[(l * 2 + 0) * DIN + n] = d0; SHW[(l * 2 + 1) * DIN + n] = d1; }
          if (idn < 2 * DIN) {
#pragma unroll
              for (int j = 0; j < 4; ++j) wr[j] = wn[j];
          }
      }
#undef SHW_LOAD
    }
    __syncthreads();
}

constexpr int XLF_STRIDE = 68, XLB_STRIDE = 72;
constexpr int LRU_XLF = 0, LRU_XLB = 128 * XLF_STRIDE * 4, LRU_TAGG = LRU_XLB + 128 * XLB_STRIDE * 2;

template <bool PASSC>
__device__ __forceinline__ void lru_item(const Args a, int l, int chunk, int hd, LAS unsigned char* lds) {
    const int tid = tid_fresh(), lane = tid & 63, wave = tid >> 6;
    unsigned char* ws = ptr_fresh(a.ws);
    const bf16_t* PX = (const bf16_t*)(ws + WS_PX);
    LAS float* XLF = (LAS float*)(lds + LRU_XLF);
    LAS bf16_t* XLB = (LAS bf16_t*)(lds + LRU_XLB);
    LAS f32x2* TAGG = (LAS f32x2*)(lds + LRU_TAGG);
    __syncthreads();
    {
        const int t = tid >> 2, q = tid & 3, ch0 = hd * 64 + q * 16;
        const int grow = chunk * 128 + t, seg_lo = chunk < 2 ? 0 : CL, seg_hi = chunk < 2 ? CL : R;
        const float* cw = a.in[9] + (size_t)l * 4 * 1024 + ch0; const float* cb = a.in[10] + (size_t)l * 1024 + ch0;
        float xl[16];
#pragma unroll
        for (int c4 = 0; c4 < 4; ++c4) { const f32x4 bb = *(const f32x4*)(cb + 4 * c4); xl[4 * c4] = bb[0]; xl[4 * c4 + 1] = bb[1]; xl[4 * c4 + 2] = bb[2]; xl[4 * c4 + 3] = bb[3]; }
#pragma unroll
        for (int j = 0; j < 4; ++j) {
            const int rr = grow + j - 2;
            if (rr >= seg_lo && rr < seg_hi) {
                const u32x4 p0 = *(const u32x4*)(PX + (size_t)rr * DIN + ch0), p1 = *(const u32x4*)(PX + (size_t)rr * DIN + ch0 + 8);
                const unsigned pw[8] = {p0.x, p0.y, p0.z, p0.w, p1.x, p1.y, p1.z, p1.w};
#pragma unroll
                for (int c4 = 0; c4 < 4; ++c4) { const f32x4 wv = *(const f32x4*)(cw + j * 1024 + 4 * c4);
                    xl[4 * c4 + 0] += wv[0] * bflo(pw[2 * c4]); xl[4 * c4 + 1] += wv[1] * bfhi(pw[2 * c4]); xl[4 * c4 + 2] += wv[2] * bflo(pw[2 * c4 + 1]); xl[4 * c4 + 3] += wv[3] * bfhi(pw[2 * c4 + 1]); }
            }
        }
        LAS float* xf = XLF + t * XLF_STRIDE + q * 16;
#pragma unroll
        for (int c4 = 0; c4 < 4; ++c4) *(LAS f32x4*)(xf + 4 * c4) = (f32x4){xl[4 * c4], xl[4 * c4 + 1], xl[4 * c4 + 2], xl[4 * c4 + 3]};
        LAS bf16_t* xb = XLB + t * XLB_STRIDE + q * 16;
        u32x4 o0, o1; o0.x = pk2(xl[0], xl[1]); o0.y = pk2(xl[2], xl[3]); o0.z = pk2(xl[4], xl[5]); o0.w = pk2(xl[6], xl[7]); o1.x = pk2(xl[8], xl[9]); o1.y = pk2(xl[10], xl[11]); o1.z = pk2(xl[12], xl[13]); o1.w = pk2(xl[14], xl[15]);
        *(LAS u32x4*)xb = o0; *(LAS u32x4*)(xb + 8) = o1;
    }
    __syncthreads();
    const int tw = wave >> 1, chh = wave & 1, cl = lane & 31, hh = lane >> 5;
    const int cin = 32 * chh + cl, cg_ = hd * 64 + cin;
    bf16x8 Af[4];
#pragma unroll
    for (int s = 0; s < 4; ++s) Af[s] = *(const LAS bf16x8*)(XLB + (32 * tw + cl) * XLB_STRIDE + 16 * s + 8 * hh);
    float xlv[16];
#pragma unroll
    for (int i = 0; i < 16; ++i) xlv[i] = XLF[(32 * tw + (i & 3) + 8 * (i >> 2) + 4 * hh) * XLF_STRIDE + cin];
    float av[2][16], bv[2][16];
    float GA[2][8], GB[2][8];
    const bf16_t* GW = (const bf16_t*)(ws + WS_GW);
#pragma unroll
    for (int dir = 0; dir < 2; ++dir) {
        f32x16 ar, ai;
#pragma unroll
        for (int i = 0; i < 16; ++i) { ar[i] = 0.f; ai[i] = 0.f; }
#pragma unroll
        for (int s = 0; s < 4; ++s) {
            const size_t gr = ((((((size_t)(l * 16 + hd) * 2 + dir) * 2 + 0) * 2 + chh) * 4 + s) * 64 + lane) * 8;
            const size_t gi = ((((((size_t)(l * 16 + hd) * 2 + dir) * 2 + 1) * 2 + chh) * 4 + s) * 64 + lane) * 8;
            const bf16x8 Br = *(const bf16x8*)(GW + gr), Bi = *(const bf16x8*)(GW + gi);
            ar = __builtin_amdgcn_mfma_f32_32x32x16_bf16(Af[s], Br, ar, 0, 0, 0);
            ai = __builtin_amdgcn_mfma_f32_32x32x16_bf16(Af[s], Bi, ai, 0, 0, 0);
        }
        const float brv = a.in[13][(size_t)(l * 2 + dir) * 1024 + cg_], biv = a.in[15][(size_t)(l * 2 + dir) * 1024 + cg_];
        const float lam = a.in[11][(size_t)(l * 2 + dir) * 1024 + cg_];
        const float k8 = -8.0f * log1pf(__expf(-lam));
#pragma unroll
        for (int i = 0; i < 16; ++i) {
            const float rg = sigm(ar[i] + brv), ig = sigm(ai[i] + biv);
            const float la = k8 * rg;
            av[dir][i] = __expf(la);
            const float aa = av[dir][i]; bv[dir][i] = __builtin_amdgcn_sqrtf(fmaxf(1.0f - aa * aa, 0.f)) * ig * xlv[i];
        }
        float oA[4], oB[4];
#pragma unroll
        for (int g = 0; g < 4; ++g) {
            const float a0 = av[dir][4 * g], a1 = av[dir][4 * g + 1], a2 = av[dir][4 * g + 2], a3 = av[dir][4 * g + 3];
            const float b0 = bv[dir][4 * g], b1 = bv[dir][4 * g + 1], b2 = bv[dir][4 * g + 2], b3 = bv[dir][4 * g + 3];
            oA[g] = (a0 * a1) * (a2 * a3);
            oB[g] = dir == 0 ? ((b0 * a1 + b1) * a2 + b2) * a3 + b3 : ((b3 * a2 + b2) * a1 + b1) * a0 + b0;
        }
#pragma unroll
        for (int g = 0; g < 4; ++g) {
            const float pA = __shfl_xor(oA[g], 32), pB = __shfl_xor(oB[g], 32);
            GA[dir][2 * g] = hh ? pA : oA[g]; GA[dir][2 * g + 1] = hh ? oA[g] : pA;
            GB[dir][2 * g] = hh ? pB : oB[g]; GB[dir][2 * g + 1] = hh ? oB[g] : pB;
        }
        float tA = 1.f, tB = 0.f;
        if (dir == 0) {
#pragma unroll
            for (int gq = 0; gq < 8; ++gq) { tB = GA[dir][gq] * tB + GB[dir][gq]; tA *= GA[dir][gq]; }
        } else {
#pragma unroll
            for (int gq = 7; gq >= 0; --gq) { tB = GA[dir][gq] * tB + GB[dir][gq]; tA *= GA[dir][gq]; }
        }
        if (hh == 0) TAGG[(tw * 2 + dir) * 64 + cin] = (f32x2){tA, tB};
    }
    __syncthreads();
    if constexpr (!PASSC) {
        if (tid < 128) {
            const int dir = tid >> 6, c = tid & 63;
            float cA = 1.f, cB = 0.f;
#pragma unroll
            for (int k = 0; k < 4; ++k) { const int t2 = dir == 0 ? k : 3 - k; const f32x2 v = TAGG[(t2 * 2 + dir) * 64 + c]; cB = v[0] * cB + v[1]; cA *= v[0]; }
            f32x2* AGG = (f32x2*)(ws + WS_AGG);
            AGG[((size_t)dir * NCHK + chunk) * 1024 + hd * 64 + c] = (f32x2){cA, cB};
        }
    } else {
        const float* CARRY = (const float*)(ws + WS_CARRY);
        float yv[16];
#pragma unroll
        for (int dir = 0; dir < 2; ++dir) {
            float st = CARRY[((size_t)dir * NCHK + chunk) * 1024 + cg_];
            if (dir == 0) {
#pragma unroll
                for (int t2 = 0; t2 < 3; ++t2) if (t2 < tw) { const f32x2 v = TAGG[(t2 * 2 + 0) * 64 + cin]; st = v[0] * st + v[1]; }
            } else {
#pragma unroll
                for (int t2 = 3; t2 > 0; --t2) if (t2 > tw) { const f32x2 v = TAGG[(t2 * 2 + 1) * 64 + cin]; st = v[0] * st + v[1]; }
            }
            float hst[4];
            if (dir == 0) {
                float s = st;
#pragma unroll
                for (int g = 0; g < 4; ++g) { const float sE = s; s = GA[0][2 * g] * s + GB[0][2 * g]; const float sO = s; s = GA[0][2 * g + 1] * s + GB[0][2 * g + 1]; hst[g] = hh ? sO : sE; }
            } else {
                float s = st;
#pragma unroll
                for (int g = 3; g >= 0; --g) { const float sO = s; s = GA[1][2 * g + 1] * s + GB[1][2 * g + 1]; const float sE = s; s = GA[1][2 * g] * s + GB[1][2 * g]; hst[g] = hh ? sO : sE; }
            }
#pragma unroll
            for (int g = 0; g < 4; ++g) {
                float h = hst[g];
                if (dir == 0) {
#pragma unroll
                    for (int k = 0; k < 4; ++k) { h = av[0][4 * g + k] * h + bv[0][4 * g + k]; yv[4 * g + k] = h; }
                } else {
#pragma unroll
                    for (int k = 3; k >= 0; --k) { h = av[1][4 * g + k] * h + bv[1][4 * g + k]; yv[4 * g + k] += h; }
                }
            }
        }
        bf16_t* Y = (bf16_t*)(ws + WS_Y);
#pragma unroll
        for (int i = 0; i < 16; ++i) {
            const int row = chunk * 128 + 32 * tw + (i & 3) + 8 * (i >> 2) + 4 * hh;
            const float gt = bf1(PX[(size_t)row * DIN + 1024 + cg_]);
            Y[(size_t)row * D + cg_] = f2bf(yv[i] * silu(gt));
        }
    }
}

__device__ __forceinline__ void conv_item(const Args a, int l, int ct, LAS unsigned char* lds) {
    const int tid = tid_fresh(), lane = tid & 63, wave = tid >> 6, c = tid;
    unsigned char* ws = ptr_fresh(a.ws);
    const bf16_t* PX = (const bf16_t*)(ws + WS_PX); bf16_t* Y = (bf16_t*)(ws + WS_Y);
    LAS float* CB = (LAS float*)lds;
    const int t0 = ct * 128, seg_lo = ct < 2 ? 0 : CL, seg_hi = ct < 2 ? CL : R;
    float w[31];
#pragma unroll
    for (int j = 0; j < 31; ++j) w[j] = a.in[16][((size_t)l * 31 + j) * 512 + c];
    const float bias = a.in[17][l * 512 + c];
    float win[32];
#define CONV_Z(dst, rr_) do { const int _rr = (rr_); const int _rc = _rr < seg_lo ? seg_lo : (_rr >= seg_hi ? seg_hi - 1 : _rr); const float _v = bf1(PX[(size_t)_rc * DIN + 2048 + c]), _g = bf1(PX[(size_t)_rc * DIN + 2560 + c]); const float _z = _v * sigm(_g); dst = (_rr == _rc) ? _z : 0.f; } while (0)
#pragma unroll
    for (int e = 0; e < 30; ++e) CONV_Z(win[e], t0 - 15 + e);
    win[30] = 0.f; win[31] = 0.f;
    __syncthreads();
#pragma unroll 1
    for (int bb = 0; bb < 4; ++bb) {
        LAS float* cbuf = CB + (bb & 1) * (32 * 512);
#pragma unroll
        for (int u = 0; u < 32; ++u) {
            if ((u & 7) == 0) asm volatile("" ::: "memory");
            CONV_Z(win[(u + 30) & 31], t0 - 15 + 32 * bb + u + 30);
            float acc = bias;
#pragma unroll
            for (int j = 0; j < 31; ++j) acc += w[j] * win[(u + j) & 31];
            cbuf[u * 512 + c] = acc;
        }
        __syncthreads();
#pragma unroll 1
        for (int uu = 0; uu < 4; ++uu) {
            const int u = wave * 4 + uu, row = t0 + 32 * bb + u;
            float v[8]; float s = 0.f;
#pragma unroll
            for (int k = 0; k < 8; ++k) { v[k] = cbuf[u * 512 + lane + 64 * k]; s += v[k]; }
            const float mean = wave_sum(s) * (1.0f / 512.0f);
            float s2 = 0.f;
#pragma unroll
            for (int k = 0; k < 8; ++k) { v[k] -= mean; s2 += v[k] * v[k]; }
            const float rstd = 1.0f / sqrtf(wave_sum(s2) * (1.0f / 512.0f) + EPS);
#pragma unroll
            for (int k = 0; k < 8; ++k) {
                const int ch = lane + 64 * k;
                const float y = silu(v[k] * rstd * a.in[18][l * 512 + ch] + a.in[19][l * 512 + ch]);
                const float gt = bf1(PX[(size_t)row * DIN + 3072 + ch]);
                Y[(size_t)row * D + 1024 + ch] = f2bf(y * silu(gt));
            }
        }
    }
#undef CONV_Z
}

constexpr int TT_STRIDE = 136;
__device__ __forceinline__ void sgu_item(const Args a, int l, int sc, LAS unsigned char* lds) {
    const int tid = tid_fresh(), lane = tid & 63, wave = tid >> 6;
    unsigned char* ws = ptr_fresh(a.ws);
    const bf16_t* PX = (const bf16_t*)(ws + WS_PX); bf16_t* Y = (bf16_t*)(ws + WS_Y);
    const bf16_t* SW = (const bf16_t*)(ws + WS_SW) + (size_t)l * 8 * 128 * 128;
    LAS f32x2* ST = (LAS f32x2*)lds;
    LAS bf16_t* TT = (LAS bf16_t*)(lds + 1024);
    const int t0 = sc * 128;
    __syncthreads();
#pragma unroll 1
    for (int k = 0; k < 16; ++k) {
        const int tok = wave * 16 + k;
        const u32x4 p = *(const u32x4*)(PX + (size_t)(t0 + tok) * DIN + 4096 + 8 * lane);
        float g[8] = {gelu_t(bflo(p.x)), gelu_t(bfhi(p.x)), gelu_t(bflo(p.y)), gelu_t(bfhi(p.y)), gelu_t(bflo(p.z)), gelu_t(bfhi(p.z)), gelu_t(bflo(p.w)), gelu_t(bfhi(p.w))};
        float s = 0.f;
#pragma unroll
        for (int j = 0; j < 8; ++j) s += g[j];
        const float mean = wave_sum(s) * (1.0f / 512.0f);
        float s2 = 0.f;
#pragma unroll
        for (int j = 0; j < 8; ++j) { const float d = g[j] - mean; s2 += d * d; }
        const float rstd = 1.0f / sqrtf(wave_sum(s2) * (1.0f / 512.0f) + EPS);
        if (lane == 0) ST[tok] = (f32x2){mean, rstd};
    }
    __syncthreads();
    const int p_ = tid >> 2, dq = tid & 3;
    const f32x2 st = ST[p_];
    const int fr = lane & 15, fq = lane >> 4;
#pragma unroll 1
    for (int h = 0; h < 8; ++h) {
        LAS bf16_t* tt = TT + (h & 1) * (64 * TT_STRIDE);
        {
            const int ch = 64 * h + 16 * dq;
            const u32x4 q0 = *(const u32x4*)(PX + (size_t)(t0 + p_) * DIN + 4096 + ch), q1 = *(const u32x4*)(PX + (size_t)(t0 + p_) * DIN + 4096 + ch + 8);
            const unsigned pw[8] = {q0.x, q0.y, q0.z, q0.w, q1.x, q1.y, q1.z, q1.w};
            const float* lg = a.in[20] + l * 512 + ch; const float* lb = a.in[21] + l * 512 + ch;
#pragma unroll
            for (int j = 0; j < 8; ++j) {
                const float v0 = (gelu_t(bflo(pw[j])) - st[0]) * st[1] * lg[2 * j] + lb[2 * j];
                const float v1 = (gelu_t(bfhi(pw[j])) - st[0]) * st[1] * lg[2 * j + 1] + lb[2 * j + 1];
                tt[(16 * dq + 2 * j) * TT_STRIDE + p_] = f2bf(v0);
                tt[(16 * dq + 2 * j + 1) * TT_STRIDE + p_] = f2bf(v1);
            }
        }
        __syncthreads();
        f32x4 acc[4];
#pragma unroll
        for (int nt = 0; nt < 4; ++nt) acc[nt] = (f32x4){0.f, 0.f, 0.f, 0.f};
#pragma unroll
        for (int s = 0; s < 4; ++s) {
            const bf16x8 Afr = *(const bf16x8*)(SW + ((size_t)h * 128 + 16 * wave + fr) * 128 + 32 * s + 8 * fq);
#pragma unroll
            for (int nt = 0; nt < 4; ++nt) {
                const bf16x8 Bfr = *(const LAS bf16x8*)(tt + (16 * nt + fr) * TT_STRIDE + 32 * s + 8 * fq);
                acc[nt] = __builtin_amdgcn_mfma_f32_16x16x32_bf16(Afr, Bfr, acc[nt], 0, 0, 0);
            }
        }
#pragma unroll
        for (int reg = 0; reg < 4; ++reg) {
            const int q = 16 * wave + 4 * fq + reg, row = t0 + q;
            const float bs = a.in[23][((size_t)l * 8 + h) * 128 + q];
#pragma unroll
            for (int nt = 0; nt < 4; ++nt) {
                const int ch = 64 * h + 16 * nt + fr;
                const float uu = gelu_t(bf1(PX[(size_t)row * DIN + 3584 + ch]));
                const float gt = bf1(PX[(size_t)row * DIN + 4608 + ch]);
                Y[(size_t)row * D + 1536 + ch] = f2bf(uu * (acc[nt][reg] + bs) * silu(gt));
            }
        }
    }
}


constexpr int L2_GWL = 0;
constexpr int L2_CW = 32768;
constexpr int L2_RAW = 34816;
constexpr int RAW_ROWB = 144, RAW_BUFB = 132 * RAW_ROWB;
constexpr int L2_XLF = L2_RAW + 2 * RAW_BUFB;
constexpr int L2_XLB = L2_XLF + 128 * XLF_STRIDE * 4;
constexpr int L2_TAGG = L2_XLB + 128 * XLB_STRIDE * 2;
static_assert(L2_TAGG + 4096 <= LDS_BYTES, "lds map");

template <bool PASSC>
__device__ __forceinline__ void lru_phase(const Args a, int l, int c_lo, LAS unsigned char* lds) {
    const int tid = tid_fresh(), lane = tid & 63, wave = tid >> 6, b = blockIdx.x, G = gridDim.x;
    unsigned char* ws = ptr_fresh(a.ws);
    const bf16_t* PX = (const bf16_t*)(ws + WS_PX);
    const int hd = b & 15, cstep = G >> 4;
    int chunk = c_lo + (b >> 4);
    if (chunk >= NCHK) return;
    LAS float* CW = (LAS float*)(lds + L2_CW);
    LAS float* XLF = (LAS float*)(lds + L2_XLF);
    LAS bf16_t* XLB = (LAS bf16_t*)(lds + L2_XLB);
    LAS f32x2* TAGG = (LAS f32x2*)(lds + L2_TAGG);
    __syncthreads();
    {
        const bf16_t* GW = (const bf16_t*)(ws + WS_GW) + (size_t)(l * 16 + hd) * 16384;
#pragma unroll
        for (int i = 0; i < 4; ++i) *(LAS u32x4*)(lds + L2_GWL + (tid + 512 * i) * 16) = *(const u32x4*)(GW + (size_t)(tid + 512 * i) * 8);
        if (tid < 320) { const int j = tid >> 6, c = tid & 63; CW[tid] = j < 4 ? a.in[9][((size_t)l * 4 + j) * 1024 + hd * 64 + c] : a.in[10][(size_t)l * 1024 + hd * 64 + c]; }
    }
    const int tw = wave >> 1, chh = wave & 1, cl = lane & 31, hh = lane >> 5;
    const int cin = 32 * chh + cl, cg_ = hd * 64 + cin;
    float brv[2], biv[2], k8[2];
#pragma unroll
    for (int dir = 0; dir < 2; ++dir) {
        brv[dir] = a.in[13][(size_t)(l * 2 + dir) * 1024 + cg_]; biv[dir] = a.in[15][(size_t)(l * 2 + dir) * 1024 + cg_];
        k8[dir] = -8.0f * log1pf(__expf(-a.in[11][(size_t)(l * 2 + dir) * 1024 + cg_]));
    }
    const int t = tid >> 2, q = tid & 3, ch0 = hd * 64 + q * 16;
    const int hrow = (tid >> 2) < 2 ? (tid >> 2) : 130;
    u32x4 r0, r1, h0, h1;
    const u32x4 zero4 = {0u, 0u, 0u, 0u};
#define LRU_LOAD_RAW(ck) do { const int _t0 = (ck) * 128, _lo = (ck) < 2 ? 0 : CL, _hi = (ck) < 2 ? CL : R; \
        const bf16_t* _p = PX + (size_t)(_t0 + t) * DIN + ch0; r0 = *(const u32x4*)_p; r1 = *(const u32x4*)(_p + 8); \
        h0 = zero4; h1 = zero4; \
        if (tid < 12) { const int _gr = _t0 - 2 + hrow; if (_gr >= _lo && _gr < _hi) { const bf16_t* _ph = PX + (size_t)_gr * DIN + ch0; h0 = *(const u32x4*)_ph; h1 = *(const u32x4*)(_ph + 8); } } } while (0)
#define LRU_STORE_RAW(buf) do { LAS unsigned char* _rb = lds + L2_RAW + (buf) * RAW_BUFB; \
        *(LAS u32x4*)(_rb + (t + 2) * RAW_ROWB + 32 * q) = r0; *(LAS u32x4*)(_rb + (t + 2) * RAW_ROWB + 32 * q + 16) = r1; \
        if (tid < 12) { *(LAS u32x4*)(_rb + hrow * RAW_ROWB + 32 * q) = h0; *(LAS u32x4*)(_rb + hrow * RAW_ROWB + 32 * q + 16) = h1; } } while (0)
    LRU_LOAD_RAW(chunk);
    LRU_STORE_RAW(0);
    int cur = 0;
    __syncthreads();
#pragma unroll 1
    for (; chunk < NCHK; chunk += cstep) {
        const int nchunk = chunk + cstep;
        const bool has_next = nchunk < NCHK;
        u32x4 g0 = zero4, g1 = zero4; float cry[2] = {0.f, 0.f};
        if (PASSC) {
            const bf16_t* gp = PX + (size_t)(chunk * 128 + t) * DIN + 1024 + ch0;
            g0 = *(const u32x4*)gp; g1 = *(const u32x4*)(gp + 8);
            const float* CARRY = (const float*)(ws + WS_CARRY);
            cry[0] = CARRY[((size_t)0 * NCHK + chunk) * 1024 + cg_]; cry[1] = CARRY[((size_t)1 * NCHK + chunk) * 1024 + cg_];
        }
        if (has_next) LRU_LOAD_RAW(nchunk);
        {
            LAS unsigned char* rb = lds + L2_RAW + cur * RAW_BUFB;
            const int tg = tid >> 4, c4 = (tid & 15) * 4;
            f32x4 wv[4];
#pragma unroll
            for (int j = 0; j < 4; ++j) wv[j] = *(LAS f32x4*)(CW + j * 64 + c4);
            const f32x4 bb = *(LAS f32x4*)(CW + 256 + c4);
            f32x4 xr[7];
#pragma unroll
            for (int r = 0; r < 7; ++r) { const u32x2 pr = *(LAS u32x2*)(rb + (4 * tg + r) * RAW_ROWB + c4 * 2); xr[r] = (f32x4){bflo(pr.x), bfhi(pr.x), bflo(pr.y), bfhi(pr.y)}; }
#pragma unroll
            for (int tt = 0; tt < 4; ++tt) {
                const f32x4 xl = bb + wv[0] * xr[tt] + wv[1] * xr[tt + 1] + wv[2] * xr[tt + 2] + wv[3] * xr[tt + 3];
                *(LAS f32x4*)(XLF + (4 * tg + tt) * XLF_STRIDE + c4) = xl;
                u32x2 o; o.x = pk2(xl[0], xl[1]); o.y = pk2(xl[2], xl[3]);
                *(LAS u32x2*)(XLB + (4 * tg + tt) * XLB_STRIDE + c4) = o;
            }
        }
        __syncthreads();
        bf16x8 Af[4];
#pragma unroll
        for (int s = 0; s < 4; ++s) Af[s] = *(const LAS bf16x8*)(XLB + (32 * tw + cl) * XLB_STRIDE + 16 * s + 8 * hh);
        float xlv[16];
#pragma unroll
        for (int i = 0; i < 16; ++i) xlv[i] = XLF[(32 * tw + (i & 3) + 8 * (i >> 2) + 4 * hh) * XLF_STRIDE + cin];
        float av[2][16], bv[2][16], GA[2][8], GB[2][8];
#pragma unroll
        for (int dir = 0; dir < 2; ++dir) {
            f32x16 ar, ai;
#pragma unroll
            for (int i = 0; i < 16; ++i) { ar[i] = 0.f; ai[i] = 0.f; }
#pragma unroll
            for (int s = 0; s < 4; ++s) {
                const bf16x8 Br = *(const LAS bf16x8*)(lds + L2_GWL + ((((dir * 2 + 0) * 2 + chh) * 4 + s) * 64 + lane) * 16);
                const bf16x8 Bi = *(const LAS bf16x8*)(lds + L2_GWL + ((((dir * 2 + 1) * 2 + chh) * 4 + s) * 64 + lane) * 16);
                ar = __builtin_amdgcn_mfma_f32_32x32x16_bf16(Af[s], Br, ar, 0, 0, 0);
                ai = __builtin_amdgcn_mfma_f32_32x32x16_bf16(Af[s], Bi, ai, 0, 0, 0);
            }
#pragma unroll
            for (int i = 0; i < 16; ++i) {
                const float rg = sigm(ar[i] + brv[dir]), ig = sigm(ai[i] + biv[dir]);
                const float aa = __expf(k8[dir] * rg);
                av[dir][i] = aa;
                bv[dir][i] = __builtin_amdgcn_sqrtf(fmaxf(1.0f - aa * aa, 0.f)) * ig * xlv[i];
            }
            float oA[4], oB[4];
#pragma unroll
            for (int g = 0; g < 4; ++g) {
                const float a0 = av[dir][4 * g], a1 = av[dir][4 * g + 1], a2 = av[dir][4 * g + 2], a3 = av[dir][4 * g + 3];
                const float b0 = bv[dir][4 * g], b1 = bv[dir][4 * g + 1], b2 = bv[dir][4 * g + 2], b3 = bv[dir][4 * g + 3];
                oA[g] = (a0 * a1) * (a2 * a3);
                oB[g] = dir == 0 ? ((b0 * a1 + b1) * a2 + b2) * a3 + b3 : ((b3 * a2 + b2) * a1 + b1) * a0 + b0;
            }
#pragma unroll
            for (int g = 0; g < 4; ++g) {
                const float pA = __shfl_xor(oA[g], 32), pB = __shfl_xor(oB[g], 32);
                GA[dir][2 * g] = hh ? pA : oA[g]; GA[dir][2 * g + 1] = hh ? oA[g] : pA;
                GB[dir][2 * g] = hh ? pB : oB[g]; GB[dir][2 * g + 1] = hh ? oB[g] : pB;
            }
            float tA = 1.f, tB = 0.f;
            if (dir == 0) {
#pragma unroll
                for (int gq = 0; gq < 8; ++gq) { tB = GA[dir][gq] * tB + GB[dir][gq]; tA *= GA[dir][gq]; }
            } else {
#pragma unroll
                for (int gq = 7; gq >= 0; --gq) { tB = GA[dir][gq] * tB + GB[dir][gq]; tA *= GA[dir][gq]; }
            }
            if (hh == 0) TAGG[(tw * 2 + dir) * 64 + cin] = (f32x2){tA, tB};
        }
        if (has_next) LRU_STORE_RAW(cur ^ 1);
        __syncthreads();
        if constexpr (!PASSC) {
            if (tid < 128) {
                const int dir = tid >> 6, c = tid & 63;
                float cA = 1.f, cB = 0.f;
#pragma unroll
                for (int k = 0; k < 4; ++k) { const int t2 = dir == 0 ? k : 3 - k; const f32x2 v = TAGG[(t2 * 2 + dir) * 64 + c]; cB = v[0] * cB + v[1]; cA *= v[0]; }
                f32x2* AGG = (f32x2*)(ws + WS_AGG);
                AGG[((size_t)dir * NCHK + chunk) * 1024 + hd * 64 + c] = (f32x2){cA, cB};
            }
        } else {
            float yv[16];
#pragma unroll
            for (int dir = 0; dir < 2; ++dir) {
                float st = cry[dir];
                if (dir == 0) {
#pragma unroll
                    for (int t2 = 0; t2 < 3; ++t2) if (t2 < tw) { const f32x2 v = TAGG[(t2 * 2 + 0) * 64 + cin]; st = v[0] * st + v[1]; }
                } else {
#pragma unroll
                    for (int t2 = 3; t2 > 0; --t2) if (t2 > tw) { const f32x2 v = TAGG[(t2 * 2 + 1) * 64 + cin]; st = v[0] * st + v[1]; }
                }
                float hst[4];
                if (dir == 0) {
                    float s = st;
#pragma unroll
                    for (int g = 0; g < 4; ++g) { const float sE = s; s = GA[0][2 * g] * s + GB[0][2 * g]; const float sO = s; s = GA[0][2 * g + 1] * s + GB[0][2 * g + 1]; hst[g] = hh ? sO : sE; }
                } else {
                    float s = st;
#pragma unroll
                    for (int g = 3; g >= 0; --g) { const float sO = s; s = GA[1][2 * g + 1] * s + GB[1][2 * g + 1]; const float sE = s; s = GA[1][2 * g] * s + GB[1][2 * g]; hst[g] = hh ? sO : sE; }
                }
#pragma unroll
                for (int g = 0; g < 4; ++g) {
                    float h = hst[g];
                    if (dir == 0) {
#pragma unroll
                        for (int k = 0; k < 4; ++k) { h = av[0][4 * g + k] * h + bv[0][4 * g + k]; yv[4 * g + k] = h; }
                    } else {
#pragma unroll
                        for (int k = 3; k >= 0; --k) { h = av[1][4 * g + k] * h + bv[1][4 * g + k]; yv[4 * g + k] += h; }
                    }
                }
            }
            LAS bf16_t* YB = (LAS bf16_t*)(lds + L2_RAW + cur * RAW_BUFB);
#pragma unroll
            for (int i = 0; i < 16; ++i) YB[(32 * tw + (i & 3) + 8 * (i >> 2) + 4 * hh) * 72 + cin] = f2bf(yv[i]);
            __syncthreads();
            {
                const u32x4 y0 = *(LAS u32x4*)(YB + t * 72 + 16 * q), y1 = *(LAS u32x4*)(YB + t * 72 + 16 * q + 8);
                const unsigned yw[8] = {y0.x, y0.y, y0.z, y0.w, y1.x, y1.y, y1.z, y1.w};
                const unsigned gw_[8] = {g0.x, g0.y, g0.z, g0.w, g1.x, g1.y, g1.z, g1.w};
                unsigned ow[8];
#pragma unroll
                for (int j = 0; j < 8; ++j) ow[j] = pk2(bflo(yw[j]) * silu(bflo(gw_[j])), bfhi(yw[j]) * silu(bfhi(gw_[j])));
                bf16_t* yp = (bf16_t*)(ws + WS_Y) + (size_t)(chunk * 128 + t) * D + ch0;
                *(u32x4*)yp = (u32x4){ow[0], ow[1], ow[2], ow[3]}; *(u32x4*)(yp + 8) = (u32x4){ow[4], ow[5], ow[6], ow[7]};
            }
        }
        cur ^= 1;
    }
#undef LRU_LOAD_RAW
#undef LRU_STORE_RAW
}

constexpr int CV_ZT = 0;
constexpr int CV_CB = 94 * 1024;
static_assert(CV_CB + 16 * 512 * 4 <= LDS_BYTES, "conv lds map");
__device__ __forceinline__ void conv_item2(const Args a, int l, int ct, LAS unsigned char* lds) {
    const int tid = tid_fresh(), lane = tid & 63, wave = tid >> 6, c = tid;
    unsigned char* ws = ptr_fresh(a.ws);
    const bf16_t* PX = (const bf16_t*)(ws + WS_PX); bf16_t* Y = (bf16_t*)(ws + WS_Y);
    LAS bf16_t* ZT = (LAS bf16_t*)(lds + CV_ZT);
    LAS float* CB = (LAS float*)(lds + CV_CB);
    const int t0 = ct * 64, seg_lo = t0 < CL ? 0 : CL, seg_hi = t0 < CL ? CL : R;
    float w[31];
#pragma unroll
    for (int j = 0; j < 31; ++j) w[j] = a.in[16][((size_t)l * 31 + j) * 512 + c];
    const float bias = a.in[17][l * 512 + c];
    float lg[8], lb[8];
    { const f32x4 x0 = *(const f32x4*)(a.in[18] + l * 512 + 8 * lane), x1 = *(const f32x4*)(a.in[18] + l * 512 + 8 * lane + 4), y0 = *(const f32x4*)(a.in[19] + l * 512 + 8 * lane), y1 = *(const f32x4*)(a.in[19] + l * 512 + 8 * lane + 4);
#pragma unroll
      for (int k = 0; k < 4; ++k) { lg[k] = x0[k]; lg[4 + k] = x1[k]; lb[k] = y0[k]; lb[4 + k] = y1[k]; } }
    __syncthreads();
    {
        u32x4 zv[12], zg[12];
#pragma unroll
        for (int it = 0; it < 12; ++it) {
            const int pid = tid + 512 * it, e = pid >> 6, pc = pid & 63, ec = e < 94 ? e : 93;
            const int rr = t0 - 15 + ec, rc = rr < seg_lo ? seg_lo : (rr >= seg_hi ? seg_hi - 1 : rr);
            zv[it] = *(const u32x4*)(PX + (size_t)rc * DIN + 2048 + 8 * pc); zg[it] = *(const u32x4*)(PX + (size_t)rc * DIN + 2560 + 8 * pc);
        }
#pragma unroll
        for (int it = 0; it < 12; ++it) {
            const int pid = tid + 512 * it, e = pid >> 6, pc = pid & 63;
            const int rr = t0 - 15 + e;
            const unsigned vw[4] = {zv[it].x, zv[it].y, zv[it].z, zv[it].w}, gw_[4] = {zg[it].x, zg[it].y, zg[it].z, zg[it].w};
            unsigned ow[4];
#pragma unroll
            for (int j = 0; j < 4; ++j) ow[j] = pk2(bflo(vw[j]) * sigm(bflo(gw_[j])), bfhi(vw[j]) * sigm(bfhi(gw_[j])));
            const bool ok = rr >= seg_lo && rr < seg_hi;
            u32x4 o;
            o.x = ok ? ow[0] : 0u; o.y = ok ? ow[1] : 0u; o.z = ok ? ow[2] : 0u; o.w = ok ? ow[3] : 0u;
            if (e < 94) *(LAS u32x4*)(ZT + e * 512 + 8 * pc) = o;
        }
    }
    __syncthreads();
    float win[32];
#pragma unroll
    for (int e = 0; e < 30; ++e) win[e] = bf1(ZT[e * 512 + c]);
    win[30] = 0.f; win[31] = 0.f;
#pragma unroll 1
    for (int bb = 0; bb < 2; ++bb) {
#pragma unroll
        for (int hb = 0; hb < 2; ++hb) {
            u32x4 gt[2];
#pragma unroll
            for (int uu = 0; uu < 2; ++uu) gt[uu] = *(const u32x4*)(PX + (size_t)(t0 + 32 * bb + 16 * hb + wave * 2 + uu) * DIN + 3072 + 8 * lane);
#pragma unroll
            for (int u16 = 0; u16 < 16; ++u16) {
                const int u = 16 * hb + u16;
                win[(u + 30) & 31] = bf1(ZT[(32 * bb + u + 30) * 512 + c]);
                float acc = bias;
#pragma unroll
                for (int j = 0; j < 31; ++j) acc += w[j] * win[(u + j) & 31];
                CB[u16 * 512 + c] = acc;
            }
            __syncthreads();
#pragma unroll
            for (int uu = 0; uu < 2; ++uu) {
                const int u = wave * 2 + uu, row = t0 + 32 * bb + 16 * hb + u;
                float v[8]; float s = 0.f;
                { const f32x4 c0 = *(LAS f32x4*)(CB + u * 512 + 8 * lane), c1 = *(LAS f32x4*)(CB + u * 512 + 8 * lane + 4);
#pragma unroll
                  for (int k = 0; k < 4; ++k) { v[k] = c0[k]; v[4 + k] = c1[k]; } }
#pragma unroll
                for (int k = 0; k < 8; ++k) s += v[k];
                const float mean = wave_sum(s) * (1.0f / 512.0f);
                float s2 = 0.f;
#pragma unroll
                for (int k = 0; k < 8; ++k) { v[k] -= mean; s2 += v[k] * v[k]; }
                const float rstd = 1.0f / sqrtf(wave_sum(s2) * (1.0f / 512.0f) + EPS);
                const unsigned gw_[4] = {gt[uu].x, gt[uu].y, gt[uu].z, gt[uu].w};
                unsigned ow[4];
#pragma unroll
                for (int k = 0; k < 4; ++k) {
                    const float y0 = silu(v[2 * k] * rstd * lg[2 * k] + lb[2 * k]) * silu(bflo(gw_[k]));
                    const float y1 = silu(v[2 * k + 1] * rstd * lg[2 * k + 1] + lb[2 * k + 1]) * silu(bfhi(gw_[k]));
                    ow[k] = pk2(y0, y1);
                }
                *(u32x4*)(Y + (size_t)row * D + 1024 + 8 * lane) = (u32x4){ow[0], ow[1], ow[2], ow[3]};
            }
            __syncthreads();
        }
    }
}

__device__ __forceinline__ void sgu_item2(const Args a, int l, int item, LAS unsigned char* lds) {
    const int tid = tid_fresh(), lane = tid & 63, wave = tid >> 6;
    unsigned char* ws = ptr_fresh(a.ws);
    const bf16_t* PX = (const bf16_t*)(ws + WS_PX); bf16_t* Y = (bf16_t*)(ws + WS_Y);
    const bf16_t* SW = (const bf16_t*)(ws + WS_SW) + (size_t)l * 8 * 128 * 128;
    LAS f32x2* ST = (LAS f32x2*)lds;
    LAS bf16_t* TT = (LAS bf16_t*)(lds + 1024);
    const int sc = item >> 1, hg = item & 1, t0 = sc * 128;
    __syncthreads();
#pragma unroll
    for (int kb = 0; kb < 2; ++kb) {
        u32x4 p[8];
#pragma unroll
        for (int k = 0; k < 8; ++k) p[k] = *(const u32x4*)(PX + (size_t)(t0 + wave * 16 + kb * 8 + k) * DIN + 4096 + 8 * lane);
#pragma unroll
        for (int k = 0; k < 8; ++k) {
            float g[8] = {gelu_t(bflo(p[k].x)), gelu_t(bfhi(p[k].x)), gelu_t(bflo(p[k].y)), gelu_t(bfhi(p[k].y)), gelu_t(bflo(p[k].z)), gelu_t(bfhi(p[k].z)), gelu_t(bflo(p[k].w)), gelu_t(bfhi(p[k].w))};
            float s = 0.f;
#pragma unroll
            for (int j = 0; j < 8; ++j) s += g[j];
            const float mean = wave_sum(s) * (1.0f / 512.0f);
            float s2 = 0.f;
#pragma unroll
            for (int j = 0; j < 8; ++j) { const float d = g[j] - mean; s2 += d * d; }
            const float rstd = 1.0f / sqrtf(wave_sum(s2) * (1.0f / 512.0f) + EPS);
            if (lane == 0) ST[wave * 16 + kb * 8 + k] = (f32x2){mean, rstd};
        }
    }
    __syncthreads();
    const int p_ = tid >> 2, dq = tid & 3;
    const f32x2 st = ST[p_];
    const int fr = lane & 15, fq = lane >> 4;
    LAS float* SO = (LAS float*)(lds + 1024 + 2 * 64 * TT_STRIDE * 2);
    u32x4 Lq0[2], Lq1[2], Lu0[2], Lu1[2], Lg0[2], Lg1[2]; bf16x8 LA[2][4]; f32x4 Llg[2][4], Llb[2][4]; float Lbs[2];
#define SGU_LOAD(sl, h_) do { const int _ch = 64 * (h_) + 16 * dq; const bf16_t* _pr = PX + (size_t)(t0 + p_) * DIN + _ch; \
        Lq0[sl] = *(const u32x4*)(_pr + 4096); Lq1[sl] = *(const u32x4*)(_pr + 4096 + 8); Lu0[sl] = *(const u32x4*)(_pr + 3584); Lu1[sl] = *(const u32x4*)(_pr + 3584 + 8); \
        Lg0[sl] = *(const u32x4*)(_pr + 4608); Lg1[sl] = *(const u32x4*)(_pr + 4608 + 8); \
        _Pragma("unroll") for (int s = 0; s < 4; ++s) LA[sl][s] = *(const bf16x8*)(SW + ((size_t)(h_) * 128 + 16 * wave + fr) * 128 + 32 * s + 8 * fq); \
        Lbs[sl] = a.in[23][((size_t)l * 8 + (h_)) * 128 + p_]; \
        _Pragma("unroll") for (int j = 0; j < 4; ++j) { Llg[sl][j] = *(const f32x4*)(a.in[20] + l * 512 + _ch + 4 * j); Llb[sl][j] = *(const f32x4*)(a.in[21] + l * 512 + _ch + 4 * j); } } while (0)
    SGU_LOAD(0, 4 * hg);
#pragma unroll
    for (int h4 = 0; h4 < 4; ++h4) {
        const int h = 4 * hg + h4, sl = h4 & 1;
        LAS bf16_t* tt = TT + (h4 & 1) * (64 * TT_STRIDE);
        if (h4 + 1 < 4) SGU_LOAD(sl ^ 1, h + 1);
        const int ch = 64 * h + 16 * dq;
        const u32x4 q0 = Lq0[sl], q1 = Lq1[sl], u0 = Lu0[sl], u1 = Lu1[sl], g0 = Lg0[sl], g1 = Lg1[sl];
        bf16x8 Afr[4];
#pragma unroll
        for (int s = 0; s < 4; ++s) Afr[s] = LA[sl][s];
        const float bs = Lbs[sl];
        f32x4 lgv[4], lbv[4];
#pragma unroll
        for (int j = 0; j < 4; ++j) { lgv[j] = Llg[sl][j]; lbv[j] = Llb[sl][j]; }
        {
            const unsigned pw[8] = {q0.x, q0.y, q0.z, q0.w, q1.x, q1.y, q1.z, q1.w};
#pragma unroll
            for (int j = 0; j < 8; ++j) {
                const float v0 = (gelu_t(bflo(pw[j])) - st[0]) * st[1] * lgv[j >> 1][(2 * j) & 3] + lbv[j >> 1][(2 * j) & 3];
                const float v1 = (gelu_t(bfhi(pw[j])) - st[0]) * st[1] * lgv[j >> 1][(2 * j + 1) & 3] + lbv[j >> 1][(2 * j + 1) & 3];
                tt[(16 * dq + 2 * j) * TT_STRIDE + p_] = f2bf(v0);
                tt[(16 * dq + 2 * j + 1) * TT_STRIDE + p_] = f2bf(v1);
            }
        }
        __syncthreads();
        f32x4 acc[4];
#pragma unroll
        for (int nt = 0; nt < 4; ++nt) acc[nt] = (f32x4){0.f, 0.f, 0.f, 0.f};
#pragma unroll
        for (int s = 0; s < 4; ++s)
#pragma unroll
            for (int nt = 0; nt < 4; ++nt) {
                const bf16x8 Bfr = *(const LAS bf16x8*)(tt + (16 * nt + fr) * TT_STRIDE + 32 * s + 8 * fq);
                acc[nt] = __builtin_amdgcn_mfma_f32_16x16x32_bf16(Afr[s], Bfr, acc[nt], 0, 0, 0);
            }
#pragma unroll
        for (int reg = 0; reg < 4; ++reg)
#pragma unroll
            for (int nt = 0; nt < 4; ++nt) SO[(16 * wave + 4 * fq + reg) * 68 + 16 * nt + fr] = acc[nt][reg];
        __syncthreads();
        {
            const unsigned uw[8] = {u0.x, u0.y, u0.z, u0.w, u1.x, u1.y, u1.z, u1.w}, gw_[8] = {g0.x, g0.y, g0.z, g0.w, g1.x, g1.y, g1.z, g1.w};
            unsigned ow[8];
#pragma unroll
            for (int j4 = 0; j4 < 4; ++j4) {
                const f32x4 sv = *(LAS f32x4*)(SO + p_ * 68 + 16 * dq + 4 * j4);
                ow[2 * j4] = pk2(gelu_t(bflo(uw[2 * j4])) * (sv[0] + bs) * silu(bflo(gw_[2 * j4])), gelu_t(bfhi(uw[2 * j4])) * (sv[1] + bs) * silu(bfhi(gw_[2 * j4])));
                ow[2 * j4 + 1] = pk2(gelu_t(bflo(uw[2 * j4 + 1])) * (sv[2] + bs) * silu(bflo(gw_[2 * j4 + 1])), gelu_t(bfhi(uw[2 * j4 + 1])) * (sv[3] + bs) * silu(bfhi(gw_[2 * j4 + 1])));
            }
            bf16_t* yp = Y + (size_t)(t0 + p_) * D + 1536 + ch;
            *(u32x4*)yp = (u32x4){ow[0], ow[1], ow[2], ow[3]}; *(u32x4*)(yp + 8) = (u32x4){ow[4], ow[5], ow[6], ow[7]};
        }
    }
#undef SGU_LOAD
}

__device__ __forceinline__ int scan_chunk(int dir, int o) { return dir == 0 ? o : (o == 0 ? 1 : (o == 1 ? 0 : (NCHK + 1 - o))); }
__device__ __forceinline__ void phase_carry(const Args a, LAS unsigned char* lds) {
    const int tid = tid_fresh(), b = blockIdx.x, G = gridDim.x;
    unsigned char* ws = ptr_fresh(a.ws);
    const f32x2* AGG = (const f32x2*)(ws + WS_AGG); float* CARRY = (float*)(ws + WS_CARRY);
    LAS f32x2* SEG = (LAS f32x2*)lds;
    for (int u = b; u < 64; u += G) {
        const int dir = u >> 5, ch = (u & 31) * 32 + (tid & 31), sg = tid >> 5;
        f32x2 ab[10];
        if (sg < 13) {
#pragma unroll
            for (int k = 0; k < 10; ++k) ab[k] = AGG[((size_t)dir * NCHK + scan_chunk(dir, 10 * sg + k)) * 1024 + ch];
            float sA = 1.f, sB = 0.f;
#pragma unroll
            for (int k = 0; k < 10; ++k) { sB = ab[k][0] * sB + ab[k][1]; sA *= ab[k][0]; }
            SEG[sg * 32 + (tid & 31)] = (f32x2){sA, sB};
        }
        __syncthreads();
        if (sg < 13) {
            float st = 0.f;
            for (int s2 = 0; s2 < sg; ++s2) { const f32x2 v = SEG[s2 * 32 + (tid & 31)]; st = v[0] * st + v[1]; }
#pragma unroll
            for (int k = 0; k < 10; ++k) { CARRY[((size_t)dir * NCHK + scan_chunk(dir, 10 * sg + k)) * 1024 + ch] = st; st = ab[k][0] * st + ab[k][1]; }
        }
        __syncthreads();
    }
}

__device__ __forceinline__ void phase_resid0(const Args a) {
    const int tid = tid_fresh(), lane = tid & 63, wave = tid >> 6, b = blockIdx.x, G = gridDim.x;
    unsigned char* ws = ptr_fresh(a.ws);
    const bf16_t* DL0 = (const bf16_t*)(ws + WS_DL0);
    const float* gg0 = (const float*)(ws + WS_GG);
    const float* gg = (const float*)(ws + WS_GG) + (size_t)2 * D;
    bf16_t* XG = (bf16_t*)(ws + WS_XG) + (size_t)CL * D; float* rss1 = (float*)(ws + WS_RSS) + R + CL;
    f32x4 g[8], rg0[8];
#pragma unroll
    for (int j = 0; j < 4; ++j) { g[2 * j] = *(const f32x4*)(gg + 8 * (lane + 64 * j)); g[2 * j + 1] = *(const f32x4*)(gg + 8 * (lane + 64 * j) + 4);
        const f32x4 h0 = *(const f32x4*)(gg0 + 8 * (lane + 64 * j)), h1 = *(const f32x4*)(gg0 + 8 * (lane + 64 * j) + 4);
        rg0[2 * j] = (f32x4){1.0f / h0[0], 1.0f / h0[1], 1.0f / h0[2], 1.0f / h0[3]}; rg0[2 * j + 1] = (f32x4){1.0f / h1[0], 1.0f / h1[1], 1.0f / h1[2], 1.0f / h1[3]}; }
    u32x4 xr[4], dr[4];
#define RS_LOAD(t_, X, Dd) do { _Pragma("unroll") for (int j = 0; j < 4; ++j) { X[j] = __builtin_nontemporal_load((const u32x4*)(XG + (size_t)(t_) * D + 8 * (lane + 64 * j))); Dd[j] = __builtin_nontemporal_load((const u32x4*)(DL0 + (size_t)(t_) * D + 8 * (lane + 64 * j))); } } while (0)
    int t = b * 8 + wave;
    if (t < T) RS_LOAD(t, xr, dr);
    for (; t < T; t += G * 8) {
        u32x4 xn[4], dn[4];
        const int tn = t + G * 8;
        if (tn < T) RS_LOAD(tn, xn, dn);
        f32x4 v[8]; float ss = 0.f;
#pragma unroll
        for (int j = 0; j < 4; ++j) {
            v[2 * j] = (f32x4){bflo(xr[j].x), bfhi(xr[j].x), bflo(xr[j].y), bfhi(xr[j].y)} * rg0[2 * j] + (f32x4){bflo(dr[j].x), bfhi(dr[j].x), bflo(dr[j].y), bfhi(dr[j].y)};
            v[2 * j + 1] = (f32x4){bflo(xr[j].z), bfhi(xr[j].z), bflo(xr[j].w), bfhi(xr[j].w)} * rg0[2 * j + 1] + (f32x4){bflo(dr[j].z), bfhi(dr[j].z), bflo(dr[j].w), bfhi(dr[j].w)};
        }
#pragma unroll
        for (int j = 0; j < 8; ++j) ss += (v[j][0] * v[j][0] + v[j][1] * v[j][1]) + (v[j][2] * v[j][2] + v[j][3] * v[j][3]);
#pragma unroll
        for (int j = 0; j < 4; ++j) {
            const f32x4 p0 = v[2 * j] * g[2 * j], p1 = v[2 * j + 1] * g[2 * j + 1];
            u32x4 w; w.x = pk2(p0[0], p0[1]); w.y = pk2(p0[2], p0[3]); w.z = pk2(p1[0], p1[1]); w.w = pk2(p1[2], p1[3]);
            *(u32x4*)(XG + (size_t)t * D + 8 * (lane + 64 * j)) = w;
        }
        ss = wave_sum(ss);
        if (lane == 0) rss1[t] = ss;
        if (tn < T) {
#pragma unroll
            for (int j = 0; j < 4; ++j) { xr[j] = xn[j]; dr[j] = dn[j]; }
        }
    }
#undef RS_LOAD
}
__device__ __forceinline__ void phase_final(const Args a) {
    const int tid = tid_fresh(), lane = tid & 63, wave = tid >> 6, b = blockIdx.x, G = gridDim.x;
    unsigned char* ws = ptr_fresh(a.ws);
    const bf16_t* XG1 = (const bf16_t*)(ws + WS_XG) + (size_t)CL * D;
    const bf16_t* DL1 = (const bf16_t*)(ws + WS_DL0);
    const float* fg = a.in[24];
    const float* gg = (const float*)(ws + WS_GG) + (size_t)2 * D;
    u32x4 xr[4], er[4];
#define FN_LOAD(t_, X, Ee) do { _Pragma("unroll") for (int j = 0; j < 4; ++j) { X[j] = __builtin_nontemporal_load((const u32x4*)(XG1 + (size_t)(t_) * D + 8 * (lane + 64 * j))); Ee[j] = __builtin_nontemporal_load((const u32x4*)(DL1 + (size_t)(t_) * D + 8 * (lane + 64 * j))); } } while (0)
    f32x4 fgv[8], rg[8];
#pragma unroll
    for (int j = 0; j < 4; ++j) { fgv[2 * j] = *(const f32x4*)(fg + 8 * (lane + 64 * j)); fgv[2 * j + 1] = *(const f32x4*)(fg + 8 * (lane + 64 * j) + 4);
        const f32x4 g0 = *(const f32x4*)(gg + 8 * (lane + 64 * j)), g1 = *(const f32x4*)(gg + 8 * (lane + 64 * j) + 4);
        rg[2 * j] = (f32x4){1.0f / g0[0], 1.0f / g0[1], 1.0f / g0[2], 1.0f / g0[3]}; rg[2 * j + 1] = (f32x4){1.0f / g1[0], 1.0f / g1[1], 1.0f / g1[2], 1.0f / g1[3]}; }
    int t = b * 8 + wave;
    if (t < T) FN_LOAD(t, xr, er);
    for (; t < T; t += G * 8) {
        u32x4 xn[4], en[4];
        const int tn = t + G * 8;
        if (tn < T) FN_LOAD(tn, xn, en);
        float* orow = a.out + (size_t)t * D;
        f32x4 v[8]; float ss = 0.f;
#pragma unroll
        for (int j = 0; j < 4; ++j) {
            v[2 * j] = (f32x4){bflo(xr[j].x), bfhi(xr[j].x), bflo(xr[j].y), bfhi(xr[j].y)} * rg[2 * j] + (f32x4){bflo(er[j].x), bfhi(er[j].x), bflo(er[j].y), bfhi(er[j].y)};
            v[2 * j + 1] = (f32x4){bflo(xr[j].z), bfhi(xr[j].z), bflo(xr[j].w), bfhi(xr[j].w)} * rg[2 * j + 1] + (f32x4){bflo(er[j].z), bfhi(er[j].z), bflo(er[j].w), bfhi(er[j].w)};
        }
#pragma unroll
        for (int j = 0; j < 8; ++j) ss += (v[j][0] * v[j][0] + v[j][1] * v[j][1]) + (v[j][2] * v[j][2] + v[j][3] * v[j][3]);
        const float rs = 1.0f / sqrtf(wave_sum(ss) * (1.0f / D) + EPS);
#pragma unroll
        for (int j = 0; j < 4; ++j) {
            *(f32x4*)(orow + 8 * (lane + 64 * j)) = v[2 * j] * rs * fgv[2 * j]; *(f32x4*)(orow + 8 * (lane + 64 * j) + 4) = v[2 * j + 1] * rs * fgv[2 * j + 1];
        }
        if (tn < T) {
#pragma unroll
            for (int j = 0; j < 4; ++j) { xr[j] = xn[j]; er[j] = en[j]; }
        }
    }
#undef FN_LOAD
}

template <int NT, int MODE>
__device__ __forceinline__ void ctx_gemm(const Args a, int l, LAS unsigned char* lds) {
    const int tid = tid_fresh(), lane = tid & 63, wave = tid >> 6, b = blockIdx.x, G = gridDim.x;
    unsigned char* ws = ptr_fresh(a.ws);
    constexpr int TN = 16 * NT, N = 64 * TN, TS = TN + 4;
    const bf16_t* A = (const bf16_t*)(ws + (MODE == 0 ? WS_XG : WS_Y));
    const bf16_t* Bt = MODE == 0 ? (const bf16_t*)(ws + WS_WINT) + (size_t)l * DIN * D : (const bf16_t*)(ws + WS_WOUTT) + (size_t)l * D * D;
    LAS float* CT = (LAS float*)lds;
    const int fr = lane & 15, fq = lane >> 4;
#pragma unroll 1
    for (int tile = b; tile < 256; tile += G) {
        const int r0 = (tile >> 6) * 64, n0 = (tile & 63) * TN;
        __syncthreads();
        f32x4 acc[4][NT];
#pragma unroll
        for (int m = 0; m < 4; ++m)
#pragma unroll
            for (int n = 0; n < NT; ++n) acc[m][n] = (f32x4){0.f, 0.f, 0.f, 0.f};
        const bf16_t* ap = A + (size_t)(r0 + fr) * D + wave * 256 + 8 * fq;
        const bf16_t* bp = Bt + (size_t)(n0 + fr) * D + wave * 256 + 8 * fq;
        bf16x8 af[2][4], bfr[2][NT];
#define CTXG_LOAD(buf, ks_) do { _Pragma("unroll") for (int m = 0; m < 4; ++m) af[buf][m] = *(const bf16x8*)(ap + (size_t)(16 * m) * D + 32 * (ks_)); \
        _Pragma("unroll") for (int n = 0; n < NT; ++n) bfr[buf][n] = *(const bf16x8*)(bp + (size_t)(16 * n) * D + 32 * (ks_)); } while (0)
#define CTXG_MMA(buf) do { _Pragma("unroll") for (int m = 0; m < 4; ++m) _Pragma("unroll") for (int n = 0; n < NT; ++n) \
        acc[m][n] = __builtin_amdgcn_mfma_f32_16x16x32_bf16(af[buf][m], bfr[buf][n], acc[m][n], 0, 0, 0); } while (0)
        CTXG_LOAD(0, 0);
#pragma unroll
        for (int ks = 0; ks < 8; ks += 2) {
            CTXG_LOAD(1, ks + 1);
            __builtin_amdgcn_sched_barrier(0);
            CTXG_MMA(0);
            __builtin_amdgcn_sched_barrier(0);
            if (ks + 2 < 8) CTXG_LOAD(0, ks + 2);
            __builtin_amdgcn_sched_barrier(0);
            CTXG_MMA(1);
            __builtin_amdgcn_sched_barrier(0);
        }
#undef CTXG_LOAD
#undef CTXG_MMA
#pragma unroll
        for (int ps = 0; ps < 2; ++ps) {
#pragma unroll
            for (int m2 = 0; m2 < 2; ++m2)
#pragma unroll
                for (int n = 0; n < NT; ++n)
#pragma unroll
                    for (int reg = 0; reg < 4; ++reg) CT[(wave * 32 + 16 * m2 + 4 * fq + reg) * TS + 16 * n + fr] = acc[2 * ps + m2][n][reg];
            __syncthreads();
            for (int wi = tid; wi < 32 * (TN / 8); wi += 512) {
                const int rr = wi / (TN / 8), cgp = wi % (TN / 8), row = r0 + 32 * ps + rr, col = n0 + 8 * cgp;
                f32x4 c0 = {0.f, 0.f, 0.f, 0.f}, c1 = {0.f, 0.f, 0.f, 0.f};
#pragma unroll
                for (int w8 = 0; w8 < 8; ++w8) { c0 += *(LAS f32x4*)(CT + (w8 * 32 + rr) * TS + 8 * cgp); c1 += *(LAS f32x4*)(CT + (w8 * 32 + rr) * TS + 8 * cgp + 4); }
                if (MODE == 0) {
                    const float* rss = (const float*)(ws + WS_RSS) + (size_t)l * R;
                    const float* shw = (const float*)(ws + WS_SHW) + (size_t)(l * 2 + 1) * DIN;
                    bf16_t* PXo = (bf16_t*)(ws + WS_PX);
                    const float rs = 1.0f / sqrtf(rss[row] * (1.0f / D) + EPS);
                    const f32x4 s0 = *(const f32x4*)(shw + col), s1 = *(const f32x4*)(shw + col + 4);
                    const f32x4 v0 = c0 * rs + s0, v1 = c1 * rs + s1;
                    u32x4 w; w.x = pk2(v0[0], v0[1]); w.y = pk2(v0[2], v0[3]); w.z = pk2(v1[0], v1[1]); w.w = pk2(v1[2], v1[3]);
                    *(u32x4*)(PXo + (size_t)row * DIN + col) = w;
                } else {
                    const float* gp = (const float*)(ws + WS_MOD) + (size_t)(l * 2 + 1) * 6144 + 4096;
                    const float* ggp = (const float*)(ws + WS_GG) + (size_t)((l + 1) * 2 + 1) * D;
                    float* rssn = (float*)(ws + WS_RSS) + (size_t)(l + 1) * R;
                    float* xn = (float*)(ws + WS_X1C); bf16_t* XG = (bf16_t*)(ws + WS_XG);
                    const f32x4 o0 = *(const f32x4*)(a.in[2] + (size_t)row * D + col), o1 = *(const f32x4*)(a.in[2] + (size_t)row * D + col + 4);
                    const f32x4 g0 = *(const f32x4*)(gp + col), g1 = *(const f32x4*)(gp + col + 4);
                    const f32x4 v0 = o0 + g0 * c0, v1 = o1 + g1 * c1;
                    *(f32x4*)(xn + (size_t)row * D + col) = v0; *(f32x4*)(xn + (size_t)row * D + col + 4) = v1;
                    const f32x4 q0 = *(const f32x4*)(ggp + col), q1 = *(const f32x4*)(ggp + col + 4);
                    const f32x4 a0 = v0 * q0, a1 = v1 * q1;
                    u32x4 w; w.x = pk2(a0[0], a0[1]); w.y = pk2(a0[2], a0[3]); w.z = pk2(a1[0], a1[1]); w.w = pk2(a1[2], a1[3]);
                    *(u32x4*)(XG + (size_t)row * D + col) = w;
                    const float ss = (v0[0] * v0[0] + v0[1] * v0[1]) + (v0[2] * v0[2] + v0[3] * v0[3]) + (v1[0] * v1[0] + v1[1] * v1[1]) + (v1[2] * v1[2] + v1[3] * v1[3]);
                    unsafeAtomicAdd(rssn + row, ss);
                }
            }
            __syncthreads();
        }
    }
    __syncthreads();
}

#define XB_TMO      128
#define XB_XCNT(j)  (256  + 64 * (j))
#define XB_XSUB(j)  (1280 + 64 * (j))
#define XB_XGEN(j)  (2304 + 64 * (j))
#define XB_TOP      3328
#define XB_TOPGEN   3392
#define XCD_BAR_WORDS 3456
#define XB_SPIN_CAP (1u << 18)

__device__ __forceinline__ unsigned xb_ld(unsigned* p)              { return __hip_atomic_load(p, __ATOMIC_RELAXED, __HIP_MEMORY_SCOPE_AGENT); }
__device__ __forceinline__ unsigned xb_add(unsigned* p, unsigned v) { return __hip_atomic_fetch_add(p, v, __ATOMIC_RELAXED, __HIP_MEMORY_SCOPE_AGENT); }
__device__ __forceinline__ unsigned xb_xcc_id() { return (unsigned)__builtin_amdgcn_s_getreg((3 << 11) | 20) & 0xFu; }
#define XB_SPIN(cond, bar) do { unsigned _sp = 0; while (cond) { __builtin_amdgcn_s_sleep(1); \
    if ((++_sp & 255u) == 0u) { if (xb_ld(&(bar)[XB_TMO])) break; if (_sp > XB_SPIN_CAP) { atomicAdd(&(bar)[XB_TMO], 1u); break; } } } } while (0)

struct XcdBarrier {
    unsigned* bar; unsigned x;
    volatile LAS unsigned* st;
};

__device__ __forceinline__ XcdBarrier xcd_barrier_post(unsigned* bar, volatile LAS unsigned* st) {
    XcdBarrier b; b.bar = bar; b.x = xb_xcc_id(); b.st = st;
    if (threadIdx.x == 0) (void)xb_add(&bar[XB_XCNT(b.x)], 1u);
    return b;
}
__device__ __forceinline__ void xcd_barrier_complete(unsigned* bar, unsigned x, unsigned& nloc, unsigned& nx) {
    const unsigned G = gridDim.x * gridDim.y * gridDim.z;
    unsigned sum, cnt, mine, sp = 0u;
    for (;;) {
        sum = 0u; cnt = 0u; mine = 0u;
#pragma unroll
        for (unsigned j = 0; j < 16; ++j) { const unsigned c = xb_ld(&bar[XB_XCNT(j)]); sum += c; cnt += (c > 0u) ? 1u : 0u; mine = (j == x) ? c : mine; }
        if (sum == G) break;
        __builtin_amdgcn_s_sleep(1);
        if ((++sp & 255u) == 0u) { if (xb_ld(&bar[XB_TMO])) break; if (sp > XB_SPIN_CAP) { atomicAdd(&bar[XB_TMO], 1u); break; } }
    }
    nloc = mine > 0u ? mine : 1u; nx = cnt > 0u ? cnt : 1u;
}

__device__ __forceinline__ void xcd_barrier(const XcdBarrier& b) {
    asm volatile("s_waitcnt vmcnt(0)" ::: "memory");
    __syncthreads();
    if (threadIdx.x == 0) {
        unsigned* bar = b.bar;
        __builtin_amdgcn_s_waitcnt(0);
        unsigned nloc = b.st[0], nx = b.st[1];
        if (nloc == 0u) { xcd_barrier_complete(bar, b.x, nloc, nx); b.st[0] = nloc; b.st[1] = nx; }
        const unsigned old = xb_add(&bar[XB_XSUB(b.x)], 1u);
        const unsigned gen = old / nloc;
        if (old + 1u == (gen + 1u) * nloc) {
            __builtin_amdgcn_fence(__ATOMIC_RELEASE, "agent");
            asm volatile("s_waitcnt vmcnt(0)" ::: "memory");
            const unsigned og = xb_add(&bar[XB_TOP], 1u);
            const unsigned tg = og / nx;
            if (og + 1u == (tg + 1u) * nx) xb_add(&bar[XB_TOPGEN], 1u);
            else XB_SPIN(xb_ld(&bar[XB_TOPGEN]) == tg, bar);
            __builtin_amdgcn_fence(__ATOMIC_ACQUIRE, "agent");
            xb_add(&bar[XB_XGEN(b.x)], 1u);
            asm volatile("s_waitcnt vmcnt(0)" ::: "memory");
        } else {
            XB_SPIN(xb_ld(&bar[XB_XGEN(b.x)]) == gen, bar);
            __builtin_amdgcn_fence(__ATOMIC_ACQUIRE, "agent");
            asm volatile("s_waitcnt vmcnt(0)" ::: "memory");
        }
    }
    __syncthreads();
}


__global__ void __launch_bounds__(512, 2) mega_fwd(Args a) {
    extern __shared__ __attribute__((aligned(16))) unsigned char lds_raw[];
    LAS unsigned char* lds = (LAS unsigned char*)lds_raw;
    cg::grid_group grid = cg::this_grid();
    const int lo = a.ph_lo, hi = a.ph_hi;
    const int b = blockIdx.x, G = gridDim.x;
    unsigned char* ws = ptr_fresh(a.ws);
    { volatile LAS unsigned* xst = (volatile LAS unsigned*)(lds + LDS_BYTES - 16); if (threadIdx.x < 4) xst[threadIdx.x] = 0u; }
    __syncthreads();
    const XcdBarrier xbar = xcd_barrier_post((unsigned*)(a.ws + WS_BAR), (volatile LAS unsigned*)(lds + LDS_BYTES - 16));
#ifndef PHMASK
#define PHMASK 0x1fff
#endif
#define IN(k) (((PHMASK >> (k)) & 1) && lo <= (k) && (k) < hi)
#ifndef DUPMASK
#define DUPMASK 0
#endif
#define DUP(k) ((DUPMASK >> (k)) & 1)
#define GSYNC(k) do { if (a.ph_lo < 0) grid.sync();     \
    xcd_barrier(xbar); } while (0)
#define SEAM(k) do { if (IN(k) && IN((k) + 1)) GSYNC(k); } while (0)
#define REPB(k) for (int rep_ = 0; rep_ <= DUP(k); ++rep_) { if (rep_) xcd_barrier(xbar);
#define REPE }
    if (IN(0)) { REPB(0) phase0a(a, lds); REPE }
    SEAM(0);
    if (IN(1)) { REPB(1) phase0b(a, lds); REPE }
    SEAM(1);
#pragma unroll 1
    for (int l = 0; l < 2; ++l) {
        const int pb = 2 + 5 * l; const bool last = (l == 1);
        if (IN(pb) && (PHMASK & 0x84)) { REPB(pb)
            pg8::Gemm g{(const bf16_t*)(ws + WS_XG) + (size_t)CL * D, (const bf16_t*)(ws + WS_WINT) + (size_t)l * DIN * D, T, DIN, D};
            pg8::StaticOrder S; S.init(T, DIN, G, b);
            EpiIn E{(bf16_t*)(ws + WS_PX), (const float*)(ws + WS_RSS) + (size_t)l * R, (const float*)(ws + WS_SHW) + (size_t)l * 2 * DIN};
            const bool ctx_first = (b & 1) != 0;
            if (ctx_first) ctx_gemm<5, 0>(a, l, lds);
            pg8::gemm_phase<EpiIn, pg8::StaticOrder, GEMM_ALIGN, GEMM_SP2>(lds, g, S, E);
            if (!ctx_first) ctx_gemm<5, 0>(a, l, lds);
        REPE }
        SEAM(pb);
        if (IN(pb + 1) && (PHMASK & 0x108)) { REPB(pb + 1)
            const int c_lo = last ? 2 : 0, n_cv = 2 * (NCHK - c_lo);
            lru_phase<false>(a, l, 0, lds);
            unsigned* qctr = (unsigned*)(a.ws + WS_BAR) + 16 + 2 * l + rep_;
            volatile LAS int* qslot = (volatile LAS int*)(lds + LDS_BYTES - 32);
            for (;;) {
                __syncthreads();
                if (threadIdx.x == 0) *qslot = (int)__hip_atomic_fetch_add(qctr, 1u, __ATOMIC_RELAXED, __HIP_MEMORY_SCOPE_AGENT);
                __syncthreads();
                const int it = *qslot;
                if (it >= 2 * n_cv) break;
                if (it < n_cv) sgu_item2(a, l, 2 * c_lo + it, lds); else conv_item2(a, l, 2 * c_lo + it - n_cv, lds);
            }
        REPE }
        SEAM(pb + 1);
        if (IN(pb + 2) && (PHMASK & 0x210)) { REPB(pb + 2) phase_carry(a, lds); REPE }
        SEAM(pb + 2);
        if (IN(pb + 3) && (PHMASK & 0x420)) { REPB(pb + 3)
            lru_phase<true>(a, l, last ? 2 : 0, lds);
            __syncthreads();
        REPE }
        SEAM(pb + 3);
        if (IN(pb + 4) && (PHMASK & 0x840)) {
            const int roff = CL, M = T;
            pg8::Gemm g{(const bf16_t*)(ws + WS_Y) + (size_t)roff * D, (const bf16_t*)(ws + WS_WOUTT) + (size_t)l * D * D, M, D, D};
            pg8::StaticOrder S; S.init(M, D, G, b);
            EpiDelta E{(bf16_t*)(ws + WS_DL0),
                        (const float*)(ws + WS_MOD) + (size_t)l * 2 * 6144 + 4096};
            const bool ctx_first = !last && (b & 1) != 0;
            if (ctx_first) ctx_gemm<2, 1>(a, l, lds);
            pg8::gemm_phase<EpiDelta, pg8::StaticOrder, GEMM_ALIGN, GEMM_SP2>(lds, g, S, E);
            if (!last) { if (!ctx_first) ctx_gemm<2, 1>(a, l, lds); xcd_barrier(xbar); phase_resid0(a); }
        }
        SEAM(pb + 4);
    }
    if (IN(12)) phase_final(a);
#undef IN
#undef SEAM
}

extern "C" void kernel_launch(void* const* d_in, const int* in_sizes, int n_in, void* d_out, int out_size, void* d_ws, size_t ws_size, hipStream_t stream) {
    static int grid = 0;
    if (grid == 0) {
        int dev = 0, cus = 0, per_cu = 0;
        if (n_in != 25 || ws_size < WS_END) { fprintf(stderr, "kernel_launch: unexpected inputs (n_in %d, ws %zu < %zu)\n", n_in, ws_size, (size_t)WS_END); grid = -1; return; }
        hipGetDevice(&dev);
        hipDeviceGetAttribute(&cus, hipDeviceAttributeMultiprocessorCount, dev);
        if (hipFuncSetAttribute((const void*)mega_fwd, hipFuncAttributeMaxDynamicSharedMemorySize, LDS_BYTES) != hipSuccess) { fprintf(stderr, "kernel_launch: hipFuncSetAttribute failed\n"); grid = -1; return; }
        hipOccupancyMaxActiveBlocksPerMultiprocessor(&per_cu, (const void*)mega_fwd, 512, LDS_BYTES);
        (void)hipGetLastError();
        if (per_cu < 1) { fprintf(stderr, "kernel_launch: occupancy query says %d blocks per CU\n", per_cu); per_cu = 1; }
        grid = cus;
    }
    if (grid < 0) return;
    if (hipMemsetAsync((char*)d_ws + WS_BAR, 0, 16384, stream) != hipSuccess) { fprintf(stderr, "kernel_launch: memset of the barrier words failed\n"); return; }
    Args a{};
    for (int i = 0; i < 25; ++i) a.in[i] = (const float*)d_in[i];
    a.out = (float*)d_out; a.ws = (unsigned char*)d_ws;
#if N_LAUNCH_MODE == 1
    a.ph_lo = 0; a.ph_hi = NPHASE;
    void* args[] = {&a};
    hipError_t e = hipLaunchCooperativeKernel((const void*)mega_fwd, dim3(grid), dim3(512), args, LDS_BYTES, stream);
    if (e != hipSuccess) fprintf(stderr, "kernel_launch: cooperative launch failed: %s (grid %d)\n", hipGetErrorString(e), grid);
#else
    for (int p = 0; p < NPHASE; ++p) {
        a.ph_lo = p; a.ph_hi = p + 1;
        hipLaunchKernelGGL(mega_fwd, dim3(grid), dim3(512), LDS_BYTES, stream, a);
    }
#endif
}
```

```cpp
#include <hip/hip_runtime.h>
#include <hip/hip_cooperative_groups.h>
#include <cstdio>
#include <cstdint>
namespace cg = cooperative_groups;
namespace pg8 {
#define PG8_LAS __attribute__((address_space(3)))
typedef unsigned short bf16_t;
typedef short bf16x8 __attribute__((ext_vector_type(8)));
typedef float f32x4 __attribute__((ext_vector_type(4)));
typedef unsigned u32x4 __attribute__((ext_vector_type(4)));
constexpr int BM = 256, BK = 64, HALF = 128, HTB = HALF * BK * 2  , STAGE_BYTES = 8 * HTB, NXCD = 8, WGM = 8;

__host__ __device__ __forceinline__ int lds_byte(int r, int c) { const int st = (r >> 4) * 2 + (c >> 5), rr = r & 15, cc = c & 31, ob = rr * 64 + cc * 2; return st * 1024 + (ob ^ (((ob >> 9) & 1) << 5)); }
__host__ __device__ __forceinline__ void stage_rc(int b, int& R, int& C) { const int st = b / 1024, sb = b % 1024, swz = sb ^ (((sb >> 9) & 1) << 5); R = (st >> 1) * 16 + swz / 64; C = (st & 1) * 32 + (swz % 64) / 2; }
__host__ __device__ __forceinline__ int perm32(int rho) { const int n = rho >> 4, i = rho & 15; return 8 * (i >> 2) + 4 * n + (i & 3); }

struct Unit { int pm, pn; };
struct Gemm { const bf16_t* A; const bf16_t* Bt; int M, N, K; };

struct StaticOrder {
    int nM, nN, nwg, G, c;
    __host__ __device__ void init(int M, int N, int G_, int c_) { nM = M / BM; nN = N / BM; nwg = nM * nN; G = G_; c = c_; }
    __host__ __device__ bool next(int i, Unit& u) const {
        const long L = (long)i * G + c; if (L >= nwg) return false;
        int wgid = (int)L; { const int q = nwg / NXCD, r = nwg % NXCD, xcd = wgid % NXCD, off = wgid / NXCD; wgid = (xcd < r ? xcd * (q + 1) : r * (q + 1) + (xcd - r) * q) + off; }
        const int nig = WGM * nN, gid = wgid / nig, fm = gid * WGM, gsz = (nM - fm) < WGM ? (nM - fm) : WGM;
        u.pm = fm + ((wgid % nig) % gsz); u.pn = (wgid % nig) / gsz; return true;
    }
    __device__ __forceinline__ void a_ready(const Unit&) const {}
    __device__ __forceinline__ void done(const Unit&) const {}
};
__device__ __forceinline__ unsigned cvt_pk_bf16(float lo, float hi) { unsigned r; asm volatile("v_cvt_pk_bf16_f32 %0, %1, %2" : "=v"(r) : "v"(lo), "v"(hi)); return r; }
template <class Epi, class Sched, bool ALIGN_EPI = false, bool SP2 = false>
__device__ __forceinline__ void gemm_phase(PG8_LAS unsigned char* lds, const Gemm g, const Sched& S, const Epi& E) {
    int tid_ = threadIdx.x; asm volatile("" : "+v"(tid_)); const int tid = tid_, wid = __builtin_amdgcn_readfirstlane(tid >> 6), lane = tid & 63, wr = wid >> 2, wc = wid & 3, fr = lane & 15, fq = lane >> 4;
    const int K = g.K, nt = K / BK;
    unsigned voffA[2], voffB[2];
#pragma unroll
    for (int i = 0; i < 2; ++i) { int R, C; stage_rc(tid * 16 + i * 8192, R, C); const int Rb = Epi::PERM ? ((R & ~31) + perm32(R & 31)) : R;
        voffA[i] = (unsigned)(R * K + C) * 2u; voffB[i] = (unsigned)(Rb * K + C) * 2u; }
    const size_t kstep = (size_t)(BK * 2);
    const size_t hstep = (size_t)HALF * K * 2;
    const size_t tstep = 2 * hstep;
    const unsigned ldsw = (unsigned)wid * 1024u;
    const int aoff = lds_byte(wr * 64 + fr, fq * 8), boff = lds_byte(wc * 32 + fr, fq * 8);
#define PG8_SA(b, h) (((b) * 2 + (h)) * HTB)
#define PG8_SB(b, h) ((4 + (b) * 2 + (h)) * HTB)
#define PG8_STAGE(bufoff, gbase, voff) do { _Pragma("unroll") for (int _i = 0; _i < 2; ++_i) \
        __builtin_amdgcn_global_load_lds((const unsigned*)((const char*)(gbase) + (voff)[_i]), (PG8_LAS unsigned*)(lds + (bufoff) + ldsw + _i * 8192), 16, 0, 0); } while (0)
#define PG8_LDA(dst, b, h) do { _Pragma("unroll") for (int m = 0; m < 4; ++m) _Pragma("unroll") for (int k = 0; k < 2; ++k) dst[m][k] = *(const PG8_LAS bf16x8*)(lds + PG8_SA(b, h) + aoff + m * 2048 + k * 1024); } while (0)
#define PG8_LDB(dst, b, h) do { _Pragma("unroll") for (int n = 0; n < 2; ++n) _Pragma("unroll") for (int k = 0; k < 2; ++k) dst[n][k] = *(const PG8_LAS bf16x8*)(lds + PG8_SB(b, h) + boff + n * 2048 + k * 1024); } while (0)
#define PG8_MMA(ai, bj, At, Bt) do { __builtin_amdgcn_s_setprio(1); _Pragma("unroll") for (int m = 0; m < 4; ++m) _Pragma("unroll") for (int n = 0; n < 2; ++n) _Pragma("unroll") for (int k = 0; k < 2; ++k) \
        acc[ai][bj][m][n] = __builtin_amdgcn_mfma_f32_16x16x32_bf16(Bt[n][k], At[m][k], acc[ai][bj][m][n], 0, 0, 0); __builtin_amdgcn_s_setprio(0); } while (0)
#define PG8_WAIT_V(n) asm volatile("s_waitcnt vmcnt(" #n ")" ::: "memory")
#define PG8_WAIT_L(n) asm volatile("s_waitcnt lgkmcnt(" #n ")" ::: "memory")
#define PG8_BAR __builtin_amdgcn_s_barrier()
#define PG8_SCHED __builtin_amdgcn_sched_barrier(0)
    Unit cur, nxt; int ui = 0;
    if (!S.next(0, cur)) return;
    f32x4 acc[2][2][4][2];
#pragma unroll
    for (int a = 0; a < 2; ++a)
#pragma unroll
        for (int b = 0; b < 2; ++b)
#pragma unroll
            for (int m = 0; m < 4; ++m)
#pragma unroll
                for (int n = 0; n < 2; ++n) acc[a][b][m][n] = (f32x4){0.f, 0.f, 0.f, 0.f};
    bf16x8 At[4][2], B0[2][2], B1[2][2];
    const char* cA = (const char*)g.A + (size_t)cur.pm * tstep; const char* cB = (const char*)g.Bt + (size_t)cur.pn * tstep;
    S.a_ready(cur);
    if constexpr (SP2) {
        PG8_STAGE(PG8_SB(0, 0), cB, voffB); PG8_STAGE(PG8_SB(0, 1), cB + hstep, voffB); PG8_STAGE(PG8_SA(0, 0), cA, voffA); PG8_STAGE(PG8_SA(0, 1), cA + hstep, voffA);
        if (wr == 1) PG8_BAR;
        PG8_WAIT_V(2); PG8_BAR;
        PG8_STAGE(PG8_SB(1, 0), cB + kstep, voffB); PG8_STAGE(PG8_SA(1, 0), cA + kstep, voffA); PG8_STAGE(PG8_SB(1, 1), cB + hstep + kstep, voffB);
        PG8_WAIT_V(6); PG8_BAR;
    } else {
        PG8_STAGE(PG8_SB(0, 0), cB, voffB); PG8_STAGE(PG8_SA(0, 0), cA, voffA); PG8_STAGE(PG8_SB(0, 1), cB + hstep, voffB); PG8_STAGE(PG8_SA(0, 1), cA + hstep, voffA);
        if (wr == 1) PG8_BAR;
        PG8_WAIT_V(4); PG8_BAR;
        PG8_STAGE(PG8_SB(1, 0), cB + kstep, voffB); PG8_STAGE(PG8_SA(1, 0), cA + kstep, voffA); PG8_STAGE(PG8_SB(1, 1), cB + hstep + kstep, voffB);
        PG8_WAIT_V(6); PG8_BAR;
    }
    for (;;) {
        const bool has_next = S.next(ui + 1, nxt);
        const char* nA = has_next ? (const char*)g.A + (size_t)nxt.pm * tstep : cA; const char* nB = has_next ? (const char*)g.Bt + (size_t)nxt.pn * tstep : cB;
        for (int t = 0; t < nt; t += 2) {
            const bool last = (t == nt - 2);
            const char* a1 = cA + (size_t)(t + 1) * kstep;
            const char* a2 = last ? nA : cA + (size_t)(t + 2) * kstep; const char* b2 = last ? nB : cB + (size_t)(t + 2) * kstep;
            const char* a3 = a2 + kstep; const char* b3 = b2 + kstep;
            if (last && has_next) S.a_ready(nxt);
            if constexpr (SP2) {
            PG8_LDB(B0, 0, 0); PG8_LDB(B1, 0, 1); PG8_SCHED; PG8_LDA(At, 0, 0); PG8_STAGE(PG8_SA(1, 1), a1 + hstep, voffA);
            PG8_WAIT_V(8); PG8_WAIT_L(0); PG8_BAR; PG8_MMA(0, 0, At, B0); PG8_MMA(0, 1, At, B1); PG8_BAR; PG8_SCHED;
            PG8_LDA(At, 0, 1); PG8_STAGE(PG8_SB(0, 0), b2, voffB); PG8_STAGE(PG8_SB(0, 1), b2 + hstep, voffB); PG8_STAGE(PG8_SA(0, 0), a2, voffA);
            PG8_WAIT_V(8); PG8_WAIT_L(0); PG8_BAR; PG8_MMA(1, 0, At, B0); PG8_MMA(1, 1, At, B1); PG8_BAR; PG8_SCHED;
            PG8_LDB(B0, 1, 0); PG8_LDB(B1, 1, 1); PG8_SCHED; PG8_LDA(At, 1, 0); PG8_STAGE(PG8_SA(0, 1), a2 + hstep, voffA);
            PG8_WAIT_V(8); PG8_WAIT_L(0); PG8_BAR; PG8_MMA(0, 0, At, B0); PG8_MMA(0, 1, At, B1); PG8_BAR; PG8_SCHED;
            PG8_LDA(At, 1, 1); PG8_STAGE(PG8_SB(1, 0), b3, voffB); PG8_STAGE(PG8_SB(1, 1), b3 + hstep, voffB); PG8_STAGE(PG8_SA(1, 0), a3, voffA);
            PG8_WAIT_V(8); PG8_WAIT_L(0); PG8_BAR; PG8_MMA(1, 0, At, B0); PG8_MMA(1, 1, At, B1); PG8_BAR; PG8_SCHED;
            } else {
            PG8_LDB(B0, 0, 0); PG8_SCHED; PG8_LDA(At, 0, 0); PG8_STAGE(PG8_SA(1, 1), a1 + hstep, voffA);
            PG8_WAIT_L(8); PG8_BAR; PG8_WAIT_L(0); PG8_MMA(0, 0, At, B0); PG8_BAR; PG8_SCHED;
            PG8_LDB(B1, 0, 1); PG8_STAGE(PG8_SB(0, 0), b2, voffB);
            PG8_BAR; PG8_WAIT_L(0); PG8_MMA(0, 1, At, B1); PG8_BAR;
            PG8_LDA(At, 0, 1); PG8_STAGE(PG8_SA(0, 0), a2, voffA);
            PG8_BAR; PG8_WAIT_L(0); PG8_MMA(1, 0, At, B0); PG8_BAR; PG8_SCHED;
            PG8_STAGE(PG8_SB(0, 1), b2 + hstep, voffB);
            PG8_WAIT_V(6); PG8_BAR; PG8_MMA(1, 1, At, B1); PG8_BAR;
            PG8_LDB(B0, 1, 0); PG8_SCHED; PG8_LDA(At, 1, 0); PG8_STAGE(PG8_SA(0, 1), a2 + hstep, voffA);
            PG8_WAIT_L(8); PG8_BAR; PG8_WAIT_L(0); PG8_MMA(0, 0, At, B0); PG8_BAR; PG8_SCHED;
            PG8_LDB(B1, 1, 1); PG8_STAGE(PG8_SB(1, 0), b3, voffB);
            PG8_BAR; PG8_WAIT_L(0); PG8_MMA(0, 1, At, B1); PG8_BAR;
            PG8_LDA(At, 1, 1); PG8_STAGE(PG8_SA(1, 0), a3, voffA);
            PG8_BAR; PG8_WAIT_L(0); PG8_MMA(1, 0, At, B0); PG8_BAR; PG8_SCHED;
            PG8_STAGE(PG8_SB(1, 1), b3 + hstep, voffB);
            PG8_WAIT_V(6); PG8_BAR; PG8_MMA(1, 1, At, B1); PG8_BAR;
            }
        }
        if constexpr (ALIGN_EPI) { if (wr == 0) PG8_BAR; }
        if constexpr (!Epi::AFTER_DRAIN) { E(acc, cur, wr, wc, fr, fq); S.done(cur); }
        if (!has_next) break;
#pragma unroll
        for (int a = 0; a < 2; ++a)
#pragma unroll
            for (int b = 0; b < 2; ++b)
#pragma unroll
                for (int m = 0; m < 4; ++m)
#pragma unroll
                    for (int n = 0; n < 2; ++n) acc[a][b][m][n] = (f32x4){0.f, 0.f, 0.f, 0.f};
        cur = nxt; cA = nA; cB = nB; ++ui;
        if constexpr (ALIGN_EPI) { if (wr == 1) PG8_BAR; }
    }
    PG8_WAIT_V(0);
    if constexpr (!ALIGN_EPI) { if (wr == 0) PG8_BAR; }
    PG8_BAR;
    if constexpr (Epi::AFTER_DRAIN) { E.fused(acc, cur, wr, wc, fr, fq, lds, wid, lane); S.done(cur); }
#undef PG8_SA
#undef PG8_SB
#undef PG8_STAGE
#undef PG8_LDA
#undef PG8_LDB
#undef PG8_MMA
#undef PG8_WAIT_V
#undef PG8_WAIT_L
#undef PG8_BAR
#undef PG8_SCHED
}
}

#define LAS __attribute__((address_space(3)))
typedef unsigned short bf16_t;
typedef short bf16x8 __attribute__((ext_vector_type(8)));
typedef float f32x4 __attribute__((ext_vector_type(4)));
typedef float f32x2 __attribute__((ext_vector_type(2)));
typedef float f32x16 __attribute__((ext_vector_type(16)));
typedef unsigned u32x4 __attribute__((ext_vector_type(4)));
typedef unsigned u32x2 __attribute__((ext_vector_type(2)));

#ifndef GEMM_ALIGN
#define GEMM_ALIGN true
#endif
#ifndef GEMM_SP2
#define GEMM_SP2 true
#endif
#ifndef N_LAUNCH_MODE
#define N_LAUNCH_MODE 1
#endif

constexpr int D = 2048, T = 16384, CL = 256, R = T + CL, DIN = 5120, NCHK = R / 128;
constexpr int NPHASE = 13;
constexpr float EPS = 1e-6f;
constexpr int LDS_BYTES = 131072 + 4096;

constexpr size_t WS_WINT = 0;
constexpr size_t WS_WOUTT = WS_WINT + (size_t)2 * DIN * D * 2;
constexpr size_t WS_XG = WS_WOUTT + (size_t)2 * D * D * 2;
constexpr size_t WS_PX = WS_XG + (size_t)R * D * 2;
constexpr size_t WS_Y = WS_PX + (size_t)R * DIN * 2;
constexpr size_t WS_X1C = WS_Y + (size_t)R * D * 2;
constexpr size_t WS_MOD = WS_X1C + (size_t)CL * D * 4;
constexpr size_t WS_GG = WS_MOD + (size_t)2 * 2 * 6144 * 4;
constexpr size_t WS_SHW = WS_GG + (size_t)2 * 2 * D * 4;
constexpr size_t WS_RSS = WS_SHW + (size_t)2 * 2 * DIN * 4;
constexpr size_t WS_GW = WS_RSS + (size_t)3 * R * 4 + 64;
constexpr size_t WS_SW = WS_GW + (size_t)2 * 16 * 2 * 2 * 2 * 4 * 64 * 8 * 2;
constexpr size_t WS_AGG = WS_SW + (size_t)2 * 8 * 128 * 128 * 2;
constexpr size_t WS_CARRY = WS_AGG + (size_t)2 * NCHK * 1024 * 8;
constexpr size_t WS_BAR = (WS_CARRY + (size_t)2 * NCHK * 1024 * 4 + 255) / 256 * 256;
constexpr size_t WS_DL0 = WS_BAR + 16384;
constexpr size_t WS_END = WS_DL0 + (size_t)T * D * 2;

struct Args { const float* in[25]; float* out; unsigned char* ws; int ph_lo, ph_hi; };

__device__ __forceinline__ float bflo(unsigned w) { return __uint_as_float(w << 16); }
__device__ __forceinline__ float bfhi(unsigned w) { return __uint_as_float(w & 0xffff0000u); }
__device__ __forceinline__ float bf1(bf16_t h) { return __uint_as_float((unsigned)h << 16); }
__device__ __forceinline__ unsigned pk2(float lo, float hi) { return pg8::cvt_pk_bf16(lo, hi); }
__device__ __forceinline__ bf16_t f2bf(float f) { return (bf16_t)(pk2(f, 0.f) & 0xffffu); }
__device__ __forceinline__ float rcpf_(float x) { return __builtin_amdgcn_rcpf(x); }
__device__ __forceinline__ float sigm(float x) { return rcpf_(1.0f + __expf(-x)); }
__device__ __forceinline__ float silu(float x) { return x * sigm(x); }
__device__ __forceinline__ float gelu_t(float x) { return x * sigm(1.5957691216f * (x + 0.044715f * x * x * x)); }
template <int CTRL> __device__ __forceinline__ float dpp_mov(float v) { return __int_as_float(__builtin_amdgcn_update_dpp(0, __float_as_int(v), CTRL, 0xf, 0xf, true)); }
__device__ __forceinline__ float wave_sum(float v) {
    v += dpp_mov<0xB1>(v);
    v += dpp_mov<0x4E>(v);
    v += dpp_mov<0x141>(v);
    v += dpp_mov<0x140>(v);
    const int iv = __float_as_int(v);
    return (__int_as_float(__builtin_amdgcn_readlane(iv, 0)) + __int_as_float(__builtin_amdgcn_readlane(iv, 16))) + (__int_as_float(__builtin_amdgcn_readlane(iv, 32)) + __int_as_float(__builtin_amdgcn_readlane(iv, 48)));
}
__device__ __forceinline__ int tid_fresh() { int t = threadIdx.x; asm volatile("" : "+v"(t)); return t; }
#define GAS __attribute__((address_space(1)))
__device__ __forceinline__ unsigned char* ptr_fresh(unsigned char* p) {
#ifdef FLAT_WS
    asm volatile("" : "+s"(p)); return p; }
#else
    unsigned long long v = (unsigned long long)p; asm volatile("" : "+s"(v)); return (unsigned char*)(GAS unsigned char*)v; }
#endif
#define LDS_WAIT() asm volatile("s_waitcnt lgkmcnt(0)" ::: "memory")

struct EpiIn {
    static constexpr bool PERM = true, AFTER_DRAIN = false;
    bf16_t* PX; const float* rss; const float* shw;
    __device__ __forceinline__ void operator()(const f32x4 (&acc)[2][2][4][2], const pg8::Unit& u, int wr, int wc, int fr, int fq) const {
        const int row0 = CL + u.pm * 256 + wr * 64 + fr, col0 = u.pn * 256 + wc * 32 + 8 * fq;
        const float* sw = shw + col0;
        f32x4 bv[2][2];
#pragma unroll
        for (int bj = 0; bj < 2; ++bj)
#pragma unroll
            for (int n = 0; n < 2; ++n) bv[bj][n] = *(const f32x4*)(sw + bj * 128 + 4 * n);
#pragma unroll
        for (int ai = 0; ai < 2; ++ai)
#pragma unroll
            for (int m = 0; m < 4; ++m) {
                const int r = row0 + ai * 128 + m * 16;
                const float rs = 1.0f / sqrtf(rss[r] * (1.0f / D) + EPS);
                bf16_t* rowp = PX + (size_t)r * DIN + col0;
#pragma unroll
                for (int bj = 0; bj < 2; ++bj) {
                    const f32x4 v0 = acc[ai][bj][m][0] * rs + bv[bj][0], v1 = acc[ai][bj][m][1] * rs + bv[bj][1];
                    u32x4 w; w.x = pk2(v0[0], v0[1]); w.y = pk2(v0[2], v0[3]); w.z = pk2(v1[0], v1[1]); w.w = pk2(v1[2], v1[3]);
                    *(u32x4*)(rowp + bj * 128) = w;
                }
            }
    }
};
struct EpiOut {
    static constexpr bool PERM = true, AFTER_DRAIN = false;
    int row_off, last;
    const float* xold_lat; const float* xold_ctx; float* xnew_lat; float* xnew_ctx;
    const float* gvec;
    const float* ggn;
    bf16_t* XG; float* rssn;
    __device__ __forceinline__ void operator()(const f32x4 (&acc)[2][2][4][2], const pg8::Unit& u, int wr, int wc, int fr, int fq) const {
        const int gbase = row_off + u.pm * 256;
        const bool isctx = gbase < CL;
        const int seg = isctx ? 1 : 0;
        const int grow0 = gbase + wr * 64 + fr, col0 = u.pn * 256 + wc * 32 + 8 * fq;
        const float* xo = isctx ? xold_ctx : (xold_lat - (size_t)CL * D);
        float* xn = isctx ? xnew_ctx : (xnew_lat - (size_t)CL * D);
        const float* gp = gvec + seg * 6144 + 4096 + col0;
        const float* ggp = ggn + seg * D + col0;
        f32x4 gv[2][2], gg[2][2];
#pragma unroll
        for (int bj = 0; bj < 2; ++bj)
#pragma unroll
            for (int n = 0; n < 2; ++n) { gv[bj][n] = *(const f32x4*)(gp + bj * 128 + 4 * n); gg[bj][n] = last ? (f32x4){0.f, 0.f, 0.f, 0.f} : *(const f32x4*)(ggp + bj * 128 + 4 * n); }
#pragma unroll
        for (int ai = 0; ai < 2; ++ai)
#pragma unroll
            for (int m = 0; m < 4; ++m) {
                const int r = grow0 + ai * 128 + m * 16;
                const size_t ro = (size_t)r * D + col0;
                float ss = 0.f;
#pragma unroll
                for (int bj = 0; bj < 2; ++bj) {
                    const f32x4 o0 = *(const f32x4*)(xo + ro + bj * 128), o1 = *(const f32x4*)(xo + ro + bj * 128 + 4);
                    const f32x4 v0 = o0 + gv[bj][0] * acc[ai][bj][m][0], v1 = o1 + gv[bj][1] * acc[ai][bj][m][1];
                    *(f32x4*)(xn + ro + bj * 128) = v0; *(f32x4*)(xn + ro + bj * 128 + 4) = v1;
                    ss += (v0[0] * v0[0] + v0[1] * v0[1]) + (v0[2] * v0[2] + v0[3] * v0[3]) + (v1[0] * v1[0] + v1[1] * v1[1]) + (v1[2] * v1[2] + v1[3] * v1[3]);
                    if (!last) {
                        const f32x4 a0 = v0 * gg[bj][0], a1 = v1 * gg[bj][1];
                        u32x4 w; w.x = pk2(a0[0], a0[1]); w.y = pk2(a0[2], a0[3]); w.z = pk2(a1[0], a1[1]); w.w = pk2(a1[2], a1[3]);
                        *(u32x4*)(XG + ro + bj * 128) = w;
                    }
                }
                ss += __shfl_xor(ss, 16); ss += __shfl_xor(ss, 32);
                if (fq == 0) unsafeAtomicAdd(rssn + r, ss);
            }
    }
};

struct EpiDelta {
    static constexpr bool PERM = true, AFTER_DRAIN = false;
    bf16_t* DL; const float* gvec;
    __device__ __forceinline__ void operator()(const f32x4 (&acc)[2][2][4][2], const pg8::Unit& u, int wr, int wc, int fr, int fq) const {
        const int row0 = u.pm * 256 + wr * 64 + fr, col0 = u.pn * 256 + wc * 32 + 8 * fq;
        f32x4 gv[2][2];
#pragma unroll
        for (int bj = 0; bj < 2; ++bj)
#pragma unroll
            for (int n = 0; n < 2; ++n) gv[bj][n] = *(const f32x4*)(gvec + col0 + bj * 128 + 4 * n);
#pragma unroll
        for (int ai = 0; ai < 2; ++ai)
#pragma unroll
            for (int m = 0; m < 4; ++m) {
                bf16_t* rowp = DL + (size_t)(row0 + ai * 128 + m * 16) * D + col0;
#pragma unroll
                for (int bj = 0; bj < 2; ++bj) {
                    const f32x4 v0 = acc[ai][bj][m][0] * gv[bj][0], v1 = acc[ai][bj][m][1] * gv[bj][1];
                    u32x4 w; w.x = pk2(v0[0], v0[1]); w.y = pk2(v0[2], v0[3]); w.z = pk2(v1[0], v1[1]); w.w = pk2(v1[2], v1[3]);
                    *(u32x4*)(rowp + bj * 128) = w;
                }
            }
    }
};

__device__ __forceinline__ void transpose_item(const float* W, int K, int N, bf16_t* WT, LAS float* scr, int item, int lane) {
    const int nblk = N / 32, kb = item / nblk, nb = item % nblk, k0 = 64 * kb, n0 = 32 * nb;
#pragma unroll 8
    for (int i = 0; i < 32; ++i) { const int kk = 2 * i + (lane >> 5); scr[kk * 33 + (lane & 31)] = __builtin_nontemporal_load(W + (size_t)(k0 + kk) * N + n0 + (lane & 31)); }
    LDS_WAIT();
    const int c = lane & 7;
#pragma unroll
    for (int j = 0; j < 4; ++j) { const int n = (lane >> 3) + 8 * j; const LAS float* s = scr + (8 * c) * 33 + n;
        u32x4 o; o.x = pk2(s[0 * 33], s[1 * 33]); o.y = pk2(s[2 * 33], s[3 * 33]); o.z = pk2(s[4 * 33], s[5 * 33]); o.w = pk2(s[6 * 33], s[7 * 33]);
        *(u32x4*)(WT + (size_t)(n0 + n) * K + k0 + 8 * c) = o; }
    LDS_WAIT();
}

__device__ __forceinline__ void phase0a(const Args a, LAS unsigned char* lds) {
    const int tid = tid_fresh(), lane = tid & 63, wave = tid >> 6, b = blockIdx.x, G = gridDim.x;
    unsigned char* ws = ptr_fresh(a.ws);
    { float* rss = (float*)(ws + WS_RSS); for (int i = b * 512 + tid; i < 2 * R; i += G * 512) rss[R + i] = 0.f; }
    { bf16_t* GW = (bf16_t*)(ws + WS_GW);
      for (int gid = b * 512 + tid; gid < 2 * 16 * 2 * 2 * 2 * 4 * 64; gid += G * 512) {
          int x = gid; const int ln = x & 63; x >>= 6; const int s = x & 3; x >>= 2; const int half = x & 1; x >>= 1; const int gate = x & 1; x >>= 1; const int dir = x & 1; x >>= 1; const int hd = x & 15; x >>= 4; const int l = x;
          const float* w = (gate ? a.in[14] : a.in[12]) + ((size_t)((l * 2 + dir) * 16 + hd)) * 4096;
          const int col = 32 * half + (ln & 31), k0 = 16 * s + 8 * (ln >> 5);
          float v[8];
#pragma unroll
          for (int j = 0; j < 8; ++j) v[j] = __builtin_nontemporal_load(w + (k0 + j) * 64 + col);
          u32x4 o; o.x = pk2(v[0], v[1]); o.y = pk2(v[2], v[3]); o.z = pk2(v[4], v[5]); o.w = pk2(v[6], v[7]);
          *(u32x4*)(GW + (size_t)gid * 8) = o;
      } }
    { bf16_t* SW = (bf16_t*)(ws + WS_SW); const float* sw = a.in[22];
      for (int i = b * 512 + tid; i < 2 * 8 * 128 * 128 / 4; i += G * 512) { const f32x4 v = __builtin_nontemporal_load((const f32x4*)(sw + (size_t)i * 4)); u32x2 o; o.x = pk2(v[0], v[1]); o.y = pk2(v[2], v[3]); *(u32x2*)(SW + (size_t)i * 4) = o; } }
    { const float* c = a.in[1]; const float* cc = a.in[3]; float* MOD = (float*)(ws + WS_MOD);
      LAS float* red = (LAS float*)lds;
      for (int u = b; u < 192; u += G) {
          const int l = u / 96, n0 = (u % 96) * 64, q = tid & 15, ks = tid >> 4;
          const float* W = a.in[4] + (size_t)l * D * 6144 + n0 + 4 * q;
          f32x4 a0 = {0.f, 0.f, 0.f, 0.f}, a1 = {0.f, 0.f, 0.f, 0.f};
#pragma unroll 8
          for (int kk = 0; kk < 64; ++kk) { const int k = ks * 64 + kk; const f32x4 wv = __builtin_nontemporal_load((const f32x4*)(W + (size_t)k * 6144)); const float ca = silu(c[k]), cb = silu(cc[k]); a0 += wv * ca; a1 += wv * cb; }
          LAS float* rp = red + (ks * 16 + q) * 8;
          *(LAS f32x4*)rp = a0; *(LAS f32x4*)(rp + 4) = a1;
          __syncthreads();
          if (tid < 128) { const int qq = tid >> 3, e = tid & 7; float s = 0.f;
#pragma unroll 8
              for (int k2 = 0; k2 < 32; ++k2) s += red[(k2 * 16 + qq) * 8 + e];
              const int seg = e >> 2, col = n0 + 4 * qq + (e & 3);
              MOD[(l * 2 + seg) * 6144 + col] = s + a.in[5][l * 6144 + col]; }
          __syncthreads();
      } }
    { LAS float* scr = (LAS float*)(lds + wave * 16384);
      const int gw = b * 8 + wave, NGW = G * 8;
      constexpr int I_IN = (D / 64) * (DIN / 32), I_OUT = (D / 64) * (D / 32);
      for (int it = gw; it < 2 * I_IN + 2 * I_OUT; it += NGW) {
          int r = it;
          if (r < 2 * I_IN) { const int l = r / I_IN; transpose_item(a.in[7] + (size_t)l * D * DIN, D, DIN, (bf16_t*)(ws + WS_WINT) + (size_t)l * DIN * D, scr, r % I_IN, lane); continue; }
          r -= 2 * I_IN; { const int l = r / I_OUT; transpose_item(a.in[8] + (size_t)l * D * D, D, D, (bf16_t*)(ws + WS_WOUTT) + (size_t)l * D * D, scr, r % I_OUT, lane); }
      } }
}

__device__ __forceinline__ void phase0b(const Args a, LAS unsigned char* lds) {
    const int tid = tid_fresh(), lane = tid & 63, wave = tid >> 6, b = blockIdx.x, G = gridDim.x;
    unsigned char* ws = ptr_fresh(a.ws);
    const float* MOD = (const float*)(ws + WS_MOD);
    LAS float* GG0 = (LAS float*)lds;
    LAS float* SH = (LAS float*)(lds + 16384);
    for (int i = tid; i < 2 * D; i += 512) { const int seg = i >> 11, k = i & 2047; float gv_ = a.in[6][k] * (1.0f + MOD[seg * 6144 + 2048 + k]); if (gv_ == 0.f) gv_ = 1e-30f; GG0[i] = gv_; }
    for (int i = tid; i < 4 * D; i += 512) { const int ls = i >> 11, k = i & 2047; SH[i] = MOD[ls * 6144 + k]; }
    { float* GGt = (float*)(ws + WS_GG); for (int i = b * 512 + tid; i < 4 * D; i += G * 512) { const int ls = i >> 11, l = ls >> 1, k = i & 2047; float gv_ = a.in[6][l * D + k] * (1.0f + MOD[ls * 6144 + 2048 + k]); if (gv_ == 0.f) gv_ = 1e-30f; GGt[i] = gv_; } }
    __syncthreads();
    const int gw = b * 8 + wave, NGW = G * 8;
    { bf16_t* XG = (bf16_t*)(ws + WS_XG); float* rss = (float*)(ws + WS_RSS);
      f32x4 vr[8];
#define P0B_LOAD(r_, V) do { const float* _src = (r_) < CL ? a.in[2] + (size_t)(r_) * D : a.in[0] + (size_t)((r_) - CL) * D; \
          _Pragma("unroll") for (int j = 0; j < 8; ++j) V[j] = __builtin_nontemporal_load((const f32x4*)(_src + 4 * (lane + 64 * j))); } while (0)
      int r = gw;
      if (r < R) P0B_LOAD(r, vr);
      for (; r < R; r += NGW) {
          f32x4 vn[8];
          const int rn = r + NGW;
          if (rn < R) P0B_LOAD(rn, vn);
          const int seg = r < CL ? 1 : 0;
          float ss = 0.f;
#pragma unroll
          for (int j = 0; j < 8; ++j) ss += (vr[j][0] * vr[j][0] + vr[j][1] * vr[j][1]) + (vr[j][2] * vr[j][2] + vr[j][3] * vr[j][3]);
#pragma unroll
          for (int j = 0; j < 8; ++j) { const f32x4 g = *(LAS f32x4*)(GG0 + seg * D + 4 * (lane + 64 * j)); const f32x4 p = vr[j] * g; u32x2 o; o.x = pk2(p[0], p[1]); o.y = pk2(p[2], p[3]); *(u32x2*)(XG + (size_t)r * D + 4 * (lane + 64 * j)) = o; }
          ss = wave_sum(ss);
          if (lane == 0) rss[r] = ss;
          if (rn < R) {
#pragma unroll
              for (int j = 0; j < 8; ++j) vr[j] = vn[j];
          }
      }
#undef P0B_LOAD
    }
    { float* SHW = (float*)(ws + WS_SHW); const bf16_t* WinT = (const bf16_t*)(ws + WS_WINT);
      u32x4 wr[4];
#define SHW_LOAD(i_, W_) do { const bf16_t* _row = WinT + (size_t)(i_) * D; _Pragma("unroll") for (int j = 0; j < 4; ++j) W_[j] = *(const u32x4*)(_row + 8 * (lane + 64 * j)); } while (0)
      int idx = gw;
      if (idx < 2 * DIN) SHW_LOAD(idx, wr);
      for (; idx < 2 * DIN; idx += NGW) {
          u32x4 wn[4];
          const int idn = idx + NGW;
          if (idn < 2 * DIN) SHW_LOAD(idn, wn);
          const int l = idx / DIN, n = idx % DIN;
          float d0 = 0.f, d1 = 0.f;
#pragma unroll
          for (int j = 0; j < 4; ++j) { const int k = 8 * (lane + 64 * j); const u32x4 w = wr[j];
              const LAS float* s0 = SH + (l * 2 + 0) * D + k; const LAS float* s1 = SH + (l * 2 + 1) * D + k;
              const f32x4 x0 = *(LAS f32x4*)s0, x1 = *(LAS f32x4*)(s0 + 4), y0 = *(LAS f32x4*)s1, y1 = *(LAS f32x4*)(s1 + 4);
              const float w0 = bflo(w.x), w1 = bfhi(w.x), w2 = bflo(w.y), w3 = bfhi(w.y), w4 = bflo(w.z), w5 = bfhi(w.z), w6 = bflo(w.w), w7 = bfhi(w.w);
              d0 += (w0 * x0[0] + w1 * x0[1]) + (w2 * x0[2] + w3 * x0[3]) + (w4 * x1[0] + w5 * x1[1]) + (w6 * x1[2] + w7 * x1[3]);
              d1 += (w0 * y0[0] + w1 * y0[1]) + (w2 * y0[2] + w3 * y0[3]) + (w4 * y1[0] + w5 * y1[1]) + (w6 * y1[2] + w7 * y1[3]); }
          d0 = wave_sum(d0); d1 = wave_sum(d1);
          if (lane == 0) { SHW[(l * 2 + 0) * DIN + n] = d0; SHW[(l * 2 + 1) * DIN + n] = d1; }
          if (idn < 2 * DIN) {
#pragma unroll
              for (int j = 0; j < 4; ++j) wr[j] = wn[j];
          }
      }
#undef SHW_LOAD
    }
    __syncthreads();
}

constexpr int XLF_STRIDE = 68, XLB_STRIDE = 72;
constexpr int LRU_XLF = 0, LRU_XLB = 128 * XLF_STRIDE * 4, LRU_TAGG = LRU_XLB + 128 * XLB_STRIDE * 2;

template <bool PASSC>
__device__ __forceinline__ void lru_item(const Args a, int l, int chunk, int hd, LAS unsigned char* lds) {
    const int tid = tid_fresh(), lane = tid & 63, wave = tid >> 6;
    unsigned char* ws = ptr_fresh(a.ws);
    const bf16_t* PX = (const bf16_t*)(ws + WS_PX);
    LAS float* XLF = (LAS float*)(lds + LRU_XLF);
    LAS bf16_t* XLB = (LAS bf16_t*)(lds + LRU_XLB);
    LAS f32x2* TAGG = (LAS f32x2*)(lds + LRU_TAGG);
    __syncthreads();
    {
        const int t = tid >> 2, q = tid & 3, ch0 = hd * 64 + q * 16;
        const int grow = chunk * 128 + t, seg_lo = chunk < 2 ? 0 : CL, seg_hi = chunk < 2 ? CL : R;
        const float* cw = a.in[9] + (size_t)l * 4 * 1024 + ch0; const float* cb = a.in[10] + (size_t)l * 1024 + ch0;
        float xl[16];
#pragma unroll
        for (int c4 = 0; c4 < 4; ++c4) { const f32x4 bb = *(const f32x4*)(cb + 4 * c4); xl[4 * c4] = bb[0]; xl[4 * c4 + 1] = bb[1]; xl[4 * c4 + 2] = bb[2]; xl[4 * c4 + 3] = bb[3]; }
#pragma unroll
        for (int j = 0; j < 4; ++j) {
            const int rr = grow + j - 2;
            if (rr >= seg_lo && rr < seg_hi) {
                const u32x4 p0 = *(const u32x4*)(PX + (size_t)rr * DIN + ch0), p1 = *(const u32x4*)(PX + (size_t)rr * DIN + ch0 + 8);
                const unsigned pw[8] = {p0.x, p0.y, p0.z, p0.w, p1.x, p1.y, p1.z, p1.w};
#pragma unroll
                for (int c4 = 0; c4 < 4; ++c4) { const f32x4 wv = *(const f32x4*)(cw + j * 1024 + 4 * c4);
                    xl[4 * c4 + 0] += wv[0] * bflo(pw[2 * c4]); xl[4 * c4 + 1] += wv[1] * bfhi(pw[2 * c4]); xl[4 * c4 + 2] += wv[2] * bflo(pw[2 * c4 + 1]); xl[4 * c4 + 3] += wv[3] * bfhi(pw[2 * c4 + 1]); }
            }
        }
        LAS float* xf = XLF + t * XLF_STRIDE + q * 16;
#pragma unroll
        for (int c4 = 0; c4 < 4; ++c4) *(LAS f32x4*)(xf + 4 * c4) = (f32x4){xl[4 * c4], xl[4 * c4 + 1], xl[4 * c4 + 2], xl[4 * c4 + 3]};
        LAS bf16_t* xb = XLB + t * XLB_STRIDE + q * 16;
        u32x4 o0, o1; o0.x = pk2(xl[0], xl[1]); o0.y = pk2(xl[2], xl[3]); o0.z = pk2(xl[4], xl[5]); o0.w = pk2(xl[6], xl[7]); o1.x = pk2(xl[8], xl[9]); o1.y = pk2(xl[10], xl[11]); o1.z = pk2(xl[12], xl[13]); o1.w = pk2(xl[14], xl[15]);
        *(LAS u32x4*)xb = o0; *(LAS u32x4*)(xb + 8) = o1;
    }
    __syncthreads();
    const int tw = wave >> 1, chh = wave & 1, cl = lane & 31, hh = lane >> 5;
    const int cin = 32 * chh + cl, cg_ = hd * 64 + cin;
    bf16x8 Af[4];
#pragma unroll
    for (int s = 0; s < 4; ++s) Af[s] = *(const LAS bf16x8*)(XLB + (32 * tw + cl) * XLB_STRIDE + 16 * s + 8 * hh);
    float xlv[16];
#pragma unroll
    for (int i = 0; i < 16; ++i) xlv[i] = XLF[(32 * tw + (i & 3) + 8 * (i >> 2) + 4 * hh) * XLF_STRIDE + cin];
    float av[2][16], bv[2][16];
    float GA[2][8], GB[2][8];
    const bf16_t* GW = (const bf16_t*)(ws + WS_GW);
#pragma unroll
    for (int dir = 0; dir < 2; ++dir) {
        f32x16 ar, ai;
#pragma unroll
        for (int i = 0; i < 16; ++i) { ar[i] = 0.f; ai[i] = 0.f; }
#pragma unroll
        for (int s = 0; s < 4; ++s) {
            const size_t gr = ((((((size_t)(l * 16 + hd) * 2 + dir) * 2 + 0) * 2 + chh) * 4 + s) * 64 + lane) * 8;
            const size_t gi = ((((((size_t)(l * 16 + hd) * 2 + dir) * 2 + 1) * 2 + chh) * 4 + s) * 64 + lane) * 8;
            const bf16x8 Br = *(const bf16x8*)(GW + gr), Bi = *(const bf16x8*)(GW + gi);
            ar = __builtin_amdgcn_mfma_f32_32x32x16_bf16(Af[s], Br, ar, 0, 0, 0);
            ai = __builtin_amdgcn_mfma_f32_32x32x16_bf16(Af[s], Bi, ai, 0, 0, 0);
        }
        const float brv = a.in[13][(size_t)(l * 2 + dir) * 1024 + cg_], biv = a.in[15][(size_t)(l * 2 + dir) * 1024 + cg_];
        const float lam = a.in[11][(size_t)(l * 2 + dir) * 1024 + cg_];
        const float k8 = -8.0f * log1pf(__expf(-lam));
#pragma unroll
        for (int i = 0; i < 16; ++i) {
            const float rg = sigm(ar[i] + brv), ig = sigm(ai[i] + biv);
            const float la = k8 * rg;
            av[dir][i] = __expf(la);
            const float aa = av[dir][i]; bv[dir][i] = __builtin_amdgcn_sqrtf(fmaxf(1.0f - aa * aa, 0.f)) * ig * xlv[i];
        }
        float oA[4], oB[4];
#pragma unroll
        for (int g = 0; g < 4; ++g) {
            const float a0 = av[dir][4 * g], a1 = av[dir][4 * g + 1], a2 = av[dir][4 * g + 2], a3 = av[dir][4 * g + 3];
            const float b0 = bv[dir][4 * g], b1 = bv[dir][4 * g + 1], b2 = bv[dir][4 * g + 2], b3 = bv[dir][4 * g + 3];
            oA[g] = (a0 * a1) * (a2 * a3);
            oB[g] = dir == 0 ? ((b0 * a1 + b1) * a2 + b2) * a3 + b3 : ((b3 * a2 + b2) * a1 + b1) * a0 + b0;
        }
#pragma unroll
        for (int g = 0; g < 4; ++g) {
            const float pA = __shfl_xor(oA[g], 32), pB = __shfl_xor(oB[g], 32);
            GA[dir][2 * g] = hh ? pA : oA[g]; GA[dir][2 * g + 1] = hh ? oA[g] : pA;
            GB[dir][2 * g] = hh ? pB : oB[g]; GB[dir][2 * g + 1] = hh ? oB[g] : pB;
        }
        float tA = 1.f, tB = 0.f;
        if (dir == 0) {
#pragma unroll
            for (int gq = 0; gq < 8; ++gq) { tB = GA[dir][gq] * tB + GB[dir][gq]; tA *= GA[dir][gq]; }
        } else {
#pragma unroll
            for (int gq = 7; gq >= 0; --gq) { tB = GA[dir][gq] * tB + GB[dir][gq]; tA *= GA[dir][gq]; }
        }
        if (hh == 0) TAGG[(tw * 2 + dir) * 64 + cin] = (f32x2){tA, tB};
    }
    __syncthreads();
    if constexpr (!PASSC) {
        if (tid < 128) {
            const int dir = tid >> 6, c = tid & 63;
            float cA = 1.f, cB = 0.f;
#pragma unroll
            for (int k = 0; k < 4; ++k) { const int t2 = dir == 0 ? k : 3 - k; const f32x2 v = TAGG[(t2 * 2 + dir) * 64 + c]; cB = v[0] * cB + v[1]; cA *= v[0]; }
            f32x2* AGG = (f32x2*)(ws + WS_AGG);
            AGG[((size_t)dir * NCHK + chunk) * 1024 + hd * 64 + c] = (f32x2){cA, cB};
        }
    } else {
        const float* CARRY = (const float*)(ws + WS_CARRY);
        float yv[16];
#pragma unroll
        for (int dir = 0; dir < 2; ++dir) {
            float st = CARRY[((size_t)dir * NCHK + chunk) * 1024 + cg_];
            if (dir == 0) {
#pragma unroll
                for (int t2 = 0; t2 < 3; ++t2) if (t2 < tw) { const f32x2 v = TAGG[(t2 * 2 + 0) * 64 + cin]; st = v[0] * st + v[1]; }
            } else {
#pragma unroll
                for (int t2 = 3; t2 > 0; --t2) if (t2 > tw) { const f32x2 v = TAGG[(t2 * 2 + 1) * 64 + cin]; st = v[0] * st + v[1]; }
            }
            float hst[4];
            if (dir == 0) {
                float s = st;
#pragma unroll
                for (int g = 0; g < 4; ++g) { const float sE = s; s = GA[0][2 * g] * s + GB[0][2 * g]; const float sO = s; s = GA[0][2 * g + 1] * s + GB[0][2 * g + 1]; hst[g] = hh ? sO : sE; }
            } else {
                float s = st;
#pragma unroll
                for (int g = 3; g >= 0; --g) { const float sO = s; s = GA[1][2 * g + 1] * s + GB[1][2 * g + 1]; const float sE = s; s = GA[1][2 * g] * s + GB[1][2 * g]; hst[g] = hh ? sO : sE; }
            }
#pragma unroll
            for (int g = 0; g < 4; ++g) {
                float h = hst[g];
                if (dir == 0) {
#pragma unroll
                    for (int k = 0; k < 4; ++k) { h = av[0][4 * g + k] * h + bv[0][4 * g + k]; yv[4 * g + k] = h; }
                } else {
#pragma unroll
                    for (int k = 3; k >= 0; --k) { h = av[1][4 * g + k] * h + bv[1][4 * g + k]; yv[4 * g + k] += h; }
                }
            }
        }
        bf16_t* Y = (bf16_t*)(ws + WS_Y);
#pragma unroll
        for (int i = 0; i < 16; ++i) {
            const int row = chunk * 128 + 32 * tw + (i & 3) + 8 * (i >> 2) + 4 * hh;
            const float gt = bf1(PX[(size_t)row * DIN + 1024 + cg_]);
            Y[(size_t)row * D + cg_] = f2bf(yv[i] * silu(gt));
        }
    }
}

__device__ __forceinline__ void conv_item(const Args a, int l, int ct, LAS unsigned char* lds) {
    const int tid = tid_fresh(), lane = tid & 63, wave = tid >> 6, c = tid;
    unsigned char* ws = ptr_fresh(a.ws);
    const bf16_t* PX = (const bf16_t*)(ws + WS_PX); bf16_t* Y = (bf16_t*)(ws + WS_Y);
    LAS float* CB = (LAS float*)lds;
    const int t0 = ct * 128, seg_lo = ct < 2 ? 0 : CL, seg_hi = ct < 2 ? CL : R;
    float w[31];
#pragma unroll
    for (int j = 0; j < 31; ++j) w[j] = a.in[16][((size_t)l * 31 + j) * 512 + c];
    const float bias = a.in[17][l * 512 + c];
    float win[32];
#define CONV_Z(dst, rr_) do { const int _rr = (rr_); const int _rc = _rr < seg_lo ? seg_lo : (_rr >= seg_hi ? seg_hi - 1 : _rr); const float _v = bf1(PX[(size_t)_rc * DIN + 2048 + c]), _g = bf1(PX[(size_t)_rc * DIN + 2560 + c]); const float _z = _v * sigm(_g); dst = (_rr == _rc) ? _z : 0.f; } while (0)
#pragma unroll
    for (int e = 0; e < 30; ++e) CONV_Z(win[e], t0 - 15 + e);
    win[30] = 0.f; win[31] = 0.f;
    __syncthreads();
#pragma unroll 1
    for (int bb = 0; bb < 4; ++bb) {
        LAS float* cbuf = CB + (bb & 1) * (32 * 512);
#pragma unroll
        for (int u = 0; u < 32; ++u) {
            if ((u & 7) == 0) asm volatile("" ::: "memory");
            CONV_Z(win[(u + 30) & 31], t0 - 15 + 32 * bb + u + 30);
            float acc = bias;
#pragma unroll
            for (int j = 0; j < 31; ++j) acc += w[j] * win[(u + j) & 31];
            cbuf[u * 512 + c] = acc;
        }
        __syncthreads();
#pragma unroll 1
        for (int uu = 0; uu < 4; ++uu) {
            const int u = wave * 4 + uu, row = t0 + 32 * bb + u;
            float v[8]; float s = 0.f;
#pragma unroll
            for (int k = 0; k < 8; ++k) { v[k] = cbuf[u * 512 + lane + 64 * k]; s += v[k]; }
            const float mean = wave_sum(s) * (1.0f / 512.0f);
            float s2 = 0.f;
#pragma unroll
            for (int k = 0; k < 8; ++k) { v[k] -= mean; s2 += v[k] * v[k]; }
            const float rstd = 1.0f / sqrtf(wave_sum(s2) * (1.0f / 512.0f) + EPS);
#pragma unroll
            for (int k = 0; k < 8; ++k) {
                const int ch = lane + 64 * k;
                const float y = silu(v[k] * rstd * a.in[18][l * 512 + ch] + a.in[19][l * 512 + ch]);
                const float gt = bf1(PX[(size_t)row * DIN + 3072 + ch]);
                Y[(size_t)row * D + 1024 + ch] = f2bf(y * silu(gt));
            }
        }
    }
#undef CONV_Z
}

constexpr int TT_STRIDE = 136;
__device__ __forceinline__ void sgu_item(const Args a, int l, int sc, LAS unsigned char* lds) {
    const int tid = tid_fresh(), lane = tid & 63, wave = tid >> 6;
    unsigned char* ws = ptr_fresh(a.ws);
    const bf16_t* PX = (const bf16_t*)(ws + WS_PX); bf16_t* Y = (bf16_t*)(ws + WS_Y);
    const bf16_t* SW = (const bf16_t*)(ws + WS_SW) + (size_t)l * 8 * 128 * 128;
    LAS f32x2* ST = (LAS f32x2*)lds;
    LAS bf16_t* TT = (LAS bf16_t*)(lds + 1024);
    const int t0 = sc * 128;
    __syncthreads();
#pragma unroll 1
    for (int k = 0; k < 16; ++k) {
        const int tok = wave * 16 + k;
        const u32x4 p = *(const u32x4*)(PX + (size_t)(t0 + tok) * DIN + 4096 + 8 * lane);
        float g[8] = {gelu_t(bflo(p.x)), gelu_t(bfhi(p.x)), gelu_t(bflo(p.y)), gelu_t(bfhi(p.y)), gelu_t(bflo(p.z)), gelu_t(bfhi(p.z)), gelu_t(bflo(p.w)), gelu_t(bfhi(p.w))};
        float s = 0.f;
#pragma unroll
        for (int j = 0; j < 8; ++j) s += g[j];
        const float mean = wave_sum(s) * (1.0f / 512.0f);
        float s2 = 0.f;
#pragma unroll
        for (int j = 0; j < 8; ++j) { const float d = g[j] - mean; s2 += d * d; }
        const float rstd = 1.0f / sqrtf(wave_sum(s2) * (1.0f / 512.0f) + EPS);
        if (lane == 0) ST[tok] = (f32x2){mean, rstd};
    }
    __syncthreads();
    const int p_ = tid >> 2, dq = tid & 3;
    const f32x2 st = ST[p_];
    const int fr = lane & 15, fq = lane >> 4;
#pragma unroll 1
    for (int h = 0; h < 8; ++h) {
        LAS bf16_t* tt = TT + (h & 1) * (64 * TT_STRIDE);
        {
            const int ch = 64 * h + 16 * dq;
            const u32x4 q0 = *(const u32x4*)(PX + (size_t)(t0 + p_) * DIN + 4096 + ch), q1 = *(const u32x4*)(PX + (size_t)(t0 + p_) * DIN + 4096 + ch + 8);
            const unsigned pw[8] = {q0.x, q0.y, q0.z, q0.w, q1.x, q1.y, q1.z, q1.w};
            const float* lg = a.in[20] + l * 512 + ch; const float* lb = a.in[21] + l * 512 + ch;
#pragma unroll
            for (int j = 0; j < 8; ++j) {
                const float v0 = (gelu_t(bflo(pw[j])) - st[0]) * st[1] * lg[2 * j] + lb[2 * j];
                const float v1 = (gelu_t(bfhi(pw[j])) - st[0]) * st[1] * lg[2 * j + 1] + lb[2 * j + 1];
                tt[(16 * dq + 2 * j) * TT_STRIDE + p_] = f2bf(v0);
                tt[(16 * dq + 2 * j + 1) * TT_STRIDE + p_] = f2bf(v1);
            }
        }
        __syncthreads();
        f32x4 acc[4];
#pragma unroll
        for (int nt = 0; nt < 4; ++nt) acc[nt] = (f32x4){0.f, 0.f, 0.f, 0.f};
#pragma unroll
        for (int s = 0; s < 4; ++s) {
            const bf16x8 Afr = *(const bf16x8*)(SW + ((size_t)h * 128 + 16 * wave + fr) * 128 + 32 * s + 8 * fq);
#pragma unroll
            for (int nt = 0; nt < 4; ++nt) {
                const bf16x8 Bfr = *(const LAS bf16x8*)(tt + (16 * nt + fr) * TT_STRIDE + 32 * s + 8 * fq);
                acc[nt] = __builtin_amdgcn_mfma_f32_16x16x32_bf16(Afr, Bfr, acc[nt], 0, 0, 0);
            }
        }
#pragma unroll
        for (int reg = 0; reg < 4; ++reg) {
            const int q = 16 * wave + 4 * fq + reg, row = t0 + q;
            const float bs = a.in[23][((size_t)l * 8 + h) * 128 + q];
#pragma unroll
            for (int nt = 0; nt < 4; ++nt) {
                const int ch = 64 * h + 16 * nt + fr;
                const float uu = gelu_t(bf1(PX[(size_t)row * DIN + 3584 + ch]));
                const float gt = bf1(PX[(size_t)row * DIN + 4608 + ch]);
                Y[(size_t)row * D + 1536 + ch] = f2bf(uu * (acc[nt][reg] + bs) * silu(gt));
            }
        }
    }
}


constexpr int L2_GWL = 0;
constexpr int L2_CW = 32768;
constexpr int L2_RAW = 34816;
constexpr int RAW_ROWB = 144, RAW_BUFB = 132 * RAW_ROWB;
constexpr int L2_XLF = L2_RAW + 2 * RAW_BUFB;
constexpr int L2_XLB = L2_XLF + 128 * XLF_STRIDE * 4;
constexpr int L2_TAGG = L2_XLB + 128 * XLB_STRIDE * 2;
static_assert(L2_TAGG + 4096 <= LDS_BYTES, "lds map");

template <bool PASSC>
__device__ __forceinline__ void lru_phase(const Args a, int l, int c_lo, LAS unsigned char* lds) {
    const int tid = tid_fresh(), lane = tid & 63, wave = tid >> 6, b = blockIdx.x, G = gridDim.x;
    unsigned char* ws = ptr_fresh(a.ws);
    const bf16_t* PX = (const bf16_t*)(ws + WS_PX);
    const int hd = b & 15, cstep = G >> 4;
    int chunk = c_lo + (b >> 4);
    if (chunk >= NCHK) return;
    LAS float* CW = (LAS float*)(lds + L2_CW);
    LAS float* XLF = (LAS float*)(lds + L2_XLF);
    LAS bf16_t* XLB = (LAS bf16_t*)(lds + L2_XLB);
    LAS f32x2* TAGG = (LAS f32x2*)(lds + L2_TAGG);
    __syncthreads();
    {
        const bf16_t* GW = (const bf16_t*)(ws + WS_GW) + (size_t)(l * 16 + hd) * 16384;
#pragma unroll
        for (int i = 0; i < 4; ++i) *(LAS u32x4*)(lds + L2_GWL + (tid + 512 * i) * 16) = *(const u32x4*)(GW + (size_t)(tid + 512 * i) * 8);
        if (tid < 320) { const int j = tid >> 6, c = tid & 63; CW[tid] = j < 4 ? a.in[9][((size_t)l * 4 + j) * 1024 + hd * 64 + c] : a.in[10][(size_t)l * 1024 + hd * 64 + c]; }
    }
    const int tw = wave >> 1, chh = wave & 1, cl = lane & 31, hh = lane >> 5;
    const int cin = 32 * chh + cl, cg_ = hd * 64 + cin;
    float brv[2], biv[2], k8[2];
#pragma unroll
    for (int dir = 0; dir < 2; ++dir) {
        brv[dir] = a.in[13][(size_t)(l * 2 + dir) * 1024 + cg_]; biv[dir] = a.in[15][(size_t)(l * 2 + dir) * 1024 + cg_];
        k8[dir] = -8.0f * log1pf(__expf(-a.in[11][(size_t)(l * 2 + dir) * 1024 + cg_]));
    }
    const int t = tid >> 2, q = tid & 3, ch0 = hd * 64 + q * 16;
    const int hrow = (tid >> 2) < 2 ? (tid >> 2) : 130;
    u32x4 r0, r1, h0, h1;
    const u32x4 zero4 = {0u, 0u, 0u, 0u};
#define LRU_LOAD_RAW(ck) do { const int _t0 = (ck) * 128, _lo = (ck) < 2 ? 0 : CL, _hi = (ck) < 2 ? CL : R; \
        const bf16_t* _p = PX + (size_t)(_t0 + t) * DIN + ch0; r0 = *(const u32x4*)_p; r1 = *(const u32x4*)(_p + 8); \
        h0 = zero4; h1 = zero4; \
        if (tid < 12) { const int _gr = _t0 - 2 + hrow; if (_gr >= _lo && _gr < _hi) { const bf16_t* _ph = PX + (size_t)_gr * DIN + ch0; h0 = *(const u32x4*)_ph; h1 = *(const u32x4*)(_ph + 8); } } } while (0)
#define LRU_STORE_RAW(buf) do { LAS unsigned char* _rb = lds + L2_RAW + (buf) * RAW_BUFB; \
        *(LAS u32x4*)(_rb + (t + 2) * RAW_ROWB + 32 * q) = r0; *(LAS u32x4*)(_rb + (t + 2) * RAW_ROWB + 32 * q + 16) = r1; \
        if (tid < 12) { *(LAS u32x4*)(_rb + hrow * RAW_ROWB + 32 * q) = h0; *(LAS u32x4*)(_rb + hrow * RAW_ROWB + 32 * q + 16) = h1; } } while (0)
    LRU_LOAD_RAW(chunk);
    LRU_STORE_RAW(0);
    int cur = 0;
    __syncthreads();
#pragma unroll 1
    for (; chunk < NCHK; chunk += cstep) {
        const int nchunk = chunk + cstep;
        const bool has_next = nchunk < NCHK;
        u32x4 g0 = zero4, g1 = zero4; float cry[2] = {0.f, 0.f};
        if (PASSC) {
            const bf16_t* gp = PX + (size_t)(chunk * 128 + t) * DIN + 1024 + ch0;
            g0 = *(const u32x4*)gp; g1 = *(const u32x4*)(gp + 8);
            const float* CARRY = (const float*)(ws + WS_CARRY);
            cry[0] = CARRY[((size_t)0 * NCHK + chunk) * 1024 + cg_]; cry[1] = CARRY[((size_t)1 * NCHK + chunk) * 1024 + cg_];
        }
        if (has_next) LRU_LOAD_RAW(nchunk);
        {
            LAS unsigned char* rb = lds + L2_RAW + cur * RAW_BUFB;
            const int tg = tid >> 4, c4 = (tid & 15) * 4;
            f32x4 wv[4];
#pragma unroll
            for (int j = 0; j < 4; ++j) wv[j] = *(LAS f32x4*)(CW + j * 64 + c4);
            const f32x4 bb = *(LAS f32x4*)(CW + 256 + c4);
            f32x4 xr[7];
#pragma unroll
            for (int r = 0; r < 7; ++r) { const u32x2 pr = *(LAS u32x2*)(rb + (4 * tg + r) * RAW_ROWB + c4 * 2); xr[r] = (f32x4){bflo(pr.x), bfhi(pr.x), bflo(pr.y), bfhi(pr.y)}; }
#pragma unroll
            for (int tt = 0; tt < 4; ++tt) {
                const f32x4 xl = bb + wv[0] * xr[tt] + wv[1] * xr[tt + 1] + wv[2] * xr[tt + 2] + wv[3] * xr[tt + 3];
                *(LAS f32x4*)(XLF + (4 * tg + tt) * XLF_STRIDE + c4) = xl;
                u32x2 o; o.x = pk2(xl[0], xl[1]); o.y = pk2(xl[2], xl[3]);
                *(LAS u32x2*)(XLB + (4 * tg + tt) * XLB_STRIDE + c4) = o;
            }
        }
        __syncthreads();
        bf16x8 Af[4];
#pragma unroll
        for (int s = 0; s < 4; ++s) Af[s] = *(const LAS bf16x8*)(XLB + (32 * tw + cl) * XLB_STRIDE + 16 * s + 8 * hh);
        float xlv[16];
#pragma unroll
        for (int i = 0; i < 16; ++i) xlv[i] = XLF[(32 * tw + (i & 3) + 8 * (i >> 2) + 4 * hh) * XLF_STRIDE + cin];
        float av[2][16], bv[2][16], GA[2][8], GB[2][8];
#pragma unroll
        for (int dir = 0; dir < 2; ++dir) {
            f32x16 ar, ai;
#pragma unroll
            for (int i = 0; i < 16; ++i) { ar[i] = 0.f; ai[i] = 0.f; }
#pragma unroll
            for (int s = 0; s < 4; ++s) {
                const bf16x8 Br = *(const LAS bf16x8*)(lds + L2_GWL + ((((dir * 2 + 0) * 2 + chh) * 4 + s) * 64 + lane) * 16);
                const bf16x8 Bi = *(const LAS bf16x8*)(lds + L2_GWL + ((((dir * 2 + 1) * 2 + chh) * 4 + s) * 64 + lane) * 16);
                ar = __builtin_amdgcn_mfma_f32_32x32x16_bf16(Af[s], Br, ar, 0, 0, 0);
                ai = __builtin_amdgcn_mfma_f32_32x32x16_bf16(Af[s], Bi, ai, 0, 0, 0);
            }
#pragma unroll
            for (int i = 0; i < 16; ++i) {
                const float rg = sigm(ar[i] + brv[dir]), ig = sigm(ai[i] + biv[dir]);
                const float aa = __expf(k8[dir] * rg);
                av[dir][i] = aa;
                bv[dir][i] = __builtin_amdgcn_sqrtf(fmaxf(1.0f - aa * aa, 0.f)) * ig * xlv[i];
            }
            float oA[4], oB[4];
#pragma unroll
            for (int g = 0; g < 4; ++g) {
                const float a0 = av[dir][4 * g], a1 = av[dir][4 * g + 1], a2 = av[dir][4 * g + 2], a3 = av[dir][4 * g + 3];
                const float b0 = bv[dir][4 * g], b1 = bv[dir][4 * g + 1], b2 = bv[dir][4 * g + 2], b3 = bv[dir][4 * g + 3];
                oA[g] = (a0 * a1) * (a2 * a3);
                oB[g] = dir == 0 ? ((b0 * a1 + b1) * a2 + b2) * a3 + b3 : ((b3 * a2 + b2) * a1 + b1) * a0 + b0;
            }
#pragma unroll
            for (int g = 0; g < 4; ++g) {
                const float pA = __shfl_xor(oA[g], 32), pB = __shfl_xor(oB[g], 32);
                GA[dir][2 * g] = hh ? pA : oA[g]; GA[dir][2 * g + 1] = hh ? oA[g] : pA;
                GB[dir][2 * g] = hh ? pB : oB[g]; GB[dir][2 * g + 1] = hh ? oB[g] : pB;
            }
            float tA = 1.f, tB = 0.f;
            if (dir == 0) {
#pragma unroll
                for (int gq = 0; gq < 8; ++gq) { tB = GA[dir][gq] * tB + GB[dir][gq]; tA *= GA[dir][gq]; }
            } else {
#pragma unroll
                for (int gq = 7; gq >= 0; --gq) { tB = GA[dir][gq] * tB + GB[dir][gq]; tA *= GA[dir][gq]; }
            }
            if (hh == 0) TAGG[(tw * 2 + dir) * 64 + cin] = (f32x2){tA, tB};
        }
        if (has_next) LRU_STORE_RAW(cur ^ 1);
        __syncthreads();
        if constexpr (!PASSC) {
            if (tid < 128) {
                const int dir = tid >> 6, c = tid & 63;
                float cA = 1.f, cB = 0.f;
#pragma unroll
                for (int k = 0; k < 4; ++k) { const int t2 = dir == 0 ? k : 3 - k; const f32x2 v = TAGG[(t2 * 2 + dir) * 64 + c]; cB = v[0] * cB + v[1]; cA *= v[0]; }
                f32x2* AGG = (f32x2*)(ws + WS_AGG);
                AGG[((size_t)dir * NCHK + chunk) * 1024 + hd * 64 + c] = (f32x2){cA, cB};
            }
        } else {
            float yv[16];
#pragma unroll
            for (int dir = 0; dir < 2; ++dir) {
                float st = cry[dir];
                if (dir == 0) {
#pragma unroll
                    for (int t2 = 0; t2 < 3; ++t2) if (t2 < tw) { const f32x2 v = TAGG[(t2 * 2 + 0) * 64 + cin]; st = v[0] * st + v[1]; }
                } else {
#pragma unroll
                    for (int t2 = 3; t2 > 0; --t2) if (t2 > tw) { const f32x2 v = TAGG[(t2 * 2 + 1) * 64 + cin]; st = v[0] * st + v[1]; }
                }
                float hst[4];
                if (dir == 0) {
                    float s = st;
#pragma unroll
                    for (int g = 0; g < 4; ++g) { const float sE = s; s = GA[0][2 * g] * s + GB[0][2 * g]; const float sO = s; s = GA[0][2 * g + 1] * s + GB[0][2 * g + 1]; hst[g] = hh ? sO : sE; }
                } else {
                    float s = st;
#pragma unroll
                    for (int g = 3; g >= 0; --g) { const float sO = s; s = GA[1][2 * g + 1] * s + GB[1][2 * g + 1]; const float sE = s; s = GA[1][2 * g] * s + GB[1][2 * g]; hst[g] = hh ? sO : sE; }
                }
#pragma unroll
                for (int g = 0; g < 4; ++g) {
                    float h = hst[g];
                    if (dir == 0) {
#pragma unroll
                        for (int k = 0; k < 4; ++k) { h = av[0][4 * g + k] * h + bv[0][4 * g + k]; yv[4 * g + k] = h; }
                    } else {
#pragma unroll
                        for (int k = 3; k >= 0; --k) { h = av[1][4 * g + k] * h + bv[1][4 * g + k]; yv[4 * g + k] += h; }
                    }
                }
            }
            LAS bf16_t* YB = (LAS bf16_t*)(lds + L2_RAW + cur * RAW_BUFB);
#pragma unroll
            for (int i = 0; i < 16; ++i) YB[(32 * tw + (i & 3) + 8 * (i >> 2) + 4 * hh) * 72 + cin] = f2bf(yv[i]);
            __syncthreads();
            {
                const u32x4 y0 = *(LAS u32x4*)(YB + t * 72 + 16 * q), y1 = *(LAS u32x4*)(YB + t * 72 + 16 * q + 8);
                const unsigned yw[8] = {y0.x, y0.y, y0.z, y0.w, y1.x, y1.y, y1.z, y1.w};
                const unsigned gw_[8] = {g0.x, g0.y, g0.z, g0.w, g1.x, g1.y, g1.z, g1.w};
                unsigned ow[8];
#pragma unroll
                for (int j = 0; j < 8; ++j) ow[j] = pk2(bflo(yw[j]) * silu(bflo(gw_[j])), bfhi(yw[j]) * silu(bfhi(gw_[j])));
                bf16_t* yp = (bf16_t*)(ws + WS_Y) + (size_t)(chunk * 128 + t) * D + ch0;
                *(u32x4*)yp = (u32x4){ow[0], ow[1], ow[2], ow[3]}; *(u32x4*)(yp + 8) = (u32x4){ow[4], ow[5], ow[6], ow[7]};
            }
        }
        cur ^= 1;
    }
#undef LRU_LOAD_RAW
#undef LRU_STORE_RAW
}

constexpr int CV_ZT = 0;
constexpr int CV_CB = 94 * 1024;
static_assert(CV_CB + 16 * 512 * 4 <= LDS_BYTES, "conv lds map");
__device__ __forceinline__ void conv_item2(const Args a, int l, int ct, LAS unsigned char* lds) {
    const int tid = tid_fresh(), lane = tid & 63, wave = tid >> 6, c = tid;
    unsigned char* ws = ptr_fresh(a.ws);
    const bf16_t* PX = (const bf16_t*)(ws + WS_PX); bf16_t* Y = (bf16_t*)(ws + WS_Y);
    LAS bf16_t* ZT = (LAS bf16_t*)(lds + CV_ZT);
    LAS float* CB = (LAS float*)(lds + CV_CB);
    const int t0 = ct * 64, seg_lo = t0 < CL ? 0 : CL, seg_hi = t0 < CL ? CL : R;
    float w[31];
#pragma unroll
    for (int j = 0; j < 31; ++j) w[j] = a.in[16][((size_t)l * 31 + j) * 512 + c];
    const float bias = a.in[17][l * 512 + c];
    float lg[8], lb[8];
    { const f32x4 x0 = *(const f32x4*)(a.in[18] + l * 512 + 8 * lane), x1 = *(const f32x4*)(a.in[18] + l * 512 + 8 * lane + 4), y0 = *(const f32x4*)(a.in[19] + l * 512 + 8 * lane), y1 = *(const f32x4*)(a.in[19] + l * 512 + 8 * lane + 4);
#pragma unroll
      for (int k = 0; k < 4; ++k) { lg[k] = x0[k]; lg[4 + k] = x1[k]; lb[k] = y0[k]; lb[4 + k] = y1[k]; } }
    __syncthreads();
    {
        u32x4 zv[12], zg[12];
#pragma unroll
        for (int it = 0; it < 12; ++it) {
            const int pid = tid + 512 * it, e = pid >> 6, pc = pid & 63, ec = e < 94 ? e : 93;
            const int rr = t0 - 15 + ec, rc = rr < seg_lo ? seg_lo : (rr >= seg_hi ? seg_hi - 1 : rr);
            zv[it] = *(const u32x4*)(PX + (size_t)rc * DIN + 2048 + 8 * pc); zg[it] = *(const u32x4*)(PX + (size_t)rc * DIN + 2560 + 8 * pc);
        }
#pragma unroll
        for (int it = 0; it < 12; ++it) {
            const int pid = tid + 512 * it, e = pid >> 6, pc = pid & 63;
            const int rr = t0 - 15 + e;
            const unsigned vw[4] = {zv[it].x, zv[it].y, zv[it].z, zv[it].w}, gw_[4] = {zg[it].x, zg[it].y, zg[it].z, zg[it].w};
            unsigned ow[4];
#pragma unroll
            for (int j = 0; j < 4; ++j) ow[j] = pk2(bflo(vw[j]) * sigm(bflo(gw_[j])), bfhi(vw[j]) * sigm(bfhi(gw_[j])));
            const bool ok = rr >= seg_lo && rr < seg_hi;
            u32x4 o;
            o.x = ok ? ow[0] : 0u; o.y = ok ? ow[1] : 0u; o.z = ok ? ow[2] : 0u; o.w = ok ? ow[3] : 0u;
            if (e < 94) *(LAS u32x4*)(ZT + e * 512 + 8 * pc) = o;
        }
    }
    __syncthreads();
    float win[32];
#pragma unroll
    for (int e = 0; e < 30; ++e) win[e] = bf1(ZT[e * 512 + c]);
    win[30] = 0.f; win[31] = 0.f;
#pragma unroll 1
    for (int bb = 0; bb < 2; ++bb) {
#pragma unroll
        for (int hb = 0; hb < 2; ++hb) {
            u32x4 gt[2];
#pragma unroll
            for (int uu = 0; uu < 2; ++uu) gt[uu] = *(const u32x4*)(PX + (size_t)(t0 + 32 * bb + 16 * hb + wave * 2 + uu) * DIN + 3072 + 8 * lane);
#pragma unroll
            for (int u16 = 0; u16 < 16; ++u16) {
                const int u = 16 * hb + u16;
                win[(u + 30) & 31] = bf1(ZT[(32 * bb + u + 30) * 512 + c]);
                float acc = bias;
#pragma unroll
                for (int j = 0; j < 31; ++j) acc += w[j] * win[(u + j) & 31];
                CB[u16 * 512 + c] = acc;
            }
            __syncthreads();
#pragma unroll
            for (int uu = 0; uu < 2; ++uu) {
                const int u = wave * 2 + uu, row = t0 + 32 * bb + 16 * hb + u;
                float v[8]; float s = 0.f;
                { const f32x4 c0 = *(LAS f32x4*)(CB + u * 512 + 8 * lane), c1 = *(LAS f32x4*)(CB + u * 512 + 8 * lane + 4);
#pragma unroll
                  for (int k = 0; k < 4; ++k) { v[k] = c0[k]; v[4 + k] = c1[k]; } }
#pragma unroll
                for (int k = 0; k < 8; ++k) s += v[k];
                const float mean = wave_sum(s) * (1.0f / 512.0f);
                float s2 = 0.f;
#pragma unroll
                for (int k = 0; k < 8; ++k) { v[k] -= mean; s2 += v[k] * v[k]; }
                const float rstd = 1.0f / sqrtf(wave_sum(s2) * (1.0f / 512.0f) + EPS);
                const unsigned gw_[4] = {gt[uu].x, gt[uu].y, gt[uu].z, gt[uu].w};
                unsigned ow[4];
#pragma unroll
                for (int k = 0; k < 4; ++k) {
                    const float y0 = silu(v[2 * k] * rstd * lg[2 * k] + lb[2 * k]) * silu(bflo(gw_[k]));
                    const float y1 = silu(v[2 * k + 1] * rstd * lg[2 * k + 1] + lb[2 * k + 1]) * silu(bfhi(gw_[k]));
                    ow[k] = pk2(y0, y1);
                }
                *(u32x4*)(Y + (size_t)row * D + 1024 + 8 * lane) = (u32x4){ow[0], ow[1], ow[2], ow[3]};
            }
            __syncthreads();
        }
    }
}

__device__ __forceinline__ void sgu_item2(const Args a, int l, int item, LAS unsigned char* lds) {
    const int tid = tid_fresh(), lane = tid & 63, wave = tid >> 6;
    unsigned char* ws = ptr_fresh(a.ws);
    const bf16_t* PX = (const bf16_t*)(ws + WS_PX); bf16_t* Y = (bf16_t*)(ws + WS_Y);
    const bf16_t* SW = (const bf16_t*)(ws + WS_SW) + (size_t)l * 8 * 128 * 128;
    LAS f32x2* ST = (LAS f32x2*)lds;
    LAS bf16_t* TT = (LAS bf16_t*)(lds + 1024);
    const int sc = item >> 1, hg = item & 1, t0 = sc * 128;
    __syncthreads();
#pragma unroll
    for (int kb = 0; kb < 2; ++kb) {
        u32x4 p[8];
#pragma unroll
        for (int k = 0; k < 8; ++k) p[k] = *(const u32x4*)(PX + (size_t)(t0 + wave * 16 + kb * 8 + k) * DIN + 4096 + 8 * lane);
#pragma unroll
        for (int k = 0; k < 8; ++k) {
            float g[8] = {gelu_t(bflo(p[k].x)), gelu_t(bfhi(p[k].x)), gelu_t(bflo(p[k].y)), gelu_t(bfhi(p[k].y)), gelu_t(bflo(p[k].z)), gelu_t(bfhi(p[k].z)), gelu_t(bflo(p[k].w)), gelu_t(bfhi(p[k].w))};
            float s = 0.f;
#pragma unroll
            for (int j = 0; j < 8; ++j) s += g[j];
            const float mean = wave_sum(s) * (1.0f / 512.0f);
            float s2 = 0.f;
#pragma unroll
            for (int j = 0; j < 8; ++j) { const float d = g[j] - mean; s2 += d * d; }
            const float rstd = 1.0f / sqrtf(wave_sum(s2) * (1.0f / 512.0f) + EPS);
            if (lane == 0) ST[wave * 16 + kb * 8 + k] = (f32x2){mean, rstd};
        }
    }
    __syncthreads();
    const int p_ = tid >> 2, dq = tid & 3;
    const f32x2 st = ST[p_];
    const int fr = lane & 15, fq = lane >> 4;
    LAS float* SO = (LAS float*)(lds + 1024 + 2 * 64 * TT_STRIDE * 2);
    u32x4 Lq0[2], Lq1[2], Lu0[2], Lu1[2], Lg0[2], Lg1[2]; bf16x8 LA[2][4]; f32x4 Llg[2][4], Llb[2][4]; float Lbs[2];
#define SGU_LOAD(sl, h_) do { const int _ch = 64 * (h_) + 16 * dq; const bf16_t* _pr = PX + (size_t)(t0 + p_) * DIN + _ch; \
        Lq0[sl] = *(const u32x4*)(_pr + 4096); Lq1[sl] = *(const u32x4*)(_pr + 4096 + 8); Lu0[sl] = *(const u32x4*)(_pr + 3584); Lu1[sl] = *(const u32x4*)(_pr + 3584 + 8); \
        Lg0[sl] = *(const u32x4*)(_pr + 4608); Lg1[sl] = *(const u32x4*)(_pr + 4608 + 8); \
        _Pragma("unroll") for (int s = 0; s < 4; ++s) LA[sl][s] = *(const bf16x8*)(SW + ((size_t)(h_) * 128 + 16 * wave + fr) * 128 + 32 * s + 8 * fq); \
        Lbs[sl] = a.in[23][((size_t)l * 8 + (h_)) * 128 + p_]; \
        _Pragma("unroll") for (int j = 0; j < 4; ++j) { Llg[sl][j] = *(const f32x4*)(a.in[20] + l * 512 + _ch + 4 * j); Llb[sl][j] = *(const f32x4*)(a.in[21] + l * 512 + _ch + 4 * j); } } while (0)
    SGU_LOAD(0, 4 * hg);
#pragma unroll
    for (int h4 = 0; h4 < 4; ++h4) {
        const int h = 4 * hg + h4, sl = h4 & 1;
        LAS bf16_t* tt = TT + (h4 & 1) * (64 * TT_STRIDE);
        if (h4 + 1 < 4) SGU_LOAD(sl ^ 1, h + 1);
        const int ch = 64 * h + 16 * dq;
        const u32x4 q0 = Lq0[sl], q1 = Lq1[sl], u0 = Lu0[sl], u1 = Lu1[sl], g0 = Lg0[sl], g1 = Lg1[sl];
        bf16x8 Afr[4];
#pragma unroll
        for (int s = 0; s < 4; ++s) Afr[s] = LA[sl][s];
        const float bs = Lbs[sl];
        f32x4 lgv[4], lbv[4];
#pragma unroll
        for (int j = 0; j < 4; ++j) { lgv[j] = Llg[sl][j]; lbv[j] = Llb[sl][j]; }
        {
            const unsigned pw[8] = {q0.x, q0.y, q0.z, q0.w, q1.x, q1.y, q1.z, q1.w};
#pragma unroll
            for (int j = 0; j < 8; ++j) {
                const float v0 = (gelu_t(bflo(pw[j])) - st[0]) * st[1] * lgv[j >> 1][(2 * j) & 3] + lbv[j >> 1][(2 * j) & 3];
                const float v1 = (gelu_t(bfhi(pw[j])) - st[0]) * st[1] * lgv[j >> 1][(2 * j + 1) & 3] + lbv[j >> 1][(2 * j + 1) & 3];
                tt[(16 * dq + 2 * j) * TT_STRIDE + p_] = f2bf(v0);
                tt[(16 * dq + 2 * j + 1) * TT_STRIDE + p_] = f2bf(v1);
            }
        }
        __syncthreads();
        f32x4 acc[4];
#pragma unroll
        for (int nt = 0; nt < 4; ++nt) acc[nt] = (f32x4){0.f, 0.f, 0.f, 0.f};
#pragma unroll
        for (int s = 0; s < 4; ++s)
#pragma unroll
            for (int nt = 0; nt < 4; ++nt) {
                const bf16x8 Bfr = *(const LAS bf16x8*)(tt + (16 * nt + fr) * TT_STRIDE + 32 * s + 8 * fq);
                acc[nt] = __builtin_amdgcn_mfma_f32_16x16x32_bf16(Afr[s], Bfr, acc[nt], 0, 0, 0);
            }
#pragma unroll
        for (int reg = 0; reg < 4; ++reg)
#pragma unroll
            for (int nt = 0; nt < 4; ++nt) SO[(16 * wave + 4 * fq + reg) * 68 + 16 * nt + fr] = acc[nt][reg];
        __syncthreads();
        {
            const unsigned uw[8] = {u0.x, u0.y, u0.z, u0.w, u1.x, u1.y, u1.z, u1.w}, gw_[8] = {g0.x, g0.y, g0.z, g0.w, g1.x, g1.y, g1.z, g1.w};
            unsigned ow[8];
#pragma unroll
            for (int j4 = 0; j4 < 4; ++j4) {
                const f32x4 sv = *(LAS f32x4*)(SO + p_ * 68 + 16 * dq + 4 * j4);
                ow[2 * j4] = pk2(gelu_t(bflo(uw[2 * j4])) * (sv[0] + bs) * silu(bflo(gw_[2 * j4])), gelu_t(bfhi(uw[2 * j4])) * (sv[1] + bs) * silu(bfhi(gw_[2 * j4])));
                ow[2 * j4 + 1] = pk2(gelu_t(bflo(uw[2 * j4 + 1])) * (sv[2] + bs) * silu(bflo(gw_[2 * j4 + 1])), gelu_t(bfhi(uw[2 * j4 + 1])) * (sv[3] + bs) * silu(bfhi(gw_[2 * j4 + 1])));
            }
            bf16_t* yp = Y + (size_t)(t0 + p_) * D + 1536 + ch;
            *(u32x4*)yp = (u32x4){ow[0], ow[1], ow[2], ow[3]}; *(u32x4*)(yp + 8) = (u32x4){ow[4], ow[5], ow[6], ow[7]};
        }
    }
#undef SGU_LOAD
}

__device__ __forceinline__ int scan_chunk(int dir, int o) { return dir == 0 ? o : (o == 0 ? 1 : (o == 1 ? 0 : (NCHK + 1 - o))); }
__device__ __forceinline__ void phase_carry(const Args a, LAS unsigned char* lds) {
    const int tid = tid_fresh(), b = blockIdx.x, G = gridDim.x;
    unsigned char* ws = ptr_fresh(a.ws);
    const f32x2* AGG = (const f32x2*)(ws + WS_AGG); float* CARRY = (float*)(ws + WS_CARRY);
    LAS f32x2* SEG = (LAS f32x2*)lds;
    for (int u = b; u < 64; u += G) {
        const int dir = u >> 5, ch = (u & 31) * 32 + (tid & 31), sg = tid >> 5;
        f32x2 ab[10];
        if (sg < 13) {
#pragma unroll
            for (int k = 0; k < 10; ++k) ab[k] = AGG[((size_t)dir * NCHK + scan_chunk(dir, 10 * sg + k)) * 1024 + ch];
            float sA = 1.f, sB = 0.f;
#pragma unroll
            for (int k = 0; k < 10; ++k) { sB = ab[k][0] * sB + ab[k][1]; sA *= ab[k][0]; }
            SEG[sg * 32 + (tid & 31)] = (f32x2){sA, sB};
        }
        __syncthreads();
        if (sg < 13) {
            float st = 0.f;
            for (int s2 = 0; s2 < sg; ++s2) { const f32x2 v = SEG[s2 * 32 + (tid & 31)]; st = v[0] * st + v[1]; }
#pragma unroll
            for (int k = 0; k < 10; ++k) { CARRY[((size_t)dir * NCHK + scan_chunk(dir, 10 * sg + k)) * 1024 + ch] = st; st = ab[k][0] * st + ab[k][1]; }
        }
        __syncthreads();
    }
}

__device__ __forceinline__ void phase_resid0(const Args a) {
    const int tid = tid_fresh(), lane = tid & 63, wave = tid >> 6, b = blockIdx.x, G = gridDim.x;
    unsigned char* ws = ptr_fresh(a.ws);
    const bf16_t* DL0 = (const bf16_t*)(ws + WS_DL0);
    const float* gg0 = (const float*)(ws + WS_GG);
    const float* gg = (const float*)(ws + WS_GG) + (size_t)2 * D;
    bf16_t* XG = (bf16_t*)(ws + WS_XG) + (size_t)CL * D; float* rss1 = (float*)(ws + WS_RSS) + R + CL;
    f32x4 g[8], rg0[8];
#pragma unroll
    for (int j = 0; j < 4; ++j) { g[2 * j] = *(const f32x4*)(gg + 8 * (lane + 64 * j)); g[2 * j + 1] = *(const f32x4*)(gg + 8 * (lane + 64 * j) + 4);
        const f32x4 h0 = *(const f32x4*)(gg0 + 8 * (lane + 64 * j)), h1 = *(const f32x4*)(gg0 + 8 * (lane + 64 * j) + 4);
        rg0[2 * j] = (f32x4){1.0f / h0[0], 1.0f / h0[1], 1.0f / h0[2], 1.0f / h0[3]}; rg0[2 * j + 1] = (f32x4){1.0f / h1[0], 1.0f / h1[1], 1.0f / h1[2], 1.0f / h1[3]}; }
    u32x4 xr[4], dr[4];
#define RS_LOAD(t_, X, Dd) do { _Pragma("unroll") for (int j = 0; j < 4; ++j) { X[j] = __builtin_nontemporal_load((const u32x4*)(XG + (size_t)(t_) * D + 8 * (lane + 64 * j))); Dd[j] = __builtin_nontemporal_load((const u32x4*)(DL0 + (size_t)(t_) * D + 8 * (lane + 64 * j))); } } while (0)
    int t = b * 8 + wave;
    if (t < T) RS_LOAD(t, xr, dr);
    for (; t < T; t += G * 8) {
        u32x4 xn[4], dn[4];
        const int tn = t + G * 8;
        if (tn < T) RS_LOAD(tn, xn, dn);
        f32x4 v[8]; float ss = 0.f;
#pragma unroll
        for (int j = 0; j < 4; ++j) {
            v[2 * j] = (f32x4){bflo(xr[j].x), bfhi(xr[j].x), bflo(xr[j].y), bfhi(xr[j].y)} * rg0[2 * j] + (f32x4){bflo(dr[j].x), bfhi(dr[j].x), bflo(dr[j].y), bfhi(dr[j].y)};
            v[2 * j + 1] = (f32x4){bflo(xr[j].z), bfhi(xr[j].z), bflo(xr[j].w), bfhi(xr[j].w)} * rg0[2 * j + 1] + (f32x4){bflo(dr[j].z), bfhi(dr[j].z), bflo(dr[j].w), bfhi(dr[j].w)};
        }
#pragma unroll
        for (int j = 0; j < 8; ++j) ss += (v[j][0] * v[j][0] + v[j][1] * v[j][1]) + (v[j][2] * v[j][2] + v[j][3] * v[j][3]);
#pragma unroll
        for (int j = 0; j < 4; ++j) {
            const f32x4 p0 = v[2 * j] * g[2 * j], p1 = v[2 * j + 1] * g[2 * j + 1];
            u32x4 w; w.x = pk2(p0[0], p0[1]); w.y = pk2(p0[2], p0[3]); w.z = pk2(p1[0], p1[1]); w.w = pk2(p1[2], p1[3]);
            *(u32x4*)(XG + (size_t)t * D + 8 * (lane + 64 * j)) = w;
        }
        ss = wave_sum(ss);
        if (lane == 0) rss1[t] = ss;
        if (tn < T) {
#pragma unroll
            for (int j = 0; j < 4; ++j) { xr[j] = xn[j]; dr[j] = dn[j]; }
        }
    }
#undef RS_LOAD
}
__device__ __forceinline__ void phase_final(const Args a) {
    const int tid = tid_fresh(), lane = tid & 63, wave = tid >> 6, b = blockIdx.x, G = gridDim.x;
    unsigned char* ws = ptr_fresh(a.ws);
    const bf16_t* XG1 = (const bf16_t*)(ws + WS_XG) + (size_t)CL * D;
    const bf16_t* DL1 = (const bf16_t*)(ws + WS_DL0);
    const float* fg = a.in[24];
    const float* gg = (const float*)(ws + WS_GG) + (size_t)2 * D;
    u32x4 xr[4], er[4];
#define FN_LOAD(t_, X, Ee) do { _Pragma("unroll") for (int j = 0; j < 4; ++j) { X[j] = __builtin_nontemporal_load((const u32x4*)(XG1 + (size_t)(t_) * D + 8 * (lane + 64 * j))); Ee[j] = __builtin_nontemporal_load((const u32x4*)(DL1 + (size_t)(t_) * D + 8 * (lane + 64 * j))); } } while (0)
    f32x4 fgv[8], rg[8];
#pragma unroll
    for (int j = 0; j < 4; ++j) { fgv[2 * j] = *(const f32x4*)(fg + 8 * (lane + 64 * j)); fgv[2 * j + 1] = *(const f32x4*)(fg + 8 * (lane + 64 * j) + 4);
        const f32x4 g0 = *(const f32x4*)(gg + 8 * (lane + 64 * j)), g1 = *(const f32x4*)(gg + 8 * (lane + 64 * j) + 4);
        rg[2 * j] = (f32x4){1.0f / g0[0], 1.0f / g0[1], 1.0f / g0[2], 1.0f / g0[3]}; rg[2 * j + 1] = (f32x4){1.0f / g1[0], 1.0f / g1[1], 1.0f / g1[2], 1.0f / g1[3]}; }
    int t = b * 8 + wave;
    if (t < T) FN_LOAD(t, xr, er);
    for (; t < T; t += G * 8) {
        u32x4 xn[4], en[4];
        const int tn = t + G * 8;
        if (tn < T) FN_LOAD(tn, xn, en);
        float* orow = a.out + (size_t)t * D;
        f32x4 v[8]; float ss = 0.f;
#pragma unroll
        for (int j = 0; j < 4; ++j) {
            v[2 * j] = (f32x4){bflo(xr[j].x), bfhi(xr[j].x), bflo(xr[j].y), bfhi(xr[j].y)} * rg[2 * j] + (f32x4){bflo(er[j].x), bfhi(er[j].x), bflo(er[j].y), bfhi(er[j].y)};
            v[2 * j + 1] = (f32x4){bflo(xr[j].z), bfhi(xr[j].z), bflo(xr[j].w), bfhi(xr[j].w)} * rg[2 * j + 1] + (f32x4){bflo(er[j].z), bfhi(er[j].z), bflo(er[j].w), bfhi(er[j].w)};
        }
#pragma unroll
        for (int j = 0; j < 8; ++j) ss += (v[j][0] * v[j][0] + v[j][1] * v[j][1]) + (v[j][2] * v[j][2] + v[j][3] * v[j][3]);
        const float rs = 1.0f / sqrtf(wave_sum(ss) * (1.0f / D) + EPS);
#pragma unroll
        for (int j = 0; j < 4; ++j) {
            *(f32x4*)(orow + 8 * (lane + 64 * j)) = v[2 * j] * rs * fgv[2 * j]; *(f32x4*)(orow + 8 * (lane + 64 * j) + 4) = v[2 * j + 1] * rs * fgv[2 * j + 1];
        }
        if (tn < T) {
#pragma unroll
            for (int j = 0; j < 4; ++j) { xr[j] = xn[j]; er[j] = en[j]; }
        }
    }
#undef FN_LOAD
}

template <int NT, int MODE>
__device__ __forceinline__ void ctx_gemm(const Args a, int l, LAS unsigned char* lds) {
    const int tid = tid_fresh(), lane = tid & 63, wave = tid >> 6, b = blockIdx.x, G = gridDim.x;
    unsigned char* ws = ptr_fresh(a.ws);
    constexpr int TN = 16 * NT, N = 64 * TN, TS = TN + 4;
    const bf16_t* A = (const bf16_t*)(ws + (MODE == 0 ? WS_XG : WS_Y));
    const bf16_t* Bt = MODE == 0 ? (const bf16_t*)(ws + WS_WINT) + (size_t)l * DIN * D : (const bf16_t*)(ws + WS_WOUTT) + (size_t)l * D * D;
    LAS float* CT = (LAS float*)lds;
    const int fr = lane & 15, fq = lane >> 4;
#pragma unroll 1
    for (int tile = b; tile < 256; tile += G) {
        const int r0 = (tile >> 6) * 64, n0 = (tile & 63) * TN;
        __syncthreads();
        f32x4 acc[4][NT];
#pragma unroll
        for (int m = 0; m < 4; ++m)
#pragma unroll
            for (int n = 0; n < NT; ++n) acc[m][n] = (f32x4){0.f, 0.f, 0.f, 0.f};
        const bf16_t* ap = A + (size_t)(r0 + fr) * D + wave * 256 + 8 * fq;
        const bf16_t* bp = Bt + (size_t)(n0 + fr) * D + wave * 256 + 8 * fq;
        bf16x8 af[2][4], bfr[2][NT];
#define CTXG_LOAD(buf, ks_) do { _Pragma("unroll") for (int m = 0; m < 4; ++m) af[buf][m] = *(const bf16x8*)(ap + (size_t)(16 * m) * D + 32 * (ks_)); \
        _Pragma("unroll") for (int n = 0; n < NT; ++n) bfr[buf][n] = *(const bf16x8*)(bp + (size_t)(16 * n) * D + 32 * (ks_)); } while (0)
#define CTXG_MMA(buf) do { _Pragma("unroll") for (int m = 0; m < 4; ++m) _Pragma("unroll") for (int n = 0; n < NT; ++n) \
        acc[m][n] = __builtin_amdgcn_mfma_f32_16x16x32_bf16(af[buf][m], bfr[buf][n], acc[m][n], 0, 0, 0); } while (0)
        CTXG_LOAD(0, 0);
#pragma unroll
        for (int ks = 0; ks < 8; ks += 2) {
            CTXG_LOAD(1, ks + 1);
            __builtin_amdgcn_sched_barrier(0);
            CTXG_MMA(0);
            __builtin_amdgcn_sched_barrier(0);
            if (ks + 2 < 8) CTXG_LOAD(0, ks + 2);
            __builtin_amdgcn_sched_barrier(0);
            CTXG_MMA(1);
            __builtin_amdgcn_sched_barrier(0);
        }
#undef CTXG_LOAD
#undef CTXG_MMA
#pragma unroll
        for (int ps = 0; ps < 2; ++ps) {
#pragma unroll
            for (int m2 = 0; m2 < 2; ++m2)
#pragma unroll
                for (int n = 0; n < NT; ++n)
#pragma unroll
                    for (int reg = 0; reg < 4; ++reg) CT[(wave * 32 + 16 * m2 + 4 * fq + reg) * TS + 16 * n + fr] = acc[2 * ps + m2][n][reg];
            __syncthreads();
            for (int wi = tid; wi < 32 * (TN / 8); wi += 512) {
                const int rr = wi / (TN / 8), cgp = wi % (TN / 8), row = r0 + 32 * ps + rr, col = n0 + 8 * cgp;
                f32x4 c0 = {0.f, 0.f, 0.f, 0.f}, c1 = {0.f, 0.f, 0.f, 0.f};
#pragma unroll
                for (int w8 = 0; w8 < 8; ++w8) { c0 += *(LAS f32x4*)(CT + (w8 * 32 + rr) * TS + 8 * cgp); c1 += *(LAS f32x4*)(CT + (w8 * 32 + rr) * TS + 8 * cgp + 4); }
                if (MODE == 0) {
                    const float* rss = (const float*)(ws + WS_RSS) + (size_t)l * R;
                    const float* shw = (const float*)(ws + WS_SHW) + (size_t)(l * 2 + 1) * DIN;
                    bf16_t* PXo = (bf16_t*)(ws + WS_PX);
                    const float rs = 1.0f / sqrtf(rss[row] * (1.0f / D) + EPS);
                    const f32x4 s0 = *(const f32x4*)(shw + col), s1 = *(const f32x4*)(shw + col + 4);
                    const f32x4 v0 = c0 * rs + s0, v1 = c1 * rs + s1;
                    u32x4 w; w.x = pk2(v0[0], v0[1]); w.y = pk2(v0[2], v0[3]); w.z = pk2(v1[0], v1[1]); w.w = pk2(v1[2], v1[3]);
                    *(u32x4*)(PXo + (size_t)row * DIN + col) = w;
                } else {
                    const float* gp = (const float*)(ws + WS_MOD) + (size_t)(l * 2 + 1) * 6144 + 4096;
                    const float* ggp = (const float*)(ws + WS_GG) + (size_t)((l + 1) * 2 + 1) * D;
                    float* rssn = (float*)(ws + WS_RSS) + (size_t)(l + 1) * R;
                    float* xn = (float*)(ws + WS_X1C); bf16_t* XG = (bf16_t*)(ws + WS_XG);
                    const f32x4 o0 = *(const f32x4*)(a.in[2] + (size_t)row * D + col), o1 = *(const f32x4*)(a.in[2] + (size_t)row * D + col + 4);
                    const f32x4 g0 = *(const f32x4*)(gp + col), g1 = *(const f32x4*)(gp + col + 4);
                    const f32x4 v0 = o0 + g0 * c0, v1 = o1 + g1 * c1;
                    *(f32x4*)(xn + (size_t)row * D + col) = v0; *(f32x4*)(xn + (size_t)row * D + col + 4) = v1;
                    const f32x4 q0 = *(const f32x4*)(ggp + col), q1 = *(const f32x4*)(ggp + col + 4);
                    const f32x4 a0 = v0 * q0, a1 = v1 * q1;
                    u32x4 w; w.x = pk2(a0[0], a0[1]); w.y = pk2(a0[2], a0[3]); w.z = pk2(a1[0], a1[1]); w.w = pk2(a1[2], a1[3]);
                    *(u32x4*)(XG + (size_t)row * D + col) = w;
                    const float ss = (v0[0] * v0[0] + v0[1] * v0[1]) + (v0[2] * v0[2] + v0[3] * v0[3]) + (v1[0] * v1[0] + v1[1] * v1[1]) + (v1[2] * v1[2] + v1[3] * v1[3]);
                    unsafeAtomicAdd(rssn + row, ss);
                }
            }
            __syncthreads();
        }
    }
    __syncthreads();
}

#define XB_TMO      128
#define XB_XCNT(j)  (256  + 64 * (j))
#define XB_XSUB(j)  (1280 + 64 * (j))
#define XB_XGEN(j)  (2304 + 64 * (j))
#define XB_TOP      3328
#define XB_TOPGEN   3392
#define XCD_BAR_WORDS 3456
#define XB_SPIN_CAP (1u << 18)

__device__ __forceinline__ unsigned xb_ld(unsigned* p)              { return __hip_atomic_load(p, __ATOMIC_RELAXED, __HIP_MEMORY_SCOPE_AGENT); }
__device__ __forceinline__ unsigned xb_add(unsigned* p, unsigned v) { return __hip_atomic_fetch_add(p, v, __ATOMIC_RELAXED, __HIP_MEMORY_SCOPE_AGENT); }
__device__ __forceinline__ unsigned xb_xcc_id() { return (unsigned)__builtin_amdgcn_s_getreg((3 << 11) | 20) & 0xFu; }
#define XB_SPIN(cond, bar) do { unsigned _sp = 0; while (cond) { __builtin_amdgcn_s_sleep(1); \
    if ((++_sp & 255u) == 0u) { if (xb_ld(&(bar)[XB_TMO])) break; if (_sp > XB_SPIN_CAP) { atomicAdd(&(bar)[XB_TMO], 1u); break; } } } } while (0)

struct XcdBarrier {
    unsigned* bar; unsigned x;
    volatile LAS unsigned* st;
};

__device__ __forceinline__ XcdBarrier xcd_barrier_post(unsigned* bar, volatile LAS unsigned* st) {
    XcdBarrier b; b.bar = bar; b.x = xb_xcc_id(); b.st = st;
    if (threadIdx.x == 0) (void)xb_add(&bar[XB_XCNT(b.x)], 1u);
    return b;
}
__device__ __forceinline__ void xcd_barrier_complete(unsigned* bar, unsigned x, unsigned& nloc, unsigned& nx) {
    const unsigned G = gridDim.x * gridDim.y * gridDim.z;
    unsigned sum, cnt, mine, sp = 0u;
    for (;;) {
        sum = 0u; cnt = 0u; mine = 0u;
#pragma unroll
        for (unsigned j = 0; j < 16; ++j) { const unsigned c = xb_ld(&bar[XB_XCNT(j)]); sum += c; cnt += (c > 0u) ? 1u : 0u; mine = (j == x) ? c : mine; }
        if (sum == G) break;
        __builtin_amdgcn_s_sleep(1);
        if ((++sp & 255u) == 0u) { if (xb_ld(&bar[XB_TMO])) break; if (sp > XB_SPIN_CAP) { atomicAdd(&bar[XB_TMO], 1u); break; } }
    }
    nloc = mine > 0u ? mine : 1u; nx = cnt > 0u ? cnt : 1u;
}

__device__ __forceinline__ void xcd_barrier(const XcdBarrier& b) {
    asm volatile("s_waitcnt vmcnt(0)" ::: "memory");
    __syncthreads();
    if (threadIdx.x == 0) {
        unsigned* bar = b.bar;
        __builtin_amdgcn_s_waitcnt(0);
        unsigned nloc = b.st[0], nx = b.st[1];
        if (nloc == 0u) { xcd_barrier_complete(bar, b.x, nloc, nx); b.st[0] = nloc; b.st[1] = nx; }
        const unsigned old = xb_add(&bar[XB_XSUB(b.x)], 1u);
        const unsigned gen = old / nloc;
        if (old + 1u == (gen + 1u) * nloc) {
            __builtin_amdgcn_fence(__ATOMIC_RELEASE, "agent");
            asm volatile("s_waitcnt vmcnt(0)" ::: "memory");
            const unsigned og = xb_add(&bar[XB_TOP], 1u);
            const unsigned tg = og / nx;
            if (og + 1u == (tg + 1u) * nx) xb_add(&bar[XB_TOPGEN], 1u);
            else XB_SPIN(xb_ld(&bar[XB_TOPGEN]) == tg, bar);
            __builtin_amdgcn_fence(__ATOMIC_ACQUIRE, "agent");
            xb_add(&bar[XB_XGEN(b.x)], 1u);
            asm volatile("s_waitcnt vmcnt(0)" ::: "memory");
        } else {
            XB_SPIN(xb_ld(&bar[XB_XGEN(b.x)]) == gen, bar);
            __builtin_amdgcn_fence(__ATOMIC_ACQUIRE, "agent");
            asm volatile("s_waitcnt vmcnt(0)" ::: "memory");
        }
    }
    __syncthreads();
}


__global__ void __launch_bounds__(512, 2) mega_fwd(Args a) {
    extern __shared__ __attribute__((aligned(16))) unsigned char lds_raw[];
    LAS unsigned char* lds = (LAS unsigned char*)lds_raw;
    cg::grid_group grid = cg::this_grid();
    const int lo = a.ph_lo, hi = a.ph_hi;
    const int b = blockIdx.x, G = gridDim.x;
    unsigned char* ws = ptr_fresh(a.ws);
    { volatile LAS unsigned* xst = (volatile LAS unsigned*)(lds + LDS_BYTES - 16); if (threadIdx.x < 4) xst[threadIdx.x] = 0u; }
    __syncthreads();
    const XcdBarrier xbar = xcd_barrier_post((unsigned*)(a.ws + WS_BAR), (volatile LAS unsigned*)(lds + LDS_BYTES - 16));
#ifndef PHMASK
#define PHMASK 0x1fff
#endif
#define IN(k) (((PHMASK >> (k)) & 1) && lo <= (k) && (k) < hi)
#ifndef DUPMASK
#define DUPMASK 0
#endif
#define DUP(k) ((DUPMASK >> (k)) & 1)
#define GSYNC(k) do { if (a.ph_lo < 0) grid.sync();     \
    xcd_barrier(xbar); } while (0)
#define SEAM(k) do { if (IN(k) && IN((k) + 1)) GSYNC(k); } while (0)
#define REPB(k) for (int rep_ = 0; rep_ <= DUP(k); ++rep_) { if (rep_) xcd_barrier(xbar);
#define REPE }
    if (IN(0)) { REPB(0) phase0a(a, lds); REPE }
    SEAM(0);
    if (IN(1)) { REPB(1) phase0b(a, lds); REPE }
    SEAM(1);
#pragma unroll 1
    for (int l = 0; l < 2; ++l) {
        const int pb = 2 + 5 * l; const bool last = (l == 1);
        if (IN(pb) && (PHMASK & 0x84)) { REPB(pb)
            pg8::Gemm g{(const bf16_t*)(ws + WS_XG) + (size_t)CL * D, (const bf16_t*)(ws + WS_WINT) + (size_t)l * DIN * D, T, DIN, D};
            pg8::StaticOrder S; S.init(T, DIN, G, b);
            EpiIn E{(bf16_t*)(ws + WS_PX), (const float*)(ws + WS_RSS) + (size_t)l * R, (const float*)(ws + WS_SHW) + (size_t)l * 2 * DIN};
            const bool ctx_first = (b & 1) != 0;
            if (ctx_first) ctx_gemm<5, 0>(a, l, lds);
            pg8::gemm_phase<EpiIn, pg8::StaticOrder, GEMM_ALIGN, GEMM_SP2>(lds, g, S, E);
            if (!ctx_first) ctx_gemm<5, 0>(a, l, lds);
        REPE }
        SEAM(pb);
        if (IN(pb + 1) && (PHMASK & 0x108)) { REPB(pb + 1)
            const int c_lo = last ? 2 : 0, n_cv = 2 * (NCHK - c_lo);
            lru_phase<false>(a, l, 0, lds);
            unsigned* qctr = (unsigned*)(a.ws + WS_BAR) + 16 + 2 * l + rep_;
            volatile LAS int* qslot = (volatile LAS int*)(lds + LDS_BYTES - 32);
            for (;;) {
                __syncthreads();
                if (threadIdx.x == 0) *qslot = (int)__hip_atomic_fetch_add(qctr, 1u, __ATOMIC_RELAXED, __HIP_MEMORY_SCOPE_AGENT);
                __syncthreads();
                const int it = *qslot;
                if (it >= 2 * n_cv) break;
                if (it < n_cv) sgu_item2(a, l, 2 * c_lo + it, lds); else conv_item2(a, l, 2 * c_lo + it - n_cv, lds);
            }
        REPE }
        SEAM(pb + 1);
        if (IN(pb + 2) && (PHMASK & 0x210)) { REPB(pb + 2) phase_carry(a, lds); REPE }
        SEAM(pb + 2);
        if (IN(pb + 3) && (PHMASK & 0x420)) { REPB(pb + 3)
            lru_phase<true>(a, l, last ? 2 : 0, lds);
            __syncthreads();
        REPE }
        SEAM(pb + 3);
        if (IN(pb + 4) && (PHMASK & 0x840)) {
            const int roff = CL, M = T;
            pg8::Gemm g{(const bf16_t*)(ws + WS_Y) + (size_t)roff * D, (const bf16_t*)(ws + WS_WOUTT) + (size_t)l * D * D, M, D, D};
            pg8::StaticOrder S; S.init(M, D, G, b);
            EpiDelta E{(bf16_t*)(ws + WS_DL0),
                        (const float*)(ws + WS_MOD) + (size_t)l * 2 * 6144 + 4096};
            const bool ctx_first = !last && (b & 1) != 0;
            if (ctx_first) ctx_gemm<2, 1>(a, l, lds);
            pg8::gemm_phase<EpiDelta, pg8::StaticOrder, GEMM_ALIGN, GEMM_SP2>(lds, g, S, E);
            if (!last) { if (!ctx_first) ctx_gemm<2, 1>(a, l, lds); xcd_barrier(xbar); phase_resid0(a); }
        }
        SEAM(pb + 4);
    }
    if (IN(12)) phase_final(a);
#undef IN
#undef SEAM
}

extern "C" void kernel_launch(void* const* d_in, const int* in_sizes, int n_in, void* d_out, int out_size, void* d_ws, size_t ws_size, hipStream_t stream) {
    static int grid = 0;
    if (grid == 0) {
        int dev = 0, cus = 0, per_cu = 0;
        if (n_in != 25 || ws_size < WS_END) { fprintf(stderr, "kernel_launch: unexpected inputs (n_in %d, ws %zu < %zu)\n", n_in, ws_size, (size_t)WS_END); grid = -1; return; }
        hipGetDevice(&dev);
        hipDeviceGetAttribute(&cus, hipDeviceAttributeMultiprocessorCount, dev);
        if (hipFuncSetAttribute((const void*)mega_fwd, hipFuncAttributeMaxDynamicSharedMemorySize, LDS_BYTES) != hipSuccess) { fprintf(stderr, "kernel_launch: hipFuncSetAttribute failed\n"); grid = -1; return; }
        hipOccupancyMaxActiveBlocksPerMultiprocessor(&per_cu, (const void*)mega_fwd, 512, LDS_BYTES);
        (void)hipGetLastError();
        if (per_cu < 1) { fprintf(stderr, "kernel_launch: occupancy query says %d blocks per CU\n", per_cu); per_cu = 1; }
        grid = cus;
    }
    if (grid < 0) return;
    if (hipMemsetAsync((char*)d_ws + WS_BAR, 0, 16384, stream) != hipSuccess) { fprintf(stderr, "kernel_launch: memset of the barrier words failed\n"); return; }
    Args a{};
    for (int i = 0; i < 25; ++i) a.in[i] = (const float*)d_in[i];
    a.out = (float*)d_out; a.ws = (unsigned char*)d_ws;
#if N_LAUNCH_MODE == 1
    a.ph_lo = 0; a.ph_hi = NPHASE;
    void* args[] = {&a};
    hipError_t e = hipLaunchCooperativeKernel((const void*)mega_fwd, dim3(grid), dim3(512), args, LDS_BYTES, stream);
    if (e != hipSuccess) fprintf(stderr, "kernel_launch: cooperative launch failed: %s (grid %d)\n", hipGetErrorString(e), grid);
#else
    for (int p = 0; p < NPHASE; ++p) {
        a.ph_lo = p; a.ph_hi = p + 1;
        hipLaunchKernelGGL(mega_fwd, dim3(grid), dim3(512), LDS_BYTES, stream, a);
    }
#endif
}
```
